# Optimizing an MI355X kernel written in HIP

```python
import math
import jax, jax.numpy as jnp
from jax import lax
import numpy as np

D_MODEL = 1024
BATCH = 8
SEQ = 2048
DEPTH = 4
DEC_BATCH = 16
DEC_SEQ = 32
PAST_LEN = 4096

CHUNK = 64
N_A_LAYERS = DEPTH // 2
N_B_LAYERS = DEPTH - N_A_LAYERS
A_HEADS = 8
A_DK = 128
A_DV = 128
A_QK = A_HEADS * A_DK
A_VW = A_HEADS * A_DV
CONV_W = 4
CONV_DIM = 2 * A_QK + A_VW
A_IN = CONV_DIM + A_VW + 2 * A_HEADS
B_Q_HEADS = 16
B_KV_HEADS = 4
B_GROUP = B_Q_HEADS // B_KV_HEADS
B_HD = 64
B_QW = B_Q_HEADS * B_HD
B_KVW = B_KV_HEADS * B_HD
B_IN = 2 * B_QW
WINDOW = 128
WINDOW_CHUNKS = WINDOW // CHUNK
ROPE_DIMS = B_HD // 4
ROPE_THETA = 500000.0
DN_ALPHA = (2 * DEPTH) ** 0.25
DN_BETA = (8 * DEPTH) ** -0.25
LN_EPS = 1e-5
RMS_EPS = 1e-6

kernel_name = 'yoco_gdn_swa_sink_stream_step'


def layer_norm(x, g, b):
    xf = x.astype(jnp.float32)
    mu = xf.mean(-1, keepdims=True)
    var = jnp.square(xf - mu).mean(-1, keepdims=True)
    return ((xf - mu) * lax.rsqrt(var + LN_EPS) * g + b).astype(x.dtype)


def l2norm(x):
    xf = x.astype(jnp.float32)
    return xf * lax.rsqrt(jnp.sum(xf * xf, -1, keepdims=True) + RMS_EPS)


def rope_partial(x, pos):
    half = ROPE_DIMS // 2
    inv = ROPE_THETA ** (-jnp.arange(half, dtype=jnp.float32) * 2.0 / ROPE_DIMS)
    ang = pos.astype(jnp.float32)[:, None] * inv[None, :]
    cos = jnp.cos(ang)[None, :, None, :]
    sin = jnp.sin(ang)[None, :, None, :]
    xf = x.astype(jnp.float32)
    x1, x2 = xf[..., :half], xf[..., half:ROPE_DIMS]
    rot = jnp.concatenate([x1 * cos - x2 * sin, x2 * cos + x1 * sin], -1)
    return jnp.concatenate([rot, xf[..., ROPE_DIMS:]], -1).astype(x.dtype)


def causal_conv(x, buf, w):
    l = x.shape[1]
    xp = jnp.concatenate([buf.astype(x.dtype), x], axis=1)
    y = xp[:, 0:l] * w[0]
    for j in range(1, CONV_W):
        y = y + xp[:, j:j + l] * w[j]
    return jax.nn.silu(y), xp[:, -(CONV_W - 1):]


def gated_delta_rule(q, k, v, g, beta, s0):
    b, l, h, _ = q.shape
    c = min(CHUNK, l)
    n = l // c

    def blocks(t):
        t = t.reshape((b, n, c) + t.shape[2:])
        return jnp.swapaxes(jnp.moveaxis(t, 1, 0), 2, 3)

    qc, kc, vc, gb, bc = blocks(q), blocks(k), blocks(v), blocks(g), blocks(beta)
    gcum = jnp.cumsum(gb, axis=-1)
    incl = jnp.tril(jnp.ones((c, c), dtype=bool))
    strict = jnp.tril(jnp.ones((c, c), dtype=bool), -1)
    decay = jnp.exp(jnp.where(incl, gcum[..., :, None] - gcum[..., None, :], -jnp.inf))
    kbeta = kc * bc[..., None]
    lower = jnp.where(strict, jnp.einsum('nbhik,nbhjk->nbhij', kbeta, kc) * decay, 0.0)
    tmat = lower + jnp.eye(c, dtype=lower.dtype)
    u = lax.linalg.triangular_solve(tmat, vc * bc[..., None], left_side=True, lower=True, unit_diagonal=True)
    w = lax.linalg.triangular_solve(tmat, kbeta * jnp.exp(gcum)[..., None], left_side=True, lower=True,
                                    unit_diagonal=True)
    intra = jnp.einsum('nbhik,nbhjk->nbhij', qc, kc) * decay
    qdec = qc * jnp.exp(gcum)[..., None]
    kdec = kc * jnp.exp(gcum[..., -1:] - gcum)[..., None]
    glast = jnp.exp(gcum[..., -1])

    def step(s, xs):
        qd, kd, ui, wi, ai, gl = xs
        v_new = ui - jnp.einsum('bhck,bhkv->bhcv', wi, s)
        o = jnp.einsum('bhck,bhkv->bhcv', qd, s) + jnp.einsum('bhij,bhjv->bhiv', ai, v_new)
        s = s * gl[..., None, None] + jnp.einsum('bhck,bhcv->bhkv', kd, v_new)
        return s, o

    s_fin, o = lax.scan(step, s0, (qdec, kdec, u, w, intra, glast))
    o = jnp.moveaxis(jnp.swapaxes(o, 2, 3), 0, 1).reshape(b, l, h, o.shape[-1])
    return o, s_fin


def delta_layer(x, conv_buf, s0, w_in, conv_w, a_log, dt_bias, norm_w, w_out, ln_g, ln_b):
    b, l, _ = x.shape
    proj = x @ w_in
    qkv, new_buf = causal_conv(proj[..., :CONV_DIM], conv_buf, conv_w)
    z = proj[..., CONV_DIM:CONV_DIM + A_VW].reshape(b, l, A_HEADS, A_DV)
    a_in = proj[..., CONV_DIM + A_VW:CONV_DIM + A_VW + A_HEADS].astype(jnp.float32)
    b_in = proj[..., CONV_DIM + A_VW + A_HEADS:].astype(jnp.float32)
    q = l2norm(qkv[..., :A_QK].reshape(b, l, A_HEADS, A_DK)) * (A_DK ** -0.5)
    k = l2norm(qkv[..., A_QK:2 * A_QK].reshape(b, l, A_HEADS, A_DK))
    v = qkv[..., 2 * A_QK:].reshape(b, l, A_HEADS, A_DV).astype(jnp.float32)
    beta = jax.nn.sigmoid(b_in)
    g = -jnp.exp(a_log.astype(jnp.float32)) * jax.nn.softplus(a_in + dt_bias.astype(jnp.float32))
    o, s_new = gated_delta_rule(q, k, v, g, beta, s0.astype(jnp.float32))
    o = o * lax.rsqrt(jnp.mean(o * o, -1, keepdims=True) + RMS_EPS) * norm_w * jax.nn.silu(z.astype(jnp.float32))
    out = o.reshape(b, l, A_VW).astype(x.dtype) @ w_out
    return layer_norm(DN_ALPHA * x + out, ln_g, ln_b), new_buf, s_new.astype(x.dtype)


def shared_kv(h, w_kv, pos):
    b, l, _ = h.shape
    kv = h @ w_kv
    k = rope_partial(kv[..., :B_KVW].reshape(b, l, B_KV_HEADS, B_HD), pos)
    v = kv[..., B_KVW:].reshape(b, l, B_KV_HEADS, B_HD)
    return k, v


def sink_softmax(s, sinks):
    sk = sinks.astype(jnp.float32)[..., None, None]
    m = jnp.maximum(s.max(-1, keepdims=True), sk)
    p = jnp.exp(s - m)
    return p / (p.sum(-1, keepdims=True) + jnp.exp(sk - m))


def banded_attention(q, k, v, sinks):
    b, l = q.shape[:2]
    n = l // CHUNK
    qb = q.reshape(b, n, CHUNK, B_KV_HEADS, B_GROUP, B_HD)

    def band(t):
        t = t.reshape(b, n, CHUNK, B_KV_HEADS, B_HD)
        t = jnp.pad(t, ((0, 0), (WINDOW_CHUNKS, 0), (0, 0), (0, 0), (0, 0)))
        return jnp.concatenate([t[:, j:j + n] for j in range(WINDOW_CHUNKS + 1)], axis=2)

    kb, vb = band(k), band(v)
    s = jnp.einsum('bnqkgd,bnskd->bnkgqs', qb, kb, preferred_element_type=jnp.float32)
    key_chunk = jnp.arange(n)[:, None] + (jnp.arange((WINDOW_CHUNKS + 1) * CHUNK) // CHUNK)[None, :] - WINDOW_CHUNKS
    s = jnp.where((key_chunk >= 0)[None, :, None, None, None, :], s, -jnp.inf)
    p = sink_softmax(s, sinks)
    o = jnp.einsum('bnkgqs,bnskd->bnqkgd', p.astype(v.dtype), vb)
    return o.reshape(b, l, B_QW)


def cached_attention(q, k, v, sinks):
    b, l = q.shape[:2]
    s = jnp.einsum('bqkgd,bskd->bkgqs', q, k, preferred_element_type=jnp.float32)
    p = sink_softmax(s, sinks)
    o = jnp.einsum('bkgqs,bskd->bqkgd', p.astype(v.dtype), v)
    return o.reshape(b, l, B_QW)


def swa_layer(x, k, v, pos, cached, w_in, sinks, w_out, ln_g, ln_b):
    b, l, _ = x.shape
    proj = x @ w_in
    q = rope_partial(proj[..., :B_QW].reshape(b, l, B_Q_HEADS, B_HD), pos) * (B_HD ** -0.5)
    q = q.reshape(b, l, B_KV_HEADS, B_GROUP, B_HD)
    z = proj[..., B_QW:]
    sk = sinks.reshape(B_KV_HEADS, B_GROUP)
    o = cached_attention(q, k, v, sk) if cached else banded_attention(q, k, v, sk)
    out = (o * jax.nn.silu(z)) @ w_out
    return layer_norm(DN_ALPHA * x + out, ln_g, ln_b)


def trunk(x, pos, conv_state, delta_state, past_k, past_v, a_w_in, a_conv_w, a_log, a_dt_bias, a_norm_w, a_w_out,
          a_ln_g, a_ln_b, b_w_kv, b_w_in, b_sinks, b_w_out, b_ln_g, b_ln_b):
    bsz = x.shape[0]
    cached = past_k is not None
    new_conv, new_delta = [], []
    for layer in range(DEPTH):
        if layer < N_A_LAYERS:
            i = layer
            if cached:
                cbuf, s0 = conv_state[i], delta_state[i]
            else:
                cbuf = jnp.zeros((bsz, CONV_W - 1, CONV_DIM), x.dtype)
                s0 = jnp.zeros((bsz, A_HEADS, A_DK, A_DV), jnp.float32)
            x, cb, st = delta_layer(x, cbuf, s0, a_w_in[i], a_conv_w[i], a_log[i], a_dt_bias[i], a_norm_w[i],
                                    a_w_out[i], a_ln_g[i], a_ln_b[i])
            new_conv.append(cb)
            new_delta.append(st)
            if layer == N_A_LAYERS - 1:
                k, v = shared_kv(x, b_w_kv, pos)
                if cached:
                    k = jnp.concatenate([past_k.astype(k.dtype), k], axis=1)
                    v = jnp.concatenate([past_v.astype(v.dtype), v], axis=1)
                new_k, new_v = k[:, -WINDOW:], v[:, -WINDOW:]
        else:
            j = layer - N_A_LAYERS
            x = swa_layer(x, k, v, pos, cached, b_w_in[j], b_sinks[j], b_w_out[j], b_ln_g[j], b_ln_b[j])
    return x, jnp.stack(new_conv), jnp.stack(new_delta), new_k, new_v


def setup_inputs(seed: int = 0) -> dict:
    key = jax.random.key(seed)
    ks = jax.random.split(key, 24)

    def nrm(k, shape, scale):
        return jax.random.normal(k, shape, jnp.float32) * scale

    cache_rows = min(WINDOW, PAST_LEN)
    dt = jnp.exp(jax.random.uniform(ks[9], (N_A_LAYERS, A_HEADS), jnp.float32,
                                    minval=math.log(1e-3), maxval=math.log(1e-1)))
    return {
        'x_prompt': nrm(ks[0], (BATCH, SEQ, D_MODEL), 1.0),
        'x_sample': nrm(ks[1], (DEC_BATCH, DEC_SEQ, D_MODEL), 1.0),
        'state_delta': nrm(ks[2], (N_A_LAYERS, DEC_BATCH, A_HEADS, A_DK, A_DV), A_DK ** -0.5),
        'state_conv': nrm(ks[3], (N_A_LAYERS, DEC_BATCH, CONV_W - 1, CONV_DIM), 1.0),
        'cache_k': nrm(ks[4], (DEC_BATCH, cache_rows, B_KV_HEADS, B_HD), 1.0),
        'cache_v': nrm(ks[5], (DEC_BATCH, cache_rows, B_KV_HEADS, B_HD), 1.0),
        'a_w_in': nrm(ks[6], (N_A_LAYERS, D_MODEL, A_IN), D_MODEL ** -0.5),
        'a_conv_w': nrm(ks[7], (N_A_LAYERS, CONV_W, CONV_DIM), CONV_W ** -0.5),
        'a_log': jnp.log(jax.random.uniform(ks[8], (N_A_LAYERS, A_HEADS), jnp.float32, minval=1.0, maxval=16.0)),
        'a_dt_bias': dt + jnp.log(-jnp.expm1(-dt)),
        'a_norm_w': 1.0 + nrm(ks[10], (N_A_LAYERS, A_DV), 0.02),
        'a_w_out': nrm(ks[11], (N_A_LAYERS, A_VW, D_MODEL), (A_VW ** -0.5) * DN_BETA),
        'a_ln_g': 1.0 + nrm(ks[12], (N_A_LAYERS, D_MODEL), 0.02),
        'a_ln_b': nrm(ks[13], (N_A_LAYERS, D_MODEL), 0.02),
        'b_w_kv': nrm(ks[14], (D_MODEL, 2 * B_KVW), D_MODEL ** -0.5),
        'b_w_in': nrm(ks[15], (N_B_LAYERS, D_MODEL, B_IN), D_MODEL ** -0.5),
        'b_sinks': nrm(ks[16], (N_B_LAYERS, B_Q_HEADS), 0.5),
        'b_w_out': nrm(ks[17], (N_B_LAYERS, B_QW, D_MODEL), (B_QW ** -0.5) * DN_BETA),
        'b_ln_g': 1.0 + nrm(ks[18], (N_B_LAYERS, D_MODEL), 0.02),
        'b_ln_b': nrm(ks[19], (N_B_LAYERS, D_MODEL), 0.02),
    }


def reference(x_prompt, x_sample, state_delta, state_conv, cache_k, cache_v, a_w_in, a_conv_w, a_log, a_dt_bias,
              a_norm_w, a_w_out, a_ln_g, a_ln_b, b_w_kv, b_w_in, b_sinks, b_w_out, b_ln_g, b_ln_b):
    pos_prompt = jnp.arange(x_prompt.shape[1], dtype=jnp.int32)
    pos_sample = PAST_LEN + jnp.arange(x_sample.shape[1], dtype=jnp.int32)
    y_prompt, p_conv, p_delta, p_k, p_v = trunk(
        x_prompt, pos_prompt, None, None, None, None, a_w_in, a_conv_w, a_log, a_dt_bias, a_norm_w, a_w_out,
        a_ln_g, a_ln_b, b_w_kv, b_w_in, b_sinks, b_w_out, b_ln_g, b_ln_b)
    y_sample, s_conv, s_delta, s_k, s_v = trunk(
        x_sample, pos_sample, state_conv, state_delta, cache_k, cache_v, a_w_in, a_conv_w, a_log, a_dt_bias,
        a_norm_w, a_w_out, a_ln_g, a_ln_b, b_w_kv, b_w_in, b_sinks, b_w_out, b_ln_g, b_ln_b)
    return (y_prompt, y_sample, p_delta, p_conv, p_k, p_v, s_delta, s_conv, s_k, s_v)
```

```cpp
#ifdef EMU
#include "hip_emu.h"
#else
#include <hip/hip_runtime.h>
#endif
#include <cstdint>
#include <cstddef>
#include <cstdio>

#ifdef CFG_SMALL
constexpr int D_MODEL = 256, BATCH = 2, SEQ = 256, DEC_BATCH = 4, DEC_SEQ = 32, A_HEADS = 2, B_Q_HEADS = 4, B_KV_HEADS = 2;
#else
constexpr int D_MODEL = 1024, BATCH = 8, SEQ = 2048, DEC_BATCH = 16, DEC_SEQ = 32, A_HEADS = 8, B_Q_HEADS = 16, B_KV_HEADS = 4;
#endif
constexpr int PAST_LEN = 4096, CHUNK = 64, N_A = 2, N_B = 2, DEPTH = 4;
constexpr int A_DK = 128, A_DV = 128, A_QK = A_HEADS * A_DK, A_VW = A_HEADS * A_DV, CONV_W = 4, CONV_DIM = 2 * A_QK + A_VW;
constexpr int A_IN = CONV_DIM + A_VW + 2 * A_HEADS, A_MAIN = CONV_DIM + A_VW;
constexpr int B_GROUP = B_Q_HEADS / B_KV_HEADS, B_HD = 64, B_QW = B_Q_HEADS * B_HD, B_KVW = B_KV_HEADS * B_HD, B_IN = 2 * B_QW;
constexpr int WINDOW = 128, ROPE_DIMS = 16, ROPE_HALF = 8;
constexpr float LN_EPS = 1e-5f, RMS_EPS = 1e-6f;
constexpr float DN_ALPHA = 1.681792830507429f;
constexpr int PT = BATCH * SEQ, ST = DEC_BATCH * DEC_SEQ, MT = PT + ST, NSEQ = BATCH + DEC_BATCH;
constexpr int NCPS = SEQ / CHUNK, NCP = BATCH * NCPS, NCH = NCP + DEC_BATCH;
constexpr int PLD = A_MAIN;
static_assert(A_MAIN >= B_IN + 2 * B_KVW, "PROJ pitch");
static_assert(MT % 128 == 0 && A_MAIN % 128 == 0 && D_MODEL % 128 == 0 && B_IN % 128 == 0 && (2 * B_KVW) % 128 == 0, "gemm tiles");
static_assert(DEC_SEQ == 32 && WINDOW == 128 && CHUNK == 64, "fixed");

constexpr size_t O_YP = 0, O_YS = O_YP + (size_t)PT * D_MODEL, O_PDELTA = O_YS + (size_t)ST * D_MODEL;
constexpr size_t O_PCONV = O_PDELTA + (size_t)N_A * BATCH * A_HEADS * A_DK * A_DV, O_PK = O_PCONV + (size_t)N_A * BATCH * 3 * CONV_DIM;
constexpr size_t O_PV = O_PK + (size_t)BATCH * WINDOW * B_KVW, O_SDELTA = O_PV + (size_t)BATCH * WINDOW * B_KVW;
constexpr size_t O_SCONV = O_SDELTA + (size_t)N_A * DEC_BATCH * A_HEADS * A_DK * A_DV, O_SK = O_SCONV + (size_t)N_A * DEC_BATCH * 3 * CONV_DIM;
constexpr size_t O_SV = O_SK + (size_t)DEC_BATCH * WINDOW * B_KVW, O_END = O_SV + (size_t)DEC_BATCH * WINDOW * B_KVW;

constexpr size_t al256(size_t x) { return (x + 255) & ~(size_t)255; }
constexpr size_t WS_CTL = 0, WS_ROPE = 1u << 20;
constexpr size_t WS_GB = al256(WS_ROPE + (size_t)(SEQ + DEC_SEQ) * ROPE_HALF * 2 * 4);
constexpr size_t WS_HALO = al256(WS_GB + (size_t)MT * A_HEADS * 2 * 4);
constexpr size_t WS_XB = al256(WS_HALO + (size_t)NCH * 3 * CONV_DIM * 2);
constexpr size_t WS_PROJ = al256(WS_XB + (size_t)MT * D_MODEL * 2);
constexpr size_t WS_END = al256(WS_PROJ + (size_t)MT * PLD * 2);

typedef unsigned short bf16;
constexpr int NTHR = 512;

struct Prm {
    const float *x_prompt, *x_sample, *state_delta, *state_conv, *cache_k, *cache_v, *a_w_in, *a_conv_w, *a_log, *a_dt_bias, *a_norm_w, *a_w_out, *a_ln_g, *a_ln_b,
        *b_w_kv, *b_w_in, *b_sinks, *b_w_out, *b_ln_g, *b_ln_b;
    float* out; unsigned char* ws;
};

__device__ __forceinline__ unsigned f2bf(float f) { unsigned u = __builtin_bit_cast(unsigned, f); return (u + 0x7fffu + ((u >> 16) & 1u)) >> 16; }
__device__ __forceinline__ float bf2f(bf16 h) { return __builtin_bit_cast(float, (unsigned)h << 16); }
__device__ __forceinline__ float siluf(float x) { return x / (1.f + expf(-x)); }
__device__ __forceinline__ float sigmoidf_(float x) { return 1.f / (1.f + expf(-x)); }
__device__ __forceinline__ float softplusf_(float x) { return x > 20.f ? x : log1pf(expf(x)); }
__device__ __forceinline__ float wave_sum(float v) {
#pragma unroll
    for (int o = 1; o < 64; o <<= 1) v += __shfl_xor(v, o);
    return v;
}
__device__ __forceinline__ int seq_row0(int s) { return s < BATCH ? s * SEQ : PT + (s - BATCH) * DEC_SEQ; }
__device__ __forceinline__ int seq_len(int s) { return s < BATCH ? SEQ : DEC_SEQ; }
__device__ __forceinline__ int chunk_row0(int c) { return c < NCP ? c * CHUNK : PT + (c - NCP) * DEC_SEQ; }
__device__ __forceinline__ int chunk_len(int c) { return c < NCP ? CHUNK : DEC_SEQ; }
__device__ __forceinline__ int row_posidx(int row) { return row < PT ? (row % SEQ) : SEQ + ((row - PT) % DEC_SEQ); }

struct Ctx { int tid, lane, wave, gtid, gwave, nthreads, nwaves, bid, nblk; };

__device__ __forceinline__ void ph_init(const Prm& p, const Ctx& c) {
    bf16* XB = (bf16*)(p.ws + WS_XB);
    for (size_t i = c.gtid; i < (size_t)MT * D_MODEL; i += c.nthreads) {
        const float v = i < (size_t)PT * D_MODEL ? p.x_prompt[i] : p.x_sample[i - (size_t)PT * D_MODEL];
        XB[i] = (bf16)f2bf(v);
    }
    float* rope = (float*)(p.ws + WS_ROPE);
    for (int i = c.gtid; i < (SEQ + DEC_SEQ) * ROPE_HALF; i += c.nthreads) {
        const int pi = i / ROPE_HALF, f = i % ROPE_HALF; const double pos = pi < SEQ ? (double)pi : (double)(PAST_LEN + pi - SEQ);
        const double inv = pow(500000.0, -(double)f / 8.0), ang = pos * inv;
        rope[2 * i] = (float)cos(ang); rope[2 * i + 1] = (float)sin(ang);
    }
}

__device__ __forceinline__ void gemm_naive(const bf16* A, int lda, const float* W, int ldw, bf16* C, int ldc, int M, int N, int K, const Ctx& c, unsigned char* lds) {
    float* As = (float*)lds;
    float* Bs = As + 16 * 132;
    const int tm = M / 128, tn = N / 128, ty = c.tid / 16, tx = c.tid % 16;
    for (int t = c.bid; t < tm * tn; t += c.nblk) {
        const int m0 = (t / tn) * 128, n0 = (t % tn) * 128;
        float acc[4][8];
#pragma unroll
        for (int i = 0; i < 4; ++i)
#pragma unroll
            for (int j = 0; j < 8; ++j) acc[i][j] = 0.f;
        for (int k0 = 0; k0 < K; k0 += 16) {
            __syncthreads();
#pragma unroll
            for (int e = 0; e < 4; ++e) { const int idx = c.tid + e * NTHR; const int r = idx / 16, kk = idx % 16; As[kk * 132 + r] = bf2f(A[(size_t)(m0 + r) * lda + k0 + kk]); }
#pragma unroll
            for (int e = 0; e < 4; ++e) { const int idx = c.tid + e * NTHR; const int kk = idx / 128, n = idx % 128; Bs[kk * 132 + n] = W[(size_t)(k0 + kk) * ldw + n0 + n]; }
            __syncthreads();
#pragma unroll
            for (int kk = 0; kk < 16; ++kk) {
                float a[4], b[8];
#pragma unroll
                for (int i = 0; i < 4; ++i) a[i] = As[kk * 132 + ty * 4 + i];
#pragma unroll
                for (int j = 0; j < 8; ++j) b[j] = Bs[kk * 132 + tx * 8 + j];
#pragma unroll
                for (int i = 0; i < 4; ++i)
#pragma unroll
                    for (int j = 0; j < 8; ++j) acc[i][j] += a[i] * b[j];
            }
        }
#pragma unroll
        for (int i = 0; i < 4; ++i)
#pragma unroll
            for (int j = 0; j < 8; ++j) C[(size_t)(m0 + ty * 4 + i) * ldc + n0 + tx * 8 + j] = (bf16)f2bf(acc[i][j]);
    }
}

__device__ __forceinline__ void ph_a_gemm(const Prm& p, const Ctx& c, int li, unsigned char* lds) {
    const bf16* XB = (const bf16*)(p.ws + WS_XB); bf16* PROJ = (bf16*)(p.ws + WS_PROJ);
    const float* W = p.a_w_in + (size_t)li * D_MODEL * A_IN;
    gemm_naive(XB, D_MODEL, W, A_IN, PROJ, PLD, MT, A_MAIN, D_MODEL, c, lds);
    float* GB = (float*)(p.ws + WS_GB);
    for (int it = c.gtid; it < MT * 2 * A_HEADS; it += c.nthreads) {
        const int row = it / (2 * A_HEADS), j = it % (2 * A_HEADS);
        float s = 0.f;
        for (int k = 0; k < D_MODEL; ++k) s += bf2f(XB[(size_t)row * D_MODEL + k]) * W[(size_t)k * A_IN + A_MAIN + j];
        if (j < A_HEADS) { const int h = j; GB[((size_t)row * A_HEADS + h) * 2 + 0] = -expf(p.a_log[li * A_HEADS + h]) * softplusf_(s + p.a_dt_bias[li * A_HEADS + h]); }
        else { const int h = j - A_HEADS; GB[((size_t)row * A_HEADS + h) * 2 + 1] = sigmoidf_(s); }
    }
}
__device__ __forceinline__ void ph_a_halo(const Prm& p, const Ctx& c, int li) {
    const bf16* PROJ = (const bf16*)(p.ws + WS_PROJ); bf16* HALO = (bf16*)(p.ws + WS_HALO);
    for (int it = c.gtid; it < NCH * 3 * CONV_DIM; it += c.nthreads) {
        const int ch = it % CONV_DIM, r = (it / CONV_DIM) % 3, ck = it / (3 * CONV_DIM);
        const int row = chunk_row0(ck) + chunk_len(ck) - 3 + r;
        const bf16 v = PROJ[(size_t)row * PLD + ch]; HALO[it] = v;
        if (ck < NCP) { if (ck % NCPS == NCPS - 1) { const int b = ck / NCPS; p.out[O_PCONV + (((size_t)li * BATCH + b) * 3 + r) * CONV_DIM + ch] = bf2f(v); } }
        else { const int b = ck - NCP; p.out[O_SCONV + (((size_t)li * DEC_BATCH + b) * 3 + r) * CONV_DIM + ch] = bf2f(v); }
    }
}
__device__ __forceinline__ void ph_a_conv(const Prm& p, const Ctx& c, int li) {
    bf16* PROJ = (bf16*)(p.ws + WS_PROJ); const bf16* HALO = (const bf16*)(p.ws + WS_HALO);
    const float* cw = p.a_conv_w + (size_t)li * CONV_W * CONV_DIM;
    for (int it = c.gtid; it < NCH * CONV_DIM; it += c.nthreads) {
        const int ch = it % CONV_DIM, ck = it / CONV_DIM;
        float h0, h1, h2;
        if (ck < NCP) { if (ck % NCPS == 0) { h0 = h1 = h2 = 0.f; } else { const bf16* hp = HALO + (size_t)(ck - 1) * 3 * CONV_DIM + ch; h0 = bf2f(hp[0]); h1 = bf2f(hp[CONV_DIM]); h2 = bf2f(hp[2 * CONV_DIM]); } }
        else { const float* sp = p.state_conv + (((size_t)li * DEC_BATCH + (ck - NCP)) * 3) * CONV_DIM + ch; h0 = sp[0]; h1 = sp[CONV_DIM]; h2 = sp[2 * CONV_DIM]; }
        const float w0 = cw[ch], w1 = cw[CONV_DIM + ch], w2 = cw[2 * CONV_DIM + ch], w3 = cw[3 * CONV_DIM + ch];
        const int r0 = chunk_row0(ck), n = chunk_len(ck);
        for (int t = 0; t < n; ++t) {
            bf16* e = PROJ + (size_t)(r0 + t) * PLD + ch; const float x = bf2f(*e);
            const float y = w0 * h0 + w1 * h1 + w2 * h2 + w3 * x;
            *e = (bf16)f2bf(siluf(y)); h0 = h1; h1 = h2; h2 = x;
        }
    }
}
__device__ __forceinline__ void ph_a_l2n(const Prm& p, const Ctx& c) {
    bf16* PROJ = (bf16*)(p.ws + WS_PROJ);
    for (int it = c.gwave; it < MT * A_HEADS * 2; it += c.nwaves) {
        const int which = it % 2, h = (it / 2) % A_HEADS, row = it / (2 * A_HEADS);
        bf16* e = PROJ + (size_t)row * PLD + which * A_QK + h * A_DK + 2 * c.lane;
        const float a = bf2f(e[0]), b = bf2f(e[1]);
        const float ss = wave_sum(a * a + b * b);
        const float sc = (1.f / sqrtf(ss + RMS_EPS)) * (which == 0 ? 0.08838834764831845f : 1.f);
        e[0] = (bf16)f2bf(a * sc); e[1] = (bf16)f2bf(b * sc);
    }
}
__device__ __forceinline__ void ph_a_scan(const Prm& p, const Ctx& c, int li, unsigned char* lds) {
    bf16* PROJ = (bf16*)(p.ws + WS_PROJ); const float* GB = (const float*)(p.ws + WS_GB);
    float* kq = (float*)lds;
    const int col = c.tid >> 2, part = c.tid & 3;
    constexpr int NGRP = NSEQ * A_HEADS;
    for (int g = c.bid; g < NGRP; g += c.nblk) {
        const int s = g / A_HEADS, h = g % A_HEADS;
        const int r0 = seq_row0(s), n = seq_len(s);
        float S[32];
        if (s < BATCH) {
#pragma unroll
            for (int k = 0; k < 32; ++k) S[k] = 0.f;
        } else {
            const float* s0 = p.state_delta + (((size_t)li * DEC_BATCH + (s - BATCH)) * A_HEADS + h) * A_DK * A_DV;
#pragma unroll
            for (int k = 0; k < 32; ++k) S[k] = s0[(size_t)(part * 32 + k) * A_DV + col];
        }
        for (int t = 0; t < n; ++t) {
            const size_t rb = (size_t)(r0 + t) * PLD;
            __syncthreads();
            if (c.tid < 128) kq[c.tid] = bf2f(PROJ[rb + A_QK + h * A_DK + c.tid]);
            else if (c.tid < 256) kq[c.tid] = bf2f(PROJ[rb + h * A_DK + (c.tid - 128)]);
            __syncthreads();
            const float gg = GB[((size_t)(r0 + t) * A_HEADS + h) * 2], beta = GB[((size_t)(r0 + t) * A_HEADS + h) * 2 + 1];
            const float eg = expf(gg); const float v = bf2f(PROJ[rb + 2 * A_QK + h * A_DV + col]);
            const float* kk = kq + part * 32; const float* qq = kq + 128 + part * 32;
            float ks = 0.f;
#pragma unroll
            for (int k = 0; k < 32; ++k) { S[k] *= eg; ks += kk[k] * S[k]; }
            ks += __shfl_xor(ks, 1); ks += __shfl_xor(ks, 2);
            const float vn = (v - ks) * beta; float o = 0.f;
#pragma unroll
            for (int k = 0; k < 32; ++k) { S[k] += kk[k] * vn; o += qq[k] * S[k]; }
            o += __shfl_xor(o, 1); o += __shfl_xor(o, 2);
            if (part == 0) PROJ[rb + 2 * A_QK + h * A_DV + col] = (bf16)f2bf(o);
        }
        float* so = s < BATCH ? p.out + O_PDELTA + (((size_t)li * BATCH + s) * A_HEADS + h) * A_DK * A_DV
                              : p.out + O_SDELTA + (((size_t)li * DEC_BATCH + (s - BATCH)) * A_HEADS + h) * A_DK * A_DV;
#pragma unroll
        for (int k = 0; k < 32; ++k) so[(size_t)(part * 32 + k) * A_DV + col] = S[k];
    }
}
__device__ __forceinline__ void ph_a_gateo(const Prm& p, const Ctx& c, int li) {
    bf16* PROJ = (bf16*)(p.ws + WS_PROJ); const float* nw = p.a_norm_w + (size_t)li * A_DV;
    for (int it = c.gwave; it < MT * A_HEADS; it += c.nwaves) {
        const int h = it % A_HEADS, row = it / A_HEADS;
        bf16* e = PROJ + (size_t)row * PLD + 2 * A_QK + h * A_DV + 2 * c.lane; const bf16* z = PROJ + (size_t)row * PLD + CONV_DIM + h * A_DV + 2 * c.lane;
        const float a = bf2f(e[0]), b = bf2f(e[1]);
        const float r = 1.f / sqrtf(wave_sum(a * a + b * b) * (1.f / A_DV) + RMS_EPS);
        e[0] = (bf16)f2bf(a * r * nw[2 * c.lane] * siluf(bf2f(z[0]))); e[1] = (bf16)f2bf(b * r * nw[2 * c.lane + 1] * siluf(bf2f(z[1])));
    }
}
__device__ __forceinline__ void ph_ln(const Prm& p, const Ctx& c, const bf16* OUT, int ldo, const float* g, const float* b, bool last) {
    bf16* XB = (bf16*)(p.ws + WS_XB);
    constexpr int PER = D_MODEL / 64;
    for (int row = c.gwave; row < MT; row += c.nwaves) {
        float v[PER]; float s = 0.f;
#pragma unroll
        for (int j = 0; j < PER; ++j) { const int col = j * 64 + c.lane; v[j] = DN_ALPHA * bf2f(XB[(size_t)row * D_MODEL + col]) + bf2f(OUT[(size_t)row * ldo + col]); s += v[j]; }
        const float mean = wave_sum(s) * (1.f / D_MODEL); float q = 0.f;
#pragma unroll
        for (int j = 0; j < PER; ++j) { v[j] -= mean; q += v[j] * v[j]; }
        const float rstd = 1.f / sqrtf(wave_sum(q) * (1.f / D_MODEL) + LN_EPS);
#pragma unroll
        for (int j = 0; j < PER; ++j) { const int col = j * 64 + c.lane; const float y = v[j] * rstd * g[col] + b[col];
            XB[(size_t)row * D_MODEL + col] = (bf16)f2bf(y);
            if (last) { if (row < PT) p.out[O_YP + (size_t)row * D_MODEL + col] = y; else p.out[O_YS + (size_t)(row - PT) * D_MODEL + col] = y; } }
    }
}
__device__ __forceinline__ void ph_b_rope(const Prm& p, const Ctx& c, bool first) {
    bf16* PROJ = (bf16*)(p.ws + WS_PROJ); const float* rope = (const float*)(p.ws + WS_ROPE);
    const int nh = B_Q_HEADS + (first ? B_KV_HEADS : 0);
    for (int it = c.gtid; it < MT * nh * ROPE_HALF; it += c.nthreads) {
        const int f = it % ROPE_HALF, hh = (it / ROPE_HALF) % nh, row = it / (ROPE_HALF * nh);
        bf16* e = PROJ + (size_t)row * PLD + (hh < B_Q_HEADS ? hh * B_HD : B_IN + (hh - B_Q_HEADS) * B_HD);
        const float cs = rope[(row_posidx(row) * ROPE_HALF + f) * 2], sn = rope[(row_posidx(row) * ROPE_HALF + f) * 2 + 1];
        const float x1 = bf2f(e[f]), x2 = bf2f(e[ROPE_HALF + f]);
        e[f] = (bf16)f2bf(x1 * cs - x2 * sn); e[ROPE_HALF + f] = (bf16)f2bf(x2 * cs + x1 * sn);
    }
}
__device__ __forceinline__ void ph_b_att(const Prm& p, const Ctx& c, int lj, bool first) {
    bf16* PROJ = (bf16*)(p.ws + WS_PROJ);
    for (int it = c.gwave; it < NCH * B_Q_HEADS * 2; it += c.nwaves) {
        const int hr = it % 2, hq = (it / 2) % B_Q_HEADS, ck = it / (2 * B_Q_HEADS), kvh = hq / B_GROUP;
        const int r0 = chunk_row0(ck), n = chunk_len(ck);
        const int rl = hr * 32 + (c.lane >> 1), half = c.lane & 1, d0 = half * 32;
        if (hr * 32 < n) {
            const int row = r0 + rl;
            float q[32], acc[32];
#pragma unroll
            for (int d = 0; d < 32; ++d) { q[d] = bf2f(PROJ[(size_t)row * PLD + hq * B_HD + d0 + d]) * 0.125f; acc[d] = 0.f; }
            float m = p.b_sinks[lj * B_Q_HEADS + hq], l = 1.f;
            int nkeys, kfirst = 0;
            if (ck < NCP) { const int nc = ck % NCPS; kfirst = nc >= 2 ? r0 - 2 * CHUNK : r0 - nc * CHUNK; nkeys = r0 + CHUNK - kfirst; }
            else nkeys = WINDOW + DEC_SEQ;
            for (int j = 0; j < nkeys; ++j) {
                float s = 0.f;
                if (ck >= NCP && j < WINDOW) {
                    const size_t cb = (((size_t)(ck - NCP) * WINDOW + j) * B_KV_HEADS + kvh) * B_HD + d0;
#pragma unroll
                    for (int d = 0; d < 32; ++d) s += q[d] * p.cache_k[cb + d];
                    s += __shfl_xor(s, 1);
                    const float mn = fmaxf(m, s), sc = expf(m - mn), pe = expf(s - mn);
                    l = l * sc + pe; m = mn;
#pragma unroll
                    for (int d = 0; d < 32; ++d) acc[d] = acc[d] * sc + pe * p.cache_v[cb + d];
                } else {
                    const int kr = ck < NCP ? kfirst + j : r0 + (j - WINDOW);
                    const bf16* kp = PROJ + (size_t)kr * PLD + B_IN + kvh * B_HD + d0;
#pragma unroll
                    for (int d = 0; d < 32; ++d) s += q[d] * bf2f(kp[d]);
                    s += __shfl_xor(s, 1);
                    const float mn = fmaxf(m, s), sc = expf(m - mn), pe = expf(s - mn);
                    l = l * sc + pe; m = mn;
#pragma unroll
                    for (int d = 0; d < 32; ++d) acc[d] = acc[d] * sc + pe * bf2f(kp[B_KVW + d]);
                }
            }
            const float il = 1.f / l;
#pragma unroll
            for (int d = 0; d < 32; ++d) { const float z = bf2f(PROJ[(size_t)row * PLD + B_QW + hq * B_HD + d0 + d]); PROJ[(size_t)row * PLD + hq * B_HD + d0 + d] = (bf16)f2bf(acc[d] * il * siluf(z)); }
        }
    }
    if (first) {
        for (int it = c.gtid; it < (BATCH + DEC_BATCH) * WINDOW * B_KVW; it += c.nthreads) {
            const int e = it % B_KVW, w = (it / B_KVW) % WINDOW, s = it / (B_KVW * WINDOW);
            if (s < BATCH) { const int row = s * SEQ + SEQ - WINDOW + w; const bf16* kp = PROJ + (size_t)row * PLD + B_IN;
                p.out[O_PK + ((size_t)s * WINDOW + w) * B_KVW + e] = bf2f(kp[e]); p.out[O_PV + ((size_t)s * WINDOW + w) * B_KVW + e] = bf2f(kp[B_KVW + e]); }
            else { const int b = s - BATCH; float kx, vx;
                if (w < WINDOW - DEC_SEQ) { kx = p.cache_k[((size_t)b * WINDOW + w + DEC_SEQ) * B_KVW + e]; vx = p.cache_v[((size_t)b * WINDOW + w + DEC_SEQ) * B_KVW + e]; }
                else { const int row = PT + b * DEC_SEQ + (w - (WINDOW - DEC_SEQ)); const bf16* kp = PROJ + (size_t)row * PLD + B_IN; kx = bf2f(kp[e]); vx = bf2f(kp[B_KVW + e]); }
                p.out[O_SK + ((size_t)b * WINDOW + w) * B_KVW + e] = kx; p.out[O_SV + ((size_t)b * WINDOW + w) * B_KVW + e] = vx; }
        }
    }
}

constexpr int PH_A0 = 1, PH_APER = 8, PH_B0 = PH_A0 + N_A * PH_APER, PH_BPER = 5, N_PHASES = PH_B0 + N_B * PH_BPER;
__device__ __forceinline__ void run_phase(const Prm& p, const Ctx& c, int ph, unsigned char* lds) {
    bf16* PROJ = (bf16*)(p.ws + WS_PROJ); const bf16* XB = (const bf16*)(p.ws + WS_XB);
    if (ph == 0) { ph_init(p, c); return; }
    if (ph < PH_B0) {
        const int li = (ph - PH_A0) / PH_APER, k = (ph - PH_A0) % PH_APER;
        switch (k) {
            case 0: ph_a_gemm(p, c, li, lds); break;
            case 1: ph_a_halo(p, c, li); break;
            case 2: ph_a_conv(p, c, li); break;
            case 3: ph_a_l2n(p, c); break;
            case 4: ph_a_scan(p, c, li, lds); break;
            case 5: ph_a_gateo(p, c, li); break;
            case 6: gemm_naive(PROJ + 2 * A_QK, PLD, p.a_w_out + (size_t)li * A_VW * D_MODEL, D_MODEL, PROJ, PLD, MT, D_MODEL, A_VW, c, lds); break;
            case 7: ph_ln(p, c, PROJ, PLD, p.a_ln_g + (size_t)li * D_MODEL, p.a_ln_b + (size_t)li * D_MODEL, false); break;
        }
        return;
    }
    const int lj = (ph - PH_B0) / PH_BPER, k = (ph - PH_B0) % PH_BPER;
    switch (k) {
        case 0: gemm_naive(XB, D_MODEL, p.b_w_in + (size_t)lj * D_MODEL * B_IN, B_IN, PROJ, PLD, MT, B_IN, D_MODEL, c, lds);
                if (lj == 0) gemm_naive(XB, D_MODEL, p.b_w_kv, 2 * B_KVW, PROJ + B_IN, PLD, MT, 2 * B_KVW, D_MODEL, c, lds);
                break;
        case 1: ph_b_rope(p, c, lj == 0); break;
        case 2: ph_b_att(p, c, lj, lj == 0); break;
        case 3: gemm_naive(PROJ, PLD, p.b_w_out + (size_t)lj * B_QW * D_MODEL, D_MODEL, PROJ + B_QW, PLD, MT, D_MODEL, B_QW, c, lds); break;
        case 4: ph_ln(p, c, PROJ + B_QW, PLD, p.b_ln_g + (size_t)lj * D_MODEL, p.b_ln_b + (size_t)lj * D_MODEL, lj == N_B - 1); break;
    }
}

constexpr int LDS_BYTES = 32768;
#ifdef EMU
#define DECL_LDS(name) unsigned char* name = emu::blk()->lds
#else
#define DECL_LDS(name) extern __shared__ __attribute__((aligned(16))) unsigned char name[]
#endif

__global__ void __launch_bounds__(NTHR) fwd_kernel(Prm p, int ph_lo, int ph_hi) {
    DECL_LDS(lds);
#pragma unroll 1
    for (int ph = ph_lo; ph < ph_hi; ++ph) {
        int tid_ = threadIdx.x, bid_ = blockIdx.x;
#ifndef EMU
        asm volatile("" : "+v"(tid_), "+s"(bid_));
#endif
        Ctx c; c.tid = tid_; c.lane = c.tid & 63; c.wave = c.tid >> 6; c.bid = bid_; c.nblk = gridDim.x;
        c.gtid = c.bid * NTHR + c.tid; c.nthreads = c.nblk * NTHR; c.gwave = c.bid * (NTHR / 64) + c.wave; c.nwaves = c.nblk * (NTHR / 64);
        run_phase(p, c, ph, lds);
    }
}

extern "C" void kernel_launch(void* const* d_in, const int* in_sizes, int n_in, void* d_out, int out_size, void* d_ws, size_t ws_size, hipStream_t stream) {
    if (n_in != 20 || (size_t)out_size != O_END || ws_size < WS_END) { fprintf(stderr, "kernel_launch: unexpected sizes n_in=%d out=%d ws=%zu (need %zu, out %zu)\n", n_in, out_size, ws_size, (size_t)WS_END, (size_t)O_END); return; }
    Prm p{};
    const float** pp = (const float**)&p;
    for (int i = 0; i < 20; ++i) pp[i] = (const float*)d_in[i];
    p.out = (float*)d_out; p.ws = (unsigned char*)d_ws;
#ifdef EMU
    const int grid = 8;
    for (int ph = 0; ph < N_PHASES; ++ph) { emu::launch([=]() { fwd_kernel(p, ph, ph + 1); }, dim3(grid), dim3(NTHR), LDS_BYTES); fprintf(stderr, "phase %d done\n", ph); }
#else
    const int grid = 256;
    for (int ph = 0; ph < N_PHASES; ++ph) hipLaunchKernelGGL(fwd_kernel, dim3(grid), dim3(NTHR), LDS_BYTES, stream, p, ph, ph + 1);
#endif
}
```

```cpp
#ifdef EMU
#include "hip_emu.h"
#else
#include <hip/hip_runtime.h>
#include <hip/hip_cooperative_groups.h>
namespace cg = cooperative_groups;
#endif
#include <cstdint>
#include <cstddef>
#include <cstdio>

typedef short bf16x8 __attribute__((ext_vector_type(8)));
typedef float f32x4 __attribute__((ext_vector_type(4)));
typedef float f32x16 __attribute__((ext_vector_type(16)));
typedef unsigned u32x4 __attribute__((ext_vector_type(4)));
typedef unsigned u32x2 __attribute__((ext_vector_type(2)));
#ifdef EMU
#define LAS
#define WAVE_SYNC() emu::wave_sync()
#define GLDS16(gp, lp) memcpy((unsigned char*)(lp) + emu::lane_id() * 16, (const void*)(gp), 16)
#define MFMA16(a, b, c) emu_mfma_16x16x32_bf16(a, b, c)
#define MFMA32(a, b, c) emu_mfma_32x32x16_bf16(a, b, c)
#define MFMAF(a, b, c) emu_mfma_16x16x4_f32(a, b, c)
#define SETPRIO(n)
#define SCHED_BARRIER()
#define S_BARRIER() emu::block_sync()
#define WAIT_VM(n)
#define WAIT_LGKM(n)
#define READFIRSTLANE(x) (x)
#define BCAST_LANE(v, n) __shfl(v, n)
#define LBAR() emu::block_sync()
#else
#define LAS __attribute__((address_space(3)))
#define WAVE_SYNC() asm volatile("s_waitcnt lgkmcnt(0)" ::: "memory")
#define GLDS16(gp, lp) __builtin_amdgcn_global_load_lds((const unsigned*)(gp), (LAS unsigned*)(lp), 16, 0, 0)
#define MFMA16(a, b, c) __builtin_amdgcn_mfma_f32_16x16x32_bf16(a, b, c, 0, 0, 0)
#define MFMA32(a, b, c) __builtin_amdgcn_mfma_f32_32x32x16_bf16(a, b, c, 0, 0, 0)
#define MFMAF(a, b, c) __builtin_amdgcn_mfma_f32_16x16x4f32(a, b, c, 0, 0, 0)
#define SETPRIO(n) __builtin_amdgcn_s_setprio(n)
#define SCHED_BARRIER() __builtin_amdgcn_sched_barrier(0)
#define S_BARRIER() __builtin_amdgcn_s_barrier()
#define WAIT_VM(n) asm volatile("s_waitcnt vmcnt(" #n ")" ::: "memory")
#define WAIT_LGKM(n) asm volatile("s_waitcnt lgkmcnt(" #n ")" ::: "memory")
#define READFIRSTLANE(x) __builtin_amdgcn_readfirstlane(x)
#define BCAST_LANE(v, n) __builtin_bit_cast(float, __builtin_amdgcn_readlane(__builtin_bit_cast(int, v), n))
#define LBAR() do { asm volatile("s_waitcnt lgkmcnt(0)" ::: "memory"); __builtin_amdgcn_s_barrier(); asm volatile("" ::: "memory"); } while (0)
#endif

#ifdef CFG_SMALL
constexpr int D_MODEL = 512, BATCH = 2, SEQ = 256, DEC_BATCH = 8, DEC_SEQ = 32, A_HEADS = 4, B_Q_HEADS = 8, B_KV_HEADS = 2;
#else
constexpr int D_MODEL = 1024, BATCH = 8, SEQ = 2048, DEC_BATCH = 16, DEC_SEQ = 32, A_HEADS = 8, B_Q_HEADS = 16, B_KV_HEADS = 4;
#endif
constexpr int PAST_LEN = 4096, CHUNK = 64, N_A = 2, N_B = 2, DEPTH = 4;
constexpr int A_DK = 128, A_DV = 128, A_QK = A_HEADS * A_DK, A_VW = A_HEADS * A_DV, CONV_W = 4, CONV_DIM = 2 * A_QK + A_VW;
constexpr int A_IN = CONV_DIM + A_VW + 2 * A_HEADS, A_MAIN = CONV_DIM + A_VW;
constexpr int B_GROUP = B_Q_HEADS / B_KV_HEADS, B_HD = 64, B_QW = B_Q_HEADS * B_HD, B_KVW = B_KV_HEADS * B_HD, B_IN = 2 * B_QW;
constexpr int WINDOW = 128, ROPE_DIMS = 16, ROPE_HALF = 8;
constexpr float LN_EPS = 1e-5f, RMS_EPS = 1e-6f;
constexpr float DN_ALPHA = 1.681792830507429f;
constexpr int PT = BATCH * SEQ, ST = DEC_BATCH * DEC_SEQ, MT = PT + ST, NSEQ = BATCH + DEC_BATCH;
constexpr int NCPS = SEQ / CHUNK, NCP = BATCH * NCPS, NCH = NCP + DEC_BATCH;
constexpr int PLD = A_MAIN > B_IN + 2 * B_KVW ? A_MAIN : B_IN + 2 * B_KVW;
static_assert(B_GROUP == 4, "attention wave map");
static_assert(PT % 256 == 0 && ST % 64 == 0 && D_MODEL % 256 == 0 && A_VW % 256 == 0 && B_QW % 256 == 0 && A_MAIN % 256 == 0 && D_MODEL % 256 == 0 && B_IN % 256 == 0 && (2 * B_KVW) % 256 == 0 && D_MODEL % 128 == 0 && D_MODEL >= 256, "gemm tiles");
static_assert(DEC_SEQ == 32 && WINDOW == 128 && CHUNK == 64, "fixed");

constexpr size_t O_YP = 0, O_YS = O_YP + (size_t)PT * D_MODEL, O_PDELTA = O_YS + (size_t)ST * D_MODEL;
constexpr size_t O_PCONV = O_PDELTA + (size_t)N_A * BATCH * A_HEADS * A_DK * A_DV, O_PK = O_PCONV + (size_t)N_A * BATCH * 3 * CONV_DIM;
constexpr size_t O_PV = O_PK + (size_t)BATCH * WINDOW * B_KVW, O_SDELTA = O_PV + (size_t)BATCH * WINDOW * B_KVW;
constexpr size_t O_SCONV = O_SDELTA + (size_t)N_A * DEC_BATCH * A_HEADS * A_DK * A_DV, O_SK = O_SCONV + (size_t)N_A * DEC_BATCH * 3 * CONV_DIM;
constexpr size_t O_SV = O_SK + (size_t)DEC_BATCH * WINDOW * B_KVW, O_END = O_SV + (size_t)DEC_BATCH * WINDOW * B_KVW;

constexpr size_t al256(size_t x) { return (x + 255) & ~(size_t)255; }
constexpr size_t WS_CTL = 0, WS_ROPE = 1u << 20;
constexpr size_t WS_GB = al256(WS_ROPE + (size_t)(SEQ + DEC_SEQ) * ROPE_HALF * 2 * 4);
constexpr size_t WS_HALO = al256(WS_GB + (size_t)MT * A_HEADS * 2 * 4);
constexpr size_t WS_XB = al256(WS_HALO + (size_t)NCH * 3 * CONV_DIM * 2);
constexpr size_t WS_PROJ = al256(WS_XB + (size_t)MT * D_MODEL * 2);
constexpr size_t WS_WAIN = al256(WS_PROJ + (size_t)MT * PLD * 2);
constexpr int A_NG = A_MAIN + 256;
constexpr size_t WS_WAOUT = al256(WS_WAIN + (size_t)N_A * A_NG * D_MODEL * 2);
constexpr int B_N0 = B_IN + 2 * B_KVW;
constexpr size_t WS_WBIN = al256(WS_WAOUT + (size_t)N_A * D_MODEL * A_VW * 2);
constexpr size_t WS_WBOUT = al256(WS_WBIN + (size_t)(B_N0 + B_IN) * D_MODEL * 2);
constexpr size_t WS_WB = al256(WS_WBOUT + (size_t)N_B * D_MODEL * B_QW * 2);
constexpr size_t WS_IA = al256(WS_WB + (size_t)PT * A_QK * 2);
constexpr size_t WS_GL = al256(WS_IA + (size_t)BATCH * A_HEADS * (SEQ / CHUNK) * 64 * 64 * 2);
constexpr size_t WS_END = al256(WS_GL + (size_t)BATCH * A_HEADS * (SEQ / CHUNK) * 4);
static_assert(WS_END <= ((size_t)256 << 20), "workspace");
constexpr size_t WS_VT = WS_WB, WS_CK = al256(WS_VT + (size_t)NCH * B_KV_HEADS * 64 * 64 * 2), WS_CVT = al256(WS_CK + (size_t)DEC_BATCH * B_KV_HEADS * 128 * 64 * 2);
constexpr size_t WS_BEND = al256(WS_CVT + (size_t)DEC_BATCH * B_KV_HEADS * 128 * 64 * 2), WS_NEED = WS_BEND > WS_END ? WS_BEND : WS_END;
static_assert(WS_NEED <= ((size_t)256 << 20), "workspace (B-layer buffers overlay the A-layer WB | IA | GL region)");

static_assert(N_B == 2, "weight map");

typedef unsigned short bf16;
constexpr int NTHR = 512;

struct Prm {
    const float *x_prompt, *x_sample, *state_delta, *state_conv, *cache_k, *cache_v, *a_w_in, *a_conv_w, *a_log, *a_dt_bias, *a_norm_w, *a_w_out, *a_ln_g, *a_ln_b,
        *b_w_kv, *b_w_in, *b_sinks, *b_w_out, *b_ln_g, *b_ln_b;
    float* out; unsigned char* ws;
};

__device__ __forceinline__ unsigned f2bf(float f) { unsigned u = __builtin_bit_cast(unsigned, f); return (u + 0x7fffu + ((u >> 16) & 1u)) >> 16; }
__device__ __forceinline__ float bf2f(bf16 h) { return __builtin_bit_cast(float, (unsigned)h << 16); }
__device__ __forceinline__ float siluf(float x) { return x / (1.f + expf(-x)); }
__device__ __forceinline__ float sigmoidf_(float x) { return 1.f / (1.f + expf(-x)); }
__device__ __forceinline__ float softplusf_(float x) { return x > 20.f ? x : log1pf(expf(x)); }
__device__ __forceinline__ float wave_sum(float v) {
#pragma unroll
    for (int o = 1; o < 64; o <<= 1) v += __shfl_xor(v, o);
    return v;
}

#ifdef EMU
__device__ __forceinline__ float fast_rcp(float x) { return 1.f / x; }
__device__ __forceinline__ float fast_rsq(float x) { return 1.f / sqrtf(x); }
__device__ __forceinline__ float fast_ex2(float x) { return exp2f(x); }
__device__ __forceinline__ unsigned cvtpk(float lo, float hi) { return f2bf(lo) | (f2bf(hi) << 16); }
__device__ __forceinline__ float dpp_xor1(float v) { return __shfl(v, emu::lane_id() ^ 1); }
__device__ __forceinline__ float dpp_xor2(float v) { return __shfl(v, emu::lane_id() ^ 2); }
__device__ __forceinline__ float dpp_hmirror(float v) { const int l = emu::lane_id(); return __shfl(v, (l & ~7) | (7 - (l & 7))); }
__device__ __forceinline__ float dpp_mirror(float v) { const int l = emu::lane_id(); return __shfl(v, (l & ~15) | (15 - (l & 15))); }
#else
__device__ __forceinline__ float fast_rcp(float x) { return __builtin_amdgcn_rcpf(x); }
__device__ __forceinline__ float fast_rsq(float x) { return __builtin_amdgcn_rsqf(x); }
__device__ __forceinline__ float fast_ex2(float x) { return __builtin_amdgcn_exp2f(x); }
__device__ __forceinline__ unsigned cvtpk(float lo, float hi) { typedef float f2_t __attribute__((ext_vector_type(2))); typedef __bf16 b2_t __attribute__((ext_vector_type(2)));
    f2_t v = {lo, hi}; b2_t b = __builtin_convertvector(v, b2_t); return __builtin_bit_cast(unsigned, b); }
template <int CTRL> __device__ __forceinline__ float dpp_mov(float v) { return __builtin_bit_cast(float, __builtin_amdgcn_update_dpp(0, __builtin_bit_cast(int, v), CTRL, 0xf, 0xf, true)); }
__device__ __forceinline__ float dpp_xor1(float v) { return dpp_mov<0xB1>(v); }
__device__ __forceinline__ float dpp_xor2(float v) { return dpp_mov<0x4E>(v); }
__device__ __forceinline__ float dpp_hmirror(float v) { return dpp_mov<0x141>(v); }
__device__ __forceinline__ float dpp_mirror(float v) { return dpp_mov<0x140>(v); }
#endif
__device__ __forceinline__ float sum8(float v) { v += dpp_xor1(v); v += dpp_xor2(v); v += dpp_hmirror(v); return v; }
__device__ __forceinline__ float sum16(float v) { v = sum8(v); v += dpp_mirror(v); return v; }
__device__ __forceinline__ float fsilu(float x) { return x * fast_rcp(1.f + fast_ex2(-1.4426950408889634f * x)); }
__device__ __forceinline__ float fexp(float x) { return fast_ex2(1.4426950408889634f * x); }
__device__ __forceinline__ float bflo(unsigned u) { return __builtin_bit_cast(float, u << 16); }
__device__ __forceinline__ float bfhi(unsigned u) { return __builtin_bit_cast(float, u & 0xffff0000u); }
__device__ __forceinline__ int seq_row0(int s) { return s < BATCH ? s * SEQ : PT + (s - BATCH) * DEC_SEQ; }
__device__ __forceinline__ int seq_len(int s) { return s < BATCH ? SEQ : DEC_SEQ; }
__device__ __forceinline__ int chunk_row0(int c) { return c < NCP ? c * CHUNK : PT + (c - NCP) * DEC_SEQ; }
__device__ __forceinline__ int chunk_len(int c) { return c < NCP ? CHUNK : DEC_SEQ; }
__device__ __forceinline__ int row_posidx(int row) { return row < PT ? (row % SEQ) : SEQ + ((row - PT) % DEC_SEQ); }

#ifdef EMU
typedef const Prm& PrmRef;
#else
typedef const __attribute__((address_space(4))) Prm& PrmRef;
#endif
struct Ctx { int tid, lane, wave, gtid, gwave, nthreads, nwaves, bid, nblk; };

namespace pg8 {
constexpr int BM = 256, BK = 64, HALF = 128, HTB = HALF * BK * 2  , STAGE_BYTES = 8 * HTB, NXCD = 8, WGM = 8;
__host__ __device__ __forceinline__ int lds_byte(int r, int c) { const int st = (r >> 4) * 2 + (c >> 5), rr = r & 15, cc = c & 31, ob = rr * 64 + cc * 2; return st * 1024 + (ob ^ (((ob >> 9) & 1) << 5)); }
__host__ __device__ __forceinline__ void stage_rc(int b, int& R, int& C) { const int st = b / 1024, sb = b % 1024, swz = sb ^ (((sb >> 9) & 1) << 5); R = (st >> 1) * 16 + swz / 64; C = (st & 1) * 32 + (swz % 64) / 2; }
__host__ __device__ __forceinline__ int perm32(int rho) { const int n = rho >> 4, i = rho & 15; return 8 * (i >> 2) + 4 * n + (i & 3); }
struct Unit { int pm, pn; };
struct Gemm { const bf16* A; int lda; const bf16* Bt; int M, N, K; };
struct StaticOrder {
    int nM, nN, nwg, G, c;
    __host__ __device__ void init(int M, int N, int G_, int c_) { nM = M / BM; nN = N / BM; nwg = nM * nN; G = G_; c = c_; }
    __host__ __device__ bool next(int i, Unit& u) const {
        const long L = (long)i * G + c; if (L >= nwg) return false;
        int wgid = (int)L; { const int q = nwg / NXCD, r = nwg % NXCD, xcd = wgid % NXCD, off = wgid / NXCD; wgid = (xcd < r ? xcd * (q + 1) : r * (q + 1) + (xcd - r) * q) + off; }
        const int nig = WGM * nN, gid = wgid / nig, fm = gid * WGM, gsz = (nM - fm) < WGM ? (nM - fm) : WGM;
        u.pm = fm + ((wgid % nig) % gsz); u.pn = (wgid % nig) / gsz; return true;
    }
};
__device__ __forceinline__ unsigned cvt_pk_bf16(float lo, float hi) {
#ifdef EMU
    return f2bf(lo) | (f2bf(hi) << 16);
#else
    unsigned r; asm volatile("v_cvt_pk_bf16_f32 %0, %1, %2" : "=v"(r) : "v"(lo), "v"(hi)); return r;
#endif
}
struct EpiBf16 {
    static constexpr bool PERM = true;
    bf16* O; int ldc;
    __device__ __forceinline__ void operator()(const f32x4 (&acc)[2][2][4][2], const Unit& u, int wr, int wc, int fr, int fq) const {
        int fr_ = fr, fq_ = fq;
#ifndef EMU
        asm volatile("" : "+v"(fr_), "+v"(fq_));
#endif
        const int row0 = u.pm * BM + wr * 64 + fr_, col0 = u.pn * BM + wc * 32 + 8 * fq_;
#pragma unroll
        for (int ai = 0; ai < 2; ++ai)
#pragma unroll
            for (int m = 0; m < 4; ++m) { bf16* rowp = O + (size_t)(row0 + ai * HALF + m * 16) * ldc + col0;
#pragma unroll
                for (int bj = 0; bj < 2; ++bj) { const f32x4 v0 = acc[ai][bj][m][0], v1 = acc[ai][bj][m][1];
                    u32x4 w; w.x = cvt_pk_bf16(v0[0], v0[1]); w.y = cvt_pk_bf16(v0[2], v0[3]); w.z = cvt_pk_bf16(v1[0], v1[1]); w.w = cvt_pk_bf16(v1[2], v1[3]);
                    *(u32x4*)(rowp + bj * HALF) = w; } }
    }
};
struct EpiAIn {
    static constexpr bool PERM = true;
    bf16* O; int ldc; bf16* HALO; float* pconv;
    __device__ __forceinline__ void operator()(const f32x4 (&acc)[2][2][4][2], const Unit& u, int wr, int wc, int fr, int fq) const {
        int fr_ = fr, fq_ = fq;
#ifndef EMU
        asm volatile("" : "+v"(fr_), "+v"(fq_));
#endif
        const int row0 = u.pm * BM + wr * 64 + fr_, col0 = u.pn * BM + wc * 32 + 8 * fq_;
#pragma unroll
        for (int ai = 0; ai < 2; ++ai)
#pragma unroll
            for (int m = 0; m < 4; ++m) { const int row = row0 + ai * HALF + m * 16; bf16* rowp = O + (size_t)row * ldc + col0;
#pragma unroll
                for (int bj = 0; bj < 2; ++bj) { const f32x4 v0 = acc[ai][bj][m][0], v1 = acc[ai][bj][m][1];
                    u32x4 w; w.x = cvt_pk_bf16(v0[0], v0[1]); w.y = cvt_pk_bf16(v0[2], v0[3]); w.z = cvt_pk_bf16(v1[0], v1[1]); w.w = cvt_pk_bf16(v1[2], v1[3]);
                    *(u32x4*)(rowp + bj * HALF) = w;
                    if (m == 3 && fr_ >= 13 && col0 + bj * HALF < CONV_DIM) {
                        const int ck = row >> 6, hr = fr_ - 13, col = col0 + bj * HALF;
                        *(u32x4*)(HALO + ((size_t)ck * 3 + hr) * CONV_DIM + col) = w;
                        if (ck % NCPS == NCPS - 1) { float* dst = pconv + ((size_t)(ck / NCPS) * 3 + hr) * CONV_DIM + col; *(f32x4*)dst = v0; *(f32x4*)(dst + 4) = v1; }
                    } } }
    }
};
struct EpiBIn {
    static constexpr bool PERM = true;
    bf16* O; int ldc; const float* rope; bf16* VT;
    __device__ __forceinline__ void operator()(const f32x4 (&acc)[2][2][4][2], const Unit& u, int wr, int wc, int fr, int fq) const {
        int fr_ = fr, fq_ = fq;
#ifndef EMU
        asm volatile("" : "+v"(fr_), "+v"(fq_));
#endif
        static_assert(B_QW % 128 == 0 && B_KVW % 128 == 0, "a 128-column half tile has one kind");
        const int ct = u.pn * BM;
        int kinds[2]; bool ropes[2];
#pragma unroll
        for (int bj = 0; bj < 2; ++bj) { const int cc = ct + bj * HALF; kinds[bj] = cc < B_QW ? 0 : cc < B_IN ? 1 : cc < B_IN + B_KVW ? 2 : 3;
            ropes[bj] = (kinds[bj] == 0 || kinds[bj] == 2) && (wc & 1) == 0; }
        const int row0 = u.pm * BM + wr * 64 + fr_, col0 = ct + wc * 32 + 8 * fq_;
#pragma unroll
        for (int ai = 0; ai < 2; ++ai)
#pragma unroll
            for (int m = 0; m < 4; ++m) { const int row = row0 + ai * HALF + m * 16; bf16* rowp = O + (size_t)row * ldc + col0;
                f32x4 cs[4];
                if (ropes[0] || ropes[1]) { const f32x4* rp = (const f32x4*)(rope + (size_t)(row % SEQ) * ROPE_HALF * 2);
#pragma unroll
                    for (int q4 = 0; q4 < 4; ++q4) cs[q4] = rp[q4]; }
#pragma unroll
                for (int bj = 0; bj < 2; ++bj) { f32x4 v0 = acc[ai][bj][m][0], v1 = acc[ai][bj][m][1]; const int kind = kinds[bj]; const float sc = kind == 0 ? 0.125f : 1.f;
                    if (ropes[bj]) {
                        float x[8] = {v0[0], v0[1], v0[2], v0[3], v1[0], v1[1], v1[2], v1[3]}, o[8];
#pragma unroll
                        for (int j = 0; j < 8; ++j) o[j] = __shfl_xor(x[j], 16);
                        if (fq_ < 2) {
#pragma unroll
                            for (int j = 0; j < 8; ++j) { const float c_ = cs[j >> 1][2 * (j & 1)], s_ = cs[j >> 1][2 * (j & 1) + 1]; x[j] = fq_ == 0 ? x[j] * c_ - o[j] * s_ : x[j] * c_ + o[j] * s_; }
                        }
                        v0 = (f32x4){x[0], x[1], x[2], x[3]}; v1 = (f32x4){x[4], x[5], x[6], x[7]};
                    }
                    v0 = v0 * sc; v1 = v1 * sc;
                    u32x4 w; w.x = cvt_pk_bf16(v0[0], v0[1]); w.y = cvt_pk_bf16(v0[2], v0[3]); w.z = cvt_pk_bf16(v1[0], v1[1]); w.w = cvt_pk_bf16(v1[2], v1[3]);
                    *(u32x4*)(rowp + bj * HALF) = w;
                    if (kind == 3) { const int dd = col0 + bj * HALF - (B_IN + B_KVW), kvh = dd / B_HD, d = dd % B_HD; bf16* vt = VT + (((size_t)(row >> 6) * B_KV_HEADS + kvh) * B_HD + d) * 64 + (row & 63);
                        vt[0] = (bf16)(w.x & 0xffffu); vt[64] = (bf16)(w.x >> 16); vt[128] = (bf16)(w.y & 0xffffu); vt[192] = (bf16)(w.y >> 16);
                        vt[256] = (bf16)(w.z & 0xffffu); vt[320] = (bf16)(w.z >> 16); vt[384] = (bf16)(w.w & 0xffffu); vt[448] = (bf16)(w.w >> 16); }
                } }
    }
};
template <class Epi, class Sched, bool ALIGN_EPI>
__device__ __forceinline__ void gemm_phase(LAS unsigned char* lds, const Gemm g, const Sched& S, const Epi& E, const int tid) {
    const int wid = READFIRSTLANE(tid >> 6), lane = tid & 63, wr = wid >> 2, wc = wid & 3, fr = lane & 15, fq = lane >> 4;
    const int K = g.K, nt = K / BK;
    unsigned voffA[2], voffB[2];
#pragma unroll
    for (int i = 0; i < 2; ++i) { int R, C; stage_rc(tid * 16 + i * 8192, R, C); const int Rb = Epi::PERM ? ((R & ~31) + perm32(R & 31)) : R;
        voffA[i] = (unsigned)(R * g.lda + C) * 2u; voffB[i] = (unsigned)(Rb * K + C) * 2u; }
    const size_t kstep = (size_t)(BK * 2);
    const size_t hstepA = (size_t)HALF * g.lda * 2, hstepB = (size_t)HALF * K * 2;
    const size_t tstepA = 2 * hstepA, tstepB = 2 * hstepB;
    const unsigned ldsw = (unsigned)wid * 1024u;
    const int aoff = lds_byte(wr * 64 + fr, fq * 8), boff = lds_byte(wc * 32 + fr, fq * 8);
#define PG8_SA(b, h) (((b) * 2 + (h)) * HTB)
#define PG8_SB(b, h) ((4 + (b) * 2 + (h)) * HTB)
#define PG8_STAGE(bufoff, gbase, voff) do { _Pragma("unroll") for (int _i = 0; _i < 2; ++_i) \
        GLDS16((const char*)(gbase) + (voff)[_i], lds + (bufoff) + ldsw + _i * 8192); } while (0)
#define PG8_LDA(dst, b, h) do { _Pragma("unroll") for (int m = 0; m < 4; ++m) _Pragma("unroll") for (int k = 0; k < 2; ++k) dst[m][k] = *(const LAS bf16x8*)(lds + PG8_SA(b, h) + aoff + m * 2048 + k * 1024); } while (0)
#define PG8_LDB(dst, b, h) do { _Pragma("unroll") for (int n = 0; n < 2; ++n) _Pragma("unroll") for (int k = 0; k < 2; ++k) dst[n][k] = *(const LAS bf16x8*)(lds + PG8_SB(b, h) + boff + n * 2048 + k * 1024); } while (0)
#define PG8_MMA(ai, bj, At, Bt) do { SETPRIO(1); _Pragma("unroll") for (int m = 0; m < 4; ++m) _Pragma("unroll") for (int n = 0; n < 2; ++n) _Pragma("unroll") for (int k = 0; k < 2; ++k) \
        acc[ai][bj][m][n] = MFMA16(Bt[n][k], At[m][k], acc[ai][bj][m][n]); SETPRIO(0); } while (0)
    Unit cur, nxt; int ui = 0;
    if (!S.next(0, cur)) return;
    f32x4 acc[2][2][4][2];
#pragma unroll
    for (int a = 0; a < 2; ++a)
#pragma unroll
        for (int b = 0; b < 2; ++b)
#pragma unroll
            for (int m = 0; m < 4; ++m)
#pragma unroll
                for (int n = 0; n < 2; ++n) acc[a][b][m][n] = (f32x4){0.f, 0.f, 0.f, 0.f};
    bf16x8 At[4][2], B0[2][2], B1[2][2];
    const char* cA = (const char*)g.A + (size_t)cur.pm * tstepA; const char* cB = (const char*)g.Bt + (size_t)cur.pn * tstepB;
    PG8_STAGE(PG8_SB(0, 0), cB, voffB); PG8_STAGE(PG8_SB(0, 1), cB + hstepB, voffB); PG8_STAGE(PG8_SA(0, 0), cA, voffA); PG8_STAGE(PG8_SA(0, 1), cA + hstepA, voffA);
    if (wr == 1) S_BARRIER();
    WAIT_VM(2); S_BARRIER();
    PG8_STAGE(PG8_SB(1, 0), cB + kstep, voffB); PG8_STAGE(PG8_SA(1, 0), cA + kstep, voffA); PG8_STAGE(PG8_SB(1, 1), cB + hstepB + kstep, voffB);
    WAIT_VM(6); S_BARRIER();
    for (;;) {
        const bool has_next = S.next(ui + 1, nxt);
        const char* nA = has_next ? (const char*)g.A + (size_t)nxt.pm * tstepA : cA; const char* nB = has_next ? (const char*)g.Bt + (size_t)nxt.pn * tstepB : cB;
        for (int t = 0; t < nt; t += 2) {
            const bool last = (t == nt - 2);
            const char* a1 = cA + (size_t)(t + 1) * kstep;
            const char* a2 = last ? nA : cA + (size_t)(t + 2) * kstep; const char* b2 = last ? nB : cB + (size_t)(t + 2) * kstep;
            const char* a3 = a2 + kstep; const char* b3 = b2 + kstep;
            PG8_LDB(B0, 0, 0); PG8_LDB(B1, 0, 1); SCHED_BARRIER(); PG8_LDA(At, 0, 0); PG8_STAGE(PG8_SA(1, 1), a1 + hstepA, voffA);
            WAIT_VM(8); WAIT_LGKM(0); S_BARRIER(); PG8_MMA(0, 0, At, B0); PG8_MMA(0, 1, At, B1); S_BARRIER(); SCHED_BARRIER();
            PG8_LDA(At, 0, 1); PG8_STAGE(PG8_SB(0, 0), b2, voffB); PG8_STAGE(PG8_SB(0, 1), b2 + hstepB, voffB); PG8_STAGE(PG8_SA(0, 0), a2, voffA);
            WAIT_VM(8); WAIT_LGKM(0); S_BARRIER(); PG8_MMA(1, 0, At, B0); PG8_MMA(1, 1, At, B1); S_BARRIER(); SCHED_BARRIER();
            PG8_LDB(B0, 1, 0); PG8_LDB(B1, 1, 1); SCHED_BARRIER(); PG8_LDA(At, 1, 0); PG8_STAGE(PG8_SA(0, 1), a2 + hstepA, voffA);
            WAIT_VM(8); WAIT_LGKM(0); S_BARRIER(); PG8_MMA(0, 0, At, B0); PG8_MMA(0, 1, At, B1); S_BARRIER(); SCHED_BARRIER();
            PG8_LDA(At, 1, 1); PG8_STAGE(PG8_SB(1, 0), b3, voffB); PG8_STAGE(PG8_SB(1, 1), b3 + hstepB, voffB); PG8_STAGE(PG8_SA(1, 0), a3, voffA);
            WAIT_VM(8); WAIT_LGKM(0); S_BARRIER(); PG8_MMA(1, 0, At, B0); PG8_MMA(1, 1, At, B1); S_BARRIER(); SCHED_BARRIER();
        }
        if constexpr (ALIGN_EPI) { if (wr == 0) S_BARRIER(); }
        E(acc, cur, wr, wc, fr, fq);
        if (!has_next) break;
#pragma unroll
        for (int a = 0; a < 2; ++a)
#pragma unroll
            for (int b = 0; b < 2; ++b)
#pragma unroll
                for (int m = 0; m < 4; ++m)
#pragma unroll
                    for (int n = 0; n < 2; ++n) acc[a][b][m][n] = (f32x4){0.f, 0.f, 0.f, 0.f};
        cur = nxt; cA = nA; cB = nB; ++ui;
        if constexpr (ALIGN_EPI) { if (wr == 1) S_BARRIER(); }
    }
    WAIT_VM(0);
    if constexpr (!ALIGN_EPI) { if (wr == 0) S_BARRIER(); }
    S_BARRIER();
#undef PG8_SA
#undef PG8_SB
#undef PG8_STAGE
#undef PG8_LDA
#undef PG8_LDB
#undef PG8_MMA
}
}
__device__ __forceinline__ void gemm_mfma(const bf16* A, int lda, const bf16* Bt, bf16* C, int ldc, int M, int N, int K, const Ctx& c, unsigned char* lds) {
    pg8::Gemm g{A, lda, Bt, M, N, K}; pg8::StaticOrder S; S.init(M, N, c.nblk, c.bid); pg8::EpiBf16 E{C, ldc};
    __syncthreads();
    pg8::gemm_phase<pg8::EpiBf16, pg8::StaticOrder, true>((LAS unsigned char*)lds, g, S, E, c.tid);
    __syncthreads();
}
__device__ __forceinline__ void transpose_item(const float* W, int ldw, int K, int N, bf16* WT, int row_off, float* scr, int item, int lane) {
    const int nblk = N / 64, kb = item / nblk, nb = item % nblk, k0 = 64 * kb, n0 = 64 * nb;
#pragma unroll 8
    for (int kk = 0; kk < 64; ++kk) scr[kk * 65 + lane] = W[(size_t)(k0 + kk) * ldw + n0 + lane];
    WAVE_SYNC();
    const int cc = lane & 7;
#pragma unroll
    for (int j = 0; j < 8; ++j) { const int n = (lane >> 3) + 8 * j; const float* sp = scr + (8 * cc) * 65 + n;
        u32x4 o; o.x = cvtpk(sp[0 * 65], sp[1 * 65]); o.y = cvtpk(sp[2 * 65], sp[3 * 65]); o.z = cvtpk(sp[4 * 65], sp[5 * 65]); o.w = cvtpk(sp[6 * 65], sp[7 * 65]);
        *(u32x4*)(WT + (size_t)(row_off + n0 + n) * K + k0 + 8 * cc) = o; }
    WAVE_SYNC();
}
constexpr int WI_AIN = (D_MODEL / 64) * (A_MAIN / 64), WI_AOUT = (A_VW / 64) * (D_MODEL / 64), WI_BIN = (D_MODEL / 64) * (B_IN / 64), WI_BKV = (D_MODEL / 64) * (2 * B_KVW / 64), WI_BOUT = (B_QW / 64) * (D_MODEL / 64);
constexpr int WI_A_END = N_A * (WI_AIN + WI_AOUT), WI_ALL = WI_A_END + N_B * (WI_BIN + WI_BOUT) + WI_BKV;
__device__ __forceinline__ void weights_range(PrmRef p, int lane, int wave, unsigned char* lds, int vw, int nvw, int lo, int hi) {
    float* scr = (float*)lds + wave * (64 * 65);
    bf16* WAIN = (bf16*)(p.ws + WS_WAIN); bf16* WAOUT = (bf16*)(p.ws + WS_WAOUT); bf16* WBIN = (bf16*)(p.ws + WS_WBIN); bf16* WBOUT = (bf16*)(p.ws + WS_WBOUT);
    for (int it = lo + vw; it < hi; it += nvw) {
        int r = it;
        if (r < N_A * WI_AIN) { const int li = r / WI_AIN; transpose_item(p.a_w_in + (size_t)li * D_MODEL * A_IN, A_IN, D_MODEL, A_MAIN, WAIN + (size_t)li * A_NG * D_MODEL, 0, scr, r % WI_AIN, lane); continue; } r -= N_A * WI_AIN;
        if (r < N_A * WI_AOUT) { const int li = r / WI_AOUT; transpose_item(p.a_w_out + (size_t)li * A_VW * D_MODEL, D_MODEL, A_VW, D_MODEL, WAOUT + (size_t)li * D_MODEL * A_VW, 0, scr, r % WI_AOUT, lane); continue; } r -= N_A * WI_AOUT;
        if (r < N_B * WI_BIN) { const int lj = r / WI_BIN; transpose_item(p.b_w_in + (size_t)lj * D_MODEL * B_IN, B_IN, D_MODEL, B_IN, WBIN + (size_t)lj * B_N0 * D_MODEL, 0, scr, r % WI_BIN, lane); continue; } r -= N_B * WI_BIN;
        if (r < N_B * WI_BOUT) { const int lj = r / WI_BOUT; transpose_item(p.b_w_out + (size_t)lj * B_QW * D_MODEL, D_MODEL, B_QW, D_MODEL, WBOUT + (size_t)lj * D_MODEL * B_QW, 0, scr, r % WI_BOUT, lane); continue; } r -= N_B * WI_BOUT;
        transpose_item(p.b_w_kv, 2 * B_KVW, D_MODEL, 2 * B_KVW, WBIN, B_IN, scr, r, lane);
    }
}
__device__ __forceinline__ void ph_weights(PrmRef p, const Ctx& c, unsigned char* lds) {
    weights_range(p, c.lane, c.wave, lds, c.gwave, c.nwaves, 0, WI_AIN);
    bf16* WAIN = (bf16*)(p.ws + WS_WAIN);
    for (int it = c.gtid; it < N_A * 256 * D_MODEL; it += c.nthreads) {
        const int k = it % D_MODEL, j = (it / D_MODEL) % 256, li = it / (256 * D_MODEL);
        WAIN[((size_t)li * A_NG + A_MAIN + j) * D_MODEL + k] = j < 2 * A_HEADS ? (bf16)f2bf(p.a_w_in[((size_t)li * D_MODEL + k) * A_IN + A_MAIN + j]) : (bf16)0;
    }
}
__device__ __forceinline__ void weights_deferred(PrmRef p, const Ctx& c, int li, unsigned char* lds, int vw, int nvw) {
    static_assert(N_A == 2, "deferred weight conversion schedule");
    if (li == 0) weights_range(p, c.lane, c.wave, lds, vw, nvw, WI_AIN, WI_A_END); else weights_range(p, c.lane, c.wave, lds, vw, nvw, WI_A_END, WI_ALL);
}

__device__ __forceinline__ void ph_init(PrmRef p, const Ctx& c) {
    bf16* XB = (bf16*)(p.ws + WS_XB);
    for (size_t i8 = c.gtid; i8 < (size_t)MT * D_MODEL / 8; i8 += c.nthreads) {
        const size_t i = i8 * 8; const float* src = i < (size_t)PT * D_MODEL ? p.x_prompt + i : p.x_sample + (i - (size_t)PT * D_MODEL);
        const f32x4 a = *(const f32x4*)src, b = *(const f32x4*)(src + 4);
        u32x4 o; o.x = cvtpk(a[0], a[1]); o.y = cvtpk(a[2], a[3]); o.z = cvtpk(b[0], b[1]); o.w = cvtpk(b[2], b[3]);
        *(u32x4*)(XB + i) = o;
    }
    float* rope = (float*)(p.ws + WS_ROPE);
    for (int i = c.gtid; i < (SEQ + DEC_SEQ) * ROPE_HALF; i += c.nthreads) {
        const int pi = i / ROPE_HALF, f = i % ROPE_HALF; const float pos = pi < SEQ ? (float)pi : (float)(PAST_LEN + pi - SEQ);
        const float inv = f == 0 ? 1.0f : f == 1 ? 0.1939227432012558f : f == 2 ? 0.03760603070259094f : f == 3 ? 0.007292664609849453f : f == 4 ? 0.0014142135623842478f
                        : f == 5 ? 0.00027424818836152554f : f == 6 ? 5.3182957344688475e-05f : 1.0313385246263351e-05f;
        const float ang = pos * inv;
        rope[2 * i] = cosf(ang); rope[2 * i + 1] = sinf(ang);
    }
}

constexpr int SG_PITCH = 528, SG_A = 0, SG_B = 64 * SG_PITCH;
template <bool GATES, bool BMODE = false> __device__ __forceinline__ void sgemm_tile(PrmRef p, int li, const bf16* A, int lda, const bf16* Bt, int K, bf16* C, int ldc, int row0, int col0, int tid, unsigned char* lds) {
    const int lane = tid & 63, wave = tid >> 6, r = lane & 15, g = lane >> 4;
    u32x4 ra[4], rb[4];
#define SG_LOAD(kc) do { _Pragma("unroll") for (int j = 0; j < 4; ++j) { const int idx = tid + 512 * j, row = idx >> 5, pc = idx & 31; \
        ra[j] = *(const u32x4*)(A + (size_t)(row0 + row) * lda + (kc) + pc * 8); rb[j] = *(const u32x4*)(Bt + (size_t)(col0 + row) * K + (kc) + pc * 8); } } while (0)
    SG_LOAD(0);
    f32x4 acc0 = (f32x4){0.f, 0.f, 0.f, 0.f}, acc1 = acc0;
    for (int kc = 0; kc < K; kc += 256) {
        LBAR();
#pragma unroll
        for (int j = 0; j < 4; ++j) { const int idx = tid + 512 * j, row = idx >> 5, pc = idx & 31;
            *(u32x4*)(lds + SG_A + row * SG_PITCH + pc * 16) = ra[j]; *(u32x4*)(lds + SG_B + row * SG_PITCH + pc * 16) = rb[j]; }
        if (kc + 256 < K) SG_LOAD(kc + 256);
        LBAR();
        const unsigned char* ap = lds + SG_A + (16 * (wave & 3) + r) * SG_PITCH + 16 * g;
        const unsigned char* bp = lds + SG_B + (32 * (wave >> 2) + r) * SG_PITCH + 16 * g;
#pragma unroll
        for (int ks = 0; ks < 8; ++ks) {
            const bf16x8 a = *(const bf16x8*)(ap + 64 * ks), b0 = *(const bf16x8*)(bp + 64 * ks), b1 = *(const bf16x8*)(bp + 16 * SG_PITCH + 64 * ks);
            acc0 = MFMA16(a, b0, acc0); acc1 = MFMA16(a, b1, acc1);
        }
    }
#undef SG_LOAD
    if (!GATES) {
        if (BMODE) {
            const int kind = col0 < B_QW ? 0 : col0 < B_IN ? 1 : col0 < B_IN + B_KVW ? 2 : 3, rowb = row0 + 16 * (wave & 3) + 4 * g;
            if ((kind == 0 || kind == 2) && wave < 4) {
                const float* rope = (const float*)(p.ws + WS_ROPE);
#pragma unroll
                for (int e = 0; e < 4; ++e) { const float x = acc0[e], o = __shfl_xor(x, 8); const float* rp = rope + ((size_t)(SEQ + (rowb + e - PT) % DEC_SEQ) * ROPE_HALF + (r & 7)) * 2;
                    acc0[e] = r < 8 ? x * rp[0] - o * rp[1] : x * rp[0] + o * rp[1]; }
            }
            if (kind == 0) { acc0 = acc0 * 0.125f; acc1 = acc1 * 0.125f; }
            if (kind == 3) { bf16* VT = (bf16*)(p.ws + WS_VT); const int kvh = (col0 - (B_IN + B_KVW)) / B_HD, d = 32 * (wave >> 2) + r;
#pragma unroll
                for (int e = 0; e < 4; ++e) { const int srow = rowb + e - PT, ck = NCP + srow / DEC_SEQ, key = srow % DEC_SEQ;
                    VT[(((size_t)ck * B_KV_HEADS + kvh) * B_HD + d) * 64 + key] = (bf16)(cvtpk(acc0[e], 0.f) & 0xffffu); VT[(((size_t)ck * B_KV_HEADS + kvh) * B_HD + d + 16) * 64 + key] = (bf16)(cvtpk(acc1[e], 0.f) & 0xffffu); } }
        }
        bf16* cp = C + (size_t)(row0 + 16 * (wave & 3) + 4 * g) * ldc + col0 + 32 * (wave >> 2) + r;
#pragma unroll
        for (int e = 0; e < 4; ++e) { cp[(size_t)e * ldc] = (bf16)(cvtpk(acc0[e], 0.f) & 0xffffu); cp[(size_t)e * ldc + 16] = (bf16)(cvtpk(acc1[e], 0.f) & 0xffffu); }
    } else if (wave < 4) {
        static_assert(2 * A_HEADS <= 16, "gate columns");
        float* GB = (float*)(p.ws + WS_GB); const int col = r, rowb = row0 + 16 * wave + 4 * g;
        if (col < A_HEADS) { const float al = -expf(p.a_log[li * A_HEADS + col]), db = p.a_dt_bias[li * A_HEADS + col];
#pragma unroll
            for (int e = 0; e < 4; ++e) GB[((size_t)(rowb + e) * A_HEADS + col) * 2] = al * softplusf_(acc0[e] + db); }
        else if (col < 2 * A_HEADS) {
#pragma unroll
            for (int e = 0; e < 4; ++e) GB[((size_t)(rowb + e) * A_HEADS + (col - A_HEADS)) * 2 + 1] = sigmoidf_(acc0[e]); }
    }
}
template <bool BMODE = false> __device__ __forceinline__ void sgemm_rows(PrmRef p, const bf16* A, int lda, const bf16* Bt, int K, bf16* C, int ldc, int row_begin, int nrows, int N, const Ctx& c, int first_wg, unsigned char* lds, bool only_tail = false) {
    const int tn = N / 64, nt = (nrows / 64) * tn;
    const int f = first_wg % c.nblk, np = (only_tail && f > 0) ? c.nblk - f : c.nblk;
    const int v = only_tail && f > 0 ? c.bid - f : (c.bid + c.nblk - f) % c.nblk;
    if (v >= 0) for (int it = v; it < nt; it += np) sgemm_tile<false, BMODE>(p, 0, A, lda, Bt, K, C, ldc, row_begin + (it / tn) * 64, (it % tn) * 64, c.tid, lds);
    LBAR();
}
__device__ __forceinline__ void ph_a_gemm(PrmRef p, const Ctx& c, int li, unsigned char* lds) {
    const bf16* XB = (const bf16*)(p.ws + WS_XB); bf16* PROJ = (bf16*)(p.ws + WS_PROJ); const bf16* Wt = (const bf16*)(p.ws + WS_WAIN) + (size_t)li * A_NG * D_MODEL;
    pg8::Gemm g{XB, D_MODEL, Wt, PT, A_MAIN, D_MODEL}; pg8::StaticOrder S; S.init(PT, A_MAIN, c.nblk, c.bid);
    pg8::EpiAIn E{PROJ, PLD, (bf16*)(p.ws + WS_HALO), p.out + O_PCONV + (size_t)li * BATCH * 3 * CONV_DIM};
    __syncthreads();
    pg8::gemm_phase<pg8::EpiAIn, pg8::StaticOrder, true>((LAS unsigned char*)lds, g, S, E, c.tid);
    __syncthreads();
    for (int it = c.bid; it < MT / 64; it += c.nblk) sgemm_tile<true>(p, li, XB, D_MODEL, Wt, D_MODEL, nullptr, 0, it * 64, A_MAIN, c.tid, lds);
    sgemm_rows(p, XB, D_MODEL, Wt, D_MODEL, PROJ, PLD, PT, ST, A_MAIN, c, MT / 64, lds);
}
constexpr int NPG = BATCH * A_HEADS, NSG = DEC_BATCH * A_HEADS, NPI = NPG * NCPS;
__device__ __forceinline__ unsigned pk2bf(float lo, float hi) { return cvtpk(lo, hi); }
constexpr int PP_KN = 0, PP_QN = 17408, PP_KF = 34816, PP_VF = 67584, PP_GC = 100352, PP_LN = 102400, PP_LNP = 68, PP_TI = PP_LN + 64 * PP_LNP * 4, PP_WST = PP_TI + 4 * 16 * 17 * 4, PP_CW = PP_WST + 17408, PP_END = PP_CW + 3 * 4 * 128 * 4;
static_assert(PP_END <= 163840 - 64 && PP_TI % 16 == 0 && PP_WST % 16 == 0 && PP_CW % 16 == 0, "prepass LDS");
typedef u32x4 RawTile[3][4][2];
__device__ __forceinline__ void prepass_load_raw(PrmRef p, int item, int tid, RawTile& xr) {
    const bf16* PROJ = (const bf16*)(p.ws + WS_PROJ); const bf16* HALO = (const bf16*)(p.ws + WS_HALO);
    const int n = item % NCPS, grp = item / NCPS, h = grp % A_HEADS, s = grp / A_HEADS, R0 = s * SEQ + n * CHUNK, r = tid >> 3, seg = tid & 7;
#pragma unroll
    for (int X = 0; X < 3; ++X) {
        const int cb = X * A_QK + h * A_DK + 16 * seg;
#pragma unroll
        for (int j = 0; j < 4; ++j) {
            const int rr = r - 3 + j;
            if (rr >= 0) { const u32x4* src = (const u32x4*)(PROJ + (size_t)(R0 + rr) * PLD + cb); xr[X][j][0] = src[0]; xr[X][j][1] = src[1]; }
            else if (n > 0) { const u32x4* src = (const u32x4*)(HALO + ((size_t)(s * NCPS + n - 1) * 3 + (3 + rr)) * CONV_DIM + cb); xr[X][j][0] = src[0]; xr[X][j][1] = src[1]; }
            else { xr[X][j][0] = (u32x4){0u, 0u, 0u, 0u}; xr[X][j][1] = xr[X][j][0]; }
        }
    }
}
__device__ __forceinline__ void prepass_gcum(PrmRef p, int item, int lane, float* GC) {
    const float* GB = (const float*)(p.ws + WS_GB); float* GL = (float*)(p.ws + WS_GL);
    const int n = item % NCPS, grp = item / NCPS, h = grp % A_HEADS, s = grp / A_HEADS, R0 = s * SEQ + n * CHUNK;
    const float g = GB[((size_t)(R0 + lane) * A_HEADS + h) * 2], bt = GB[((size_t)(R0 + lane) * A_HEADS + h) * 2 + 1];
    float cs = g;
#pragma unroll
    for (int d = 1; d < 64; d <<= 1) { const float o = __shfl(cs, lane >= d ? lane - d : lane); if (lane >= d) cs += o; }
    const float gl = __shfl(cs, 63);
    GC[lane] = cs; GC[64 + lane] = bt; GC[128 + lane] = fexp(cs); GC[192 + lane] = fexp(gl - cs);
    if (lane == 0) GL[item] = fexp(gl);
}
__device__ __forceinline__ void prepass_store_w(PrmRef p, int item, int tid, const unsigned char* lds) {
    bf16* WB = (bf16*)(p.ws + WS_WB); const bf16* WST = (const bf16*)(lds + PP_WST);
    const int n = item % NCPS, grp = item / NCPS, h = grp % A_HEADS, s = grp / A_HEADS, R0 = s * SEQ + n * CHUNK, r = tid >> 3, seg = tid & 7;
    const u32x4 w0 = *(const u32x4*)(WST + r * 136 + 16 * seg), w1 = *(const u32x4*)(WST + r * 136 + 16 * seg + 8);
    u32x4* dst = (u32x4*)(WB + (size_t)(R0 + r) * A_QK + h * A_DK + 16 * seg); dst[0] = w0; dst[1] = w1;
}
template <int VAR = 0> __device__ __forceinline__ void delta_prepass_item(PrmRef p, int li, int item, int next_item, int prev_item, int pb, int tid, unsigned char* lds, RawTile& xr) {
#ifndef EMU
    asm volatile("" : "+v"(tid));
#endif
    bf16* PROJ = (bf16*)(p.ws + WS_PROJ); bf16* IA = (bf16*)(p.ws + WS_IA);
    const int n = item % NCPS, grp = item / NCPS, h = grp % A_HEADS, s = grp / A_HEADS;
    const int R0 = s * SEQ + n * CHUNK, lane = tid & 63, wave = READFIRSTLANE(tid >> 6);
    bf16* KN = (bf16*)(lds + PP_KN); bf16* QN = (bf16*)(lds + PP_QN); float* KF = (float*)(lds + PP_KF); float* VF = (float*)(lds + PP_VF);
    float* GC = (float*)(lds + PP_GC) + pb * 256; float* BT = GC + 64; float* EG = GC + 128; float* KD = GC + 192;
    float* LN = (float*)(lds + PP_LN);
    float* TI = (float*)(lds + PP_TI);
    bf16* WST = (bf16*)(lds + PP_WST);
    if (prev_item >= 0) prepass_store_w(p, prev_item, tid, lds);
    const int r = tid >> 3, seg = tid & 7;
    float qf[16];
#pragma unroll
    for (int X = 0; X < 3; ++X) {
        const int cb = X * A_QK + h * A_DK + 16 * seg;
        float acc[16];
#pragma unroll
        for (int e = 0; e < 16; ++e) acc[e] = 0.f;
#pragma unroll
        for (int j = 0; j < 4; ++j) {
            const f32x4* wp = (const f32x4*)(lds + PP_CW) + ((X * 4 + j) * 128 + 16 * seg) / 4;
#pragma unroll
            for (int e = 0; e < 4; ++e) {
                const f32x4 w4 = wp[e]; const unsigned a = xr[X][j][e >> 1][2 * (e & 1)], b = xr[X][j][e >> 1][2 * (e & 1) + 1];
                acc[4 * e] += w4[0] * bflo(a); acc[4 * e + 1] += w4[1] * bfhi(a); acc[4 * e + 2] += w4[2] * bflo(b); acc[4 * e + 3] += w4[3] * bfhi(b);
            }
        }
        float ss = 0.f;
#pragma unroll
        for (int e = 0; e < 16; ++e) { acc[e] = fsilu(acc[e]); ss += acc[e] * acc[e]; }
        if (X < 2) {
            ss = sum8(ss);
            const float rs = fast_rsq(ss + RMS_EPS) * (X == 0 ? 0.08838834764831845f : 1.f);
#pragma unroll
            for (int e = 0; e < 16; ++e) acc[e] *= rs;
        }
        if (X == 0) {
#pragma unroll
            for (int e = 0; e < 16; ++e) qf[e] = acc[e];
            u32x4 o0, o1;
#pragma unroll
            for (int e = 0; e < 4; ++e) { o0[e] = cvtpk(acc[2 * e], acc[2 * e + 1]); o1[e] = cvtpk(acc[8 + 2 * e], acc[8 + 2 * e + 1]); }
            *(u32x4*)(QN + r * 136 + 16 * seg) = o0; *(u32x4*)(QN + r * 136 + 16 * seg + 8) = o1;
        } else if (X == 1) {
            u32x4 o0, o1;
#pragma unroll
            for (int e = 0; e < 4; ++e) { o0[e] = cvtpk(acc[2 * e], acc[2 * e + 1]); o1[e] = cvtpk(acc[8 + 2 * e], acc[8 + 2 * e + 1]); }
            *(u32x4*)(KN + r * 136 + 16 * seg) = o0; *(u32x4*)(KN + r * 136 + 16 * seg + 8) = o1;
#pragma unroll
            for (int e = 0; e < 4; ++e) *(f32x4*)(KF + r * 128 + 16 * seg + 4 * e) = (f32x4){acc[4 * e], acc[4 * e + 1], acc[4 * e + 2], acc[4 * e + 3]};
        } else {
#pragma unroll
            for (int e = 0; e < 4; ++e) *(f32x4*)(VF + r * 128 + 16 * seg + 4 * e) = (f32x4){acc[4 * e], acc[4 * e + 1], acc[4 * e + 2], acc[4 * e + 3]};
        }
    }
    LBAR();
    if (next_item >= 0) prepass_load_raw(p, next_item, tid, xr);
    {
        const float eg = EG[r]; u32x4 o0, o1;
#pragma unroll
        for (int e = 0; e < 4; ++e) { o0[e] = cvtpk(qf[2 * e] * eg, qf[2 * e + 1] * eg); o1[e] = cvtpk(qf[8 + 2 * e] * eg, qf[8 + 2 * e + 1] * eg); }
        u32x4* dst = (u32x4*)(PROJ + (size_t)(R0 + r) * PLD + h * A_DK + 16 * seg); dst[0] = o0; dst[1] = o1;
    }
    if (VAR != 4) {
        const int kind = wave >> 2, ti = (wave >> 1) & 1, tj = wave & 1, l31 = lane & 31, hi = lane >> 5;
        if (wave == 1) {
            if (next_item >= 0) prepass_gcum(p, next_item, lane, (float*)(lds + PP_GC) + (pb ^ 1) * 256);
#pragma unroll
            for (int e = 0; e < 16; ++e) LN[((e & 3) + 8 * (e >> 2) + 4 * hi) * PP_LNP + 32 + l31] = 0.f;
        } else {
            f32x16 acc;
#pragma unroll
            for (int e = 0; e < 16; ++e) acc[e] = 0.f;
            const unsigned char* ap = (const unsigned char*)(kind == 0 ? KN : QN) + (32 * ti + l31) * 272 + 16 * hi;
            const unsigned char* bp = (const unsigned char*)KN + (32 * tj + l31) * 272 + 16 * hi;
            if (ti >= tj) {
#pragma unroll
                for (int ks = 0; ks < 8; ++ks) { const bf16x8 a = *(const bf16x8*)(ap + 32 * ks), b = *(const bf16x8*)(bp + 32 * ks); acc = MFMA32(a, b, acc); }
            }
            const int col = 32 * tj + l31; const float gcc = GC[col];
#pragma unroll
            for (int e = 0; e < 16; ++e) {
                const int row = 32 * ti + (e & 3) + 8 * (e >> 2) + 4 * hi;
                if (kind == 0) LN[row * PP_LNP + col] = row > col ? -(BT[row] * acc[e] * fexp(GC[row] - gcc)) : 0.f;
                else IA[((size_t)item * 64 + row) * 64 + col] = (bf16)f2bf(row >= col ? acc[e] * fexp(GC[row] - gcc) : 0.f);
            }
            if (wave == 0 || wave == 3) {
                WAVE_SYNC();
                if (lane < 32) {
                    const int b = (wave == 3 ? 2 : 0) + (lane >> 4), j = lane & 15; float t[16];
#pragma unroll
                    for (int i = 0; i < 16; ++i) {
                        float v = i == j ? 1.f : 0.f;
#pragma unroll
                        for (int k = 0; k < i; ++k) v += LN[(16 * b + i) * PP_LNP + 16 * b + k] * t[k];
                        t[i] = v;
                    }
#pragma unroll
                    for (int i = 0; i < 16; ++i) TI[(b * 16 + i) * 17 + j] = t[i];
                }
            } else if (wave >= 4) {
                const int u = tid - 256, m = u & 127, half = u >> 7;
                unsigned char* dst = (unsigned char*)PROJ + ((size_t)(R0 + (m >> 1)) * PLD + A_QK + h * A_DK) * 2 + (m & 1) * 128 + half * 64;
#pragma unroll
                for (int q4 = 0; q4 < 4; ++q4) {
                    u32x4 o;
#pragma unroll
                    for (int e = 0; e < 4; ++e) { const int j = 32 * half + 8 * q4 + 2 * e; o[e] = cvtpk(KF[j * 128 + m] * KD[j], KF[(j + 1) * 128 + m] * KD[j + 1]); }
                    *(u32x4*)(dst + 16 * q4) = o;
                }
            }
        }
    }
    LBAR();
    if (VAR != 4 && VAR != 1) {
        const int g = lane >> 4, cl = lane & 15;
        f32x4 XU[4], XW[4];
#pragma unroll
        for (int b = 0; b < 4; ++b) {
            f32x4 yu, yw;
#pragma unroll
            for (int e = 0; e < 4; ++e) { const int row = 16 * b + 4 * g + e; const float bt = BT[row]; yu[e] = VF[row * 128 + 16 * wave + cl] * bt; yw[e] = KF[row * 128 + 16 * wave + cl] * (bt * EG[row]); }
            float la[12], ta[4];
#pragma unroll
            for (int c = 0; c < b; ++c)
#pragma unroll
                for (int ks = 0; ks < 4; ++ks) la[4 * c + ks] = LN[(16 * b + cl) * PP_LNP + 16 * c + 4 * g + ks];
#pragma unroll
            for (int ks = 0; ks < 4; ++ks) ta[ks] = TI[(b * 16 + cl) * 17 + 4 * g + ks];
            SCHED_BARRIER();
#pragma unroll
            for (int c = 0; c < b; ++c)
#pragma unroll
                for (int ks = 0; ks < 4; ++ks) { yu = MFMAF(la[4 * c + ks], XU[c][ks], yu); yw = MFMAF(la[4 * c + ks], XW[c][ks], yw); }
            f32x4 xu = (f32x4){0.f, 0.f, 0.f, 0.f}, xw = xu;
#pragma unroll
            for (int ks = 0; ks < 4; ++ks) { xu = MFMAF(ta[ks], yu[ks], xu); xw = MFMAF(ta[ks], yw[ks], xw); }
            XU[b] = xu; XW[b] = xw;
            u32x2 o; o.x = cvtpk(xu[0], xu[1]); o.y = cvtpk(xu[2], xu[3]);
            *(u32x2*)((unsigned char*)PROJ + ((size_t)(R0 + wave * 8 + 2 * b + (lane >> 5)) * PLD + 2 * A_QK + h * A_DV) * 2 + (lane & 31) * 8) = o;
#pragma unroll
            for (int e = 0; e < 4; ++e) WST[(16 * b + 4 * g + e) * 136 + 16 * wave + cl] = (bf16)(cvtpk(xw[e], 0.f) & 0xffffu);
        }
    }
    LBAR();
}

__device__ __forceinline__ bf16x8 pack_b(const f32x4 a, const f32x4 b) {
    u32x4 o; o.x = pk2bf(a[0], a[1]); o.y = pk2bf(a[2], a[3]); o.z = pk2bf(b[0], b[1]); o.w = pk2bf(b[2], b[3]); return __builtin_bit_cast(bf16x8, o);
}
__device__ __forceinline__ bf16x8 ld_frag(const unsigned char* base, int off0, int off1) {
    const u32x2 lo = *(const u32x2*)(base + off0), hi = *(const u32x2*)(base + off1);
    u32x4 o; o.x = lo.x; o.y = lo.y; o.z = hi.x; o.w = hi.y; return __builtin_bit_cast(bf16x8, o);
}
constexpr int SC_BUF = 65536, SC_W = 0, SC_QD = 16384, SC_KDT = 32768, SC_IA = 49152, SC_U = 57344;
__device__ __forceinline__ void scan_dma(PrmRef p, int grp, int half, int n, int lw, int lane, unsigned char* buf) {
    const unsigned char* PROJ = (const unsigned char*)(p.ws + WS_PROJ); const unsigned char* WB = (const unsigned char*)(p.ws + WS_WB); const unsigned char* IA = (const unsigned char*)(p.ws + WS_IA);
    const int h = grp % A_HEADS, s = grp / A_HEADS, R0 = s * SEQ + n * CHUNK;
    const unsigned char* bW = WB + ((size_t)R0 * A_QK + h * A_DK) * 2;
    const unsigned char* bQ = PROJ + ((size_t)R0 * PLD + h * A_DK) * 2;
    const unsigned char* bK = PROJ + ((size_t)R0 * PLD + A_QK + h * A_DK) * 2;
    const unsigned char* bU = PROJ + ((size_t)(R0 + 32 * half) * PLD + 2 * A_QK + h * A_DV) * 2;
    const unsigned char* bI = IA + (size_t)(grp * NCPS + n) * 8192;
#pragma unroll
    for (int j = 0; j < 4; ++j) {
        const int ip = lw + 4 * j, sg = ip * 64 + lane;
        { const int row = sg >> 4, pc = (sg & 15) ^ (row & 15);
          GLDS16(bW + (unsigned)row * (unsigned)(A_QK * 2) + (unsigned)pc * 16u, buf + SC_W + ip * 1024);
          GLDS16(bQ + (unsigned)row * (unsigned)(PLD * 2) + (unsigned)pc * 16u, buf + SC_QD + ip * 1024); }
        { const int m = sg >> 3, pc = (sg & 7) ^ ((m >> 1) & 7);
          GLDS16(bK + (unsigned)(m >> 1) * (unsigned)(PLD * 2) + (unsigned)(m & 1) * 128u + (unsigned)pc * 16u, buf + SC_KDT + ip * 1024); }
        if (j < 2) {
          { const int row = sg >> 3, pc = (sg & 7) ^ ((row >> 1) & 7); GLDS16(bI + (unsigned)row * 128u + (unsigned)pc * 16u, buf + SC_IA + ip * 1024); }
          GLDS16(bU + (unsigned)(sg >> 4) * (unsigned)(PLD * 2) + (unsigned)(sg & 15) * 16u, buf + SC_U + ip * 1024);
        }
    }
}
template <int SV = 0> __device__ __forceinline__ void delta_scan_group(PrmRef p, int li, int item, int tid, unsigned char* lds, bool wstate = true) {
    unsigned char* PROJ = (unsigned char*)(p.ws + WS_PROJ); const float* GL = (const float*)(p.ws + WS_GL);
    const int grp = item >> 1, half = item & 1;
    const int h = grp % A_HEADS, s = grp / A_HEADS, lane = tid & 63, wave = READFIRSTLANE(tid >> 6);
    const bool loader = wave >= 4; const int cw = 4 * half + (wave & 3);
    f32x4 S[8];
#pragma unroll
    for (int m = 0; m < 8; ++m) S[m] = (f32x4){0.f, 0.f, 0.f, 0.f};
    unsigned char* fp = PROJ + ((size_t)(s * SEQ + cw * 8 + (lane >> 5)) * PLD + 2 * A_QK + h * A_DV) * 2 + (lane & 31) * 8;
    constexpr size_t TSTEP = (size_t)2 * PLD * 2, CSTEP = (size_t)CHUNK * PLD * 2;
    static_assert(NCPS <= 64, "glast per lane");
    const float glv = GL[grp * NCPS + (lane < NCPS ? lane : 0)];
    if (loader) { if (SV != 1) scan_dma(p, grp, half, 0, wave - 4, lane, lds); }
    WAIT_VM(0); LBAR();
    for (int n = 0; n < NCPS; ++n) {
        unsigned char* buf = lds + (n & 1) * SC_BUF;
        if (loader) {
            if (n + 1 < NCPS) { if (SV != 1) scan_dma(p, grp, half, n + 1, wave - 4, lane, lds + ((n + 1) & 1) * SC_BUF); }
            WAIT_VM(0);
        } else {
        int lane2 = lane;
#ifndef EMU
        asm volatile("" : "+v"(lane2));
#endif
        const int g = lane2 >> 4, cl = lane2 & 15, gh = g >> 1;
        int oW[4][2], oH[2][2];
#pragma unroll
        for (int ks = 0; ks < 4; ++ks) { const int x = (4 * ks + gh) ^ cl; oW[ks][0] = cl * 256 + (x << 4) + 8 * (g & 1); oW[ks][1] = cl * 256 + ((x ^ 2) << 4) + 8 * (g & 1); }
#pragma unroll
        for (int ks = 0; ks < 2; ++ks) { const int x = (4 * ks + gh) ^ (cl >> 1); oH[ks][0] = cl * 128 + (x << 4) + 8 * (g & 1); oH[ks][1] = cl * 128 + ((x ^ 2) << 4) + 8 * (g & 1); }
        u32x2 uf[4];
#pragma unroll
        for (int t = 0; t < 4; ++t) uf[t] = *(const u32x2*)(buf + SC_U + ((wave & 3) * 8 + 2 * t + (lane2 >> 5)) * 256 + (lane2 & 31) * 8);
        const float glast = BCAST_LANE(glv, n);
        bf16x8 Bs[4];
#pragma unroll
        for (int ks = 0; ks < 4; ++ks) Bs[ks] = pack_b(S[2 * ks], S[2 * ks + 1]);
        bf16x8 fa[4][4];
#pragma unroll
        for (int t = 0; t < 4; ++t)
#pragma unroll
            for (int ks = 0; ks < 4; ++ks) fa[t][ks] = ld_frag(buf + SC_W + t * 4096, oW[ks][0], oW[ks][1]);
        SCHED_BARRIER();
        f32x4 vn[4];
#pragma unroll
        for (int t = 0; t < 4; ++t) vn[t] = (f32x4){0.f, 0.f, 0.f, 0.f};
#pragma unroll
        for (int ks = 0; ks < (SV == 3 ? 0 : 4); ++ks)
#pragma unroll
            for (int t = 0; t < 4; ++t) vn[t] = MFMA16(fa[t][ks], Bs[ks], vn[t]);
#pragma unroll
        for (int t = 0; t < 4; ++t) { const f32x4 u = (f32x4){bflo(uf[t].x), bfhi(uf[t].x), bflo(uf[t].y), bfhi(uf[t].y)}; vn[t] = u - vn[t]; }
        SCHED_BARRIER();
        bf16x8 fk[8][2];
#pragma unroll
        for (int m = 0; m < 8; ++m)
#pragma unroll
            for (int ks = 0; ks < 2; ++ks) fk[m][ks] = ld_frag(buf + SC_KDT + m * 2048, oH[ks][0], oH[ks][1]);
        SCHED_BARRIER();
        bf16x8 Vb[2];
        Vb[0] = pack_b(vn[0], vn[1]); Vb[1] = pack_b(vn[2], vn[3]);
#pragma unroll
        for (int m = 0; m < 8; ++m) S[m] = S[m] * glast;
#pragma unroll
        for (int ks = 0; ks < 2; ++ks)
#pragma unroll
            for (int m = 0; m < 8; ++m) S[m] = MFMA16(fk[m][ks], Vb[ks], S[m]);
#pragma unroll
        for (int t = 0; t < 4; ++t)
#pragma unroll
            for (int ks = 0; ks < 4; ++ks) fa[t][ks] = ld_frag(buf + SC_QD + t * 4096, oW[ks][0], oW[ks][1]);
        bf16x8 fi[4][2];
#pragma unroll
        for (int t = 0; t < 4; ++t)
#pragma unroll
            for (int ks = 0; ks < 2; ++ks) fi[t][ks] = ld_frag(buf + SC_IA + t * 2048, oH[ks][0], oH[ks][1]);
        SCHED_BARRIER();
        f32x4 oa[4];
#pragma unroll
        for (int t = 0; t < 4; ++t) oa[t] = (f32x4){0.f, 0.f, 0.f, 0.f};
        if (SV != 2) {
#pragma unroll
        for (int ks = 0; ks < 4; ++ks)
#pragma unroll
            for (int t = 0; t < 4; ++t) oa[t] = MFMA16(fa[t][ks], Bs[ks], oa[t]);
#pragma unroll
        for (int ks = 0; ks < 2; ++ks)
#pragma unroll
            for (int t = 0; t < 4; ++t) oa[t] = MFMA16(fi[t][ks], Vb[ks], oa[t]);
#pragma unroll
        for (int t = 0; t < 4; ++t) {
            u32x2 w; w.x = cvtpk(oa[t][0], oa[t][1]); w.y = cvtpk(oa[t][2], oa[t][3]);
            if (SV == 4) { asm volatile("" :: "v"(w.x), "v"(w.y)); } else
            *(u32x2*)(fp + (size_t)n * CSTEP + t * TSTEP) = w;
        }
        }
        WAIT_VM(4);
        }
        LBAR();
    }
    if (!loader && (wstate || SV != 0)) {
    float* so = SV != 0 ? (float*)(p.ws + WS_XB) + (size_t)grp * A_DK * A_DV : p.out + O_PDELTA + (((size_t)li * BATCH + s) * A_HEADS + h) * A_DK * A_DV;
#pragma unroll
    for (int m = 0; m < 8; ++m)
#pragma unroll
        for (int e = 0; e < 4; ++e) so[(size_t)(16 * m + 4 * (lane >> 4) + e) * A_DV + 16 * cw + (lane & 15)] = S[m][e];
    }
    LBAR();
}
constexpr int NM_PART = 0, NM_OST = 2048;
struct NormRaw { u32x2 of[4]; u32x4 z0, z1; };
__device__ __forceinline__ void norm_load(PrmRef p, int item, int tid, NormRaw& q) {
    const unsigned char* PROJ = (const unsigned char*)(p.ws + WS_PROJ);
    const int n = item % NCPS, grp = item / NCPS, h = grp % A_HEADS, s = grp / A_HEADS, R0 = s * SEQ + n * CHUNK;
    const int lane = tid & 63, wave = tid >> 6, r = tid >> 3, seg = tid & 7;
    const unsigned char* fp = PROJ + ((size_t)(R0 + wave * 8 + (lane >> 5)) * PLD + 2 * A_QK + h * A_DV) * 2 + (lane & 31) * 8;
#pragma unroll
    for (int t = 0; t < 4; ++t) q.of[t] = *(const u32x2*)(fp + (size_t)t * 2 * PLD * 2);
    const u32x4* zp = (const u32x4*)(PROJ + ((size_t)(R0 + r) * PLD + CONV_DIM + h * A_DV + 16 * seg) * 2); q.z0 = zp[0]; q.z1 = zp[1];
}
__device__ __forceinline__ void delta_norm_item(PrmRef p, int li, int item, int next_item, int tid, unsigned char* lds, NormRaw& raw) {
    unsigned char* PROJ = (unsigned char*)(p.ws + WS_PROJ);
    const int n = item % NCPS, grp = item / NCPS, h = grp % A_HEADS, s = grp / A_HEADS, R0 = s * SEQ + n * CHUNK;
    const int lane = tid & 63, wave = tid >> 6, g = lane >> 4, cl = lane & 15, r = tid >> 3, seg = tid & 7;
    float* PART = (float*)(lds + NM_PART);
    const float nw = p.a_norm_w[li * A_DV + 16 * wave + cl];
    const u32x4 z0 = raw.z0, z1 = raw.z1;
    f32x4 oa[4];
#pragma unroll
    for (int t = 0; t < 4; ++t) {
        oa[t] = (f32x4){bflo(raw.of[t].x), bfhi(raw.of[t].x), bflo(raw.of[t].y), bfhi(raw.of[t].y)};
        f32x4 q4;
#pragma unroll
        for (int e = 0; e < 4; ++e) q4[e] = sum16(oa[t][e] * oa[t][e]);
        if (cl < 4) PART[(16 * t + 4 * g + cl) * 8 + wave] = cl == 0 ? q4[0] : cl == 1 ? q4[1] : cl == 2 ? q4[2] : q4[3];
    }
    if (next_item >= 0) norm_load(p, next_item, tid, raw);
    LBAR();
#pragma unroll
    for (int t = 0; t < 4; ++t)
#pragma unroll
        for (int e = 0; e < 4; ++e) {
            const int row = 16 * t + 4 * g + e;
            const f32x4 p0 = *(const f32x4*)(PART + row * 8), p1 = *(const f32x4*)(PART + row * 8 + 4);
            const float ss = ((p0[0] + p0[1]) + (p0[2] + p0[3])) + ((p1[0] + p1[1]) + (p1[2] + p1[3]));
            *(bf16*)(lds + NM_OST + row * 272 + (16 * wave + cl) * 2) = (bf16)(cvtpk(oa[t][e] * fast_rsq(ss * (1.f / A_DV) + RMS_EPS) * nw, 0.f) & 0xffffu);
        }
    LBAR();
    {
        const u32x4 o0 = *(const u32x4*)(lds + NM_OST + r * 272 + 32 * seg), o1 = *(const u32x4*)(lds + NM_OST + r * 272 + 32 * seg + 16);
        u32x4 w0, w1;
#pragma unroll
        for (int e = 0; e < 4; ++e) {
            w0[e] = cvtpk(bflo(o0[e]) * fsilu(bflo(z0[e])), bfhi(o0[e]) * fsilu(bfhi(z0[e])));
            w1[e] = cvtpk(bflo(o1[e]) * fsilu(bflo(z1[e])), bfhi(o1[e]) * fsilu(bfhi(z1[e])));
        }
        u32x4* dst = (u32x4*)(PROJ + ((size_t)(R0 + r) * PLD + 2 * A_QK + h * A_DV + 16 * seg) * 2); dst[0] = w0; dst[1] = w1;
    }
    LBAR();
}
__device__ __forceinline__ void ph_a_norm(PrmRef p, const Ctx& c, int li, unsigned char* lds) {
    NormRaw raw;
    if (c.bid < NPI) norm_load(p, c.bid, c.tid, raw);
    for (int item = c.bid; item < NPI; item += c.nblk) delta_norm_item(p, li, item, item + c.nblk < NPI ? item + c.nblk : -1, c.tid, lds, raw);
    bf16* PROJ = (bf16*)(p.ws + WS_PROJ);
    sgemm_rows(p, PROJ + 2 * A_QK, PLD, (const bf16*)(p.ws + WS_WAOUT) + (size_t)li * D_MODEL * A_VW, A_VW, PROJ, PLD, PT, ST, D_MODEL, c, NPI, lds);
}
__device__ __forceinline__ void sample_conv(PrmRef p, const Ctx& c, int li) {
    bf16* PROJ = (bf16*)(p.ws + WS_PROJ);
    const float* cw = p.a_conv_w + (size_t)li * CONV_W * CONV_DIM;
    for (int it = c.gtid; it < DEC_BATCH * CONV_DIM; it += c.nthreads) {
        const int ch = it % CONV_DIM, b = it / CONV_DIM;
        const float* sp = p.state_conv + (((size_t)li * DEC_BATCH + b) * 3) * CONV_DIM + ch;
        float h0 = sp[0], h1 = sp[CONV_DIM], h2 = sp[2 * CONV_DIM];
        const float w0 = cw[ch], w1 = cw[CONV_DIM + ch], w2 = cw[2 * CONV_DIM + ch], w3 = cw[3 * CONV_DIM + ch];
        bf16* e0 = PROJ + (size_t)(PT + b * DEC_SEQ) * PLD + ch;
        bf16 xv[DEC_SEQ];
#pragma unroll
        for (int t = 0; t < DEC_SEQ; ++t) xv[t] = e0[(size_t)t * PLD];
#pragma unroll
        for (int t = 0; t < DEC_SEQ; ++t) {
            const float x = bf2f(xv[t]);
            const float y = w0 * h0 + w1 * h1 + w2 * h2 + w3 * x;
            e0[(size_t)t * PLD] = (bf16)(cvtpk(fsilu(y), 0.f) & 0xffffu); h0 = h1; h1 = h2; h2 = x;
        }
        float* so = p.out + O_SCONV + (((size_t)li * DEC_BATCH + b) * 3) * CONV_DIM + ch;
        so[0] = h0; so[CONV_DIM] = h1; so[2 * CONV_DIM] = h2;
    }
}
__device__ __forceinline__ void sample_scan_group(PrmRef p, int li, int sg, int tid, unsigned char* lds, bool wstate = true) {
    bf16* PROJ = (bf16*)(p.ws + WS_PROJ); const float* GB = (const float*)(p.ws + WS_GB);
    float* kq = (float*)lds;
    const int b = sg / A_HEADS, h = sg % A_HEADS, r0 = PT + b * DEC_SEQ, col = tid >> 2, part = tid & 3, lane = tid & 63, wave = tid >> 6;
    float S[32];
    const float* s0 = p.state_delta + (((size_t)li * DEC_BATCH + b) * A_HEADS + h) * A_DK * A_DV;
#pragma unroll
    for (int k = 0; k < 32; ++k) S[k] = s0[(size_t)(part * 32 + k) * A_DV + col];
    for (int t = 0; t < DEC_SEQ; ++t) {
        const size_t rb = (size_t)(r0 + t) * PLD;
        __syncthreads();
        if (wave < 2) {
            const bf16* e = PROJ + rb + (wave == 0 ? A_QK : 0) + h * A_DK + 2 * lane;
            const float a = bf2f(e[0]), bb = bf2f(e[1]);
            const float sc = (1.f / sqrtf(wave_sum(a * a + bb * bb) + RMS_EPS)) * (wave == 0 ? 1.f : 0.08838834764831845f);
            kq[wave * 128 + 2 * lane] = a * sc; kq[wave * 128 + 2 * lane + 1] = bb * sc;
        }
        __syncthreads();
        const float gg = GB[((size_t)(r0 + t) * A_HEADS + h) * 2], beta = GB[((size_t)(r0 + t) * A_HEADS + h) * 2 + 1];
        const float eg = expf(gg); const float v = bf2f(PROJ[rb + 2 * A_QK + h * A_DV + col]);
        const float* kk = kq + part * 32; const float* qq = kq + 128 + part * 32;
        float ks = 0.f;
#pragma unroll
        for (int k = 0; k < 32; ++k) { S[k] *= eg; ks += kk[k] * S[k]; }
        ks += __shfl_xor(ks, 1); ks += __shfl_xor(ks, 2);
        const float vn = (v - ks) * beta; float o = 0.f;
#pragma unroll
        for (int k = 0; k < 32; ++k) { S[k] += kk[k] * vn; o += qq[k] * S[k]; }
        o += __shfl_xor(o, 1); o += __shfl_xor(o, 2);
        if (part == 0) PROJ[rb + 2 * A_QK + h * A_DV + col] = (bf16)f2bf(o);
    }
    float* so = p.out + O_SDELTA + (((size_t)li * DEC_BATCH + b) * A_HEADS + h) * A_DK * A_DV;
    if (wstate) {
#pragma unroll
    for (int k = 0; k < 32; ++k) so[(size_t)(part * 32 + k) * A_DV + col] = S[k];
    }
    __syncthreads();
    const float* nw = p.a_norm_w + (size_t)li * A_DV;
#pragma unroll 1
    for (int i = 0; i < 4; ++i) {
        const int row = r0 + wave * 4 + i;
        bf16* e = PROJ + (size_t)row * PLD + 2 * A_QK + h * A_DV + 2 * lane; const bf16* z = PROJ + (size_t)row * PLD + CONV_DIM + h * A_DV + 2 * lane;
        const float a = bf2f(e[0]), bb = bf2f(e[1]);
        const float r = 1.f / sqrtf(wave_sum(a * a + bb * bb) * (1.f / A_DV) + RMS_EPS);
        e[0] = (bf16)f2bf(a * r * nw[2 * lane] * siluf(bf2f(z[0]))); e[1] = (bf16)f2bf(bb * r * nw[2 * lane + 1] * siluf(bf2f(z[1])));
    }
    __syncthreads();
}
template <int VAR = 0> __device__ __forceinline__ void ph_a_pre(PrmRef p, const Ctx& c, int li, unsigned char* lds) {
    RawTile xr;
    if (c.bid < NPI) { prepass_load_raw(p, c.bid, c.tid, xr); if (c.wave == 1) prepass_gcum(p, c.bid, c.lane, (float*)(lds + PP_GC)); }
    int prev = -1, pb = 0, cur_h = -1;
    for (int item = c.bid; item < NPI; item += c.nblk) {
        const int h = (item / NCPS) % A_HEADS;
        if (h != cur_h) {
            LBAR();
            for (int i = c.tid; i < 3 * 4 * 128; i += NTHR) { const int X = i / 512, j = (i / 128) & 3, ch = i & 127; ((float*)(lds + PP_CW))[i] = p.a_conv_w[((size_t)li * CONV_W + j) * CONV_DIM + X * A_QK + h * A_DK + ch]; }
            LBAR(); cur_h = h;
        }
        delta_prepass_item<VAR>(p, li, item, item + c.nblk < NPI ? item + c.nblk : -1, prev, pb, c.tid, lds, xr); prev = item; pb ^= 1;
    }
    if (prev >= 0) prepass_store_w(p, prev, c.tid, lds);
    LBAR();
    if (VAR == 0) sample_conv(p, c, li);
}
template <int SV = 0> __device__ __forceinline__ void ph_a_scan2(PrmRef p, const Ctx& c, int li, unsigned char* lds, bool wstate = true, bool do_prompt = true, bool do_sample = true) {
    const int v = (c.bid + c.nblk - ((2 * NPG) % c.nblk)) % c.nblk;
    if (do_sample) for (int sg = v; sg < NSG; sg += c.nblk) sample_scan_group(p, li, sg, c.tid, lds, wstate);
    if (SV == 0) {
        const int nfree = c.nblk > 2 * NPG ? c.nblk - 2 * NPG : 0;
        if (nfree == 0) weights_deferred(p, c, li, lds, c.gwave, c.nwaves); else if (v < nfree) weights_deferred(p, c, li, lds, v * (NTHR / 64) + c.wave, nfree * (NTHR / 64));
        LBAR();
    }
    if (do_prompt) for (int it = c.bid; it < 2 * NPG; it += c.nblk) delta_scan_group<SV>(p, li, it, c.tid, lds, wstate);
}

__device__ __forceinline__ void ph_ln(PrmRef p, const Ctx& c, const bf16* OUT, int ldo, const float* g, const float* b, bool last) {
    bf16* XB = (bf16*)(p.ws + WS_XB);
    constexpr int PER = D_MODEL / 64;
    constexpr int RB = 3;
    static_assert(PER % 8 == 0, "ln vector width");
    const int col0 = c.lane * PER;
    f32x4 gv[PER / 4], bv[PER / 4];
#pragma unroll
    for (int j = 0; j < PER / 4; ++j) { gv[j] = *(const f32x4*)(g + col0 + 4 * j); bv[j] = *(const f32x4*)(b + col0 + 4 * j); }
    for (int row0 = c.gwave; row0 < MT; row0 += RB * c.nwaves) {
        u32x4 xa[RB][PER / 8], oa[RB][PER / 8];
#pragma unroll
        for (int r = 0; r < RB; ++r) { const int row = row0 + r * c.nwaves;
            if (row < MT) {
#pragma unroll
                for (int j = 0; j < PER / 8; ++j) { xa[r][j] = *(const u32x4*)(XB + (size_t)row * D_MODEL + col0 + 8 * j); oa[r][j] = *(const u32x4*)(OUT + (size_t)row * ldo + col0 + 8 * j); } } }
#pragma unroll
        for (int r = 0; r < RB; ++r) { const int row = row0 + r * c.nwaves;
            if (row < MT) {
                float v[PER]; float s = 0.f;
#pragma unroll
                for (int j = 0; j < PER / 8; ++j)
#pragma unroll
                    for (int e = 0; e < 4; ++e) { v[8 * j + 2 * e] = DN_ALPHA * bflo(xa[r][j][e]) + bflo(oa[r][j][e]); v[8 * j + 2 * e + 1] = DN_ALPHA * bfhi(xa[r][j][e]) + bfhi(oa[r][j][e]); }
#pragma unroll
                for (int j = 0; j < PER; ++j) s += v[j];
                const float mean = wave_sum(s) * (1.f / D_MODEL); float q = 0.f;
#pragma unroll
                for (int j = 0; j < PER; ++j) { v[j] -= mean; q += v[j] * v[j]; }
                const float rstd = fast_rsq(wave_sum(q) * (1.f / D_MODEL) + LN_EPS);
#pragma unroll
                for (int j = 0; j < PER; ++j) v[j] = v[j] * rstd * gv[j >> 2][j & 3] + bv[j >> 2][j & 3];
#pragma unroll
                for (int j = 0; j < PER / 8; ++j) { u32x4 o;
#pragma unroll
                    for (int e = 0; e < 4; ++e) o[e] = cvtpk(v[8 * j + 2 * e], v[8 * j + 2 * e + 1]);
                    *(u32x4*)(XB + (size_t)row * D_MODEL + col0 + 8 * j) = o; }
                if (last) { float* yo = row < PT ? p.out + O_YP + (size_t)row * D_MODEL + col0 : p.out + O_YS + (size_t)(row - PT) * D_MODEL + col0;
#pragma unroll
                    for (int j = 0; j < PER; j += 4) *(f32x4*)(yo + j) = (f32x4){v[j], v[j + 1], v[j + 2], v[j + 3]}; }
            } }
    }
}
__device__ __forceinline__ float fast_exp2(float x) {
#ifdef EMU
    return exp2f(x);
#else
    return __builtin_amdgcn_exp2f(x);
#endif
}
__device__ __forceinline__ void b_cache_copies(PrmRef p, const Ctx& c) {
    bf16* CK = (bf16*)(p.ws + WS_CK); bf16* CVT = (bf16*)(p.ws + WS_CVT);
    for (int it = c.gtid; it < DEC_BATCH * WINDOW * B_KVW; it += c.nthreads) {
        const int dd = it % B_KVW, w = (it / B_KVW) % WINDOW, b = it / (B_KVW * WINDOW), kvh = dd / B_HD, d = dd % B_HD;
        CK[(((size_t)b * B_KV_HEADS + kvh) * WINDOW + w) * B_HD + d] = (bf16)f2bf(p.cache_k[it]);
        CVT[(((size_t)b * B_KV_HEADS + kvh) * B_HD + d) * WINDOW + w] = (bf16)f2bf(p.cache_v[it]);
    }
}
__device__ __forceinline__ void ph_b_gemm(PrmRef p, const Ctx& c, int lj, unsigned char* lds) {
    const bf16* XB = (const bf16*)(p.ws + WS_XB); bf16* PROJ = (bf16*)(p.ws + WS_PROJ); const bf16* Wt = (const bf16*)(p.ws + WS_WBIN) + (size_t)lj * B_N0 * D_MODEL;
    const int N = lj == 0 ? B_N0 : B_IN;
    pg8::Gemm g{XB, D_MODEL, Wt, PT, N, D_MODEL}; pg8::StaticOrder S; S.init(PT, N, c.nblk, c.bid);
    pg8::EpiBIn E{PROJ, PLD, (const float*)(p.ws + WS_ROPE), (bf16*)(p.ws + WS_VT)};
    __syncthreads();
    pg8::gemm_phase<pg8::EpiBIn, pg8::StaticOrder, true>((LAS unsigned char*)lds, g, S, E, c.tid);
    __syncthreads();
    sgemm_rows<true>(p, XB, D_MODEL, Wt, D_MODEL, PROJ, PLD, PT, ST, N, c, lj == 0 ? (PT / 256) * (B_N0 / 256) : 0, lds, true);
    if (lj == 0) b_cache_copies(p, c);
}
constexpr int AT_KPITCH = 144, AT_VPITCH = 392, AT_K = 0, AT_V = 192 * AT_KPITCH, AT_O = AT_V + 64 * AT_VPITCH + 64  , AT_OPITCH = 144;
static_assert(2 * SC_BUF <= 163840 - 64, "scan LDS");
static_assert(AT_O % 16 == 0 && AT_O + 256 * AT_OPITCH <= 131072, "attention LDS");
struct AttRaw { u32x4 k[3], v[3]; bf16x8 q[4]; };
__device__ __forceinline__ void att_load(PrmRef p, int ck, int kvh, int tid, AttRaw& raw) {
    const unsigned char* PROJ = (const unsigned char*)(p.ws + WS_PROJ); const unsigned char* VT = (const unsigned char*)(p.ws + WS_VT);
    const unsigned char* CK = (const unsigned char*)(p.ws + WS_CK); const unsigned char* CVT = (const unsigned char*)(p.ws + WS_CVT);
    const int lane = tid & 63, wave = tid >> 6, l31 = lane & 31, hi = lane >> 5;
    const bool smp = ck >= NCP; const int r0 = chunk_row0(ck);
    const int nc = smp ? 0 : ck % NCPS, nblk = smp ? 0 : (nc >= 2 ? 3 : nc + 1);
    if (!smp) {
        const int kfirst = r0 - (nblk - 1) * CHUNK;
#pragma unroll
        for (int j = 0; j < 3; ++j) if (j < nblk) { const int idx = tid + NTHR * j, key = idx >> 3, pc = idx & 7, d = (idx >> 3) & 63;
            raw.k[j] = *(const u32x4*)(PROJ + ((size_t)(kfirst + key) * PLD + B_IN + kvh * B_HD) * 2 + pc * 16);
            raw.v[j] = *(const u32x4*)(VT + ((((size_t)(ck - (nblk - 1) + j) * B_KV_HEADS + kvh) * B_HD + d) * 64) * 2 + pc * 16); }
    } else {
        const int b = ck - NCP;
#pragma unroll
        for (int j = 0; j < 3; ++j) { const int idx = tid + NTHR * j;
            if (idx < 160 * 8) { const int key = idx >> 3, pc = idx & 7;
                raw.k[j] = *(const u32x4*)(key < WINDOW ? CK + ((((size_t)b * B_KV_HEADS + kvh) * WINDOW + key) * B_HD) * 2 + pc * 16 : PROJ + ((size_t)(r0 + key - WINDOW) * PLD + B_IN + kvh * B_HD) * 2 + pc * 16); }
            if (idx < 64 * 20) { const int d = idx / 20, pc = idx % 20;
                raw.v[j] = *(const u32x4*)(pc < 16 ? CVT + ((((size_t)b * B_KV_HEADS + kvh) * B_HD + d) * WINDOW) * 2 + pc * 16 : VT + ((((size_t)ck * B_KV_HEADS + kvh) * B_HD + d) * 64) * 2 + (pc - 16) * 16); } }
    }
    const bool active = smp ? wave < 4 : true;
    const int hq = kvh * B_GROUP + (smp ? wave : (wave >> 1)), qrow0 = smp ? 0 : 32 * (wave & 1);
    if (active) {
#pragma unroll
        for (int ks = 0; ks < 4; ++ks) raw.q[ks] = *(const bf16x8*)(PROJ + ((size_t)(r0 + qrow0 + l31) * PLD + hq * B_HD + 16 * ks + 8 * hi) * 2);
    }
}
__device__ __forceinline__ void att_item(PrmRef p, int lj, int ck, int kvh, int nck, int nkvh, int tid, unsigned char* lds, AttRaw& raw) {
#ifndef EMU
    asm volatile("" : "+v"(tid));
#endif
    unsigned char* PROJ = (unsigned char*)(p.ws + WS_PROJ);
    const int lane = tid & 63, wave = READFIRSTLANE(tid >> 6), l31 = lane & 31, hi = lane >> 5;
    const bool smp = ck >= NCP; const int r0 = chunk_row0(ck);
    const int nc = smp ? 0 : ck % NCPS, nblk = smp ? 0 : (nc >= 2 ? 3 : nc + 1);
    const int nkt = smp ? 5 : 2 * nblk;
    if (!smp) {
#pragma unroll
        for (int j = 0; j < 3; ++j) if (j < nblk) { const int idx = tid + NTHR * j, key = idx >> 3, pc = idx & 7, d = (idx >> 3) & 63;
            *(u32x4*)(lds + AT_K + key * AT_KPITCH + pc * 16) = raw.k[j];
            unsigned char* dst = lds + AT_V + d * AT_VPITCH + j * 128 + pc * 16; *(u32x2*)dst = (u32x2){raw.v[j].x, raw.v[j].y}; *(u32x2*)(dst + 8) = (u32x2){raw.v[j].z, raw.v[j].w}; }
    } else {
#pragma unroll
        for (int j = 0; j < 3; ++j) { const int idx = tid + NTHR * j;
            if (idx < 160 * 8) { const int key = idx >> 3, pc = idx & 7; *(u32x4*)(lds + AT_K + key * AT_KPITCH + pc * 16) = raw.k[j]; }
            if (idx < 64 * 20) { const int d = idx / 20, pc = idx % 20; unsigned char* dst = lds + AT_V + d * AT_VPITCH + pc * 16; *(u32x2*)dst = (u32x2){raw.v[j].x, raw.v[j].y}; *(u32x2*)(dst + 8) = (u32x2){raw.v[j].z, raw.v[j].w}; } }
    }
    const bool active = smp ? wave < 4 : true;
    const int hq = kvh * B_GROUP + (smp ? wave : (wave >> 1));
    bf16x8 qf[4];
#pragma unroll
    for (int ks = 0; ks < 4; ++ks) qf[ks] = raw.q[ks];
    LBAR();
    if (nck >= 0) att_load(p, nck, nkvh, tid, raw);
    const int nrows = smp ? 128 : 256;
    u32x4 zr[4];
    if (active) {
        f32x16 sc[6];
#pragma unroll
        for (int kt = 0; kt < 6; ++kt) {
#pragma unroll
            for (int e = 0; e < 16; ++e) sc[kt][e] = 0.f;
            if (kt < nkt) {
#pragma unroll
                for (int ks = 0; ks < 4; ++ks) sc[kt] = MFMA32(*(const bf16x8*)(lds + AT_K + (32 * kt + l31) * AT_KPITCH + 32 * ks + 16 * hi), qf[ks], sc[kt]);
            }
        }
        const float sink = p.b_sinks[lj * B_Q_HEADS + hq];
        float m = sink;
#pragma unroll
        for (int kt = 0; kt < 6; ++kt) if (kt < nkt) {
#pragma unroll
            for (int e = 0; e < 16; ++e) m = fmaxf(m, sc[kt][e]); }
        m = fmaxf(m, __shfl_xor(m, 32));
        float l = 0.f; const float ml2 = m * 1.4426950408889634f;
#pragma unroll
        for (int kt = 0; kt < 6; ++kt) if (kt < nkt) {
#pragma unroll
            for (int e = 0; e < 16; ++e) { const float pe = fast_exp2(sc[kt][e] * 1.4426950408889634f - ml2); sc[kt][e] = pe; l += pe; } }
        l += __shfl_xor(l, 32);
        l += fast_exp2(sink * 1.4426950408889634f - ml2);
        f32x16 o[2];
#pragma unroll
        for (int e = 0; e < 16; ++e) { o[0][e] = 0.f; o[1][e] = 0.f; }
#pragma unroll
        for (int kt = 0; kt < 6; ++kt) if (kt < nkt) {
#pragma unroll
            for (int s = 0; s < 2; ++s) {
                u32x4 pw; pw.x = cvtpk(sc[kt][8 * s], sc[kt][8 * s + 1]); pw.y = cvtpk(sc[kt][8 * s + 2], sc[kt][8 * s + 3]); pw.z = cvtpk(sc[kt][8 * s + 4], sc[kt][8 * s + 5]); pw.w = cvtpk(sc[kt][8 * s + 6], sc[kt][8 * s + 7]);
                const bf16x8 pb = __builtin_bit_cast(bf16x8, pw);
#pragma unroll
                for (int mt = 0; mt < 2; ++mt) {
                    const unsigned char* vp = lds + AT_V + (32 * mt + l31) * AT_VPITCH + (32 * kt + 16 * s + 4 * hi) * 2;
                    const u32x2 a0 = *(const u32x2*)vp, a1 = *(const u32x2*)(vp + 16);
                    u32x4 aw; aw.x = a0.x; aw.y = a0.y; aw.z = a1.x; aw.w = a1.y;
                    o[mt] = MFMA32(__builtin_bit_cast(bf16x8, aw), pb, o[mt]);
                }
            }
        }
        const float il = fast_rcp(l);
        unsigned char* orow = lds + AT_O + (32 * wave + l31) * AT_OPITCH;
#pragma unroll
        for (int mt = 0; mt < 2; ++mt)
#pragma unroll
            for (int cg4 = 0; cg4 < 4; ++cg4) {
                u32x2 w2; w2.x = cvtpk(o[mt][4 * cg4] * il, o[mt][4 * cg4 + 1] * il); w2.y = cvtpk(o[mt][4 * cg4 + 2] * il, o[mt][4 * cg4 + 3] * il);
                *(u32x2*)(orow + (32 * mt + 8 * cg4 + 4 * hi) * 2) = w2;
            }
    }
#pragma unroll
    for (int i = 0; i < 4; ++i) { const int idx = tid + NTHR * i;
        if (idx < nrows * 8) { const int qr = idx >> 3, pc = idx & 7, w = qr >> 5, hq2 = kvh * B_GROUP + (smp ? w : (w >> 1)), row = r0 + (smp ? 0 : 32 * (w & 1)) + (qr & 31);
            zr[i] = *(const u32x4*)(PROJ + ((size_t)row * PLD + B_QW + hq2 * B_HD) * 2 + pc * 16); } }
    LBAR();
#pragma unroll
    for (int i = 0; i < 4; ++i) { const int idx = tid + NTHR * i;
        if (idx < nrows * 8) { const int qr = idx >> 3, pc = idx & 7, w = qr >> 5, hq2 = kvh * B_GROUP + (smp ? w : (w >> 1)), row = r0 + (smp ? 0 : 32 * (w & 1)) + (qr & 31);
            const u32x4 ov = *(const u32x4*)(lds + AT_O + qr * AT_OPITCH + pc * 16); const u32x4 zv = zr[i];
            u32x4 r;
#pragma unroll
            for (int e = 0; e < 4; ++e) r[e] = cvtpk(bflo(ov[e]) * fsilu(bflo(zv[e])), bfhi(ov[e]) * fsilu(bfhi(zv[e])));
            *(u32x4*)(PROJ + ((size_t)row * PLD + hq2 * B_HD) * 2 + pc * 16) = r; } }
    LBAR();
}
__device__ __forceinline__ void ph_b_att2(PrmRef p, const Ctx& c, int lj, bool first, unsigned char* lds) {
    AttRaw raw;
    if (c.bid < NCH * B_KV_HEADS) att_load(p, c.bid / B_KV_HEADS, c.bid % B_KV_HEADS, c.tid, raw);
    for (int it = c.bid; it < NCH * B_KV_HEADS; it += c.nblk) { const int nx = it + c.nblk < NCH * B_KV_HEADS ? it + c.nblk : -1;
        att_item(p, lj, it / B_KV_HEADS, it % B_KV_HEADS, nx < 0 ? -1 : nx / B_KV_HEADS, nx < 0 ? 0 : nx % B_KV_HEADS, c.tid, lds, raw); }
    if (first) {
        const bf16* PROJ = (const bf16*)(p.ws + WS_PROJ);
        for (int it = c.gtid; it < (BATCH + DEC_BATCH) * WINDOW * B_KVW; it += c.nthreads) {
            const int e = it % B_KVW, w = (it / B_KVW) % WINDOW, s = it / (B_KVW * WINDOW);
            if (s < BATCH) { const int row = s * SEQ + SEQ - WINDOW + w; const bf16* kp = PROJ + (size_t)row * PLD + B_IN;
                p.out[O_PK + ((size_t)s * WINDOW + w) * B_KVW + e] = bf2f(kp[e]); p.out[O_PV + ((size_t)s * WINDOW + w) * B_KVW + e] = bf2f(kp[B_KVW + e]); }
            else { const int b = s - BATCH; float kx, vx;
                if (w < WINDOW - DEC_SEQ) { kx = p.cache_k[((size_t)b * WINDOW + w + DEC_SEQ) * B_KVW + e]; vx = p.cache_v[((size_t)b * WINDOW + w + DEC_SEQ) * B_KVW + e]; }
                else { const int row = PT + b * DEC_SEQ + (w - (WINDOW - DEC_SEQ)); const bf16* kp = PROJ + (size_t)row * PLD + B_IN; kx = bf2f(kp[e]); vx = bf2f(kp[B_KVW + e]); }
                p.out[O_SK + ((size_t)b * WINDOW + w) * B_KVW + e] = kx; p.out[O_SV + ((size_t)b * WINDOW + w) * B_KVW + e] = vx; }
        }
    }
}

#ifndef EMU
#define XB_TMO      128
#define XB_XCNT(j)  (256  + 64 * (j))
#define XB_XSUB(j)  (1280 + 64 * (j))
#define XB_XGEN(j)  (2304 + 64 * (j))
#define XB_TOP      3328
#define XB_TOPGEN   3392
#define XCD_BAR_WORDS 3456
#define XB_SPIN_CAP (1u << 20)
__device__ __forceinline__ unsigned xb_ld(unsigned* p)              { return __hip_atomic_load(p, __ATOMIC_RELAXED, __HIP_MEMORY_SCOPE_AGENT); }
__device__ __forceinline__ unsigned xb_add(unsigned* p, unsigned v) { return __hip_atomic_fetch_add(p, v, __ATOMIC_RELAXED, __HIP_MEMORY_SCOPE_AGENT); }
__device__ __forceinline__ unsigned xb_xcc_id() { return (unsigned)__builtin_amdgcn_s_getreg((3 << 11) | 20) & 0xFu; }
#define XB_SPIN(cond, bar) do { unsigned _sp = 0; while (cond) { __builtin_amdgcn_s_sleep(1); \
    if ((++_sp & 255u) == 0u) { if (xb_ld(&(bar)[XB_TMO])) break; if (_sp > XB_SPIN_CAP) { atomicAdd(&(bar)[XB_TMO], 1u); break; } } } } while (0)
__device__ __forceinline__ void xcd_barrier_complete(unsigned* bar, unsigned x, unsigned& nloc, unsigned& nx) {
    const unsigned G = gridDim.x * gridDim.y * gridDim.z;
    unsigned sum, cnt, mine, sp = 0u;
    for (;;) {
        sum = 0u; cnt = 0u; mine = 0u;
#pragma unroll
        for (unsigned j = 0; j < 16; ++j) { const unsigned c = xb_ld(&bar[XB_XCNT(j)]); sum += c; cnt += (c > 0u) ? 1u : 0u; mine = (j == x) ? c : mine; }
        if (sum == G) break;
        __builtin_amdgcn_s_sleep(1);
        if ((++sp & 255u) == 0u) { if (xb_ld(&bar[XB_TMO])) break; if (sp > XB_SPIN_CAP) { atomicAdd(&bar[XB_TMO], 1u); break; } }
    }
    nloc = mine > 0u ? mine : 1u; nx = cnt > 0u ? cnt : 1u;
}
__device__ __forceinline__ void xcd_barrier(unsigned* bar, volatile LAS unsigned* st, const int tid) {
    asm volatile("s_waitcnt vmcnt(0)" ::: "memory");
    __syncthreads();
    if (tid == 0) {
        __builtin_amdgcn_s_waitcnt(0);
        const unsigned x = xb_xcc_id();
        unsigned nloc = st[0], nx = st[1];
        if (nloc == 0u) { xcd_barrier_complete(bar, x, nloc, nx); st[0] = nloc; st[1] = nx; }
        const unsigned old = xb_add(&bar[XB_XSUB(x)], 1u);
        const unsigned gen = old / nloc;
        if (old + 1u == (gen + 1u) * nloc) {
            __builtin_amdgcn_fence(__ATOMIC_RELEASE, "agent");
            asm volatile("s_waitcnt vmcnt(0)" ::: "memory");
            const unsigned og = xb_add(&bar[XB_TOP], 1u);
            const unsigned tg = og / nx;
            if (og + 1u == (tg + 1u) * nx) xb_add(&bar[XB_TOPGEN], 1u);
            else XB_SPIN(xb_ld(&bar[XB_TOPGEN]) == tg, bar);
            __builtin_amdgcn_fence(__ATOMIC_ACQUIRE, "agent");
            xb_add(&bar[XB_XGEN(x)], 1u);
            asm volatile("s_waitcnt vmcnt(0)" ::: "memory");
        } else {
            XB_SPIN(xb_ld(&bar[XB_XGEN(x)]) == gen, bar);
            __builtin_amdgcn_fence(__ATOMIC_ACQUIRE, "agent");
            asm volatile("s_waitcnt vmcnt(0)" ::: "memory");
        }
    }
    __syncthreads();
}
#endif
constexpr int PH_A0 = 1, PH_APER = 6, PH_B0 = PH_A0 + N_A * PH_APER, PH_BPER = 4, N_PHASES = PH_B0 + N_B * PH_BPER;
constexpr int LDS_BAR_OFF = 163840 - 64;
constexpr int LDS_BYTES = 163840;
#ifdef EMU
#define DECL_LDS(name) unsigned char* name = emu::blk()->lds
#else
#define DECL_LDS(name) extern __shared__ __attribute__((aligned(16))) unsigned char name[]
#endif

#ifdef EMU
#define PH_PROLOGUE() PrmRef p = p_; int tid_ = threadIdx.x, bid_ = blockIdx.x;
#define GRID_SYNC()
#else
#define PH_PROLOGUE() const __attribute__((address_space(4))) Prm* pp = (const __attribute__((address_space(4))) Prm*)__builtin_amdgcn_kernarg_segment_ptr(); \
    int tid_ = wave_s_ * 64 + (int)__builtin_amdgcn_mbcnt_hi(~0u, __builtin_amdgcn_mbcnt_lo(~0u, 0u)), bid_ = blockIdx.x; asm volatile("" : "+s"(pp), "+v"(tid_), "+s"(bid_)); PrmRef p = *pp;
#define GRID_SYNC() xcd_barrier((unsigned*)(p.ws + WS_CTL), (volatile LAS unsigned*)(lds + LDS_BAR_OFF), c.tid)
#endif
#define PHASE(k, ...) if (ph_lo <= (k) && (k) < ph_hi) { PH_PROLOGUE() \
        Ctx c; c.tid = tid_; c.lane = c.tid & 63; c.wave = c.tid >> 6; c.bid = bid_; c.nblk = gridDim.x; \
        c.gtid = c.bid * NTHR + c.tid; c.nthreads = c.nblk * NTHR; c.gwave = c.bid * (NTHR / 64) + c.wave; c.nwaves = c.nblk * (NTHR / 64); \
        bf16* PROJ = (bf16*)(p.ws + WS_PROJ); const bf16* XB = (const bf16*)(p.ws + WS_XB); (void)PROJ; (void)XB; \
        __VA_ARGS__; \
        if ((k) + 1 < ph_hi) { GRID_SYNC(); } }
#define A_LAYER(li) \
    PHASE(PH_A0 + (li) * PH_APER + 0, ph_a_gemm(p, c, li, lds)) \
    PHASE(PH_A0 + (li) * PH_APER + 1, ph_a_pre(p, c, li, lds)) \
    PHASE(PH_A0 + (li) * PH_APER + 2, ph_a_scan2(p, c, li, lds)) \
    PHASE(PH_A0 + (li) * PH_APER + 3, ph_a_norm(p, c, li, lds)) \
    PHASE(PH_A0 + (li) * PH_APER + 4, gemm_mfma(PROJ + 2 * A_QK, PLD, (const bf16*)(p.ws + WS_WAOUT) + (size_t)(li) * D_MODEL * A_VW, PROJ, PLD, PT, D_MODEL, A_VW, c, lds)) \
    PHASE(PH_A0 + (li) * PH_APER + 5, ph_ln(p, c, PROJ, PLD, p.a_ln_g + (size_t)(li) * D_MODEL, p.a_ln_b + (size_t)(li) * D_MODEL, false))
#define B_LAYER(lj) \
    PHASE(PH_B0 + (lj) * PH_BPER + 0, ph_b_gemm(p, c, lj, lds)) \
    PHASE(PH_B0 + (lj) * PH_BPER + 1, ph_b_att2(p, c, lj, (lj) == 0, lds)) \
    PHASE(PH_B0 + (lj) * PH_BPER + 2, gemm_mfma(PROJ, PLD, (const bf16*)(p.ws + WS_WBOUT) + (size_t)(lj) * D_MODEL * B_QW, PROJ + B_QW, PLD, PT, D_MODEL, B_QW, c, lds); \
        sgemm_rows(p, PROJ, PLD, (const bf16*)(p.ws + WS_WBOUT) + (size_t)(lj) * D_MODEL * B_QW, B_QW, PROJ + B_QW, PLD, PT, ST, D_MODEL, c, 0, lds)) \
    PHASE(PH_B0 + (lj) * PH_BPER + 3, ph_ln(p, c, PROJ + B_QW, PLD, p.b_ln_g + (size_t)(lj) * D_MODEL, p.b_ln_b + (size_t)(lj) * D_MODEL, (lj) == N_B - 1))

__global__ void __launch_bounds__(NTHR, 2) fwd_kernel(Prm p_, int ph_lo, int ph_hi) {
    DECL_LDS(lds);
#ifndef EMU
    const int wave_s_ = __builtin_amdgcn_readfirstlane((int)threadIdx.x >> 6);
    {
        if (threadIdx.x < 2) ((volatile LAS unsigned*)(lds + LDS_BAR_OFF))[threadIdx.x] = 0u;
        if (threadIdx.x == 0) (void)xb_add((unsigned*)(p_.ws + WS_CTL) + XB_XCNT(xb_xcc_id()), 1u);
        __syncthreads();
    }
#endif
    PHASE(0, ph_init(p, c); ph_weights(p, c, lds))
    A_LAYER(0)
    A_LAYER(1)
    B_LAYER(0)
    B_LAYER(1)
#ifdef PROBE_TAIL
    PROBE_TAIL
#endif
}

extern "C" void kernel_launch(void* const* d_in, const int* in_sizes, int n_in, void* d_out, int out_size, void* d_ws, size_t ws_size, hipStream_t stream) {
    if (n_in != 20 || (size_t)out_size != O_END || ws_size < WS_NEED) { fprintf(stderr, "kernel_launch: unexpected sizes n_in=%d out=%d ws=%zu (need %zu, out %zu)\n", n_in, out_size, ws_size, (size_t)WS_END, (size_t)O_END); return; }
    Prm p{};
    const float** pp = (const float**)&p;
    for (int i = 0; i < 20; ++i) pp[i] = (const float*)d_in[i];
    p.out = (float*)d_out; p.ws = (unsigned char*)d_ws;
#ifdef EMU
    const int grid = 8;
    const int stop = getenv("EMU_STOP") ? atoi(getenv("EMU_STOP")) : N_PHASES;
    for (int ph = 0; ph < N_PHASES && ph < stop; ++ph) { emu::launch([=]() { fwd_kernel(p, ph, ph + 1); }, dim3(grid), dim3(NTHR), LDS_BYTES); fprintf(stderr, "phase %d done\n", ph); }
#else
    static int grid = 0;
    if (grid == 0) {
        int dev = 0, cus = 0, per_cu = 0;
        (void)hipGetDevice(&dev); (void)hipDeviceGetAttribute(&cus, hipDeviceAttributeMultiprocessorCount, dev);
        (void)hipFuncSetAttribute((const void*)fwd_kernel, hipFuncAttributeMaxDynamicSharedMemorySize, LDS_BYTES);
        (void)hipOccupancyMaxActiveBlocksPerMultiprocessor(&per_cu, (const void*)fwd_kernel, NTHR, LDS_BYTES);
        if (per_cu < 1) { fprintf(stderr, "kernel_launch: occupancy query says %d blocks per CU\n", per_cu); per_cu = 1; }
        grid = cus;
    }
    (void)hipMemsetAsync((char*)d_ws + WS_CTL, 0, 65536, stream);
#ifdef PROBE_TAIL
    int lo = 0, hi = N_PHASES + PROBE_NTAIL;
#else
    int lo = 0, hi = N_PHASES;
#endif
    void* args[] = {(void*)&p, (void*)&lo, (void*)&hi};
    hipError_t e = hipLaunchCooperativeKernel((const void*)fwd_kernel, dim3(grid), dim3(NTHR), args, LDS_BYTES, stream);
    if (e != hipSuccess) fprintf(stderr, "cooperative launch failed: %s (grid %d)\n", hipGetErrorString(e), grid);
#endif
}
```

```cpp
#ifdef EMU
#include "hip_emu.h"
#else
#include <hip/hip_runtime.h>
#include <hip/hip_cooperative_groups.h>
namespace cg = cooperative_groups;
#endif
#include <cstdint>
#include <cstddef>
#include <cstdio>

typedef short bf16x8 __attribute__((ext_vector_type(8)));
typedef float f32x4 __attribute__((ext_vector_type(4)));
typedef float f32x16 __attribute__((ext_vector_type(16)));
typedef unsigned u32x4 __attribute__((ext_vector_type(4)));
typedef unsigned u32x2 __attribute__((ext_vector_type(2)));
#ifdef EMU
#define LAS
#define WAVE_SYNC() emu::wave_sync()
#define GLDS16(gp, lp) memcpy((unsigned char*)(lp) + emu::lane_id() * 16, (const void*)(gp), 16)
#define MFMA16(a, b, c) emu_mfma_16x16x32_bf16(a, b, c)
#define MFMA32(a, b, c) emu_mfma_32x32x16_bf16(a, b, c)
#define MFMAF(a, b, c) emu_mfma_16x16x4_f32(a, b, c)
#define SETPRIO(n)
#define SCHED_BARRIER()
#define S_BARRIER() emu::block_sync()
#define WAIT_VM(n)
#define WAIT_LGKM(n)
#define READFIRSTLANE(x) (x)
#define BCAST_LANE(v, n) __shfl(v, n)
#define LBAR() emu::block_sync()
#else
#define LAS __attribute__((address_space(3)))
#define WAVE_SYNC() asm volatile("s_waitcnt lgkmcnt(0)" ::: "memory")
#define GLDS16(gp, lp) __builtin_amdgcn_global_load_lds((const unsigned*)(gp), (LAS unsigned*)(lp), 16, 0, 0)
#define MFMA16(a, b, c) __builtin_amdgcn_mfma_f32_16x16x32_bf16(a, b, c, 0, 0, 0)
#define MFMA32(a, b, c) __builtin_amdgcn_mfma_f32_32x32x16_bf16(a, b, c, 0, 0, 0)
#define MFMAF(a, b, c) __builtin_amdgcn_mfma_f32_16x16x4f32(a, b, c, 0, 0, 0)
#define SETPRIO(n) __builtin_amdgcn_s_setprio(n)
#define SCHED_BARRIER() __builtin_amdgcn_sched_barrier(0)
#define S_BARRIER() __builtin_amdgcn_s_barrier()
#define WAIT_VM(n) asm volatile("s_waitcnt vmcnt(" #n ")" ::: "memory")
#define WAIT_LGKM(n) asm volatile("s_waitcnt lgkmcnt(" #n ")" ::: "memory")
#define READFIRSTLANE(x) __builtin_amdgcn_readfirstlane(x)
#define BCAST_LANE(v, n) __builtin_bit_cast(float, __builtin_amdgcn_readlane(__builtin_bit_cast(int, v), n))
#define LBAR() do { asm volatile("s_waitcnt lgkmcnt(0)" ::: "memory"); __builtin_amdgcn_s_barrier(); asm volatile("" ::: "memory"); } while (0)
#endif

#ifdef CFG_SMALL
constexpr int D_MODEL = 512, BATCH = 2, SEQ = 256, DEC_BATCH = 8, DEC_SEQ = 32, A_HEADS = 4, B_Q_HEADS = 8, B_KV_HEADS = 2;
#else
constexpr int D_MODEL = 1024, BATCH = 8, SEQ = 2048, DEC_BATCH = 16, DEC_SEQ = 32, A_HEADS = 8, B_Q_HEADS = 16, B_KV_HEADS = 4;
#endif
constexpr int PAST_LEN = 4096, CHUNK = 64, N_A = 2, N_B = 2, DEPTH = 4;
constexpr int A_DK = 128, A_DV = 128, A_QK = A_HEADS * A_DK, A_VW = A_HEADS * A_DV, CONV_W = 4, CONV_DIM = 2 * A_QK + A_VW;
constexpr int A_IN = CONV_DIM + A_VW + 2 * A_HEADS, A_MAIN = CONV_DIM + A_VW;
constexpr int B_GROUP = B_Q_HEADS / B_KV_HEADS, B_HD = 64, B_QW = B_Q_HEADS * B_HD, B_KVW = B_KV_HEADS * B_HD, B_IN = 2 * B_QW;
constexpr int WINDOW = 128, ROPE_DIMS = 16, ROPE_HALF = 8;
constexpr float LN_EPS = 1e-5f, RMS_EPS = 1e-6f;
constexpr float DN_ALPHA = 1.681792830507429f;
constexpr int PT = BATCH * SEQ, ST = DEC_BATCH * DEC_SEQ, MT = PT + ST, NSEQ = BATCH + DEC_BATCH;
constexpr int NCPS = SEQ / CHUNK, NCP = BATCH * NCPS, NCH = NCP + DEC_BATCH;
constexpr int PLD = A_MAIN > B_IN + 2 * B_KVW ? A_MAIN : B_IN + 2 * B_KVW;
static_assert(B_GROUP == 4, "attention wave map");
static_assert(PT % 256 == 0 && ST % 64 == 0 && D_MODEL % 256 == 0 && A_VW % 256 == 0 && B_QW % 256 == 0 && A_MAIN % 256 == 0 && D_MODEL % 256 == 0 && B_IN % 256 == 0 && (2 * B_KVW) % 256 == 0 && D_MODEL % 128 == 0 && D_MODEL >= 256, "gemm tiles");
static_assert(DEC_SEQ == 32 && WINDOW == 128 && CHUNK == 64, "fixed");

constexpr size_t O_YP = 0, O_YS = O_YP + (size_t)PT * D_MODEL, O_PDELTA = O_YS + (size_t)ST * D_MODEL;
constexpr size_t O_PCONV = O_PDELTA + (size_t)N_A * BATCH * A_HEADS * A_DK * A_DV, O_PK = O_PCONV + (size_t)N_A * BATCH * 3 * CONV_DIM;
constexpr size_t O_PV = O_PK + (size_t)BATCH * WINDOW * B_KVW, O_SDELTA = O_PV + (size_t)BATCH * WINDOW * B_KVW;
constexpr size_t O_SCONV = O_SDELTA + (size_t)N_A * DEC_BATCH * A_HEADS * A_DK * A_DV, O_SK = O_SCONV + (size_t)N_A * DEC_BATCH * 3 * CONV_DIM;
constexpr size_t O_SV = O_SK + (size_t)DEC_BATCH * WINDOW * B_KVW, O_END = O_SV + (size_t)DEC_BATCH * WINDOW * B_KVW;

constexpr size_t al256(size_t x) { return (x + 255) & ~(size_t)255; }
constexpr size_t WS_CTL = 0, WS_ROPE = 1u << 20;
constexpr size_t WS_GB = al256(WS_ROPE + (size_t)(SEQ + DEC_SEQ) * ROPE_HALF * 2 * 4);
constexpr size_t WS_HALO = al256(WS_GB + (size_t)MT * A_HEADS * 2 * 4);
constexpr size_t WS_XB = al256(WS_HALO + (size_t)NCH * 3 * CONV_DIM * 2);
constexpr size_t WS_PROJ = al256(WS_XB + (size_t)MT * D_MODEL * 2);
constexpr size_t WS_WAIN = al256(WS_PROJ + (size_t)MT * PLD * 2);
constexpr int A_NG = A_MAIN + 256;
constexpr size_t WS_WAOUT = al256(WS_WAIN + (size_t)N_A * A_NG * D_MODEL * 2);
constexpr int B_N0 = B_IN + 2 * B_KVW;
constexpr size_t WS_WBIN = al256(WS_WAOUT + (size_t)N_A * D_MODEL * A_VW * 2);
constexpr size_t WS_WBOUT = al256(WS_WBIN + (size_t)(B_N0 + B_IN) * D_MODEL * 2);
constexpr size_t WS_WB = al256(WS_WBOUT + (size_t)N_B * D_MODEL * B_QW * 2);
constexpr size_t WS_IA = al256(WS_WB + (size_t)PT * A_QK * 2);
constexpr size_t WS_GL = al256(WS_IA + (size_t)BATCH * A_HEADS * (SEQ / CHUNK) * 64 * 64 * 2);
constexpr size_t WS_END = al256(WS_GL + (size_t)BATCH * A_HEADS * (SEQ / CHUNK) * 4);
static_assert(WS_END <= ((size_t)256 << 20), "workspace");
constexpr size_t WS_VT = WS_WB, WS_CK = al256(WS_VT + (size_t)NCH * B_KV_HEADS * 64 * 64 * 2), WS_CVT = al256(WS_CK + (size_t)DEC_BATCH * B_KV_HEADS * 128 * 64 * 2);
constexpr size_t WS_BEND = al256(WS_CVT + (size_t)DEC_BATCH * B_KV_HEADS * 128 * 64 * 2), WS_NEED = WS_BEND > WS_END ? WS_BEND : WS_END;
static_assert(WS_NEED <= ((size_t)256 << 20), "workspace (B-layer buffers overlay the A-layer WB | IA | GL region)");

static_assert(N_B == 2, "weight map");

typedef unsigned short bf16;
constexpr int NTHR = 512;

struct Prm {
    const float *x_prompt, *x_sample, *state_delta, *state_conv, *cache_k, *cache_v, *a_w_in, *a_conv_w, *a_log, *a_dt_bias, *a_norm_w, *a_w_out, *a_ln_g, *a_ln_b,
        *b_w_kv, *b_w_in, *b_sinks, *b_w_out, *b_ln_g, *b_ln_b;
    float* out; unsigned char* ws;
};

__device__ __forceinline__ unsigned f2bf(float f) { unsigned u = __builtin_bit_cast(unsigned, f); return (u + 0x7fffu + ((u >> 16) & 1u)) >> 16; }
__device__ __forceinline__ float bf2f(bf16 h) { return __builtin_bit_cast(float, (unsigned)h << 16); }
__device__ __forceinline__ float siluf(float x) { return x / (1.f + expf(-x)); }
__device__ __forceinline__ float sigmoidf_(float x) { return 1.f / (1.f + expf(-x)); }
__device__ __forceinline__ float softplusf_(float x) { return x > 20.f ? x : log1pf(expf(x)); }
__device__ __forceinline__ float wave_sum(float v) {
#pragma unroll
    for (int o = 1; o < 64; o <<= 1) v += __shfl_xor(v, o);
    return v;
}

#ifdef EMU
__device__ __forceinline__ float fast_rcp(float x) { return 1.f / x; }
__device__ __forceinline__ float fast_rsq(float x) { return 1.f / sqrtf(x); }
__device__ __forceinline__ float fast_ex2(float x) { return exp2f(x); }
__device__ __forceinline__ unsigned cvtpk(float lo, float hi) { return f2bf(lo) | (f2bf(hi) << 16); }
__device__ __forceinline__ float dpp_xor1(float v) { return __shfl(v, emu::lane_id() ^ 1); }
__device__ __forceinline__ float dpp_xor2(float v) { return __shfl(v, emu::lane_id() ^ 2); }
__device__ __forceinline__ float dpp_hmirror(float v) { const int l = emu::lane_id(); return __shfl(v, (l & ~7) | (7 - (l & 7))); }
__device__ __forceinline__ float dpp_mirror(float v) { const int l = emu::lane_id(); return __shfl(v, (l & ~15) | (15 - (l & 15))); }
#else
__device__ __forceinline__ float fast_rcp(float x) { return __builtin_amdgcn_rcpf(x); }
__device__ __forceinline__ float fast_rsq(float x) { return __builtin_amdgcn_rsqf(x); }
__device__ __forceinline__ float fast_ex2(float x) { return __builtin_amdgcn_exp2f(x); }
__device__ __forceinline__ unsigned cvtpk(float lo, float hi) { typedef float f2_t __attribute__((ext_vector_type(2))); typedef __bf16 b2_t __attribute__((ext_vector_type(2)));
    f2_t v = {lo, hi}; b2_t b = __builtin_convertvector(v, b2_t); return __builtin_bit_cast(unsigned, b); }
template <int CTRL> __device__ __forceinline__ float dpp_mov(float v) { return __builtin_bit_cast(float, __builtin_amdgcn_update_dpp(0, __builtin_bit_cast(int, v), CTRL, 0xf, 0xf, true)); }
__device__ __forceinline__ float dpp_xor1(float v) { return dpp_mov<0xB1>(v); }
__device__ __forceinline__ float dpp_xor2(float v) { return dpp_mov<0x4E>(v); }
__device__ __forceinline__ float dpp_hmirror(float v) { return dpp_mov<0x141>(v); }
__device__ __forceinline__ float dpp_mirror(float v) { return dpp_mov<0x140>(v); }
#endif
__device__ __forceinline__ float sum8(float v) { v += dpp_xor1(v); v += dpp_xor2(v); v += dpp_hmirror(v); return v; }
__device__ __forceinline__ float sum16(float v) { v = sum8(v); v += dpp_mirror(v); return v; }
__device__ __forceinline__ float fsilu(float x) { return x * fast_rcp(1.f + fast_ex2(-1.4426950408889634f * x)); }
__device__ __forceinline__ float fexp(float x) { return fast_ex2(1.4426950408889634f * x); }
__device__ __forceinline__ float bflo(unsigned u) { return __builtin_bit_cast(float, u << 16); }
__device__ __forceinline__ float bfhi(unsigned u) { return __builtin_bit_cast(float, u & 0xffff0000u); }
__device__ __forceinline__ int seq_row0(int s) { return s < BATCH ? s * SEQ : PT + (s - BATCH) * DEC_SEQ; }
__device__ __forceinline__ int seq_len(int s) { return s < BATCH ? SEQ : DEC_SEQ; }
__device__ __forceinline__ int chunk_row0(int c) { return c < NCP ? c * CHUNK : PT + (c - NCP) * DEC_SEQ; }
__device__ __forceinline__ int chunk_len(int c) { return c < NCP ? CHUNK : DEC_SEQ; }
__device__ __forceinline__ int row_posidx(int row) { return row < PT ? (row % SEQ) : SEQ + ((row - PT) % DEC_SEQ); }

#ifdef EMU
typedef const Prm& PrmRef;
#else
typedef const __attribute__((address_space(4))) Prm& PrmRef;
#endif
struct Ctx { int tid, lane, wave, gtid, gwave, nthreads, nwaves, bid, nblk; };

namespace pg8 {
constexpr int BM = 256, BK = 64, HALF = 128, HTB = HALF * BK * 2  , STAGE_BYTES = 8 * HTB, NXCD = 8, WGM = 8;
__host__ __device__ __forceinline__ int lds_byte(int r, int c) { const int st = (r >> 4) * 2 + (c >> 5), rr = r & 15, cc = c & 31, ob = rr * 64 + cc * 2; return st * 1024 + (ob ^ (((ob >> 9) & 1) << 5)); }
__host__ __device__ __forceinline__ void stage_rc(int b, int& R, int& C) { const int st = b / 1024, sb = b % 1024, swz = sb ^ (((sb >> 9) & 1) << 5); R = (st >> 1) * 16 + swz / 64; C = (st & 1) * 32 + (swz % 64) / 2; }
__host__ __device__ __forceinline__ int perm32(int rho) { const int n = rho >> 4, i = rho & 15; return 8 * (i >> 2) + 4 * n + (i & 3); }
struct Unit { int pm, pn; };
struct Gemm { const bf16* A; int lda; const bf16* Bt; int M, N, K; };
struct StaticOrder {
    int nM, nN, nwg, G, c;
    __host__ __device__ void init(int M, int N, int G_, int c_) { nM = M / BM; nN = N / BM; nwg = nM * nN; G = G_; c = c_; }
    __host__ __device__ bool next(int i, Unit& u) const {
        const long L = (long)i * G + c; if (L >= nwg) return false;
        int wgid = (int)L; { const int q = nwg / NXCD, r = nwg % NXCD, xcd = wgid % NXCD, off = wgid / NXCD; wgid = (xcd < r ? xcd * (q + 1) : r * (q + 1) + (xcd - r) * q) + off; }
        const int nig = WGM * nN, gid = wgid / nig, fm = gid * WGM, gsz = (nM - fm) < WGM ? (nM - fm) : WGM;
        u.pm = fm + ((wgid % nig) % gsz); u.pn = (wgid % nig) / gsz; return true;
    }
};
__device__ __forceinline__ unsigned cvt_pk_bf16(float lo, float hi) {
#ifdef EMU
    return f2bf(lo) | (f2bf(hi) << 16);
#else
    unsigned r; asm volatile("v_cvt_pk_bf16_f32 %0, %1, %2" : "=v"(r) : "v"(lo), "v"(hi)); return r;
#endif
}
struct EpiBf16 {
    static constexpr bool PERM = true;
    bf16* O; int ldc;
    __device__ __forceinline__ void operator()(const f32x4 (&acc)[2][2][4][2], const Unit& u, int wr, int wc, int fr, int fq) const {
        int fr_ = fr, fq_ = fq;
#ifndef EMU
        asm volatile("" : "+v"(fr_), "+v"(fq_));
#endif
        const int row0 = u.pm * BM + wr * 64 + fr_, col0 = u.pn * BM + wc * 32 + 8 * fq_;
#pragma unroll
        for (int ai = 0; ai < 2; ++ai)
#pragma unroll
            for (int m = 0; m < 4; ++m) { bf16* rowp = O + (size_t)(row0 + ai * HALF + m * 16) * ldc + col0;
#pragma unroll
                for (int bj = 0; bj < 2; ++bj) { const f32x4 v0 = acc[ai][bj][m][0], v1 = acc[ai][bj][m][1];
                    u32x4 w; w.x = cvt_pk_bf16(v0[0], v0[1]); w.y = cvt_pk_bf16(v0[2], v0[3]); w.z = cvt_pk_bf16(v1[0], v1[1]); w.w = cvt_pk_bf16(v1[2], v1[3]);
                    *(u32x4*)(rowp + bj * HALF) = w; } }
    }
};
struct EpiAIn {
    static constexpr bool PERM = true;
    bf16* O; int ldc; bf16* HALO; float* pconv;
    __device__ __forceinline__ void operator()(const f32x4 (&acc)[2][2][4][2], const Unit& u, int wr, int wc, int fr, int fq) const {
        int fr_ = fr, fq_ = fq;
#ifndef EMU
        asm volatile("" : "+v"(fr_), "+v"(fq_));
#endif
        const int row0 = u.pm * BM + wr * 64 + fr_, col0 = u.pn * BM + wc * 32 + 8 * fq_;
#pragma unroll
        for (int ai = 0; ai < 2; ++ai)
#pragma unroll
            for (int m = 0; m < 4; ++m) { const int row = row0 + ai * HALF + m * 16; bf16* rowp = O + (size_t)row * ldc + col0;
#pragma unroll
                for (int bj = 0; bj < 2; ++bj) { const f32x4 v0 = acc[ai][bj][m][0], v1 = acc[ai][bj][m][1];
                    u32x4 w; w.x = cvt_pk_bf16(v0[0], v0[1]); w.y = cvt_pk_bf16(v0[2], v0[3]); w.z = cvt_pk_bf16(v1[0], v1[1]); w.w = cvt_pk_bf16(v1[2], v1[3]);
                    *(u32x4*)(rowp + bj * HALF) = w;
                    if (m == 3 && fr_ >= 13 && col0 + bj * HALF < CONV_DIM) {
                        const int ck = row >> 6, hr = fr_ - 13, col = col0 + bj * HALF;
                        *(u32x4*)(HALO + ((size_t)ck * 3 + hr) * CONV_DIM + col) = w;
                        if (ck % NCPS == NCPS - 1) { float* dst = pconv + ((size_t)(ck / NCPS) * 3 + hr) * CONV_DIM + col; *(f32x4*)dst = v0; *(f32x4*)(dst + 4) = v1; }
                    } } }
    }
};
struct EpiBIn {
    static constexpr bool PERM = true;
    bf16* O; int ldc; const float* rope; bf16* VT;
    __device__ __forceinline__ void operator()(const f32x4 (&acc)[2][2][4][2], const Unit& u, int wr, int wc, int fr, int fq) const {
        int fr_ = fr, fq_ = fq;
#ifndef EMU
        asm volatile("" : "+v"(fr_), "+v"(fq_));
#endif
        static_assert(B_QW % 128 == 0 && B_KVW % 128 == 0, "a 128-column half tile has one kind");
        const int ct = u.pn * BM;
        int kinds[2]; bool ropes[2];
#pragma unroll
        for (int bj = 0; bj < 2; ++bj) { const int cc = ct + bj * HALF; kinds[bj] = cc < B_QW ? 0 : cc < B_IN ? 1 : cc < B_IN + B_KVW ? 2 : 3;
            ropes[bj] = (kinds[bj] == 0 || kinds[bj] == 2) && (wc & 1) == 0; }
        const int row0 = u.pm * BM + wr * 64 + fr_, col0 = ct + wc * 32 + 8 * fq_;
#pragma unroll
        for (int ai = 0; ai < 2; ++ai)
#pragma unroll
            for (int m = 0; m < 4; ++m) { const int row = row0 + ai * HALF + m * 16; bf16* rowp = O + (size_t)row * ldc + col0;
                f32x4 cs[4];
                if (ropes[0] || ropes[1]) { const f32x4* rp = (const f32x4*)(rope + (size_t)(row % SEQ) * ROPE_HALF * 2);
#pragma unroll
                    for (int q4 = 0; q4 < 4; ++q4) cs[q4] = rp[q4]; }
#pragma unroll
                for (int bj = 0; bj < 2; ++bj) { f32x4 v0 = acc[ai][bj][m][0], v1 = acc[ai][bj][m][1]; const int kind = kinds[bj]; const float sc = kind == 0 ? 0.125f : 1.f;
                    if (ropes[bj]) {
                        float x[8] = {v0[0], v0[1], v0[2], v0[3], v1[0], v1[1], v1[2], v1[3]}, o[8];
#pragma unroll
                        for (int j = 0; j < 8; ++j) o[j] = __shfl_xor(x[j], 16);
                        if (fq_ < 2) {
#pragma unroll
                            for (int j = 0; j < 8; ++j) { const float c_ = cs[j >> 1][2 * (j & 1)], s_ = cs[j >> 1][2 * (j & 1) + 1]; x[j] = fq_ == 0 ? x[j] * c_ - o[j] * s_ : x[j] * c_ + o[j] * s_; }
                        }
                        v0 = (f32x4){x[0], x[1], x[2], x[3]}; v1 = (f32x4){x[4], x[5], x[6], x[7]};
                    }
                    v0 = v0 * sc; v1 = v1 * sc;
                    u32x4 w; w.x = cvt_pk_bf16(v0[0], v0[1]); w.y = cvt_pk_bf16(v0[2], v0[3]); w.z = cvt_pk_bf16(v1[0], v1[1]); w.w = cvt_pk_bf16(v1[2], v1[3]);
                    *(u32x4*)(rowp + bj * HALF) = w;
                    if (kind == 3) { const int dd = col0 + bj * HALF - (B_IN + B_KVW), kvh = dd / B_HD, d = dd % B_HD; bf16* vt = VT + (((size_t)(row >> 6) * B_KV_HEADS + kvh) * B_HD + d) * 64 + (row & 63);
                        vt[0] = (bf16)(w.x & 0xffffu); vt[64] = (bf16)(w.x >> 16); vt[128] = (bf16)(w.y & 0xffffu); vt[192] = (bf16)(w.y >> 16);
                        vt[256] = (bf16)(w.z & 0xffffu); vt[320] = (bf16)(w.z >> 16); vt[384] = (bf16)(w.w & 0xffffu); vt[448] = (bf16)(w.w >> 16); }
                } }
    }
};
template <class Epi, class Sched, bool ALIGN_EPI>
__device__ __forceinline__ void gemm_phase(LAS unsigned char* lds, const Gemm g, const Sched& S, const Epi& E, const int tid) {
    const int wid = READFIRSTLANE(tid >> 6), lane = tid & 63, wr = wid >> 2, wc = wid & 3, fr = lane & 15, fq = lane >> 4;
    const int K = g.K, nt = K / BK;
    unsigned voffA[2], voffB[2];
#pragma unroll
    for (int i = 0; i < 2; ++i) { int R, C; stage_rc(tid * 16 + i * 8192, R, C); const int Rb = Epi::PERM ? ((R & ~31) + perm32(R & 31)) : R;
        voffA[i] = (unsigned)(R * g.lda + C) * 2u; voffB[i] = (unsigned)(Rb * K + C) * 2u; }
    const size_t kstep = (size_t)(BK * 2);
    const size_t hstepA = (size_t)HALF * g.lda * 2, hstepB = (size_t)HALF * K * 2;
    const size_t tstepA = 2 * hstepA, tstepB = 2 * hstepB;
    const unsigned ldsw = (unsigned)wid * 1024u;
    const int aoff = lds_byte(wr * 64 + fr, fq * 8), boff = lds_byte(wc * 32 + fr, fq * 8);
#define PG8_SA(b, h) (((b) * 2 + (h)) * HTB)
#define PG8_SB(b, h) ((4 + (b) * 2 + (h)) * HTB)
#define PG8_STAGE(bufoff, gbase, voff) do { _Pragma("unroll") for (int _i = 0; _i < 2; ++_i) \
        GLDS16((const char*)(gbase) + (voff)[_i], lds + (bufoff) + ldsw + _i * 8192); } while (0)
#define PG8_LDA(dst, b, h) do { _Pragma("unroll") for (int m = 0; m < 4; ++m) _Pragma("unroll") for (int k = 0; k < 2; ++k) dst[m][k] = *(const LAS bf16x8*)(lds + PG8_SA(b, h) + aoff + m * 2048 + k * 1024); } while (0)
#define PG8_LDB(dst, b, h) do { _Pragma("unroll") for (int n = 0; n < 2; ++n) _Pragma("unroll") for (int k = 0; k < 2; ++k) dst[n][k] = *(const LAS bf16x8*)(lds + PG8_SB(b, h) + boff + n * 2048 + k * 1024); } while (0)
#define PG8_MMA(ai, bj, At, Bt) do { SETPRIO(1); _Pragma("unroll") for (int m = 0; m < 4; ++m) _Pragma("unroll") for (int n = 0; n < 2; ++n) _Pragma("unroll") for (int k = 0; k < 2; ++k) \
        acc[ai][bj][m][n] = MFMA16(Bt[n][k], At[m][k], acc[ai][bj][m][n]); SETPRIO(0); } while (0)
    Unit cur, nxt; int ui = 0;
    if (!S.next(0, cur)) return;
    f32x4 acc[2][2][4][2];
#pragma unroll
    for (int a = 0; a < 2; ++a)
#pragma unroll
        for (int b = 0; b < 2; ++b)
#pragma unroll
            for (int m = 0; m < 4; ++m)
#pragma unroll
                for (int n = 0; n < 2; ++n) acc[a][b][m][n] = (f32x4){0.f, 0.f, 0.f, 0.f};
    bf16x8 At[4][2], B0[2][2], B1[2][2];
    const char* cA = (const char*)g.A + (size_t)cur.pm * tstepA; const char* cB = (const char*)g.Bt + (size_t)cur.pn * tstepB;
    PG8_STAGE(PG8_SB(0, 0), cB, voffB); PG8_STAGE(PG8_SB(0, 1), cB + hstepB, voffB); PG8_STAGE(PG8_SA(0, 0), cA, voffA); PG8_STAGE(PG8_SA(0, 1), cA + hstepA, voffA);
    if (wr == 1) S_BARRIER();
    WAIT_VM(2); S_BARRIER();
    PG8_STAGE(PG8_SB(1, 0), cB + kstep, voffB); PG8_STAGE(PG8_SA(1, 0), cA + kstep, voffA); PG8_STAGE(PG8_SB(1, 1), cB + hstepB + kstep, voffB);
    WAIT_VM(6); S_BARRIER();
    for (;;) {
        const bool has_next = S.next(ui + 1, nxt);
        const char* nA = has_next ? (const char*)g.A + (size_t)nxt.pm * tstepA : cA; const char* nB = has_next ? (const char*)g.Bt + (size_t)nxt.pn * tstepB : cB;
        for (int t = 0; t < nt; t += 2) {
            const bool last = (t == nt - 2);
            const char* a1 = cA + (size_t)(t + 1) * kstep;
            const char* a2 = last ? nA : cA + (size_t)(t + 2) * kstep; const char* b2 = last ? nB : cB + (size_t)(t + 2) * kstep;
            const char* a3 = a2 + kstep; const char* b3 = b2 + kstep;
            PG8_LDB(B0, 0, 0); PG8_LDB(B1, 0, 1); SCHED_BARRIER(); PG8_LDA(At, 0, 0); PG8_STAGE(PG8_SA(1, 1), a1 + hstepA, voffA);
            WAIT_VM(8); WAIT_LGKM(0); S_BARRIER(); PG8_MMA(0, 0, At, B0); PG8_MMA(0, 1, At, B1); S_BARRIER(); SCHED_BARRIER();
            PG8_LDA(At, 0, 1); PG8_STAGE(PG8_SB(0, 0), b2, voffB); PG8_STAGE(PG8_SB(0, 1), b2 + hstepB, voffB); PG8_STAGE(PG8_SA(0, 0), a2, voffA);
            WAIT_VM(8); WAIT_LGKM(0); S_BARRIER(); PG8_MMA(1, 0, At, B0); PG8_MMA(1, 1, At, B1); S_BARRIER(); SCHED_BARRIER();
            PG8_LDB(B0, 1, 0); PG8_LDB(B1, 1, 1); SCHED_BARRIER(); PG8_LDA(At, 1, 0); PG8_STAGE(PG8_SA(0, 1), a2 + hstepA, voffA);
            WAIT_VM(8); WAIT_LGKM(0); S_BARRIER(); PG8_MMA(0, 0, At, B0); PG8_MMA(0, 1, At, B1); S_BARRIER(); SCHED_BARRIER();
            PG8_LDA(At, 1, 1); PG8_STAGE(PG8_SB(1, 0), b3, voffB); PG8_STAGE(PG8_SB(1, 1), b3 + hstepB, voffB); PG8_STAGE(PG8_SA(1, 0), a3, voffA);
            WAIT_VM(8); WAIT_LGKM(0); S_BARRIER(); PG8_MMA(1, 0, At, B0); PG8_MMA(1, 1, At, B1); S_BARRIER(); SCHED_BARRIER();
        }
        if constexpr (ALIGN_EPI) { if (wr == 0) S_BARRIER(); }
        E(acc, cur, wr, wc, fr, fq);
        if (!has_next) break;
#pragma unroll
        for (int a = 0; a < 2; ++a)
#pragma unroll
            for (int b = 0; b < 2; ++b)
#pragma unroll
                for (int m = 0; m < 4; ++m)
#pragma unroll
                    for (int n = 0; n < 2; ++n) acc[a][b][m][n] = (f32x4){0.f, 0.f, 0.f, 0.f};
        cur = nxt; cA = nA; cB = nB; ++ui;
        if constexpr (ALIGN_EPI) { if (wr == 1) S_BARRIER(); }
    }
    WAIT_VM(0);
    if constexpr (!ALIGN_EPI) { if (wr == 0) S_BARRIER(); }
    S_BARRIER();
#undef PG8_SA
#undef PG8_SB
#undef PG8_STAGE
#undef PG8_LDA
#undef PG8_LDB
#undef PG8_MMA
}
}
__device__ __forceinline__ void gemm_mfma(const bf16* A, int lda, const bf16* Bt, bf16* C, int ldc, int M, int N, int K, const Ctx& c, unsigned char* lds) {
    pg8::Gemm g{A, lda, Bt, M, N, K}; pg8::StaticOrder S; S.init(M, N, c.nblk, c.bid); pg8::EpiBf16 E{C, ldc};
    __syncthreads();
    pg8::gemm_phase<pg8::EpiBf16, pg8::StaticOrder, true>((LAS unsigned char*)lds, g, S, E, c.tid);
    __syncthreads();
}
__device__ __forceinline__ void transpose_item(const float* W, int ldw, int K, int N, bf16* WT, int row_off, float* scr, int item, int lane) {
    const int nblk = N / 64, kb = item / nblk, nb = item % nblk, k0 = 64 * kb, n0 = 64 * nb;
#pragma unroll 8
    for (int kk = 0; kk < 64; ++kk) scr[kk * 65 + lane] = W[(size_t)(k0 + kk) * ldw + n0 + lane];
    WAVE_SYNC();
    const int cc = lane & 7;
#pragma unroll
    for (int j = 0; j < 8; ++j) { const int n = (lane >> 3) + 8 * j; const float* sp = scr + (8 * cc) * 65 + n;
        u32x4 o; o.x = cvtpk(sp[0 * 65], sp[1 * 65]); o.y = cvtpk(sp[2 * 65], sp[3 * 65]); o.z = cvtpk(sp[4 * 65], sp[5 * 65]); o.w = cvtpk(sp[6 * 65], sp[7 * 65]);
        *(u32x4*)(WT + (size_t)(row_off + n0 + n) * K + k0 + 8 * cc) = o; }
    WAVE_SYNC();
}
constexpr int WI_AIN = (D_MODEL / 64) * (A_MAIN / 64), WI_AOUT = (A_VW / 64) * (D_MODEL / 64), WI_BIN = (D_MODEL / 64) * (B_IN / 64), WI_BKV = (D_MODEL / 64) * (2 * B_KVW / 64), WI_BOUT = (B_QW / 64) * (D_MODEL / 64);
constexpr int WI_A_END = N_A * (WI_AIN + WI_AOUT), WI_ALL = WI_A_END + N_B * (WI_BIN + WI_BOUT) + WI_BKV;
__device__ __forceinline__ void weights_range(PrmRef p, int lane, int wave, unsigned char* lds, int vw, int nvw, int lo, int hi) {
    float* scr = (float*)lds + wave * (64 * 65);
    bf16* WAIN = (bf16*)(p.ws + WS_WAIN); bf16* WAOUT = (bf16*)(p.ws + WS_WAOUT); bf16* WBIN = (bf16*)(p.ws + WS_WBIN); bf16* WBOUT = (bf16*)(p.ws + WS_WBOUT);
    for (int it = lo + vw; it < hi; it += nvw) {
        int r = it;
        if (r < N_A * WI_AIN) { const int li = r / WI_AIN; transpose_item(p.a_w_in + (size_t)li * D_MODEL * A_IN, A_IN, D_MODEL, A_MAIN, WAIN + (size_t)li * A_NG * D_MODEL, 0, scr, r % WI_AIN, lane); continue; } r -= N_A * WI_AIN;
        if (r < N_A * WI_AOUT) { const int li = r / WI_AOUT; transpose_item(p.a_w_out + (size_t)li * A_VW * D_MODEL, D_MODEL, A_VW, D_MODEL, WAOUT + (size_t)li * D_MODEL * A_VW, 0, scr, r % WI_AOUT, lane); continue; } r -= N_A * WI_AOUT;
        if (r < N_B * WI_BIN) { const int lj = r / WI_BIN; transpose_item(p.b_w_in + (size_t)lj * D_MODEL * B_IN, B_IN, D_MODEL, B_IN, WBIN + (size_t)lj * B_N0 * D_MODEL, 0, scr, r % WI_BIN, lane); continue; } r -= N_B * WI_BIN;
        if (r < N_B * WI_BOUT) { const int lj = r / WI_BOUT; transpose_item(p.b_w_out + (size_t)lj * B_QW * D_MODEL, D_MODEL, B_QW, D_MODEL, WBOUT + (size_t)lj * D_MODEL * B_QW, 0, scr, r % WI_BOUT, lane); continue; } r -= N_B * WI_BOUT;
        transpose_item(p.b_w_kv, 2 * B_KVW, D_MODEL, 2 * B_KVW, WBIN, B_IN, scr, r, lane);
    }
}
__device__ __forceinline__ void ph_weights(PrmRef p, const Ctx& c, unsigned char* lds) {
    weights_range(p, c.lane, c.wave, lds, c.gwave, c.nwaves, 0, WI_AIN);
    bf16* WAIN = (bf16*)(p.ws + WS_WAIN);
    for (int it = c.gtid; it < N_A * 256 * D_MODEL; it += c.nthreads) {
        const int k = it % D_MODEL, j = (it / D_MODEL) % 256, li = it / (256 * D_MODEL);
        WAIN[((size_t)li * A_NG + A_MAIN + j) * D_MODEL + k] = j < 2 * A_HEADS ? (bf16)f2bf(p.a_w_in[((size_t)li * D_MODEL + k) * A_IN + A_MAIN + j]) : (bf16)0;
    }
}
__device__ __forceinline__ void weights_deferred(PrmRef p, const Ctx& c, int li, unsigned char* lds, int vw, int nvw) {
    static_assert(N_A == 2, "deferred weight conversion schedule");
    if (li == 0) weights_range(p, c.lane, c.wave, lds, vw, nvw, WI_AIN, WI_A_END); else weights_range(p, c.lane, c.wave, lds, vw, nvw, WI_A_END, WI_ALL);
}

__device__ __forceinline__ void ph_init(PrmRef p, const Ctx& c) {
    bf16* XB = (bf16*)(p.ws + WS_XB);
    for (size_t i8 = c.gtid; i8 < (size_t)MT * D_MODEL / 8; i8 += c.nthreads) {
        const size_t i = i8 * 8; const float* src = i < (size_t)PT * D_MODEL ? p.x_prompt + i : p.x_sample + (i - (size_t)PT * D_MODEL);
        const f32x4 a = *(const f32x4*)src, b = *(const f32x4*)(src + 4);
        u32x4 o; o.x = cvtpk(a[0], a[1]); o.y = cvtpk(a[2], a[3]); o.z = cvtpk(b[0], b[1]); o.w = cvtpk(b[2], b[3]);
        *(u32x4*)(XB + i) = o;
    }
    float* rope = (float*)(p.ws + WS_ROPE);
    for (int i = c.gtid; i < (SEQ + DEC_SEQ) * ROPE_HALF; i += c.nthreads) {
        const int pi = i / ROPE_HALF, f = i % ROPE_HALF; const float pos = pi < SEQ ? (float)pi : (float)(PAST_LEN + pi - SEQ);
        const float inv = f == 0 ? 1.0f : f == 1 ? 0.1939227432012558f : f == 2 ? 0.03760603070259094f : f == 3 ? 0.007292664609849453f : f == 4 ? 0.0014142135623842478f
                        : f == 5 ? 0.00027424818836152554f : f == 6 ? 5.3182957344688475e-05f : 1.0313385246263351e-05f;
        const float ang = pos * inv;
        rope[2 * i] = cosf(ang); rope[2 * i + 1] = sinf(ang);
    }
}

constexpr int SG_PITCH = 528, SG_A = 0, SG_B = 64 * SG_PITCH;
template <bool GATES, bool BMODE = false> __device__ __forceinline__ void sgemm_tile(PrmRef p, int li, const bf16* A, int lda, const bf16* Bt, int K, bf16* C, int ldc, int row0, int col0, int tid, unsigned char* lds) {
    const int lane = tid & 63, wave = tid >> 6, r = lane & 15, g = lane >> 4;
    u32x4 ra[4], rb[4];
#define SG_LOAD(kc) do { _Pragma("unroll") for (int j = 0; j < 4; ++j) { const int idx = tid + 512 * j, row = idx >> 5, pc = idx & 31; \
        ra[j] = *(const u32x4*)(A + (size_t)(row0 + row) * lda + (kc) + pc * 8); rb[j] = *(const u32x4*)(Bt + (size_t)(col0 + row) * K + (kc) + pc * 8); } } while (0)
    SG_LOAD(0);
    f32x4 acc0 = (f32x4){0.f, 0.f, 0.f, 0.f}, acc1 = acc0;
    for (int kc = 0; kc < K; kc += 256) {
        LBAR();
#pragma unroll
        for (int j = 0; j < 4; ++j) { const int idx = tid + 512 * j, row = idx >> 5, pc = idx & 31;
            *(u32x4*)(lds + SG_A + row * SG_PITCH + pc * 16) = ra[j]; *(u32x4*)(lds + SG_B + row * SG_PITCH + pc * 16) = rb[j]; }
        if (kc + 256 < K) SG_LOAD(kc + 256);
        LBAR();
        const unsigned char* ap = lds + SG_A + (16 * (wave & 3) + r) * SG_PITCH + 16 * g;
        const unsigned char* bp = lds + SG_B + (32 * (wave >> 2) + r) * SG_PITCH + 16 * g;
#pragma unroll
        for (int ks = 0; ks < 8; ++ks) {
            const bf16x8 a = *(const bf16x8*)(ap + 64 * ks), b0 = *(const bf16x8*)(bp + 64 * ks), b1 = *(const bf16x8*)(bp + 16 * SG_PITCH + 64 * ks);
            acc0 = MFMA16(a, b0, acc0); acc1 = MFMA16(a, b1, acc1);
        }
    }
#undef SG_LOAD
    if (!GATES) {
        if (BMODE) {
            const int kind = col0 < B_QW ? 0 : col0 < B_IN ? 1 : col0 < B_IN + B_KVW ? 2 : 3, rowb = row0 + 16 * (wave & 3) + 4 * g;
            if ((kind == 0 || kind == 2) && wave < 4) {
                const float* rope = (const float*)(p.ws + WS_ROPE);
#pragma unroll
                for (int e = 0; e < 4; ++e) { const float x = acc0[e], o = __shfl_xor(x, 8); const float* rp = rope + ((size_t)(SEQ + (rowb + e - PT) % DEC_SEQ) * ROPE_HALF + (r & 7)) * 2;
                    acc0[e] = r < 8 ? x * rp[0] - o * rp[1] : x * rp[0] + o * rp[1]; }
            }
            if (kind == 0) { acc0 = acc0 * 0.125f; acc1 = acc1 * 0.125f; }
            if (kind == 3) { bf16* VT = (bf16*)(p.ws + WS_VT); const int kvh = (col0 - (B_IN + B_KVW)) / B_HD, d = 32 * (wave >> 2) + r;
#pragma unroll
                for (int e = 0; e < 4; ++e) { const int srow = rowb + e - PT, ck = NCP + srow / DEC_SEQ, key = srow % DEC_SEQ;
                    VT[(((size_t)ck * B_KV_HEADS + kvh) * B_HD + d) * 64 + key] = (bf16)(cvtpk(acc0[e], 0.f) & 0xffffu); VT[(((size_t)ck * B_KV_HEADS + kvh) * B_HD + d + 16) * 64 + key] = (bf16)(cvtpk(acc1[e], 0.f) & 0xffffu); } }
        }
        bf16* cp = C + (size_t)(row0 + 16 * (wave & 3) + 4 * g) * ldc + col0 + 32 * (wave >> 2) + r;
#pragma unroll
        for (int e = 0; e < 4; ++e) { cp[(size_t)e * ldc] = (bf16)(cvtpk(acc0[e], 0.f) & 0xffffu); cp[(size_t)e * ldc + 16] = (bf16)(cvtpk(acc1[e], 0.f) & 0xffffu); }
    } else if (wave < 4) {
        static_assert(2 * A_HEADS <= 16, "gate columns");
        float* GB = (float*)(p.ws + WS_GB); const int col = r, rowb = row0 + 16 * wave + 4 * g;
        if (col < A_HEADS) { const float al = -expf(p.a_log[li * A_HEADS + col]), db = p.a_dt_bias[li * A_HEADS + col];
#pragma unroll
            for (int e = 0; e < 4; ++e) GB[((size_t)(rowb + e) * A_HEADS + col) * 2] = al * softplusf_(acc0[e] + db); }
        else if (col < 2 * A_HEADS) {
#pragma unroll
            for (int e = 0; e < 4; ++e) GB[((size_t)(rowb + e) * A_HEADS + (col - A_HEADS)) * 2 + 1] = sigmoidf_(acc0[e]); }
    }
}
template <bool BMODE = false> __device__ __forceinline__ void sgemm_rows(PrmRef p, const bf16* A, int lda, const bf16* Bt, int K, bf16* C, int ldc, int row_begin, int nrows, int N, const Ctx& c, int first_wg, unsigned char* lds, bool only_tail = false) {
    const int tn = N / 64, nt = (nrows / 64) * tn;
    const int f = first_wg % c.nblk, np = (only_tail && f > 0) ? c.nblk - f : c.nblk;
    const int v = only_tail && f > 0 ? c.bid - f : (c.bid + c.nblk - f) % c.nblk;
    if (v >= 0) for (int it = v; it < nt; it += np) sgemm_tile<false, BMODE>(p, 0, A, lda, Bt, K, C, ldc, row_begin + (it / tn) * 64, (it % tn) * 64, c.tid, lds);
    LBAR();
}
__device__ __forceinline__ void ph_a_gemm(PrmRef p, const Ctx& c, int li, unsigned char* lds) {
    const bf16* XB = (const bf16*)(p.ws + WS_XB); bf16* PROJ = (bf16*)(p.ws + WS_PROJ); const bf16* Wt = (const bf16*)(p.ws + WS_WAIN) + (size_t)li * A_NG * D_MODEL;
    pg8::Gemm g{XB, D_MODEL, Wt, PT, A_MAIN, D_MODEL}; pg8::StaticOrder S; S.init(PT, A_MAIN, c.nblk, c.bid);
    pg8::EpiAIn E{PROJ, PLD, (bf16*)(p.ws + WS_HALO), p.out + O_PCONV + (size_t)li * BATCH * 3 * CONV_DIM};
    __syncthreads();
    pg8::gemm_phase<pg8::EpiAIn, pg8::StaticOrder, true>((LAS unsigned char*)lds, g, S, E, c.tid);
    __syncthreads();
    for (int it = c.bid; it < MT / 64; it += c.nblk) sgemm_tile<true>(p, li, XB, D_MODEL, Wt, D_MODEL, nullptr, 0, it * 64, A_MAIN, c.tid, lds);
    sgemm_rows(p, XB, D_MODEL, Wt, D_MODEL, PROJ, PLD, PT, ST, A_MAIN, c, MT / 64, lds);
}
constexpr int NPG = BATCH * A_HEADS, NSG = DEC_BATCH * A_HEADS, NPI = NPG * NCPS;
__device__ __forceinline__ unsigned pk2bf(float lo, float hi) { return cvtpk(lo, hi); }
constexpr int PP_KN = 0, PP_QN = 17408, PP_KF = 34816, PP_VF = 67584, PP_GC = 100352, PP_LN = 102400, PP_LNP = 68, PP_TI = PP_LN + 64 * PP_LNP * 4, PP_WST = PP_TI + 4 * 16 * 17 * 4, PP_CW = PP_WST + 17408, PP_END = PP_CW + 3 * 4 * 128 * 4;
static_assert(PP_END <= 163840 - 64 && PP_TI % 16 == 0 && PP_WST % 16 == 0 && PP_CW % 16 == 0, "prepass LDS");
typedef u32x4 RawTile[3][4][2];
__device__ __forceinline__ void prepass_load_raw(PrmRef p, int item, int tid, RawTile& xr) {
    const bf16* PROJ = (const bf16*)(p.ws + WS_PROJ); const bf16* HALO = (const bf16*)(p.ws + WS_HALO);
    const int n = item % NCPS, grp = item / NCPS, h = grp % A_HEADS, s = grp / A_HEADS, R0 = s * SEQ + n * CHUNK, r = tid >> 3, seg = tid & 7;
#pragma unroll
    for (int X = 0; X < 3; ++X) {
        const int cb = X * A_QK + h * A_DK + 16 * seg;
#pragma unroll
        for (int j = 0; j < 4; ++j) {
            const int rr = r - 3 + j;
            if (rr >= 0) { const u32x4* src = (const u32x4*)(PROJ + (size_t)(R0 + rr) * PLD + cb); xr[X][j][0] = src[0]; xr[X][j][1] = src[1]; }
            else if (n > 0) { const u32x4* src = (const u32x4*)(HALO + ((size_t)(s * NCPS + n - 1) * 3 + (3 + rr)) * CONV_DIM + cb); xr[X][j][0] = src[0]; xr[X][j][1] = src[1]; }
            else { xr[X][j][0] = (u32x4){0u, 0u, 0u, 0u}; xr[X][j][1] = xr[X][j][0]; }
        }
    }
}
__device__ __forceinline__ void prepass_gcum(PrmRef p, int item, int lane, float* GC) {
    const float* GB = (const float*)(p.ws + WS_GB); float* GL = (float*)(p.ws + WS_GL);
    const int n = item % NCPS, grp = item / NCPS, h = grp % A_HEADS, s = grp / A_HEADS, R0 = s * SEQ + n * CHUNK;
    const float g = GB[((size_t)(R0 + lane) * A_HEADS + h) * 2], bt = GB[((size_t)(R0 + lane) * A_HEADS + h) * 2 + 1];
    float cs = g;
#pragma unroll
    for (int d = 1; d < 64; d <<= 1) { const float o = __shfl(cs, lane >= d ? lane - d : lane); if (lane >= d) cs += o; }
    const float gl = __shfl(cs, 63);
    GC[lane] = cs; GC[64 + lane] = bt; GC[128 + lane] = fexp(cs); GC[192 + lane] = fexp(gl - cs);
    if (lane == 0) GL[item] = fexp(gl);
}
__device__ __forceinline__ void prepass_store_w(PrmRef p, int item, int tid, const unsigned char* lds) {
    bf16* WB = (bf16*)(p.ws + WS_WB); const bf16* WST = (const bf16*)(lds + PP_WST);
    const int n = item % NCPS, grp = item / NCPS, h = grp % A_HEADS, s = grp / A_HEADS, R0 = s * SEQ + n * CHUNK, r = tid >> 3, seg = tid & 7;
    const u32x4 w0 = *(const u32x4*)(WST + r * 136 + 16 * seg), w1 = *(const u32x4*)(WST + r * 136 + 16 * seg + 8);
    u32x4* dst = (u32x4*)(WB + (size_t)(R0 + r) * A_QK + h * A_DK + 16 * seg); dst[0] = w0; dst[1] = w1;
}
template <int VAR = 0> __device__ __forceinline__ void delta_prepass_item(PrmRef p, int li, int item, int next_item, int prev_item, int pb, int tid, unsigned char* lds, RawTile& xr) {
#ifndef EMU
    asm volatile("" : "+v"(tid));
#endif
    bf16* PROJ = (bf16*)(p.ws + WS_PROJ); bf16* IA = (bf16*)(p.ws + WS_IA);
    const int n = item % NCPS, grp = item / NCPS, h = grp % A_HEADS, s = grp / A_HEADS;
    const int R0 = s * SEQ + n * CHUNK, lane = tid & 63, wave = READFIRSTLANE(tid >> 6);
    bf16* KN = (bf16*)(lds + PP_KN); bf16* QN = (bf16*)(lds + PP_QN); bf16* VN = (bf16*)(lds + PP_KF);
    float* GC = (float*)(lds + PP_GC) + pb * 256; float* BT = GC + 64; float* EG = GC + 128; float* KD = GC + 192;
    float* LN = (float*)(lds + PP_LN);
    float* TI = (float*)(lds + PP_TI);
    bf16* WST = (bf16*)(lds + PP_WST);
    if (prev_item >= 0) prepass_store_w(p, prev_item, tid, lds);
    const int r = tid >> 3, seg = tid & 7;
    float qf[16];
#pragma unroll
    for (int X = 0; X < 3; ++X) {
        const int cb = X * A_QK + h * A_DK + 16 * seg;
        float acc[16];
#pragma unroll
        for (int e = 0; e < 16; ++e) acc[e] = 0.f;
#pragma unroll
        for (int j = 0; j < 4; ++j) {
            const f32x4* wp = (const f32x4*)(lds + PP_CW) + ((X * 4 + j) * 128 + 16 * seg) / 4;
#pragma unroll
            for (int e = 0; e < 4; ++e) {
                const f32x4 w4 = wp[e]; const unsigned a = xr[X][j][e >> 1][2 * (e & 1)], b = xr[X][j][e >> 1][2 * (e & 1) + 1];
                acc[4 * e] += w4[0] * bflo(a); acc[4 * e + 1] += w4[1] * bfhi(a); acc[4 * e + 2] += w4[2] * bflo(b); acc[4 * e + 3] += w4[3] * bfhi(b);
            }
        }
        float ss = 0.f;
#pragma unroll
        for (int e = 0; e < 16; ++e) { acc[e] = fsilu(acc[e]); ss += acc[e] * acc[e]; }
        if (X < 2) {
            ss = sum8(ss);
            const float rs = fast_rsq(ss + RMS_EPS) * (X == 0 ? 0.08838834764831845f : 1.f);
#pragma unroll
            for (int e = 0; e < 16; ++e) acc[e] *= rs;
        }
        if (X == 0) {
#pragma unroll
            for (int e = 0; e < 16; ++e) qf[e] = acc[e];
            u32x4 o0, o1;
#pragma unroll
            for (int e = 0; e < 4; ++e) { o0[e] = cvtpk(acc[2 * e], acc[2 * e + 1]); o1[e] = cvtpk(acc[8 + 2 * e], acc[8 + 2 * e + 1]); }
            *(u32x4*)(QN + r * 136 + 16 * seg) = o0; *(u32x4*)(QN + r * 136 + 16 * seg + 8) = o1;
        } else if (X == 1) {
            u32x4 o0, o1;
#pragma unroll
            for (int e = 0; e < 4; ++e) { o0[e] = cvtpk(acc[2 * e], acc[2 * e + 1]); o1[e] = cvtpk(acc[8 + 2 * e], acc[8 + 2 * e + 1]); }
            *(u32x4*)(KN + r * 136 + 16 * seg) = o0; *(u32x4*)(KN + r * 136 + 16 * seg + 8) = o1;
        } else {
            u32x4 o0, o1;
#pragma unroll
            for (int e = 0; e < 4; ++e) { o0[e] = cvtpk(acc[2 * e], acc[2 * e + 1]); o1[e] = cvtpk(acc[8 + 2 * e], acc[8 + 2 * e + 1]); }
            *(u32x4*)(VN + r * 136 + 16 * seg) = o0; *(u32x4*)(VN + r * 136 + 16 * seg + 8) = o1;
        }
    }
    LBAR();
    if (next_item >= 0) prepass_load_raw(p, next_item, tid, xr);
    {
        const float eg = EG[r]; u32x4 o0, o1;
#pragma unroll
        for (int e = 0; e < 4; ++e) { o0[e] = cvtpk(qf[2 * e] * eg, qf[2 * e + 1] * eg); o1[e] = cvtpk(qf[8 + 2 * e] * eg, qf[8 + 2 * e + 1] * eg); }
        u32x4* dst = (u32x4*)(PROJ + (size_t)(R0 + r) * PLD + h * A_DK + 16 * seg); dst[0] = o0; dst[1] = o1;
    }
    if (VAR != 4) {
        const int kind = wave >> 2, ti = (wave >> 1) & 1, tj = wave & 1, l31 = lane & 31, hi = lane >> 5;
        if (wave == 1) {
            if (next_item >= 0) prepass_gcum(p, next_item, lane, (float*)(lds + PP_GC) + (pb ^ 1) * 256);
#pragma unroll
            for (int e = 0; e < 16; ++e) LN[((e & 3) + 8 * (e >> 2) + 4 * hi) * PP_LNP + 32 + l31] = 0.f;
        } else {
            f32x16 acc;
#pragma unroll
            for (int e = 0; e < 16; ++e) acc[e] = 0.f;
            const unsigned char* ap = (const unsigned char*)(kind == 0 ? KN : QN) + (32 * ti + l31) * 272 + 16 * hi;
            const unsigned char* bp = (const unsigned char*)KN + (32 * tj + l31) * 272 + 16 * hi;
            if (ti >= tj) {
#pragma unroll
                for (int ks = 0; ks < 8; ++ks) { const bf16x8 a = *(const bf16x8*)(ap + 32 * ks), b = *(const bf16x8*)(bp + 32 * ks); acc = MFMA32(a, b, acc); }
            }
            const int col = 32 * tj + l31; const float gcc = GC[col];
#pragma unroll
            for (int e = 0; e < 16; ++e) {
                const int row = 32 * ti + (e & 3) + 8 * (e >> 2) + 4 * hi;
                if (kind == 0) LN[row * PP_LNP + col] = row > col ? -(BT[row] * acc[e] * fexp(GC[row] - gcc)) : 0.f;
                else IA[((size_t)item * 64 + row) * 64 + col] = (bf16)f2bf(row >= col ? acc[e] * fexp(GC[row] - gcc) : 0.f);
            }
            if (wave == 0 || wave == 3) {
                WAVE_SYNC();
                if (lane < 32) {
                    const int b = (wave == 3 ? 2 : 0) + (lane >> 4), j = lane & 15; float t[16];
#pragma unroll
                    for (int i = 0; i < 16; ++i) {
                        float v = i == j ? 1.f : 0.f;
#pragma unroll
                        for (int k = 0; k < i; ++k) v += LN[(16 * b + i) * PP_LNP + 16 * b + k] * t[k];
                        t[i] = v;
                    }
#pragma unroll
                    for (int i = 0; i < 16; ++i) TI[(b * 16 + i) * 17 + j] = t[i];
                }
            } else if (wave >= 4) {
                const int u = tid - 256, m = u & 127, half = u >> 7;
                unsigned char* dst = (unsigned char*)PROJ + ((size_t)(R0 + (m >> 1)) * PLD + A_QK + h * A_DK) * 2 + (m & 1) * 128 + half * 64;
#pragma unroll
                for (int q4 = 0; q4 < 4; ++q4) {
                    u32x4 o;
#pragma unroll
                    for (int e = 0; e < 4; ++e) { const int j = 32 * half + 8 * q4 + 2 * e; o[e] = cvtpk(bf2f(KN[j * 136 + m]) * KD[j], bf2f(KN[(j + 1) * 136 + m]) * KD[j + 1]); }
                    *(u32x4*)(dst + 16 * q4) = o;
                }
            }
        }
    }
    LBAR();
    if (VAR != 4 && VAR != 1) {
        const int g = lane >> 4, cl = lane & 15;
        f32x4 XU[4], XW[4];
#pragma unroll
        for (int b = 0; b < 4; ++b) {
            f32x4 yu, yw;
#pragma unroll
            for (int e = 0; e < 4; ++e) { const int row = 16 * b + 4 * g + e; const float bt = BT[row]; yu[e] = bf2f(VN[row * 136 + 16 * wave + cl]) * bt; yw[e] = bf2f(KN[row * 136 + 16 * wave + cl]) * (bt * EG[row]); }
            float la[12], ta[4];
#pragma unroll
            for (int c = 0; c < b; ++c)
#pragma unroll
                for (int ks = 0; ks < 4; ++ks) la[4 * c + ks] = LN[(16 * b + cl) * PP_LNP + 16 * c + 4 * g + ks];
#pragma unroll
            for (int ks = 0; ks < 4; ++ks) ta[ks] = TI[(b * 16 + cl) * 17 + 4 * g + ks];
            SCHED_BARRIER();
#pragma unroll
            for (int c = 0; c < b; ++c)
#pragma unroll
                for (int ks = 0; ks < 4; ++ks) { yu = MFMAF(la[4 * c + ks], XU[c][ks], yu); yw = MFMAF(la[4 * c + ks], XW[c][ks], yw); }
            f32x4 xu = (f32x4){0.f, 0.f, 0.f, 0.f}, xw = xu;
#pragma unroll
            for (int ks = 0; ks < 4; ++ks) { xu = MFMAF(ta[ks], yu[ks], xu); xw = MFMAF(ta[ks], yw[ks], xw); }
            XU[b] = xu; XW[b] = xw;
            u32x2 o; o.x = cvtpk(xu[0], xu[1]); o.y = cvtpk(xu[2], xu[3]);
            *(u32x2*)((unsigned char*)PROJ + ((size_t)(R0 + wave * 8 + 2 * b + (lane >> 5)) * PLD + 2 * A_QK + h * A_DV) * 2 + (lane & 31) * 8) = o;
#pragma unroll
            for (int e = 0; e < 4; ++e) WST[(16 * b + 4 * g + e) * 136 + 16 * wave + cl] = (bf16)(cvtpk(xw[e], 0.f) & 0xffffu);
        }
    }
    LBAR();
}

__device__ __forceinline__ bf16x8 pack_b(const f32x4 a, const f32x4 b) {
    u32x4 o; o.x = pk2bf(a[0], a[1]); o.y = pk2bf(a[2], a[3]); o.z = pk2bf(b[0], b[1]); o.w = pk2bf(b[2], b[3]); return __builtin_bit_cast(bf16x8, o);
}
__device__ __forceinline__ bf16x8 ld_frag(const unsigned char* base, int off0, int off1) {
    const u32x2 lo = *(const u32x2*)(base + off0), hi = *(const u32x2*)(base + off1);
    u32x4 o; o.x = lo.x; o.y = lo.y; o.z = hi.x; o.w = hi.y; return __builtin_bit_cast(bf16x8, o);
}
constexpr int SC_BUF = 65536, SC_W = 0, SC_QD = 16384, SC_KDT = 32768, SC_IA = 49152, SC_U = 57344;
__device__ __forceinline__ void scan_dma(PrmRef p, int grp, int half, int n, int lw, int lane, unsigned char* buf) {
    const unsigned char* PROJ = (const unsigned char*)(p.ws + WS_PROJ); const unsigned char* WB = (const unsigned char*)(p.ws + WS_WB); const unsigned char* IA = (const unsigned char*)(p.ws + WS_IA);
    const int h = grp % A_HEADS, s = grp / A_HEADS, R0 = s * SEQ + n * CHUNK;
    const unsigned char* bW = WB + ((size_t)R0 * A_QK + h * A_DK) * 2;
    const unsigned char* bQ = PROJ + ((size_t)R0 * PLD + h * A_DK) * 2;
    const unsigned char* bK = PROJ + ((size_t)R0 * PLD + A_QK + h * A_DK) * 2;
    const unsigned char* bU = PROJ + ((size_t)(R0 + 32 * half) * PLD + 2 * A_QK + h * A_DV) * 2;
    const unsigned char* bI = IA + (size_t)(grp * NCPS + n) * 8192;
#pragma unroll
    for (int j = 0; j < 4; ++j) {
        const int ip = lw + 4 * j, sg = ip * 64 + lane;
        { const int row = sg >> 4, pc = (sg & 15) ^ (row & 15);
          GLDS16(bW + (unsigned)row * (unsigned)(A_QK * 2) + (unsigned)pc * 16u, buf + SC_W + ip * 1024);
          GLDS16(bQ + (unsigned)row * (unsigned)(PLD * 2) + (unsigned)pc * 16u, buf + SC_QD + ip * 1024); }
        { const int m = sg >> 3, pc = (sg & 7) ^ ((m >> 1) & 7);
          GLDS16(bK + (unsigned)(m >> 1) * (unsigned)(PLD * 2) + (unsigned)(m & 1) * 128u + (unsigned)pc * 16u, buf + SC_KDT + ip * 1024); }
        if (j < 2) {
          { const int row = sg >> 3, pc = (sg & 7) ^ ((row >> 1) & 7); GLDS16(bI + (unsigned)row * 128u + (unsigned)pc * 16u, buf + SC_IA + ip * 1024); }
          GLDS16(bU + (unsigned)(sg >> 4) * (unsigned)(PLD * 2) + (unsigned)(sg & 15) * 16u, buf + SC_U + ip * 1024);
        }
    }
}
template <int SV = 0> __device__ __forceinline__ void delta_scan_group(PrmRef p, int li, int item, int tid, unsigned char* lds, bool wstate = true) {
    unsigned char* PROJ = (unsigned char*)(p.ws + WS_PROJ); const float* GL = (const float*)(p.ws + WS_GL);
    const int grp = item >> 1, half = item & 1;
    const int h = grp % A_HEADS, s = grp / A_HEADS, lane = tid & 63, wave = READFIRSTLANE(tid >> 6);
    const bool loader = wave >= 4; const int cw = 4 * half + (wave & 3);
    f32x4 S[8];
#pragma unroll
    for (int m = 0; m < 8; ++m) S[m] = (f32x4){0.f, 0.f, 0.f, 0.f};
    unsigned char* fp = PROJ + ((size_t)(s * SEQ + cw * 8 + (lane >> 5)) * PLD + 2 * A_QK + h * A_DV) * 2 + (lane & 31) * 8;
    constexpr size_t TSTEP = (size_t)2 * PLD * 2, CSTEP = (size_t)CHUNK * PLD * 2;
    static_assert(NCPS <= 64, "glast per lane");
    const float glv = GL[grp * NCPS + (lane < NCPS ? lane : 0)];
    if (loader) { if (SV != 1) scan_dma(p, grp, half, 0, wave - 4, lane, lds); }
    WAIT_VM(0); LBAR();
    for (int n = 0; n < NCPS; ++n) {
        unsigned char* buf = lds + (n & 1) * SC_BUF;
        if (loader) {
            if (n + 1 < NCPS) { if (SV != 1) scan_dma(p, grp, half, n + 1, wave - 4, lane, lds + ((n + 1) & 1) * SC_BUF); }
            WAIT_VM(0);
        } else {
        int lane2 = lane;
#ifndef EMU
        asm volatile("" : "+v"(lane2));
#endif
        const int g = lane2 >> 4, cl = lane2 & 15, gh = g >> 1;
        int oW[4][2], oH[2][2];
#pragma unroll
        for (int ks = 0; ks < 4; ++ks) { const int x = (4 * ks + gh) ^ cl; oW[ks][0] = cl * 256 + (x << 4) + 8 * (g & 1); oW[ks][1] = cl * 256 + ((x ^ 2) << 4) + 8 * (g & 1); }
#pragma unroll
        for (int ks = 0; ks < 2; ++ks) { const int x = (4 * ks + gh) ^ (cl >> 1); oH[ks][0] = cl * 128 + (x << 4) + 8 * (g & 1); oH[ks][1] = cl * 128 + ((x ^ 2) << 4) + 8 * (g & 1); }
        u32x2 uf[4];
#pragma unroll
        for (int t = 0; t < 4; ++t) uf[t] = *(const u32x2*)(buf + SC_U + ((wave & 3) * 8 + 2 * t + (lane2 >> 5)) * 256 + (lane2 & 31) * 8);
        const float glast = BCAST_LANE(glv, n);
        bf16x8 Bs[4];
#pragma unroll
        for (int ks = 0; ks < 4; ++ks) Bs[ks] = pack_b(S[2 * ks], S[2 * ks + 1]);
        bf16x8 fa[4][4];
#pragma unroll
        for (int t = 0; t < 4; ++t)
#pragma unroll
            for (int ks = 0; ks < 4; ++ks) fa[t][ks] = ld_frag(buf + SC_W + t * 4096, oW[ks][0], oW[ks][1]);
        SCHED_BARRIER();
        f32x4 vn[4];
#pragma unroll
        for (int t = 0; t < 4; ++t) vn[t] = (f32x4){0.f, 0.f, 0.f, 0.f};
#pragma unroll
        for (int ks = 0; ks < (SV == 3 ? 0 : 4); ++ks)
#pragma unroll
            for (int t = 0; t < 4; ++t) vn[t] = MFMA16(fa[t][ks], Bs[ks], vn[t]);
#pragma unroll
        for (int t = 0; t < 4; ++t) { const f32x4 u = (f32x4){bflo(uf[t].x), bfhi(uf[t].x), bflo(uf[t].y), bfhi(uf[t].y)}; vn[t] = u - vn[t]; }
        SCHED_BARRIER();
        bf16x8 fk[8][2];
#pragma unroll
        for (int m = 0; m < 8; ++m)
#pragma unroll
            for (int ks = 0; ks < 2; ++ks) fk[m][ks] = ld_frag(buf + SC_KDT + m * 2048, oH[ks][0], oH[ks][1]);
        SCHED_BARRIER();
        bf16x8 Vb[2];
        Vb[0] = pack_b(vn[0], vn[1]); Vb[1] = pack_b(vn[2], vn[3]);
#pragma unroll
        for (int m = 0; m < 8; ++m) S[m] = S[m] * glast;
#pragma unroll
        for (int ks = 0; ks < 2; ++ks)
#pragma unroll
            for (int m = 0; m < 8; ++m) S[m] = MFMA16(fk[m][ks], Vb[ks], S[m]);
#pragma unroll
        for (int t = 0; t < 4; ++t)
#pragma unroll
            for (int ks = 0; ks < 4; ++ks) fa[t][ks] = ld_frag(buf + SC_QD + t * 4096, oW[ks][0], oW[ks][1]);
        bf16x8 fi[4][2];
#pragma unroll
        for (int t = 0; t < 4; ++t)
#pragma unroll
            for (int ks = 0; ks < 2; ++ks) fi[t][ks] = ld_frag(buf + SC_IA + t * 2048, oH[ks][0], oH[ks][1]);
        SCHED_BARRIER();
        f32x4 oa[4];
#pragma unroll
        for (int t = 0; t < 4; ++t) oa[t] = (f32x4){0.f, 0.f, 0.f, 0.f};
        if (SV != 2) {
#pragma unroll
        for (int ks = 0; ks < 4; ++ks)
#pragma unroll
            for (int t = 0; t < 4; ++t) oa[t] = MFMA16(fa[t][ks], Bs[ks], oa[t]);
#pragma unroll
        for (int ks = 0; ks < 2; ++ks)
#pragma unroll
            for (int t = 0; t < 4; ++t) oa[t] = MFMA16(fi[t][ks], Vb[ks], oa[t]);
#pragma unroll
        for (int t = 0; t < 4; ++t) {
            u32x2 w; w.x = cvtpk(oa[t][0], oa[t][1]); w.y = cvtpk(oa[t][2], oa[t][3]);
            if (SV == 4) { asm volatile("" :: "v"(w.x), "v"(w.y)); } else
            *(u32x2*)(fp + (size_t)n * CSTEP + t * TSTEP) = w;
        }
        }
        WAIT_VM(4);
        }
        LBAR();
    }
    if (!loader && (wstate || SV != 0)) {
    float* so = SV != 0 ? (float*)(p.ws + WS_XB) + (size_t)grp * A_DK * A_DV : p.out + O_PDELTA + (((size_t)li * BATCH + s) * A_HEADS + h) * A_DK * A_DV;
#pragma unroll
    for (int m = 0; m < 8; ++m)
#pragma unroll
        for (int e = 0; e < 4; ++e) so[(size_t)(16 * m + 4 * (lane >> 4) + e) * A_DV + 16 * cw + (lane & 15)] = S[m][e];
    }
    LBAR();
}
constexpr int NM_PART = 0, NM_OST = 2048;
struct NormRaw { u32x2 of[4]; u32x4 z0, z1; };
__device__ __forceinline__ void norm_load(PrmRef p, int item, int tid, NormRaw& q) {
    const unsigned char* PROJ = (const unsigned char*)(p.ws + WS_PROJ);
    const int n = item % NCPS, grp = item / NCPS, h = grp % A_HEADS, s = grp / A_HEADS, R0 = s * SEQ + n * CHUNK;
    const int lane = tid & 63, wave = tid >> 6, r = tid >> 3, seg = tid & 7;
    const unsigned char* fp = PROJ + ((size_t)(R0 + wave * 8 + (lane >> 5)) * PLD + 2 * A_QK + h * A_DV) * 2 + (lane & 31) * 8;
#pragma unroll
    for (int t = 0; t < 4; ++t) q.of[t] = *(const u32x2*)(fp + (size_t)t * 2 * PLD * 2);
    const u32x4* zp = (const u32x4*)(PROJ + ((size_t)(R0 + r) * PLD + CONV_DIM + h * A_DV + 16 * seg) * 2); q.z0 = zp[0]; q.z1 = zp[1];
}
__device__ __forceinline__ void delta_norm_item(PrmRef p, int li, int item, int next_item, int tid, unsigned char* lds, NormRaw& raw) {
    unsigned char* PROJ = (unsigned char*)(p.ws + WS_PROJ);
    const int n = item % NCPS, grp = item / NCPS, h = grp % A_HEADS, s = grp / A_HEADS, R0 = s * SEQ + n * CHUNK;
    const int lane = tid & 63, wave = tid >> 6, g = lane >> 4, cl = lane & 15, r = tid >> 3, seg = tid & 7;
    float* PART = (float*)(lds + NM_PART);
    const float nw = p.a_norm_w[li * A_DV + 16 * wave + cl];
    const u32x4 z0 = raw.z0, z1 = raw.z1;
    f32x4 oa[4];
#pragma unroll
    for (int t = 0; t < 4; ++t) {
        oa[t] = (f32x4){bflo(raw.of[t].x), bfhi(raw.of[t].x), bflo(raw.of[t].y), bfhi(raw.of[t].y)};
        f32x4 q4;
#pragma unroll
        for (int e = 0; e < 4; ++e) q4[e] = sum16(oa[t][e] * oa[t][e]);
        if (cl < 4) PART[(16 * t + 4 * g + cl) * 8 + wave] = cl == 0 ? q4[0] : cl == 1 ? q4[1] : cl == 2 ? q4[2] : q4[3];
    }
    if (next_item >= 0) norm_load(p, next_item, tid, raw);
    LBAR();
#pragma unroll
    for (int t = 0; t < 4; ++t)
#pragma unroll
        for (int e = 0; e < 4; ++e) {
            const int row = 16 * t + 4 * g + e;
            const f32x4 p0 = *(const f32x4*)(PART + row * 8), p1 = *(const f32x4*)(PART + row * 8 + 4);
            const float ss = ((p0[0] + p0[1]) + (p0[2] + p0[3])) + ((p1[0] + p1[1]) + (p1[2] + p1[3]));
            *(bf16*)(lds + NM_OST + row * 272 + (16 * wave + cl) * 2) = (bf16)(cvtpk(oa[t][e] * fast_rsq(ss * (1.f / A_DV) + RMS_EPS) * nw, 0.f) & 0xffffu);
        }
    LBAR();
    {
        const u32x4 o0 = *(const u32x4*)(lds + NM_OST + r * 272 + 32 * seg), o1 = *(const u32x4*)(lds + NM_OST + r * 272 + 32 * seg + 16);
        u32x4 w0, w1;
#pragma unroll
        for (int e = 0; e < 4; ++e) {
            w0[e] = cvtpk(bflo(o0[e]) * fsilu(bflo(z0[e])), bfhi(o0[e]) * fsilu(bfhi(z0[e])));
            w1[e] = cvtpk(bflo(o1[e]) * fsilu(bflo(z1[e])), bfhi(o1[e]) * fsilu(bfhi(z1[e])));
        }
        u32x4* dst = (u32x4*)(PROJ + ((size_t)(R0 + r) * PLD + 2 * A_QK + h * A_DV + 16 * seg) * 2); dst[0] = w0; dst[1] = w1;
    }
    LBAR();
}
__device__ __forceinline__ void ph_a_norm(PrmRef p, const Ctx& c, int li, unsigned char* lds) {
    NormRaw raw;
    if (c.bid < NPI) norm_load(p, c.bid, c.tid, raw);
    for (int item = c.bid; item < NPI; item += c.nblk) delta_norm_item(p, li, item, item + c.nblk < NPI ? item + c.nblk : -1, c.tid, lds, raw);
    bf16* PROJ = (bf16*)(p.ws + WS_PROJ);
    sgemm_rows(p, PROJ + 2 * A_QK, PLD, (const bf16*)(p.ws + WS_WAOUT) + (size_t)li * D_MODEL * A_VW, A_VW, PROJ, PLD, PT, ST, D_MODEL, c, NPI, lds);
}
__device__ __forceinline__ void sample_conv(PrmRef p, const Ctx& c, int li) {
    bf16* PROJ = (bf16*)(p.ws + WS_PROJ);
    const float* cw = p.a_conv_w + (size_t)li * CONV_W * CONV_DIM;
    for (int it = c.gtid; it < DEC_BATCH * CONV_DIM; it += c.nthreads) {
        const int ch = it % CONV_DIM, b = it / CONV_DIM;
        const float* sp = p.state_conv + (((size_t)li * DEC_BATCH + b) * 3) * CONV_DIM + ch;
        float h0 = sp[0], h1 = sp[CONV_DIM], h2 = sp[2 * CONV_DIM];
        const float w0 = cw[ch], w1 = cw[CONV_DIM + ch], w2 = cw[2 * CONV_DIM + ch], w3 = cw[3 * CONV_DIM + ch];
        bf16* e0 = PROJ + (size_t)(PT + b * DEC_SEQ) * PLD + ch;
        bf16 xv[DEC_SEQ];
#pragma unroll
        for (int t = 0; t < DEC_SEQ; ++t) xv[t] = e0[(size_t)t * PLD];
#pragma unroll
        for (int t = 0; t < DEC_SEQ; ++t) {
            const float x = bf2f(xv[t]);
            const float y = w0 * h0 + w1 * h1 + w2 * h2 + w3 * x;
            e0[(size_t)t * PLD] = (bf16)(cvtpk(fsilu(y), 0.f) & 0xffffu); h0 = h1; h1 = h2; h2 = x;
        }
        float* so = p.out + O_SCONV + (((size_t)li * DEC_BATCH + b) * 3) * CONV_DIM + ch;
        so[0] = h0; so[CONV_DIM] = h1; so[2 * CONV_DIM] = h2;
    }
}
__device__ __forceinline__ void sample_scan_group(PrmRef p, int li, int sg, int tid, unsigned char* lds, bool wstate = true) {
    bf16* PROJ = (bf16*)(p.ws + WS_PROJ); const float* GB = (const float*)(p.ws + WS_GB);
    float* kq = (float*)lds;
    const int b = sg / A_HEADS, h = sg % A_HEADS, r0 = PT + b * DEC_SEQ, col = tid >> 2, part = tid & 3, lane = tid & 63, wave = tid >> 6;
    float S[32];
    const float* s0 = p.state_delta + (((size_t)li * DEC_BATCH + b) * A_HEADS + h) * A_DK * A_DV;
#pragma unroll
    for (int k = 0; k < 32; ++k) S[k] = s0[(size_t)(part * 32 + k) * A_DV + col];
    for (int t = 0; t < DEC_SEQ; ++t) {
        const size_t rb = (size_t)(r0 + t) * PLD;
        __syncthreads();
        if (wave < 2) {
            const bf16* e = PROJ + rb + (wave == 0 ? A_QK : 0) + h * A_DK + 2 * lane;
            const float a = bf2f(e[0]), bb = bf2f(e[1]);
            const float sc = (1.f / sqrtf(wave_sum(a * a + bb * bb) + RMS_EPS)) * (wave == 0 ? 1.f : 0.08838834764831845f);
            kq[wave * 128 + 2 * lane] = a * sc; kq[wave * 128 + 2 * lane + 1] = bb * sc;
        }
        __syncthreads();
        const float gg = GB[((size_t)(r0 + t) * A_HEADS + h) * 2], beta = GB[((size_t)(r0 + t) * A_HEADS + h) * 2 + 1];
        const float eg = expf(gg); const float v = bf2f(PROJ[rb + 2 * A_QK + h * A_DV + col]);
        const float* kk = kq + part * 32; const float* qq = kq + 128 + part * 32;
        float ks = 0.f;
#pragma unroll
        for (int k = 0; k < 32; ++k) { S[k] *= eg; ks += kk[k] * S[k]; }
        ks += __shfl_xor(ks, 1); ks += __shfl_xor(ks, 2);
        const float vn = (v - ks) * beta; float o = 0.f;
#pragma unroll
        for (int k = 0; k < 32; ++k) { S[k] += kk[k] * vn; o += qq[k] * S[k]; }
        o += __shfl_xor(o, 1); o += __shfl_xor(o, 2);
        if (part == 0) PROJ[rb + 2 * A_QK + h * A_DV + col] = (bf16)f2bf(o);
    }
    float* so = p.out + O_SDELTA + (((size_t)li * DEC_BATCH + b) * A_HEADS + h) * A_DK * A_DV;
    if (wstate) {
#pragma unroll
    for (int k = 0; k < 32; ++k) so[(size_t)(part * 32 + k) * A_DV + col] = S[k];
    }
    __syncthreads();
    const float* nw = p.a_norm_w + (size_t)li * A_DV;
#pragma unroll 1
    for (int i = 0; i < 4; ++i) {
        const int row = r0 + wave * 4 + i;
        bf16* e = PROJ + (size_t)row * PLD + 2 * A_QK + h * A_DV + 2 * lane; const bf16* z = PROJ + (size_t)row * PLD + CONV_DIM + h * A_DV + 2 * lane;
        const float a = bf2f(e[0]), bb = bf2f(e[1]);
        const float r = 1.f / sqrtf(wave_sum(a * a + bb * bb) * (1.f / A_DV) + RMS_EPS);
        e[0] = (bf16)f2bf(a * r * nw[2 * lane] * siluf(bf2f(z[0]))); e[1] = (bf16)f2bf(bb * r * nw[2 * lane + 1] * siluf(bf2f(z[1])));
    }
    __syncthreads();
}
template <int VAR = 0> __device__ __forceinline__ void ph_a_pre(PrmRef p, const Ctx& c, int li, unsigned char* lds) {
    RawTile xr;
    if (c.bid < NPI) { prepass_load_raw(p, c.bid, c.tid, xr); if (c.wave == 1) prepass_gcum(p, c.bid, c.lane, (float*)(lds + PP_GC)); }
    int prev = -1, pb = 0, cur_h = -1;
    for (int item = c.bid; item < NPI; item += c.nblk) {
        const int h = (item / NCPS) % A_HEADS;
        if (h != cur_h) {
            LBAR();
            for (int i = c.tid; i < 3 * 4 * 128; i += NTHR) { const int X = i / 512, j = (i / 128) & 3, ch = i & 127; ((float*)(lds + PP_CW))[i] = p.a_conv_w[((size_t)li * CONV_W + j) * CONV_DIM + X * A_QK + h * A_DK + ch]; }
            LBAR(); cur_h = h;
        }
        delta_prepass_item<VAR>(p, li, item, item + c.nblk < NPI ? item + c.nblk : -1, prev, pb, c.tid, lds, xr); prev = item; pb ^= 1;
    }
    if (prev >= 0) prepass_store_w(p, prev, c.tid, lds);
    LBAR();
    if (VAR == 0) sample_conv(p, c, li);
}
template <int SV = 0> __device__ __forceinline__ void ph_a_scan2(PrmRef p, const Ctx& c, int li, unsigned char* lds, bool wstate = true, bool do_prompt = true, bool do_sample = true) {
    const int v = (c.bid + c.nblk - ((2 * NPG) % c.nblk)) % c.nblk;
    if (do_sample) for (int sg = v; sg < NSG; sg += c.nblk) sample_scan_group(p, li, sg, c.tid, lds, wstate);
    if (SV == 0) {
        const int nfree = c.nblk > 2 * NPG ? c.nblk - 2 * NPG : 0;
        if (nfree == 0) weights_deferred(p, c, li, lds, c.gwave, c.nwaves); else if (v < nfree) weights_deferred(p, c, li, lds, v * (NTHR / 64) + c.wave, nfree * (NTHR / 64));
        LBAR();
    }
    if (do_prompt) for (int it = c.bid; it < 2 * NPG; it += c.nblk) delta_scan_group<SV>(p, li, it, c.tid, lds, wstate);
}

__device__ __forceinline__ void ph_ln(PrmRef p, const Ctx& c, const bf16* OUT, int ldo, const float* g, const float* b, bool last) {
    bf16* XB = (bf16*)(p.ws + WS_XB);
    constexpr int PER = D_MODEL / 64;
    constexpr int RB = 3;
    static_assert(PER % 8 == 0, "ln vector width");
    const int col0 = c.lane * PER;
    f32x4 gv[PER / 4], bv[PER / 4];
#pragma unroll
    for (int j = 0; j < PER / 4; ++j) { gv[j] = *(const f32x4*)(g + col0 + 4 * j); bv[j] = *(const f32x4*)(b + col0 + 4 * j); }
    for (int row0 = c.gwave; row0 < MT; row0 += RB * c.nwaves) {
        u32x4 xa[RB][PER / 8], oa[RB][PER / 8];
#pragma unroll
        for (int r = 0; r < RB; ++r) { const int row = row0 + r * c.nwaves;
            if (row < MT) {
#pragma unroll
                for (int j = 0; j < PER / 8; ++j) { xa[r][j] = *(const u32x4*)(XB + (size_t)row * D_MODEL + col0 + 8 * j); oa[r][j] = *(const u32x4*)(OUT + (size_t)row * ldo + col0 + 8 * j); } } }
#pragma unroll
        for (int r = 0; r < RB; ++r) { const int row = row0 + r * c.nwaves;
            if (row < MT) {
                float v[PER]; float s = 0.f;
#pragma unroll
                for (int j = 0; j < PER / 8; ++j)
#pragma unroll
                    for (int e = 0; e < 4; ++e) { v[8 * j + 2 * e] = DN_ALPHA * bflo(xa[r][j][e]) + bflo(oa[r][j][e]); v[8 * j + 2 * e + 1] = DN_ALPHA * bfhi(xa[r][j][e]) + bfhi(oa[r][j][e]); }
#pragma unroll
                for (int j = 0; j < PER; ++j) s += v[j];
                const float mean = wave_sum(s) * (1.f / D_MODEL); float q = 0.f;
#pragma unroll
                for (int j = 0; j < PER; ++j) { v[j] -= mean; q += v[j] * v[j]; }
                const float rstd = fast_rsq(wave_sum(q) * (1.f / D_MODEL) + LN_EPS);
#pragma unroll
                for (int j = 0; j < PER; ++j) v[j] = v[j] * rstd * gv[j >> 2][j & 3] + bv[j >> 2][j & 3];
#pragma unroll
                for (int j = 0; j < PER / 8; ++j) { u32x4 o;
#pragma unroll
                    for (int e = 0; e < 4; ++e) o[e] = cvtpk(v[8 * j + 2 * e], v[8 * j + 2 * e + 1]);
                    *(u32x4*)(XB + (size_t)row * D_MODEL + col0 + 8 * j) = o; }
                if (last) { float* yo = row < PT ? p.out + O_YP + (size_t)row * D_MODEL + col0 : p.out + O_YS + (size_t)(row - PT) * D_MODEL + col0;
#pragma unroll
                    for (int j = 0; j < PER; j += 4) *(f32x4*)(yo + j) = (f32x4){v[j], v[j + 1], v[j + 2], v[j + 3]}; }
            } }
    }
}
__device__ __forceinline__ float fast_exp2(float x) {
#ifdef EMU
    return exp2f(x);
#else
    return __builtin_amdgcn_exp2f(x);
#endif
}
__device__ __forceinline__ void b_cache_copies(PrmRef p, const Ctx& c) {
    bf16* CK = (bf16*)(p.ws + WS_CK); bf16* CVT = (bf16*)(p.ws + WS_CVT);
    for (int it = c.gtid; it < DEC_BATCH * WINDOW * B_KVW; it += c.nthreads) {
        const int dd = it % B_KVW, w = (it / B_KVW) % WINDOW, b = it / (B_KVW * WINDOW), kvh = dd / B_HD, d = dd % B_HD;
        CK[(((size_t)b * B_KV_HEADS + kvh) * WINDOW + w) * B_HD + d] = (bf16)f2bf(p.cache_k[it]);
        CVT[(((size_t)b * B_KV_HEADS + kvh) * B_HD + d) * WINDOW + w] = (bf16)f2bf(p.cache_v[it]);
    }
}
__device__ __forceinline__ void ph_b_gemm(PrmRef p, const Ctx& c, int lj, unsigned char* lds) {
    const bf16* XB = (const bf16*)(p.ws + WS_XB); bf16* PROJ = (bf16*)(p.ws + WS_PROJ); const bf16* Wt = (const bf16*)(p.ws + WS_WBIN) + (size_t)lj * B_N0 * D_MODEL;
    const int N = lj == 0 ? B_N0 : B_IN;
    pg8::Gemm g{XB, D_MODEL, Wt, PT, N, D_MODEL}; pg8::StaticOrder S; S.init(PT, N, c.nblk, c.bid);
    pg8::EpiBIn E{PROJ, PLD, (const float*)(p.ws + WS_ROPE), (bf16*)(p.ws + WS_VT)};
    __syncthreads();
    pg8::gemm_phase<pg8::EpiBIn, pg8::StaticOrder, true>((LAS unsigned char*)lds, g, S, E, c.tid);
    __syncthreads();
    sgemm_rows<true>(p, XB, D_MODEL, Wt, D_MODEL, PROJ, PLD, PT, ST, N, c, lj == 0 ? (PT / 256) * (B_N0 / 256) : 0, lds, true);
    if (lj == 0) b_cache_copies(p, c);
}
constexpr int AT_KPITCH = 144, AT_VPITCH = 392, AT_K = 0, AT_V = 192 * AT_KPITCH, AT_O = AT_V + 64 * AT_VPITCH + 64  , AT_OPITCH = 144;
static_assert(2 * SC_BUF <= 163840 - 64, "scan LDS");
static_assert(AT_O % 16 == 0 && AT_O + 256 * AT_OPITCH <= 131072, "attention LDS");
struct AttRaw { u32x4 k[3], v[3]; bf16x8 q[4]; };
__device__ __forceinline__ void att_load(PrmRef p, int ck, int kvh, int tid, AttRaw& raw) {
    const unsigned char* PROJ = (const unsigned char*)(p.ws + WS_PROJ); const unsigned char* VT = (const unsigned char*)(p.ws + WS_VT);
    const unsigned char* CK = (const unsigned char*)(p.ws + WS_CK); const unsigned char* CVT = (const unsigned char*)(p.ws + WS_CVT);
    const int lane = tid & 63, wave = tid >> 6, l31 = lane & 31, hi = lane >> 5;
    const bool smp = ck >= NCP; const int r0 = chunk_row0(ck);
    const int nc = smp ? 0 : ck % NCPS, nblk = smp ? 0 : (nc >= 2 ? 3 : nc + 1);
    if (!smp) {
        const int kfirst = r0 - (nblk - 1) * CHUNK;
#pragma unroll
        for (int j = 0; j < 3; ++j) if (j < nblk) { const int idx = tid + NTHR * j, key = idx >> 3, pc = idx & 7, d = (idx >> 3) & 63;
            raw.k[j] = *(const u32x4*)(PROJ + ((size_t)(kfirst + key) * PLD + B_IN + kvh * B_HD) * 2 + pc * 16);
            raw.v[j] = *(const u32x4*)(VT + ((((size_t)(ck - (nblk - 1) + j) * B_KV_HEADS + kvh) * B_HD + d) * 64) * 2 + pc * 16); }
    } else {
        const int b = ck - NCP;
#pragma unroll
        for (int j = 0; j < 3; ++j) { const int idx = tid + NTHR * j;
            if (idx < 160 * 8) { const int key = idx >> 3, pc = idx & 7;
                raw.k[j] = *(const u32x4*)(key < WINDOW ? CK + ((((size_t)b * B_KV_HEADS + kvh) * WINDOW + key) * B_HD) * 2 + pc * 16 : PROJ + ((size_t)(r0 + key - WINDOW) * PLD + B_IN + kvh * B_HD) * 2 + pc * 16); }
            if (idx < 64 * 20) { const int d = idx / 20, pc = idx % 20;
                raw.v[j] = *(const u32x4*)(pc < 16 ? CVT + ((((size_t)b * B_KV_HEADS + kvh) * B_HD + d) * WINDOW) * 2 + pc * 16 : VT + ((((size_t)ck * B_KV_HEADS + kvh) * B_HD + d) * 64) * 2 + (pc - 16) * 16); } }
    }
    const bool active = smp ? wave < 4 : true;
    const int hq = kvh * B_GROUP + (smp ? wave : (wave >> 1)), qrow0 = smp ? 0 : 32 * (wave & 1);
    if (active) {
#pragma unroll
        for (int ks = 0; ks < 4; ++ks) raw.q[ks] = *(const bf16x8*)(PROJ + ((size_t)(r0 + qrow0 + l31) * PLD + hq * B_HD + 16 * ks + 8 * hi) * 2);
    }
}
__device__ __forceinline__ void att_item(PrmRef p, int lj, int ck, int kvh, int nck, int nkvh, int tid, unsigned char* lds, AttRaw& raw) {
#ifndef EMU
    asm volatile("" : "+v"(tid));
#endif
    unsigned char* PROJ = (unsigned char*)(p.ws + WS_PROJ);
    const int lane = tid & 63, wave = READFIRSTLANE(tid >> 6), l31 = lane & 31, hi = lane >> 5;
    const bool smp = ck >= NCP; const int r0 = chunk_row0(ck);
    const int nc = smp ? 0 : ck % NCPS, nblk = smp ? 0 : (nc >= 2 ? 3 : nc + 1);
    const int nkt = smp ? 5 : 2 * nblk;
    if (!smp) {
#pragma unroll
        for (int j = 0; j < 3; ++j) if (j < nblk) { const int idx = tid + NTHR * j, key = idx >> 3, pc = idx & 7, d = (idx >> 3) & 63;
            *(u32x4*)(lds + AT_K + key * AT_KPITCH + pc * 16) = raw.k[j];
            unsigned char* dst = lds + AT_V + d * AT_VPITCH + j * 128 + pc * 16; *(u32x2*)dst = (u32x2){raw.v[j].x, raw.v[j].y}; *(u32x2*)(dst + 8) = (u32x2){raw.v[j].z, raw.v[j].w}; }
    } else {
#pragma unroll
        for (int j = 0; j < 3; ++j) { const int idx = tid + NTHR * j;
            if (idx < 160 * 8) { const int key = idx >> 3, pc = idx & 7; *(u32x4*)(lds + AT_K + key * AT_KPITCH + pc * 16) = raw.k[j]; }
            if (idx < 64 * 20) { const int d = idx / 20, pc = idx % 20; unsigned char* dst = lds + AT_V + d * AT_VPITCH + pc * 16; *(u32x2*)dst = (u32x2){raw.v[j].x, raw.v[j].y}; *(u32x2*)(dst + 8) = (u32x2){raw.v[j].z, raw.v[j].w}; } }
    }
    const bool active = smp ? wave < 4 : true;
    const int hq = kvh * B_GROUP + (smp ? wave : (wave >> 1));
    bf16x8 qf[4];
#pragma unroll
    for (int ks = 0; ks < 4; ++ks) qf[ks] = raw.q[ks];
    LBAR();
    if (nck >= 0) att_load(p, nck, nkvh, tid, raw);
    const int nrows = smp ? 128 : 256;
    u32x4 zr[4];
    if (active) {
        f32x16 sc[6];
#pragma unroll
        for (int kt = 0; kt < 6; ++kt) {
#pragma unroll
            for (int e = 0; e < 16; ++e) sc[kt][e] = 0.f;
            if (kt < nkt) {
#pragma unroll
                for (int ks = 0; ks < 4; ++ks) sc[kt] = MFMA32(*(const bf16x8*)(lds + AT_K + (32 * kt + l31) * AT_KPITCH + 32 * ks + 16 * hi), qf[ks], sc[kt]);
            }
        }
        const float sink = p.b_sinks[lj * B_Q_HEADS + hq];
        float m = sink;
#pragma unroll
        for (int kt = 0; kt < 6; ++kt) if (kt < nkt) {
#pragma unroll
            for (int e = 0; e < 16; ++e) m = fmaxf(m, sc[kt][e]); }
        m = fmaxf(m, __shfl_xor(m, 32));
        float l = 0.f; const float ml2 = m * 1.4426950408889634f;
#pragma unroll
        for (int kt = 0; kt < 6; ++kt) if (kt < nkt) {
#pragma unroll
            for (int e = 0; e < 16; ++e) { const float pe = fast_exp2(sc[kt][e] * 1.4426950408889634f - ml2); sc[kt][e] = pe; l += pe; } }
        l += __shfl_xor(l, 32);
        l += fast_exp2(sink * 1.4426950408889634f - ml2);
        f32x16 o[2];
#pragma unroll
        for (int e = 0; e < 16; ++e) { o[0][e] = 0.f; o[1][e] = 0.f; }
#pragma unroll
        for (int kt = 0; kt < 6; ++kt) if (kt < nkt) {
#pragma unroll
            for (int s = 0; s < 2; ++s) {
                u32x4 pw; pw.x = cvtpk(sc[kt][8 * s], sc[kt][8 * s + 1]); pw.y = cvtpk(sc[kt][8 * s + 2], sc[kt][8 * s + 3]); pw.z = cvtpk(sc[kt][8 * s + 4], sc[kt][8 * s + 5]); pw.w = cvtpk(sc[kt][8 * s + 6], sc[kt][8 * s + 7]);
                const bf16x8 pb = __builtin_bit_cast(bf16x8, pw);
#pragma unroll
                for (int mt = 0; mt < 2; ++mt) {
                    const unsigned char* vp = lds + AT_V + (32 * mt + l31) * AT_VPITCH + (32 * kt + 16 * s + 4 * hi) * 2;
                    const u32x2 a0 = *(const u32x2*)vp, a1 = *(const u32x2*)(vp + 16);
                    u32x4 aw; aw.x = a0.x; aw.y = a0.y; aw.z = a1.x; aw.w = a1.y;
                    o[mt] = MFMA32(__builtin_bit_cast(bf16x8, aw), pb, o[mt]);
                }
            }
        }
        const float il = fast_rcp(l);
        unsigned char* orow = lds + AT_O + (32 * wave + l31) * AT_OPITCH;
#pragma unroll
        for (int mt = 0; mt < 2; ++mt)
#pragma unroll
            for (int cg4 = 0; cg4 < 4; ++cg4) {
                u32x2 w2; w2.x = cvtpk(o[mt][4 * cg4] * il, o[mt][4 * cg4 + 1] * il); w2.y = cvtpk(o[mt][4 * cg4 + 2] * il, o[mt][4 * cg4 + 3] * il);
                *(u32x2*)(orow + (32 * mt + 8 * cg4 + 4 * hi) * 2) = w2;
            }
    }
#pragma unroll
    for (int i = 0; i < 4; ++i) { const int idx = tid + NTHR * i;
        if (idx < nrows * 8) { const int qr = idx >> 3, pc = idx & 7, w = qr >> 5, hq2 = kvh * B_GROUP + (smp ? w : (w >> 1)), row = r0 + (smp ? 0 : 32 * (w & 1)) + (qr & 31);
            zr[i] = *(const u32x4*)(PROJ + ((size_t)row * PLD + B_QW + hq2 * B_HD) * 2 + pc * 16); } }
    LBAR();
#pragma unroll
    for (int i = 0; i < 4; ++i) { const int idx = tid + NTHR * i;
        if (idx < nrows * 8) { const int qr = idx >> 3, pc = idx & 7, w = qr >> 5, hq2 = kvh * B_GROUP + (smp ? w : (w >> 1)), row = r0 + (smp ? 0 : 32 * (w & 1)) + (qr & 31);
            const u32x4 ov = *(const u32x4*)(lds + AT_O + qr * AT_OPITCH + pc * 16); const u32x4 zv = zr[i];
            u32x4 r;
#pragma unroll
            for (int e = 0; e < 4; ++e) r[e] = cvtpk(bflo(ov[e]) * fsilu(bflo(zv[e])), bfhi(ov[e]) * fsilu(bfhi(zv[e])));
            *(u32x4*)(PROJ + ((size_t)row * PLD + hq2 * B_HD) * 2 + pc * 16) = r; } }
    LBAR();
}
__device__ __forceinline__ void ph_b_att2(PrmRef p, const Ctx& c, int lj, bool first, unsigned char* lds) {
    AttRaw raw;
    if (c.bid < NCH * B_KV_HEADS) att_load(p, c.bid / B_KV_HEADS, c.bid % B_KV_HEADS, c.tid, raw);
    for (int it = c.bid; it < NCH * B_KV_HEADS; it += c.nblk) { const int nx = it + c.nblk < NCH * B_KV_HEADS ? it + c.nblk : -1;
        att_item(p, lj, it / B_KV_HEADS, it % B_KV_HEADS, nx < 0 ? -1 : nx / B_KV_HEADS, nx < 0 ? 0 : nx % B_KV_HEADS, c.tid, lds, raw); }
    if (first) {
        const bf16* PROJ = (const bf16*)(p.ws + WS_PROJ);
        for (int it = c.gtid; it < (BATCH + DEC_BATCH) * WINDOW * B_KVW; it += c.nthreads) {
            const int e = it % B_KVW, w = (it / B_KVW) % WINDOW, s = it / (B_KVW * WINDOW);
            if (s < BATCH) { const int row = s * SEQ + SEQ - WINDOW + w; const bf16* kp = PROJ + (size_t)row * PLD + B_IN;
                p.out[O_PK + ((size_t)s * WINDOW + w) * B_KVW + e] = bf2f(kp[e]); p.out[O_PV + ((size_t)s * WINDOW + w) * B_KVW + e] = bf2f(kp[B_KVW + e]); }
            else { const int b = s - BATCH; float kx, vx;
                if (w < WINDOW - DEC_SEQ) { kx = p.cache_k[((size_t)b * WINDOW + w + DEC_SEQ) * B_KVW + e]; vx = p.cache_v[((size_t)b * WINDOW + w + DEC_SEQ) * B_KVW + e]; }
                else { const int row = PT + b * DEC_SEQ + (w - (WINDOW - DEC_SEQ)); const bf16* kp = PROJ + (size_t)row * PLD + B_IN; kx = bf2f(kp[e]); vx = bf2f(kp[B_KVW + e]); }
                p.out[O_SK + ((size_t)b * WINDOW + w) * B_KVW + e] = kx; p.out[O_SV + ((size_t)b * WINDOW + w) * B_KVW + e] = vx; }
        }
    }
}

#ifndef EMU
#define XB_TMO      128
#define XB_XCNT(j)  (256  + 64 * (j))
#define XB_XSUB(j)  (1280 + 64 * (j))
#define XB_XGEN(j)  (2304 + 64 * (j))
#define XB_TOP      3328
#define XB_TOPGEN   3392
#define XCD_BAR_WORDS 3456
#define XB_SPIN_CAP (1u << 20)
__device__ __forceinline__ unsigned xb_ld(unsigned* p)              { return __hip_atomic_load(p, __ATOMIC_RELAXED, __HIP_MEMORY_SCOPE_AGENT); }
__device__ __forceinline__ unsigned xb_add(unsigned* p, unsigned v) { return __hip_atomic_fetch_add(p, v, __ATOMIC_RELAXED, __HIP_MEMORY_SCOPE_AGENT); }
__device__ __forceinline__ unsigned xb_xcc_id() { return (unsigned)__builtin_amdgcn_s_getreg((3 << 11) | 20) & 0xFu; }
#define XB_SPIN(cond, bar) do { unsigned _sp = 0; while (cond) { __builtin_amdgcn_s_sleep(1); \
    if ((++_sp & 255u) == 0u) { if (xb_ld(&(bar)[XB_TMO])) break; if (_sp > XB_SPIN_CAP) { atomicAdd(&(bar)[XB_TMO], 1u); break; } } } } while (0)
__device__ __forceinline__ void xcd_barrier_complete(unsigned* bar, unsigned x, unsigned& nloc, unsigned& nx) {
    const unsigned G = gridDim.x * gridDim.y * gridDim.z;
    unsigned sum, cnt, mine, sp = 0u;
    for (;;) {
        sum = 0u; cnt = 0u; mine = 0u;
#pragma unroll
        for (unsigned j = 0; j < 16; ++j) { const unsigned c = xb_ld(&bar[XB_XCNT(j)]); sum += c; cnt += (c > 0u) ? 1u : 0u; mine = (j == x) ? c : mine; }
        if (sum == G) break;
        __builtin_amdgcn_s_sleep(1);
        if ((++sp & 255u) == 0u) { if (xb_ld(&bar[XB_TMO])) break; if (sp > XB_SPIN_CAP) { atomicAdd(&bar[XB_TMO], 1u); break; } }
    }
    nloc = mine > 0u ? mine : 1u; nx = cnt > 0u ? cnt : 1u;
}
__device__ __forceinline__ void xcd_barrier(unsigned* bar, volatile LAS unsigned* st, const int tid) {
    asm volatile("s_waitcnt vmcnt(0)" ::: "memory");
    __syncthreads();
    if (tid == 0) {
        __builtin_amdgcn_s_waitcnt(0);
        const unsigned x = xb_xcc_id();
        unsigned nloc = st[0], nx = st[1];
        if (nloc == 0u) { xcd_barrier_complete(bar, x, nloc, nx); st[0] = nloc; st[1] = nx; }
        const unsigned old = xb_add(&bar[XB_XSUB(x)], 1u);
        const unsigned gen = old / nloc;
        if (old + 1u == (gen + 1u) * nloc) {
            __builtin_amdgcn_fence(__ATOMIC_RELEASE, "agent");
            asm volatile("s_waitcnt vmcnt(0)" ::: "memory");
            const unsigned og = xb_add(&bar[XB_TOP], 1u);
            const unsigned tg = og / nx;
            if (og + 1u == (tg + 1u) * nx) xb_add(&bar[XB_TOPGEN], 1u);
            else XB_SPIN(xb_ld(&bar[XB_TOPGEN]) == tg, bar);
            __builtin_amdgcn_fence(__ATOMIC_ACQUIRE, "agent");
            xb_add(&bar[XB_XGEN(x)], 1u);
            asm volatile("s_waitcnt vmcnt(0)" ::: "memory");
        } else {
            XB_SPIN(xb_ld(&bar[XB_XGEN(x)]) == gen, bar);
            __builtin_amdgcn_fence(__ATOMIC_ACQUIRE, "agent");
            asm volatile("s_waitcnt vmcnt(0)" ::: "memory");
        }
    }
    __syncthreads();
}
#endif
constexpr int PH_A0 = 1, PH_APER = 6, PH_B0 = PH_A0 + N_A * PH_APER, PH_BPER = 4, N_PHASES = PH_B0 + N_B * PH_BPER;
constexpr int LDS_BAR_OFF = 163840 - 64;
constexpr int LDS_BYTES = 163840;
#ifdef EMU
#define DECL_LDS(name) unsigned char* name = emu::blk()->lds
#else
#define DECL_LDS(name) extern __shared__ __attribute__((aligned(16))) unsigned char name[]
#endif

#ifdef EMU
#define PH_PROLOGUE() PrmRef p = p_; int tid_ = threadIdx.x, bid_ = blockIdx.x;
#define GRID_SYNC()
#else
#define PH_PROLOGUE() const __attribute__((address_space(4))) Prm* pp = (const __attribute__((address_space(4))) Prm*)__builtin_amdgcn_kernarg_segment_ptr(); \
    int tid_ = wave_s_ * 64 + (int)__builtin_amdgcn_mbcnt_hi(~0u, __builtin_amdgcn_mbcnt_lo(~0u, 0u)), bid_ = blockIdx.x; asm volatile("" : "+s"(pp), "+v"(tid_), "+s"(bid_)); PrmRef p = *pp;
#define GRID_SYNC() xcd_barrier((unsigned*)(p.ws + WS_CTL), (volatile LAS unsigned*)(lds + LDS_BAR_OFF), c.tid)
#endif
#define PHASE(k, ...) if (ph_lo <= (k) && (k) < ph_hi) { PH_PROLOGUE() \
        Ctx c; c.tid = tid_; c.lane = c.tid & 63; c.wave = c.tid >> 6; c.bid = bid_; c.nblk = gridDim.x; \
        c.gtid = c.bid * NTHR + c.tid; c.nthreads = c.nblk * NTHR; c.gwave = c.bid * (NTHR / 64) + c.wave; c.nwaves = c.nblk * (NTHR / 64); \
        bf16* PROJ = (bf16*)(p.ws + WS_PROJ); const bf16* XB = (const bf16*)(p.ws + WS_XB); (void)PROJ; (void)XB; \
        __VA_ARGS__; \
        if ((k) + 1 < ph_hi) { GRID_SYNC(); } }
#define A_LAYER(li) \
    PHASE(PH_A0 + (li) * PH_APER + 0, ph_a_gemm(p, c, li, lds)) \
    PHASE(PH_A0 + (li) * PH_APER + 1, ph_a_pre(p, c, li, lds)) \
    PHASE(PH_A0 + (li) * PH_APER + 2, ph_a_scan2(p, c, li, lds)) \
    PHASE(PH_A0 + (li) * PH_APER + 3, ph_a_norm(p, c, li, lds)) \
    PHASE(PH_A0 + (li) * PH_APER + 4, gemm_mfma(PROJ + 2 * A_QK, PLD, (const bf16*)(p.ws + WS_WAOUT) + (size_t)(li) * D_MODEL * A_VW, PROJ, PLD, PT, D_MODEL, A_VW, c, lds)) \
    PHASE(PH_A0 + (li) * PH_APER + 5, ph_ln(p, c, PROJ, PLD, p.a_ln_g + (size_t)(li) * D_MODEL, p.a_ln_b + (size_t)(li) * D_MODEL, false))
#define B_LAYER(lj) \
    PHASE(PH_B0 + (lj) * PH_BPER + 0, ph_b_gemm(p, c, lj, lds)) \
    PHASE(PH_B0 + (lj) * PH_BPER + 1, ph_b_att2(p, c, lj, (lj) == 0, lds)) \
    PHASE(PH_B0 + (lj) * PH_BPER + 2, gemm_mfma(PROJ, PLD, (const bf16*)(p.ws + WS_WBOUT) + (size_t)(lj) * D_MODEL * B_QW, PROJ + B_QW, PLD, PT, D_MODEL, B_QW, c, lds); \
        sgemm_rows(p, PROJ, PLD, (const bf16*)(p.ws + WS_WBOUT) + (size_t)(lj) * D_MODEL * B_QW, B_QW, PROJ + B_QW, PLD, PT, ST, D_MODEL, c, 0, lds)) \
    PHASE(PH_B0 + (lj) * PH_BPER + 3, ph_ln(p, c, PROJ + B_QW, PLD, p.b_ln_g + (size_t)(lj) * D_MODEL, p.b_ln_b + (size_t)(lj) * D_MODEL, (lj) == N_B - 1))

__global__ void __launch_bounds__(NTHR, 2) fwd_kernel(Prm p_, int ph_lo, int ph_hi) {
    DECL_LDS(lds);
#ifndef EMU
    const int wave_s_ = __builtin_amdgcn_readfirstlane((int)threadIdx.x >> 6);
    {
        if (threadIdx.x < 2) ((volatile LAS unsigned*)(lds + LDS_BAR_OFF))[threadIdx.x] = 0u;
        if (threadIdx.x == 0) (void)xb_add((unsigned*)(p_.ws + WS_CTL) + XB_XCNT(xb_xcc_id()), 1u);
        __syncthreads();
    }
#endif
    PHASE(0, ph_init(p, c); ph_weights(p, c, lds))
    A_LAYER(0)
    A_LAYER(1)
    B_LAYER(0)
    B_LAYER(1)
#ifdef PROBE_TAIL
    PROBE_TAIL
#endif
}

extern "C" void kernel_launch(void* const* d_in, const int* in_sizes, int n_in, void* d_out, int out_size, void* d_ws, size_t ws_size, hipStream_t stream) {
    if (n_in != 20 || (size_t)out_size != O_END || ws_size < WS_NEED) { fprintf(stderr, "kernel_launch: unexpected sizes n_in=%d out=%d ws=%zu (need %zu, out %zu)\n", n_in, out_size, ws_size, (size_t)WS_END, (size_t)O_END); return; }
    Prm p{};
    const float** pp = (const float**)&p;
    for (int i = 0; i < 20; ++i) pp[i] = (const float*)d_in[i];
    p.out = (float*)d_out; p.ws = (unsigned char*)d_ws;
#ifdef EMU
    const int grid = 8;
    const int stop = getenv("EMU_STOP") ? atoi(getenv("EMU_STOP")) : N_PHASES;
    for (int ph = 0; ph < N_PHASES && ph < stop; ++ph) { emu::launch([=]() { fwd_kernel(p, ph, ph + 1); }, dim3(grid), dim3(NTHR), LDS_BYTES); fprintf(stderr, "phase %d done\n", ph); }
#else
    static int grid = 0;
    if (grid == 0) {
        int dev = 0, cus = 0, per_cu = 0;
        (void)hipGetDevice(&dev); (void)hipDeviceGetAttribute(&cus, hipDeviceAttributeMultiprocessorCount, dev);
        (void)hipFuncSetAttribute((const void*)fwd_kernel, hipFuncAttributeMaxDynamicSharedMemorySize, LDS_BYTES);
        (void)hipOccupancyMaxActiveBlocksPerMultiprocessor(&per_cu, (const void*)fwd_kernel, NTHR, LDS_BYTES);
        if (per_cu < 1) { fprintf(stderr, "kernel_launch: occupancy query says %d blocks per CU\n", per_cu); per_cu = 1; }
        grid = cus;
    }
    (void)hipMemsetAsync((char*)d_ws + WS_CTL, 0, 65536, stream);
#ifdef PROBE_TAIL
    int lo = 0, hi = N_PHASES + PROBE_NTAIL;
#else
    int lo = 0, hi = N_PHASES;
#endif
    void* args[] = {(void*)&p, (void*)&lo, (void*)&hi};
    hipError_t e = hipLaunchCooperativeKernel((const void*)fwd_kernel, dim3(grid), dim3(NTHR), args, LDS_BYTES, stream);
    if (e != hipSuccess) fprintf(stderr, "cooperative launch failed: %s (grid %d)\n", hipGetErrorString(e), grid);
#endif
}
```

```cpp
#ifdef EMU
#include "hip_emu.h"
#else
#include <hip/hip_runtime.h>
#include <hip/hip_cooperative_groups.h>
namespace cg = cooperative_groups;
#endif
#include <cstdint>
#include <cstddef>
#include <cstdio>

typedef short bf16x8 __attribute__((ext_vector_type(8)));
typedef float f32x4 __attribute__((ext_vector_type(4)));
typedef float f32x16 __attribute__((ext_vector_type(16)));
typedef unsigned u32x4 __attribute__((ext_vector_type(4)));
typedef unsigned u32x2 __attribute__((ext_vector_type(2)));
#ifdef EMU
#define LAS
#define WAVE_SYNC() emu::wave_sync()
#define GLDS16(gp, lp) memcpy((unsigned char*)(lp) + emu::lane_id() * 16, (const void*)(gp), 16)
typedef const unsigned char* BufRes;
#define MAKE_RES(p) ((const unsigned char*)(p))
#define BLDS16(res, voff, soff, lp) memcpy((unsigned char*)(lp) + emu::lane_id() * 16, (res) + (voff) + (soff), 16)
#define MFMA16(a, b, c) emu_mfma_16x16x32_bf16(a, b, c)
#define MFMA32(a, b, c) emu_mfma_32x32x16_bf16(a, b, c)
#define MFMAF(a, b, c) emu_mfma_16x16x4_f32(a, b, c)
#define SETPRIO(n)
#define SCHED_BARRIER()
#define S_BARRIER() emu::block_sync()
#define WAIT_VM(n)
#define WAIT_LGKM(n)
#define READFIRSTLANE(x) (x)
#define BCAST_LANE(v, n) __shfl(v, n)
#define LBAR() emu::block_sync()
#else
#define LAS __attribute__((address_space(3)))
#define WAVE_SYNC() asm volatile("s_waitcnt lgkmcnt(0)" ::: "memory")
#define GLDS16(gp, lp) __builtin_amdgcn_global_load_lds((const unsigned*)(gp), (LAS unsigned*)(lp), 16, 0, 0)
typedef __amdgpu_buffer_rsrc_t BufRes;
#define MAKE_RES(p) __builtin_amdgcn_make_buffer_rsrc((void*)(p), 0, 0x7fffffff, 0x00020000)
#define BLDS16(res, voff, soff, lp) __builtin_amdgcn_raw_ptr_buffer_load_lds(res, (LAS unsigned*)(lp), 16, (int)(voff), (int)(soff), 0, 0)
#define MFMA16(a, b, c) __builtin_amdgcn_mfma_f32_16x16x32_bf16(a, b, c, 0, 0, 0)
#define MFMA32(a, b, c) __builtin_amdgcn_mfma_f32_32x32x16_bf16(a, b, c, 0, 0, 0)
#define MFMAF(a, b, c) __builtin_amdgcn_mfma_f32_16x16x4f32(a, b, c, 0, 0, 0)
#define SETPRIO(n) __builtin_amdgcn_s_setprio(n)
#define SCHED_BARRIER() __builtin_amdgcn_sched_barrier(0)
#define S_BARRIER() __builtin_amdgcn_s_barrier()
#define WAIT_VM(n) asm volatile("s_waitcnt vmcnt(" #n ")" ::: "memory")
#define WAIT_LGKM(n) asm volatile("s_waitcnt lgkmcnt(" #n ")" ::: "memory")
#define READFIRSTLANE(x) __builtin_amdgcn_readfirstlane(x)
#define BCAST_LANE(v, n) __builtin_bit_cast(float, __builtin_amdgcn_readlane(__builtin_bit_cast(int, v), n))
#define LBAR() do { asm volatile("s_waitcnt lgkmcnt(0)" ::: "memory"); __builtin_amdgcn_s_barrier(); asm volatile("" ::: "memory"); } while (0)
#endif

#ifdef CFG_SMALL
constexpr int D_MODEL = 512, BATCH = 2, SEQ = 256, DEC_BATCH = 8, DEC_SEQ = 32, A_HEADS = 4, B_Q_HEADS = 8, B_KV_HEADS = 2;
#else
constexpr int D_MODEL = 1024, BATCH = 8, SEQ = 2048, DEC_BATCH = 16, DEC_SEQ = 32, A_HEADS = 8, B_Q_HEADS = 16, B_KV_HEADS = 4;
#endif
constexpr int PAST_LEN = 4096, CHUNK = 64, N_A = 2, N_B = 2, DEPTH = 4;
constexpr int A_DK = 128, A_DV = 128, A_QK = A_HEADS * A_DK, A_VW = A_HEADS * A_DV, CONV_W = 4, CONV_DIM = 2 * A_QK + A_VW;
constexpr int A_IN = CONV_DIM + A_VW + 2 * A_HEADS, A_MAIN = CONV_DIM + A_VW;
constexpr int B_GROUP = B_Q_HEADS / B_KV_HEADS, B_HD = 64, B_QW = B_Q_HEADS * B_HD, B_KVW = B_KV_HEADS * B_HD, B_IN = 2 * B_QW;
constexpr int WINDOW = 128, ROPE_DIMS = 16, ROPE_HALF = 8;
constexpr float LN_EPS = 1e-5f, RMS_EPS = 1e-6f;
constexpr float DN_ALPHA = 1.681792830507429f;
constexpr int PT = BATCH * SEQ, ST = DEC_BATCH * DEC_SEQ, MT = PT + ST, NSEQ = BATCH + DEC_BATCH;
constexpr int NCPS = SEQ / CHUNK, NCP = BATCH * NCPS, NCH = NCP + DEC_BATCH;
constexpr int PLD = A_MAIN > B_IN + 2 * B_KVW ? A_MAIN : B_IN + 2 * B_KVW;
static_assert(B_GROUP == 4, "attention wave map");
static_assert(PT % 256 == 0 && ST % 64 == 0 && D_MODEL % 256 == 0 && A_VW % 256 == 0 && B_QW % 256 == 0 && A_MAIN % 256 == 0 && D_MODEL % 256 == 0 && B_IN % 256 == 0 && (2 * B_KVW) % 256 == 0 && D_MODEL % 128 == 0 && D_MODEL >= 256, "gemm tiles");
static_assert(DEC_SEQ == 32 && WINDOW == 128 && CHUNK == 64, "fixed");

constexpr size_t O_YP = 0, O_YS = O_YP + (size_t)PT * D_MODEL, O_PDELTA = O_YS + (size_t)ST * D_MODEL;
constexpr size_t O_PCONV = O_PDELTA + (size_t)N_A * BATCH * A_HEADS * A_DK * A_DV, O_PK = O_PCONV + (size_t)N_A * BATCH * 3 * CONV_DIM;
constexpr size_t O_PV = O_PK + (size_t)BATCH * WINDOW * B_KVW, O_SDELTA = O_PV + (size_t)BATCH * WINDOW * B_KVW;
constexpr size_t O_SCONV = O_SDELTA + (size_t)N_A * DEC_BATCH * A_HEADS * A_DK * A_DV, O_SK = O_SCONV + (size_t)N_A * DEC_BATCH * 3 * CONV_DIM;
constexpr size_t O_SV = O_SK + (size_t)DEC_BATCH * WINDOW * B_KVW, O_END = O_SV + (size_t)DEC_BATCH * WINDOW * B_KVW;

constexpr size_t al256(size_t x) { return (x + 255) & ~(size_t)255; }
constexpr size_t WS_CTL = 0, WS_ROPE = 1u << 20;
constexpr size_t WS_GB = al256(WS_ROPE + (size_t)(SEQ + DEC_SEQ) * ROPE_HALF * 2 * 4);
constexpr size_t WS_HALO = al256(WS_GB + (size_t)MT * A_HEADS * 2 * 4);
constexpr size_t WS_XB = al256(WS_HALO + (size_t)NCH * 3 * CONV_DIM * 2);
constexpr size_t WS_PROJ = al256(WS_XB + (size_t)MT * D_MODEL * 2);
constexpr size_t WS_WAIN = al256(WS_PROJ + (size_t)MT * PLD * 2);
constexpr int A_NG = A_MAIN + 256;
constexpr size_t WS_WAOUT = al256(WS_WAIN + (size_t)N_A * A_NG * D_MODEL * 2);
constexpr int B_N0 = B_IN + 2 * B_KVW;
constexpr size_t WS_WBIN = al256(WS_WAOUT + (size_t)N_A * D_MODEL * A_VW * 2);
constexpr size_t WS_WBOUT = al256(WS_WBIN + (size_t)(B_N0 + B_IN) * D_MODEL * 2);
constexpr size_t WS_WB = al256(WS_WBOUT + (size_t)N_B * D_MODEL * B_QW * 2);
constexpr size_t WS_IA = al256(WS_WB + (size_t)PT * A_QK * 2);
constexpr size_t WS_GL = al256(WS_IA + (size_t)BATCH * A_HEADS * (SEQ / CHUNK) * 64 * 64 * 2);
constexpr size_t WS_END = al256(WS_GL + (size_t)BATCH * A_HEADS * (SEQ / CHUNK) * 4);
static_assert(WS_END <= ((size_t)256 << 20), "workspace");
constexpr size_t WS_VT = WS_WB, WS_CK = al256(WS_VT + (size_t)NCH * B_KV_HEADS * 64 * 64 * 2), WS_CVT = al256(WS_CK + (size_t)DEC_BATCH * B_KV_HEADS * 128 * 64 * 2);
constexpr size_t WS_BEND = al256(WS_CVT + (size_t)DEC_BATCH * B_KV_HEADS * 128 * 64 * 2), WS_NEED = WS_BEND > WS_END ? WS_BEND : WS_END;
static_assert(WS_NEED <= ((size_t)256 << 20), "workspace (B-layer buffers overlay the A-layer WB | IA | GL region)");

static_assert(N_B == 2, "weight map");

typedef unsigned short bf16;
constexpr int NTHR = 512;

struct Prm {
    const float *x_prompt, *x_sample, *state_delta, *state_conv, *cache_k, *cache_v, *a_w_in, *a_conv_w, *a_log, *a_dt_bias, *a_norm_w, *a_w_out, *a_ln_g, *a_ln_b,
        *b_w_kv, *b_w_in, *b_sinks, *b_w_out, *b_ln_g, *b_ln_b;
    float* out; unsigned char* ws;
};

__device__ __forceinline__ unsigned f2bf(float f) { unsigned u = __builtin_bit_cast(unsigned, f); return (u + 0x7fffu + ((u >> 16) & 1u)) >> 16; }
__device__ __forceinline__ float bf2f(bf16 h) { return __builtin_bit_cast(float, (unsigned)h << 16); }
__device__ __forceinline__ float siluf(float x) { return x / (1.f + expf(-x)); }
__device__ __forceinline__ float sigmoidf_(float x) { return 1.f / (1.f + expf(-x)); }
__device__ __forceinline__ float softplusf_(float x) { return x > 20.f ? x : log1pf(expf(x)); }
__device__ __forceinline__ float wave_sum(float v) {
#pragma unroll
    for (int o = 1; o < 64; o <<= 1) v += __shfl_xor(v, o);
    return v;
}

#ifdef EMU
__device__ __forceinline__ float fast_rcp(float x) { return 1.f / x; }
__device__ __forceinline__ float fast_rsq(float x) { return 1.f / sqrtf(x); }
__device__ __forceinline__ float fast_ex2(float x) { return exp2f(x); }
__device__ __forceinline__ unsigned cvtpk(float lo, float hi) { return f2bf(lo) | (f2bf(hi) << 16); }
__device__ __forceinline__ float dpp_xor1(float v) { return __shfl(v, emu::lane_id() ^ 1); }
__device__ __forceinline__ float dpp_xor2(float v) { return __shfl(v, emu::lane_id() ^ 2); }
__device__ __forceinline__ float dpp_hmirror(float v) { const int l = emu::lane_id(); return __shfl(v, (l & ~7) | (7 - (l & 7))); }
__device__ __forceinline__ float dpp_mirror(float v) { const int l = emu::lane_id(); return __shfl(v, (l & ~15) | (15 - (l & 15))); }
#else
__device__ __forceinline__ float fast_rcp(float x) { return __builtin_amdgcn_rcpf(x); }
__device__ __forceinline__ float fast_rsq(float x) { return __builtin_amdgcn_rsqf(x); }
__device__ __forceinline__ float fast_ex2(float x) { return __builtin_amdgcn_exp2f(x); }
__device__ __forceinline__ unsigned cvtpk(float lo, float hi) { typedef float f2_t __attribute__((ext_vector_type(2))); typedef __bf16 b2_t __attribute__((ext_vector_type(2)));
    f2_t v = {lo, hi}; b2_t b = __builtin_convertvector(v, b2_t); return __builtin_bit_cast(unsigned, b); }
template <int CTRL> __device__ __forceinline__ float dpp_mov(float v) { return __builtin_bit_cast(float, __builtin_amdgcn_update_dpp(0, __builtin_bit_cast(int, v), CTRL, 0xf, 0xf, true)); }
__device__ __forceinline__ float dpp_xor1(float v) { return dpp_mov<0xB1>(v); }
__device__ __forceinline__ float dpp_xor2(float v) { return dpp_mov<0x4E>(v); }
__device__ __forceinline__ float dpp_hmirror(float v) { return dpp_mov<0x141>(v); }
__device__ __forceinline__ float dpp_mirror(float v) { return dpp_mov<0x140>(v); }
#endif
__device__ __forceinline__ float sum8(float v) { v += dpp_xor1(v); v += dpp_xor2(v); v += dpp_hmirror(v); return v; }
__device__ __forceinline__ float sum16(float v) { v = sum8(v); v += dpp_mirror(v); return v; }
__device__ __forceinline__ float fsilu(float x) { return x * fast_rcp(1.f + fast_ex2(-1.4426950408889634f * x)); }
__device__ __forceinline__ float fexp(float x) { return fast_ex2(1.4426950408889634f * x); }
__device__ __forceinline__ float bflo(unsigned u) { return __builtin_bit_cast(float, u << 16); }
__device__ __forceinline__ float bfhi(unsigned u) { return __builtin_bit_cast(float, u & 0xffff0000u); }
__device__ __forceinline__ int seq_row0(int s) { return s < BATCH ? s * SEQ : PT + (s - BATCH) * DEC_SEQ; }
__device__ __forceinline__ int seq_len(int s) { return s < BATCH ? SEQ : DEC_SEQ; }
__device__ __forceinline__ int chunk_row0(int c) { return c < NCP ? c * CHUNK : PT + (c - NCP) * DEC_SEQ; }
__device__ __forceinline__ int chunk_len(int c) { return c < NCP ? CHUNK : DEC_SEQ; }
__device__ __forceinline__ int row_posidx(int row) { return row < PT ? (row % SEQ) : SEQ + ((row - PT) % DEC_SEQ); }

#ifdef EMU
typedef const Prm& PrmRef;
#else
typedef const __attribute__((address_space(4))) Prm& PrmRef;
#endif
struct Ctx { int tid, lane, wave, gtid, gwave, nthreads, nwaves, bid, nblk; };

namespace pg8 {
constexpr int BM = 256, BK = 64, HALF = 128, HTB = HALF * BK * 2  , STAGE_BYTES = 8 * HTB, NXCD = 8, WGM = 8;
__host__ __device__ __forceinline__ int lds_byte(int r, int c) { const int st = (r >> 4) * 2 + (c >> 5), rr = r & 15, cc = c & 31, ob = rr * 64 + cc * 2; return st * 1024 + (ob ^ (((ob >> 9) & 1) << 5)); }
__host__ __device__ __forceinline__ void stage_rc(int b, int& R, int& C) { const int st = b / 1024, sb = b % 1024, swz = sb ^ (((sb >> 9) & 1) << 5); R = (st >> 1) * 16 + swz / 64; C = (st & 1) * 32 + (swz % 64) / 2; }
__host__ __device__ __forceinline__ int perm32(int rho) { const int n = rho >> 4, i = rho & 15; return 8 * (i >> 2) + 4 * n + (i & 3); }
struct Unit { int pm, pn; };
struct Gemm { const bf16* A; int lda; const bf16* Bt; int M, N, K; };
struct StaticOrder {
    int nM, nN, nwg, G, c;
    __host__ __device__ void init(int M, int N, int G_, int c_) { nM = M / BM; nN = N / BM; nwg = nM * nN; G = G_; c = c_; }
    __host__ __device__ bool next(int i, Unit& u) const {
        const long L = (long)i * G + c; if (L >= nwg) return false;
        int wgid = (int)L; { const int q = nwg / NXCD, r = nwg % NXCD, xcd = wgid % NXCD, off = wgid / NXCD; wgid = (xcd < r ? xcd * (q + 1) : r * (q + 1) + (xcd - r) * q) + off; }
        const int nig = WGM * nN, gid = wgid / nig, fm = gid * WGM, gsz = (nM - fm) < WGM ? (nM - fm) : WGM;
        u.pm = fm + ((wgid % nig) % gsz); u.pn = (wgid % nig) / gsz; return true;
    }
};
__device__ __forceinline__ unsigned cvt_pk_bf16(float lo, float hi) {
#ifdef EMU
    return f2bf(lo) | (f2bf(hi) << 16);
#else
    unsigned r; asm volatile("v_cvt_pk_bf16_f32 %0, %1, %2" : "=v"(r) : "v"(lo), "v"(hi)); return r;
#endif
}
struct EpiBf16 {
    static constexpr bool PERM = true;
    bf16* O; int ldc;
    __device__ __forceinline__ void operator()(const f32x4 (&acc)[2][2][4][2], const Unit& u, int wr, int wc, int fr, int fq) const {
        int fr_ = fr, fq_ = fq;
#ifndef EMU
        asm volatile("" : "+v"(fr_), "+v"(fq_));
#endif
        const int row0 = u.pm * BM + wr * 64 + fr_, col0 = u.pn * BM + wc * 32 + 8 * fq_;
#pragma unroll
        for (int ai = 0; ai < 2; ++ai)
#pragma unroll
            for (int m = 0; m < 4; ++m) { bf16* rowp = O + (size_t)(row0 + ai * HALF + m * 16) * ldc + col0;
#pragma unroll
                for (int bj = 0; bj < 2; ++bj) { const f32x4 v0 = acc[ai][bj][m][0], v1 = acc[ai][bj][m][1];
                    u32x4 w; w.x = cvt_pk_bf16(v0[0], v0[1]); w.y = cvt_pk_bf16(v0[2], v0[3]); w.z = cvt_pk_bf16(v1[0], v1[1]); w.w = cvt_pk_bf16(v1[2], v1[3]);
                    *(u32x4*)(rowp + bj * HALF) = w; } }
    }
};
struct EpiAIn {
    static constexpr bool PERM = true;
    bf16* O; int ldc; bf16* HALO; float* pconv;
    __device__ __forceinline__ void operator()(const f32x4 (&acc)[2][2][4][2], const Unit& u, int wr, int wc, int fr, int fq) const {
        int fr_ = fr, fq_ = fq;
#ifndef EMU
        asm volatile("" : "+v"(fr_), "+v"(fq_));
#endif
        const int row0 = u.pm * BM + wr * 64 + fr_, col0 = u.pn * BM + wc * 32 + 8 * fq_;
#pragma unroll
        for (int ai = 0; ai < 2; ++ai)
#pragma unroll
            for (int m = 0; m < 4; ++m) { const int row = row0 + ai * HALF + m * 16; bf16* rowp = O + (size_t)row * ldc + col0;
#pragma unroll
                for (int bj = 0; bj < 2; ++bj) { const f32x4 v0 = acc[ai][bj][m][0], v1 = acc[ai][bj][m][1];
                    u32x4 w; w.x = cvt_pk_bf16(v0[0], v0[1]); w.y = cvt_pk_bf16(v0[2], v0[3]); w.z = cvt_pk_bf16(v1[0], v1[1]); w.w = cvt_pk_bf16(v1[2], v1[3]);
                    *(u32x4*)(rowp + bj * HALF) = w;
                    if (m == 3 && fr_ >= 13 && col0 + bj * HALF < CONV_DIM) {
                        const int ck = row >> 6, hr = fr_ - 13, col = col0 + bj * HALF;
                        *(u32x4*)(HALO + ((size_t)ck * 3 + hr) * CONV_DIM + col) = w;
                        if (ck % NCPS == NCPS - 1) { float* dst = pconv + ((size_t)(ck / NCPS) * 3 + hr) * CONV_DIM + col; *(f32x4*)dst = v0; *(f32x4*)(dst + 4) = v1; }
                    } } }
    }
};
struct EpiBIn {
    static constexpr bool PERM = true;
    bf16* O; int ldc; const float* rope; bf16* VT;
    __device__ __forceinline__ void operator()(const f32x4 (&acc)[2][2][4][2], const Unit& u, int wr, int wc, int fr, int fq) const {
        int fr_ = fr, fq_ = fq;
#ifndef EMU
        asm volatile("" : "+v"(fr_), "+v"(fq_));
#endif
        static_assert(B_QW % 128 == 0 && B_KVW % 128 == 0, "a 128-column half tile has one kind");
        const int ct = u.pn * BM;
        int kinds[2]; bool ropes[2];
#pragma unroll
        for (int bj = 0; bj < 2; ++bj) { const int cc = ct + bj * HALF; kinds[bj] = cc < B_QW ? 0 : cc < B_IN ? 1 : cc < B_IN + B_KVW ? 2 : 3;
            ropes[bj] = (kinds[bj] == 0 || kinds[bj] == 2) && (wc & 1) == 0; }
        const int row0 = u.pm * BM + wr * 64 + fr_, col0 = ct + wc * 32 + 8 * fq_;
#pragma unroll
        for (int ai = 0; ai < 2; ++ai)
#pragma unroll
            for (int m = 0; m < 4; ++m) { const int row = row0 + ai * HALF + m * 16; bf16* rowp = O + (size_t)row * ldc + col0;
                f32x4 cs[4];
                if (ropes[0] || ropes[1]) { const f32x4* rp = (const f32x4*)(rope + (size_t)(row % SEQ) * ROPE_HALF * 2);
#pragma unroll
                    for (int q4 = 0; q4 < 4; ++q4) cs[q4] = rp[q4]; }
#pragma unroll
                for (int bj = 0; bj < 2; ++bj) { f32x4 v0 = acc[ai][bj][m][0], v1 = acc[ai][bj][m][1]; const int kind = kinds[bj]; const float sc = kind == 0 ? 0.125f : 1.f;
                    if (ropes[bj]) {
                        float x[8] = {v0[0], v0[1], v0[2], v0[3], v1[0], v1[1], v1[2], v1[3]}, o[8];
#pragma unroll
                        for (int j = 0; j < 8; ++j) o[j] = __shfl_xor(x[j], 16);
                        if (fq_ < 2) {
#pragma unroll
                            for (int j = 0; j < 8; ++j) { const float c_ = cs[j >> 1][2 * (j & 1)], s_ = cs[j >> 1][2 * (j & 1) + 1]; x[j] = fq_ == 0 ? x[j] * c_ - o[j] * s_ : x[j] * c_ + o[j] * s_; }
                        }
                        v0 = (f32x4){x[0], x[1], x[2], x[3]}; v1 = (f32x4){x[4], x[5], x[6], x[7]};
                    }
                    v0 = v0 * sc; v1 = v1 * sc;
                    u32x4 w; w.x = cvt_pk_bf16(v0[0], v0[1]); w.y = cvt_pk_bf16(v0[2], v0[3]); w.z = cvt_pk_bf16(v1[0], v1[1]); w.w = cvt_pk_bf16(v1[2], v1[3]);
                    *(u32x4*)(rowp + bj * HALF) = w;
                    if (kind == 3) { const int dd = col0 + bj * HALF - (B_IN + B_KVW), kvh = dd / B_HD, d = dd % B_HD; bf16* vt = VT + (((size_t)(row >> 6) * B_KV_HEADS + kvh) * B_HD + d) * 64 + (row & 63);
                        vt[0] = (bf16)(w.x & 0xffffu); vt[64] = (bf16)(w.x >> 16); vt[128] = (bf16)(w.y & 0xffffu); vt[192] = (bf16)(w.y >> 16);
                        vt[256] = (bf16)(w.z & 0xffffu); vt[320] = (bf16)(w.z >> 16); vt[384] = (bf16)(w.w & 0xffffu); vt[448] = (bf16)(w.w >> 16); }
                } }
    }
};
template <class Epi, class Sched, bool ALIGN_EPI>
__device__ __forceinline__ void gemm_phase(LAS unsigned char* lds, const Gemm g, const Sched& S, const Epi& E, const int tid) {
    const int wid = READFIRSTLANE(tid >> 6), lane = tid & 63, wr = wid >> 2, wc = wid & 3, fr = lane & 15, fq = lane >> 4;
    const int K = g.K, nt = K / BK;
    unsigned voffA[2], voffB[2];
#pragma unroll
    for (int i = 0; i < 2; ++i) { int R, C; stage_rc(tid * 16 + i * 8192, R, C); const int Rb = Epi::PERM ? ((R & ~31) + perm32(R & 31)) : R;
        voffA[i] = (unsigned)(R * g.lda + C) * 2u; voffB[i] = (unsigned)(Rb * K + C) * 2u; }
    const unsigned kstep = (unsigned)(BK * 2);
    const unsigned hstepA = (unsigned)HALF * (unsigned)g.lda * 2u, hstepB = (unsigned)HALF * (unsigned)K * 2u;
    const unsigned tstepA = 2 * hstepA, tstepB = 2 * hstepB;
    const BufRes rA = MAKE_RES(g.A), rB = MAKE_RES(g.Bt);
    const unsigned ldsw = (unsigned)wid * 1024u;
    const int aoff = lds_byte(wr * 64 + fr, fq * 8), boff = lds_byte(wc * 32 + fr, fq * 8);
#define PG8_SA(b, h) (((b) * 2 + (h)) * HTB)
#define PG8_SB(b, h) ((4 + (b) * 2 + (h)) * HTB)
#define PG8_STAGE(bufoff, res, soff, voff) do { _Pragma("unroll") for (int _i = 0; _i < 2; ++_i) \
        BLDS16(res, (voff)[_i], soff, lds + (bufoff) + ldsw + _i * 8192); } while (0)
#define PG8_LDA(dst, b, h) do { _Pragma("unroll") for (int m = 0; m < 4; ++m) _Pragma("unroll") for (int k = 0; k < 2; ++k) dst[m][k] = *(const LAS bf16x8*)(lds + PG8_SA(b, h) + aoff + m * 2048 + k * 1024); } while (0)
#define PG8_LDB(dst, b, h) do { _Pragma("unroll") for (int n = 0; n < 2; ++n) _Pragma("unroll") for (int k = 0; k < 2; ++k) dst[n][k] = *(const LAS bf16x8*)(lds + PG8_SB(b, h) + boff + n * 2048 + k * 1024); } while (0)
#define PG8_MMA(ai, bj, At, Bt) do { SETPRIO(1); _Pragma("unroll") for (int m = 0; m < 4; ++m) _Pragma("unroll") for (int n = 0; n < 2; ++n) _Pragma("unroll") for (int k = 0; k < 2; ++k) \
        acc[ai][bj][m][n] = MFMA16(Bt[n][k], At[m][k], acc[ai][bj][m][n]); SETPRIO(0); } while (0)
    Unit cur, nxt; int ui = 0;
    if (!S.next(0, cur)) return;
    f32x4 acc[2][2][4][2];
#pragma unroll
    for (int a = 0; a < 2; ++a)
#pragma unroll
        for (int b = 0; b < 2; ++b)
#pragma unroll
            for (int m = 0; m < 4; ++m)
#pragma unroll
                for (int n = 0; n < 2; ++n) acc[a][b][m][n] = (f32x4){0.f, 0.f, 0.f, 0.f};
    bf16x8 At[4][2], B0[2][2], B1[2][2];
    unsigned cA = (unsigned)cur.pm * tstepA, cB = (unsigned)cur.pn * tstepB;
    PG8_STAGE(PG8_SB(0, 0), rB, cB, voffB); PG8_STAGE(PG8_SB(0, 1), rB, cB + hstepB, voffB); PG8_STAGE(PG8_SA(0, 0), rA, cA, voffA); PG8_STAGE(PG8_SA(0, 1), rA, cA + hstepA, voffA);
    if (wr == 1) S_BARRIER();
    WAIT_VM(2); S_BARRIER();
    PG8_STAGE(PG8_SB(1, 0), rB, cB + kstep, voffB); PG8_STAGE(PG8_SA(1, 0), rA, cA + kstep, voffA); PG8_STAGE(PG8_SB(1, 1), rB, cB + hstepB + kstep, voffB);
    WAIT_VM(6); S_BARRIER();
    for (;;) {
        const bool has_next = S.next(ui + 1, nxt);
        const unsigned nA = has_next ? (unsigned)nxt.pm * tstepA : cA, nB = has_next ? (unsigned)nxt.pn * tstepB : cB;
        for (int t = 0; t < nt; t += 2) {
            const bool last = (t == nt - 2);
            const unsigned a1 = cA + (unsigned)(t + 1) * kstep;
            const unsigned a2 = last ? nA : cA + (unsigned)(t + 2) * kstep, b2 = last ? nB : cB + (unsigned)(t + 2) * kstep;
            const unsigned a3 = a2 + kstep, b3 = b2 + kstep;
            PG8_LDB(B0, 0, 0); PG8_LDB(B1, 0, 1); SCHED_BARRIER(); PG8_LDA(At, 0, 0); PG8_STAGE(PG8_SA(1, 1), rA, a1 + hstepA, voffA);
            WAIT_VM(8); WAIT_LGKM(0); S_BARRIER(); PG8_MMA(0, 0, At, B0); PG8_MMA(0, 1, At, B1); S_BARRIER(); SCHED_BARRIER();
            PG8_LDA(At, 0, 1); PG8_STAGE(PG8_SB(0, 0), rB, b2, voffB); PG8_STAGE(PG8_SB(0, 1), rB, b2 + hstepB, voffB); PG8_STAGE(PG8_SA(0, 0), rA, a2, voffA);
            WAIT_VM(8); WAIT_LGKM(0); S_BARRIER(); PG8_MMA(1, 0, At, B0); PG8_MMA(1, 1, At, B1); S_BARRIER(); SCHED_BARRIER();
            PG8_LDB(B0, 1, 0); PG8_LDB(B1, 1, 1); SCHED_BARRIER(); PG8_LDA(At, 1, 0); PG8_STAGE(PG8_SA(0, 1), rA, a2 + hstepA, voffA);
            WAIT_VM(8); WAIT_LGKM(0); S_BARRIER(); PG8_MMA(0, 0, At, B0); PG8_MMA(0, 1, At, B1); S_BARRIER(); SCHED_BARRIER();
            PG8_LDA(At, 1, 1); PG8_STAGE(PG8_SB(1, 0), rB, b3, voffB); PG8_STAGE(PG8_SB(1, 1), rB, b3 + hstepB, voffB); PG8_STAGE(PG8_SA(1, 0), rA, a3, voffA);
            WAIT_VM(8); WAIT_LGKM(0); S_BARRIER(); PG8_MMA(1, 0, At, B0); PG8_MMA(1, 1, At, B1); S_BARRIER(); SCHED_BARRIER();
        }
        if constexpr (ALIGN_EPI) { if (wr == 0) S_BARRIER(); }
        E(acc, cur, wr, wc, fr, fq);
        if (!has_next) break;
#pragma unroll
        for (int a = 0; a < 2; ++a)
#pragma unroll
            for (int b = 0; b < 2; ++b)
#pragma unroll
                for (int m = 0; m < 4; ++m)
#pragma unroll
                    for (int n = 0; n < 2; ++n) acc[a][b][m][n] = (f32x4){0.f, 0.f, 0.f, 0.f};
        cur = nxt; cA = nA; cB = nB; ++ui;
        if constexpr (ALIGN_EPI) { if (wr == 1) S_BARRIER(); }
    }
    WAIT_VM(0);
    if constexpr (!ALIGN_EPI) { if (wr == 0) S_BARRIER(); }
    S_BARRIER();
#undef PG8_SA
#undef PG8_SB
#undef PG8_STAGE
#undef PG8_LDA
#undef PG8_LDB
#undef PG8_MMA
}
}
__device__ __forceinline__ void gemm_mfma(const bf16* A, int lda, const bf16* Bt, bf16* C, int ldc, int M, int N, int K, const Ctx& c, unsigned char* lds) {
    pg8::Gemm g{A, lda, Bt, M, N, K}; pg8::StaticOrder S; S.init(M, N, c.nblk, c.bid); pg8::EpiBf16 E{C, ldc};
    __syncthreads();
    pg8::gemm_phase<pg8::EpiBf16, pg8::StaticOrder, true>((LAS unsigned char*)lds, g, S, E, c.tid);
    __syncthreads();
}
__device__ __forceinline__ void transpose_item(const float* W, int ldw, int K, int N, bf16* WT, int row_off, float* scr, int item, int lane) {
    const int nblk = N / 64, kb = item / nblk, nb = item % nblk, k0 = 64 * kb, n0 = 64 * nb;
#pragma unroll 8
    for (int kk = 0; kk < 64; ++kk) scr[kk * 65 + lane] = W[(size_t)(k0 + kk) * ldw + n0 + lane];
    WAVE_SYNC();
    const int cc = lane & 7;
#pragma unroll
    for (int j = 0; j < 8; ++j) { const int n = (lane >> 3) + 8 * j; const float* sp = scr + (8 * cc) * 65 + n;
        u32x4 o; o.x = cvtpk(sp[0 * 65], sp[1 * 65]); o.y = cvtpk(sp[2 * 65], sp[3 * 65]); o.z = cvtpk(sp[4 * 65], sp[5 * 65]); o.w = cvtpk(sp[6 * 65], sp[7 * 65]);
        *(u32x4*)(WT + (size_t)(row_off + n0 + n) * K + k0 + 8 * cc) = o; }
    WAVE_SYNC();
}
constexpr int WI_AIN = (D_MODEL / 64) * (A_MAIN / 64), WI_AOUT = (A_VW / 64) * (D_MODEL / 64), WI_BIN = (D_MODEL / 64) * (B_IN / 64), WI_BKV = (D_MODEL / 64) * (2 * B_KVW / 64), WI_BOUT = (B_QW / 64) * (D_MODEL / 64);
constexpr int WI_A_END = N_A * (WI_AIN + WI_AOUT), WI_ALL = WI_A_END + N_B * (WI_BIN + WI_BOUT) + WI_BKV;
__device__ __forceinline__ void weights_range(PrmRef p, int lane, int wave, unsigned char* lds, int vw, int nvw, int lo, int hi) {
    float* scr = (float*)lds + wave * (64 * 65);
    bf16* WAIN = (bf16*)(p.ws + WS_WAIN); bf16* WAOUT = (bf16*)(p.ws + WS_WAOUT); bf16* WBIN = (bf16*)(p.ws + WS_WBIN); bf16* WBOUT = (bf16*)(p.ws + WS_WBOUT);
    for (int it = lo + vw; it < hi; it += nvw) {
        int r = it;
        if (r < N_A * WI_AIN) { const int li = r / WI_AIN; transpose_item(p.a_w_in + (size_t)li * D_MODEL * A_IN, A_IN, D_MODEL, A_MAIN, WAIN + (size_t)li * A_NG * D_MODEL, 0, scr, r % WI_AIN, lane); continue; } r -= N_A * WI_AIN;
        if (r < N_A * WI_AOUT) { const int li = r / WI_AOUT; transpose_item(p.a_w_out + (size_t)li * A_VW * D_MODEL, D_MODEL, A_VW, D_MODEL, WAOUT + (size_t)li * D_MODEL * A_VW, 0, scr, r % WI_AOUT, lane); continue; } r -= N_A * WI_AOUT;
        if (r < N_B * WI_BIN) { const int lj = r / WI_BIN; transpose_item(p.b_w_in + (size_t)lj * D_MODEL * B_IN, B_IN, D_MODEL, B_IN, WBIN + (size_t)lj * B_N0 * D_MODEL, 0, scr, r % WI_BIN, lane); continue; } r -= N_B * WI_BIN;
        if (r < N_B * WI_BOUT) { const int lj = r / WI_BOUT; transpose_item(p.b_w_out + (size_t)lj * B_QW * D_MODEL, D_MODEL, B_QW, D_MODEL, WBOUT + (size_t)lj * D_MODEL * B_QW, 0, scr, r % WI_BOUT, lane); continue; } r -= N_B * WI_BOUT;
        transpose_item(p.b_w_kv, 2 * B_KVW, D_MODEL, 2 * B_KVW, WBIN, B_IN, scr, r, lane);
    }
}
__device__ __forceinline__ void ph_weights(PrmRef p, const Ctx& c, unsigned char* lds) {
    weights_range(p, c.lane, c.wave, lds, c.gwave, c.nwaves, 0, WI_AIN);
    bf16* WAIN = (bf16*)(p.ws + WS_WAIN);
    for (int it = c.gtid; it < N_A * 256 * D_MODEL; it += c.nthreads) {
        const int k = it % D_MODEL, j = (it / D_MODEL) % 256, li = it / (256 * D_MODEL);
        WAIN[((size_t)li * A_NG + A_MAIN + j) * D_MODEL + k] = j < 2 * A_HEADS ? (bf16)f2bf(p.a_w_in[((size_t)li * D_MODEL + k) * A_IN + A_MAIN + j]) : (bf16)0;
    }
}
__device__ __forceinline__ void weights_deferred(PrmRef p, const Ctx& c, int li, unsigned char* lds, int vw, int nvw) {
    static_assert(N_A == 2, "deferred weight conversion schedule");
    if (li == 0) weights_range(p, c.lane, c.wave, lds, vw, nvw, WI_AIN, WI_A_END); else weights_range(p, c.lane, c.wave, lds, vw, nvw, WI_A_END, WI_ALL);
}

__device__ __forceinline__ void ph_init(PrmRef p, const Ctx& c) {
    bf16* XB = (bf16*)(p.ws + WS_XB);
    for (size_t i8 = c.gtid; i8 < (size_t)MT * D_MODEL / 8; i8 += c.nthreads) {
        const size_t i = i8 * 8; const float* src = i < (size_t)PT * D_MODEL ? p.x_prompt + i : p.x_sample + (i - (size_t)PT * D_MODEL);
        const f32x4 a = *(const f32x4*)src, b = *(const f32x4*)(src + 4);
        u32x4 o; o.x = cvtpk(a[0], a[1]); o.y = cvtpk(a[2], a[3]); o.z = cvtpk(b[0], b[1]); o.w = cvtpk(b[2], b[3]);
        *(u32x4*)(XB + i) = o;
    }
    float* rope = (float*)(p.ws + WS_ROPE);
    for (int i = c.gtid; i < (SEQ + DEC_SEQ) * ROPE_HALF; i += c.nthreads) {
        const int pi = i / ROPE_HALF, f = i % ROPE_HALF; const float pos = pi < SEQ ? (float)pi : (float)(PAST_LEN + pi - SEQ);
        const float inv = f == 0 ? 1.0f : f == 1 ? 0.1939227432012558f : f == 2 ? 0.03760603070259094f : f == 3 ? 0.007292664609849453f : f == 4 ? 0.0014142135623842478f
                        : f == 5 ? 0.00027424818836152554f : f == 6 ? 5.3182957344688475e-05f : 1.0313385246263351e-05f;
        const float ang = pos * inv;
        rope[2 * i] = cosf(ang); rope[2 * i + 1] = sinf(ang);
    }
}

constexpr int SS_KC = 128, SS_STB = 32768, SS_BOFF = 16384;
template <int MODE> __device__ __forceinline__ void ss_issue(const bf16* A, int lda, const bf16* Bt, int K, int row0, int col0, int cidx, int q, int lw, int lane, unsigned char* lds) {
    const unsigned char* sa = (const unsigned char*)(A + (size_t)row0 * lda + cidx * SS_KC); const unsigned char* sb = (const unsigned char*)(Bt + (size_t)col0 * K + cidx * SS_KC);
    unsigned char* st = lds + (q & 3) * SS_STB;
#pragma unroll
    for (int i = 0; i < 4; ++i) { const int row = (lw * 4 + i) * 4 + (lane >> 4), pc = (lane & 15) ^ (row & 15);
        GLDS16(sa + (unsigned)row * (unsigned)(lda * 2) + (unsigned)pc * 16u, st + (lw * 4 + i) * 1024);
        if (MODE != 1) GLDS16(sb + (unsigned)row * (unsigned)(K * 2) + (unsigned)pc * 16u, st + SS_BOFF + (lw * 4 + i) * 1024); }
    if (MODE == 1) { const int row = lw * 4 + (lane >> 4), pc = (lane & 15) ^ (row & 15); GLDS16(sb + (unsigned)row * (unsigned)(K * 2) + (unsigned)pc * 16u, st + SS_BOFF + lw * 1024); }
}
template <int MODE> __device__ __forceinline__ void sgemm_stream(PrmRef p, int li, const bf16* A, int lda, const bf16* Bt, int K, bf16* C, int ldc, int row_begin, int col_base, int tn, int it0, int itstep, int nitems, int tid, unsigned char* lds) {
    const int lane = tid & 63, wave = READFIRSTLANE(tid >> 6), nkc = K / SS_KC;
    const int nmine = it0 < nitems ? (nitems - it0 + itstep - 1) / itstep : 0, Q = nmine * nkc;
    LBAR();
    if (Q == 0) return;
    if (wave >= 4) {
        const int lw = wave - 4;
        int it = it0, cidx = 0, row0 = row_begin + (it / tn) * 64, col0 = col_base + (it % tn) * 64;
#define SS_NEXT() do { if (++cidx == nkc) { cidx = 0; it += itstep; row0 = row_begin + (it / tn) * 64; col0 = col_base + (it % tn) * 64; } } while (0)
        ss_issue<MODE>(A, lda, Bt, K, row0, col0, cidx, 0, lw, lane, lds); SS_NEXT();
        if (Q > 1) { ss_issue<MODE>(A, lda, Bt, K, row0, col0, cidx, 1, lw, lane, lds); SS_NEXT(); }
        if (Q > 2) { ss_issue<MODE>(A, lda, Bt, K, row0, col0, cidx, 2, lw, lane, lds); SS_NEXT(); }
        for (int q = 0; q < Q; ++q) {
            if (q + 2 < Q) { if (MODE == 1) { WAIT_VM(10); } else { WAIT_VM(16); } } else { WAIT_VM(0); }
            LBAR();
            if (q + 3 < Q) { ss_issue<MODE>(A, lda, Bt, K, row0, col0, cidx, q + 3, lw, lane, lds); SS_NEXT(); }
        }
#undef SS_NEXT
    } else {
        const int r = lane & 15, g = lane >> 4;
        f32x4 acc[4];
#pragma unroll
        for (int nt = 0; nt < 4; ++nt) acc[nt] = (f32x4){0.f, 0.f, 0.f, 0.f};
        int it = it0, cidx = 0;
        for (int q = 0; q < Q; ++q) {
            LBAR();
            const unsigned char* ap = lds + (q & 3) * SS_STB + (16 * wave + r) * 256; const unsigned char* bp = lds + (q & 3) * SS_STB + SS_BOFF + r * 256;
#pragma unroll
            for (int ks = 0; ks < 4; ++ks) { const int po = ((4 * ks + g) ^ r) << 4; const bf16x8 a = *(const bf16x8*)(ap + po);
#pragma unroll
                for (int nt = 0; nt < (MODE == 1 ? 1 : 4); ++nt) { const bf16x8 b = *(const bf16x8*)(bp + nt * 4096 + po); acc[nt] = MFMA16(b, a, acc[nt]); } }
            if (++cidx == nkc) {
                const int row0 = row_begin + (it / tn) * 64, col0 = col_base + (it % tn) * 64, row = row0 + 16 * wave + r;
                if (MODE == 1) {
                    static_assert(2 * A_HEADS <= 16, "gate columns");
                    float* GB = (float*)(p.ws + WS_GB);
#pragma unroll
                    for (int e = 0; e < 4; ++e) { const int col = 4 * g + e; const float v = acc[0][e];
                        if (col < A_HEADS) GB[((size_t)row * A_HEADS + col) * 2] = -expf(p.a_log[li * A_HEADS + col]) * softplusf_(v + p.a_dt_bias[li * A_HEADS + col]);
                        else if (col < 2 * A_HEADS) GB[((size_t)row * A_HEADS + (col - A_HEADS)) * 2 + 1] = sigmoidf_(v); }
                } else {
                    if (MODE == 2) {
                        const int kind = col0 < B_QW ? 0 : col0 < B_IN ? 1 : col0 < B_IN + B_KVW ? 2 : 3, srow = row - PT;
                        if (kind == 0 || kind == 2) {
                            const float* rp = (const float*)(p.ws + WS_ROPE) + ((size_t)(SEQ + srow % DEC_SEQ) * ROPE_HALF + 4 * (g & 1)) * 2;
                            const f32x4 cs0 = *(const f32x4*)rp, cs1 = *(const f32x4*)(rp + 4);
#pragma unroll
                            for (int e = 0; e < 4; ++e) { const float x = acc[0][e], o = __shfl_xor(x, 32), c_ = e < 2 ? cs0[2 * e] : cs1[2 * e - 4], s_ = e < 2 ? cs0[2 * e + 1] : cs1[2 * e - 3];
                                acc[0][e] = g < 2 ? x * c_ - o * s_ : x * c_ + o * s_; }
                        }
                        if (kind == 0) {
#pragma unroll
                            for (int nt = 0; nt < 4; ++nt) acc[nt] = acc[nt] * 0.125f; }
                        if (kind == 3) { bf16* VT = (bf16*)(p.ws + WS_VT); const int kvh = (col0 - (B_IN + B_KVW)) / B_HD, ck = NCP + srow / DEC_SEQ, key = srow % DEC_SEQ;
#pragma unroll
                            for (int nt = 0; nt < 4; ++nt)
#pragma unroll
                                for (int e = 0; e < 4; ++e) VT[(((size_t)ck * B_KV_HEADS + kvh) * B_HD + 16 * nt + 4 * g + e) * 64 + key] = (bf16)(cvtpk(acc[nt][e], 0.f) & 0xffffu); }
                    }
                    bf16* cp = C + (size_t)row * ldc + col0 + 4 * g;
#pragma unroll
                    for (int nt = 0; nt < 4; ++nt) { u32x2 w; w.x = cvtpk(acc[nt][0], acc[nt][1]); w.y = cvtpk(acc[nt][2], acc[nt][3]); *(u32x2*)(cp + 16 * nt) = w; }
                }
#pragma unroll
                for (int nt = 0; nt < 4; ++nt) acc[nt] = (f32x4){0.f, 0.f, 0.f, 0.f};
                cidx = 0; it += itstep;
            }
        }
    }
    LBAR();
}
template <int MODE = 0> __device__ __forceinline__ void sgemm_rows(PrmRef p, const bf16* A, int lda, const bf16* Bt, int K, bf16* C, int ldc, int row_begin, int nrows, int N, const Ctx& c, int first_wg, unsigned char* lds, bool only_tail = false) {
    const int tn = N / 64, nt = (nrows / 64) * tn;
    const int f = first_wg % c.nblk, np = (only_tail && f > 0) ? c.nblk - f : c.nblk;
    const int v = only_tail && f > 0 ? c.bid - f : (c.bid + c.nblk - f) % c.nblk;
    sgemm_stream<MODE>(p, 0, A, lda, Bt, K, C, ldc, row_begin, 0, tn, v >= 0 ? v : nt, np, nt, c.tid, lds);
}
__device__ __forceinline__ void ph_a_gemm(PrmRef p, const Ctx& c, int li, unsigned char* lds) {
    const bf16* XB = (const bf16*)(p.ws + WS_XB); bf16* PROJ = (bf16*)(p.ws + WS_PROJ); const bf16* Wt = (const bf16*)(p.ws + WS_WAIN) + (size_t)li * A_NG * D_MODEL;
    pg8::Gemm g{XB, D_MODEL, Wt, PT, A_MAIN, D_MODEL}; pg8::StaticOrder S; S.init(PT, A_MAIN, c.nblk, c.bid);
    pg8::EpiAIn E{PROJ, PLD, (bf16*)(p.ws + WS_HALO), p.out + O_PCONV + (size_t)li * BATCH * 3 * CONV_DIM};
    __syncthreads();
    pg8::gemm_phase<pg8::EpiAIn, pg8::StaticOrder, true>((LAS unsigned char*)lds, g, S, E, c.tid);
    __syncthreads();
    sgemm_stream<1>(p, li, XB, D_MODEL, Wt, D_MODEL, nullptr, 0, 0, A_MAIN, 1, c.bid, c.nblk, MT / 64, c.tid, lds);
    sgemm_rows(p, XB, D_MODEL, Wt, D_MODEL, PROJ, PLD, PT, ST, A_MAIN, c, MT / 64, lds);
}
constexpr int NPG = BATCH * A_HEADS, NSG = DEC_BATCH * A_HEADS, NPI = NPG * NCPS;
__device__ __forceinline__ unsigned pk2bf(float lo, float hi) { return cvtpk(lo, hi); }
constexpr int PP_KN = 0, PP_QN = 17408, PP_KF = 34816, PP_VF = 67584, PP_GC = 100352, PP_LN = 102400, PP_LNP = 68, PP_TI = PP_LN + 64 * PP_LNP * 4, PP_WST = PP_TI + 4 * 16 * 17 * 4, PP_CW = PP_WST + 17408, PP_END = PP_CW + 3 * 4 * 128 * 4;
static_assert(PP_END <= 163840 - 64 && PP_TI % 16 == 0 && PP_WST % 16 == 0 && PP_CW % 16 == 0, "prepass LDS");
typedef u32x4 RawTile[3][4][2];
__device__ __forceinline__ void prepass_load_raw(PrmRef p, int item, int tid, RawTile& xr) {
    const bf16* PROJ = (const bf16*)(p.ws + WS_PROJ); const bf16* HALO = (const bf16*)(p.ws + WS_HALO);
    const int n = item % NCPS, grp = item / NCPS, h = grp % A_HEADS, s = grp / A_HEADS, R0 = s * SEQ + n * CHUNK, r = tid >> 3, seg = tid & 7;
#pragma unroll
    for (int X = 0; X < 3; ++X) {
        const int cb = X * A_QK + h * A_DK + 16 * seg;
#pragma unroll
        for (int j = 0; j < 4; ++j) {
            const int rr = r - 3 + j;
            if (rr >= 0) { const u32x4* src = (const u32x4*)(PROJ + (size_t)(R0 + rr) * PLD + cb); xr[X][j][0] = src[0]; xr[X][j][1] = src[1]; }
            else if (n > 0) { const u32x4* src = (const u32x4*)(HALO + ((size_t)(s * NCPS + n - 1) * 3 + (3 + rr)) * CONV_DIM + cb); xr[X][j][0] = src[0]; xr[X][j][1] = src[1]; }
            else { xr[X][j][0] = (u32x4){0u, 0u, 0u, 0u}; xr[X][j][1] = xr[X][j][0]; }
        }
    }
}
__device__ __forceinline__ void prepass_gcum(PrmRef p, int item, int lane, float* GC) {
    const float* GB = (const float*)(p.ws + WS_GB); float* GL = (float*)(p.ws + WS_GL);
    const int n = item % NCPS, grp = item / NCPS, h = grp % A_HEADS, s = grp / A_HEADS, R0 = s * SEQ + n * CHUNK;
    const float g = GB[((size_t)(R0 + lane) * A_HEADS + h) * 2], bt = GB[((size_t)(R0 + lane) * A_HEADS + h) * 2 + 1];
    float cs = g;
#pragma unroll
    for (int d = 1; d < 64; d <<= 1) { const float o = __shfl(cs, lane >= d ? lane - d : lane); if (lane >= d) cs += o; }
    const float gl = __shfl(cs, 63);
    GC[lane] = cs; GC[64 + lane] = bt; GC[128 + lane] = fexp(cs); GC[192 + lane] = fexp(gl - cs);
    if (lane == 0) GL[item] = fexp(gl);
}
__device__ __forceinline__ void prepass_store_w(PrmRef p, int item, int tid, const unsigned char* lds) {
    bf16* WB = (bf16*)(p.ws + WS_WB); const bf16* WST = (const bf16*)(lds + PP_WST);
    const int n = item % NCPS, grp = item / NCPS, h = grp % A_HEADS, s = grp / A_HEADS, R0 = s * SEQ + n * CHUNK, r = tid >> 3, seg = tid & 7;
    const u32x4 w0 = *(const u32x4*)(WST + r * 136 + 16 * seg), w1 = *(const u32x4*)(WST + r * 136 + 16 * seg + 8);
    u32x4* dst = (u32x4*)(WB + (size_t)(R0 + r) * A_QK + h * A_DK + 16 * seg); dst[0] = w0; dst[1] = w1;
}
template <int VAR = 0> __device__ __forceinline__ void delta_prepass_item(PrmRef p, int li, int item, int next_item, int prev_item, int pb, int tid, unsigned char* lds, RawTile& xr) {
#ifndef EMU
    asm volatile("" : "+v"(tid));
#endif
    bf16* PROJ = (bf16*)(p.ws + WS_PROJ); bf16* IA = (bf16*)(p.ws + WS_IA);
    const int n = item % NCPS, grp = item / NCPS, h = grp % A_HEADS, s = grp / A_HEADS;
    const int R0 = s * SEQ + n * CHUNK, lane = tid & 63, wave = READFIRSTLANE(tid >> 6);
    bf16* KN = (bf16*)(lds + PP_KN); bf16* QN = (bf16*)(lds + PP_QN); bf16* VN = (bf16*)(lds + PP_KF);
    float* GC = (float*)(lds + PP_GC) + pb * 256; float* BT = GC + 64; float* EG = GC + 128; float* KD = GC + 192;
    float* LN = (float*)(lds + PP_LN);
    float* TI = (float*)(lds + PP_TI);
    bf16* WST = (bf16*)(lds + PP_WST);
    if (prev_item >= 0) prepass_store_w(p, prev_item, tid, lds);
    const int r = tid >> 3, seg = tid & 7;
    float qf[16];
#pragma unroll
    for (int X = 0; X < 3; ++X) {
        const int cb = X * A_QK + h * A_DK + 16 * seg;
        float acc[16];
#pragma unroll
        for (int e = 0; e < 16; ++e) acc[e] = 0.f;
#pragma unroll
        for (int j = 0; j < 4; ++j) {
            const f32x4* wp = (const f32x4*)(lds + PP_CW) + ((X * 4 + j) * 128 + 16 * seg) / 4;
#pragma unroll
            for (int e = 0; e < 4; ++e) {
                const f32x4 w4 = wp[e]; const unsigned a = xr[X][j][e >> 1][2 * (e & 1)], b = xr[X][j][e >> 1][2 * (e & 1) + 1];
                acc[4 * e] += w4[0] * bflo(a); acc[4 * e + 1] += w4[1] * bfhi(a); acc[4 * e + 2] += w4[2] * bflo(b); acc[4 * e + 3] += w4[3] * bfhi(b);
            }
        }
        float ss = 0.f;
#pragma unroll
        for (int e = 0; e < 16; ++e) { acc[e] = fsilu(acc[e]); ss += acc[e] * acc[e]; }
        if (X < 2) {
            ss = sum8(ss);
            const float rs = fast_rsq(ss + RMS_EPS) * (X == 0 ? 0.08838834764831845f : 1.f);
#pragma unroll
            for (int e = 0; e < 16; ++e) acc[e] *= rs;
        }
        if (X == 0) {
#pragma unroll
            for (int e = 0; e < 16; ++e) qf[e] = acc[e];
            u32x4 o0, o1;
#pragma unroll
            for (int e = 0; e < 4; ++e) { o0[e] = cvtpk(acc[2 * e], acc[2 * e + 1]); o1[e] = cvtpk(acc[8 + 2 * e], acc[8 + 2 * e + 1]); }
            *(u32x4*)(QN + r * 136 + 16 * seg) = o0; *(u32x4*)(QN + r * 136 + 16 * seg + 8) = o1;
        } else if (X == 1) {
            u32x4 o0, o1;
#pragma unroll
            for (int e = 0; e < 4; ++e) { o0[e] = cvtpk(acc[2 * e], acc[2 * e + 1]); o1[e] = cvtpk(acc[8 + 2 * e], acc[8 + 2 * e + 1]); }
            *(u32x4*)(KN + r * 136 + 16 * seg) = o0; *(u32x4*)(KN + r * 136 + 16 * seg + 8) = o1;
        } else {
            u32x4 o0, o1;
#pragma unroll
            for (int e = 0; e < 4; ++e) { o0[e] = cvtpk(acc[2 * e], acc[2 * e + 1]); o1[e] = cvtpk(acc[8 + 2 * e], acc[8 + 2 * e + 1]); }
            *(u32x4*)(VN + r * 136 + 16 * seg) = o0; *(u32x4*)(VN + r * 136 + 16 * seg + 8) = o1;
        }
    }
    LBAR();
    if (next_item >= 0) prepass_load_raw(p, next_item, tid, xr);
    {
        const float eg = EG[r]; u32x4 o0, o1;
#pragma unroll
        for (int e = 0; e < 4; ++e) { o0[e] = cvtpk(qf[2 * e] * eg, qf[2 * e + 1] * eg); o1[e] = cvtpk(qf[8 + 2 * e] * eg, qf[8 + 2 * e + 1] * eg); }
        u32x4* dst = (u32x4*)(PROJ + (size_t)(R0 + r) * PLD + h * A_DK + 16 * seg); dst[0] = o0; dst[1] = o1;
    }
    if (VAR != 4) {
        const int kind = wave >> 2, ti = (wave >> 1) & 1, tj = wave & 1, l31 = lane & 31, hi = lane >> 5;
        if (wave == 1) {
            if (next_item >= 0) prepass_gcum(p, next_item, lane, (float*)(lds + PP_GC) + (pb ^ 1) * 256);
#pragma unroll
            for (int e = 0; e < 16; ++e) LN[((e & 3) + 8 * (e >> 2) + 4 * hi) * PP_LNP + 32 + l31] = 0.f;
        } else {
            f32x16 acc;
#pragma unroll
            for (int e = 0; e < 16; ++e) acc[e] = 0.f;
            const unsigned char* ap = (const unsigned char*)(kind == 0 ? KN : QN) + (32 * ti + l31) * 272 + 16 * hi;
            const unsigned char* bp = (const unsigned char*)KN + (32 * tj + l31) * 272 + 16 * hi;
            if (ti >= tj) {
#pragma unroll
                for (int ks = 0; ks < 8; ++ks) { const bf16x8 a = *(const bf16x8*)(ap + 32 * ks), b = *(const bf16x8*)(bp + 32 * ks); acc = MFMA32(a, b, acc); }
            }
            const int col = 32 * tj + l31; const float gcc = GC[col];
#pragma unroll
            for (int e = 0; e < 16; ++e) {
                const int row = 32 * ti + (e & 3) + 8 * (e >> 2) + 4 * hi;
                if (kind == 0) LN[row * PP_LNP + col] = row > col ? -(BT[row] * acc[e] * fexp(GC[row] - gcc)) : 0.f;
                else IA[((size_t)item * 64 + row) * 64 + col] = (bf16)f2bf(row >= col ? acc[e] * fexp(GC[row] - gcc) : 0.f);
            }
            if (wave == 0 || wave == 3) {
                WAVE_SYNC();
                if (lane < 32) {
                    const int b = (wave == 3 ? 2 : 0) + (lane >> 4), j = lane & 15; float t[16];
#pragma unroll
                    for (int i = 0; i < 16; ++i) {
                        float v = i == j ? 1.f : 0.f;
#pragma unroll
                        for (int k = 0; k < i; ++k) v += LN[(16 * b + i) * PP_LNP + 16 * b + k] * t[k];
                        t[i] = v;
                    }
#pragma unroll
                    for (int i = 0; i < 16; ++i) TI[(b * 16 + i) * 17 + j] = t[i];
                }
            } else if (wave >= 4) {
                const int u = tid - 256, m = u & 127, half = u >> 7;
                unsigned char* dst = (unsigned char*)PROJ + ((size_t)(R0 + (m >> 1)) * PLD + A_QK + h * A_DK) * 2 + (m & 1) * 128 + half * 64;
#pragma unroll
                for (int q4 = 0; q4 < 4; ++q4) {
                    u32x4 o;
#pragma unroll
                    for (int e = 0; e < 4; ++e) { const int j = 32 * half + 8 * q4 + 2 * e; o[e] = cvtpk(bf2f(KN[j * 136 + m]) * KD[j], bf2f(KN[(j + 1) * 136 + m]) * KD[j + 1]); }
                    *(u32x4*)(dst + 16 * q4) = o;
                }
            }
        }
    }
    LBAR();
    if (VAR != 4 && VAR != 1) {
        const int g = lane >> 4, cl = lane & 15;
        f32x4 XU[4], XW[4];
#pragma unroll
        for (int b = 0; b < 4; ++b) {
            f32x4 yu, yw;
#pragma unroll
            for (int e = 0; e < 4; ++e) { const int row = 16 * b + 4 * g + e; const float bt = BT[row]; yu[e] = bf2f(VN[row * 136 + 16 * wave + cl]) * bt; yw[e] = bf2f(KN[row * 136 + 16 * wave + cl]) * (bt * EG[row]); }
            float la[12], ta[4];
#pragma unroll
            for (int c = 0; c < b; ++c)
#pragma unroll
                for (int ks = 0; ks < 4; ++ks) la[4 * c + ks] = LN[(16 * b + cl) * PP_LNP + 16 * c + 4 * g + ks];
#pragma unroll
            for (int ks = 0; ks < 4; ++ks) ta[ks] = TI[(b * 16 + cl) * 17 + 4 * g + ks];
            SCHED_BARRIER();
#pragma unroll
            for (int c = 0; c < b; ++c)
#pragma unroll
                for (int ks = 0; ks < 4; ++ks) { yu = MFMAF(la[4 * c + ks], XU[c][ks], yu); yw = MFMAF(la[4 * c + ks], XW[c][ks], yw); }
            f32x4 xu = (f32x4){0.f, 0.f, 0.f, 0.f}, xw = xu;
#pragma unroll
            for (int ks = 0; ks < 4; ++ks) { xu = MFMAF(ta[ks], yu[ks], xu); xw = MFMAF(ta[ks], yw[ks], xw); }
            XU[b] = xu; XW[b] = xw;
            u32x2 o; o.x = cvtpk(xu[0], xu[1]); o.y = cvtpk(xu[2], xu[3]);
            *(u32x2*)((unsigned char*)PROJ + ((size_t)(R0 + wave * 8 + 2 * b + (lane >> 5)) * PLD + 2 * A_QK + h * A_DV) * 2 + (lane & 31) * 8) = o;
#pragma unroll
            for (int e = 0; e < 4; ++e) WST[(16 * b + 4 * g + e) * 136 + 16 * wave + cl] = (bf16)(cvtpk(xw[e], 0.f) & 0xffffu);
        }
    }
    LBAR();
}

__device__ __forceinline__ bf16x8 pack_b(const f32x4 a, const f32x4 b) {
    u32x4 o; o.x = pk2bf(a[0], a[1]); o.y = pk2bf(a[2], a[3]); o.z = pk2bf(b[0], b[1]); o.w = pk2bf(b[2], b[3]); return __builtin_bit_cast(bf16x8, o);
}
__device__ __forceinline__ bf16x8 ld_frag(const unsigned char* base, int off0, int off1) {
    const u32x2 lo = *(const u32x2*)(base + off0), hi = *(const u32x2*)(base + off1);
    u32x4 o; o.x = lo.x; o.y = lo.y; o.z = hi.x; o.w = hi.y; return __builtin_bit_cast(bf16x8, o);
}
constexpr int SC_BUF = 65536, SC_W = 0, SC_QD = 16384, SC_KDT = 32768, SC_IA = 49152, SC_U = 57344;
__device__ __forceinline__ void scan_dma(PrmRef p, int grp, int half, int n, int lw, int lane, unsigned char* buf) {
    const unsigned char* PROJ = (const unsigned char*)(p.ws + WS_PROJ); const unsigned char* WB = (const unsigned char*)(p.ws + WS_WB); const unsigned char* IA = (const unsigned char*)(p.ws + WS_IA);
    const int h = grp % A_HEADS, s = grp / A_HEADS, R0 = s * SEQ + n * CHUNK;
    const unsigned char* bW = WB + ((size_t)R0 * A_QK + h * A_DK) * 2;
    const unsigned char* bQ = PROJ + ((size_t)R0 * PLD + h * A_DK) * 2;
    const unsigned char* bK = PROJ + ((size_t)R0 * PLD + A_QK + h * A_DK) * 2;
    const unsigned char* bU = PROJ + ((size_t)(R0 + 32 * half) * PLD + 2 * A_QK + h * A_DV) * 2;
    const unsigned char* bI = IA + (size_t)(grp * NCPS + n) * 8192;
#pragma unroll
    for (int j = 0; j < 4; ++j) {
        const int ip = lw + 4 * j, sg = ip * 64 + lane;
        { const int row = sg >> 4, pc = (sg & 15) ^ (row & 15);
          GLDS16(bW + (unsigned)row * (unsigned)(A_QK * 2) + (unsigned)pc * 16u, buf + SC_W + ip * 1024);
          GLDS16(bQ + (unsigned)row * (unsigned)(PLD * 2) + (unsigned)pc * 16u, buf + SC_QD + ip * 1024); }
        { const int m = sg >> 3, pc = (sg & 7) ^ ((m >> 1) & 7);
          GLDS16(bK + (unsigned)(m >> 1) * (unsigned)(PLD * 2) + (unsigned)(m & 1) * 128u + (unsigned)pc * 16u, buf + SC_KDT + ip * 1024); }
        if (j < 2) {
          { const int row = sg >> 3, pc = (sg & 7) ^ ((row >> 1) & 7); GLDS16(bI + (unsigned)row * 128u + (unsigned)pc * 16u, buf + SC_IA + ip * 1024); }
          GLDS16(bU + (unsigned)(sg >> 4) * (unsigned)(PLD * 2) + (unsigned)(sg & 15) * 16u, buf + SC_U + ip * 1024);
        }
    }
}
template <int SV = 0> __device__ __forceinline__ void delta_scan_group(PrmRef p, int li, int item, int tid, unsigned char* lds, bool wstate = true) {
    unsigned char* PROJ = (unsigned char*)(p.ws + WS_PROJ); const float* GL = (const float*)(p.ws + WS_GL);
    const int grp = item >> 1, half = item & 1;
    const int h = grp % A_HEADS, s = grp / A_HEADS, lane = tid & 63, wave = READFIRSTLANE(tid >> 6);
    const bool loader = wave >= 4; const int cw = 4 * half + (wave & 3);
    f32x4 S[8];
#pragma unroll
    for (int m = 0; m < 8; ++m) S[m] = (f32x4){0.f, 0.f, 0.f, 0.f};
    unsigned char* fp = PROJ + ((size_t)(s * SEQ + cw * 8 + (lane >> 5)) * PLD + 2 * A_QK + h * A_DV) * 2 + (lane & 31) * 8;
    constexpr size_t TSTEP = (size_t)2 * PLD * 2, CSTEP = (size_t)CHUNK * PLD * 2;
    static_assert(NCPS <= 64, "glast per lane");
    const float glv = GL[grp * NCPS + (lane < NCPS ? lane : 0)];
    if (loader) { if (SV != 1) scan_dma(p, grp, half, 0, wave - 4, lane, lds); }
    WAIT_VM(0); LBAR();
    for (int n = 0; n < NCPS; ++n) {
        unsigned char* buf = lds + (n & 1) * SC_BUF;
        if (loader) {
            if (n + 1 < NCPS) { if (SV != 1) scan_dma(p, grp, half, n + 1, wave - 4, lane, lds + ((n + 1) & 1) * SC_BUF); }
            WAIT_VM(0);
        } else {
        int lane2 = lane;
#ifndef EMU
        asm volatile("" : "+v"(lane2));
#endif
        const int g = lane2 >> 4, cl = lane2 & 15, gh = g >> 1;
        int oW[4][2], oH[2][2];
#pragma unroll
        for (int ks = 0; ks < 4; ++ks) { const int x = (4 * ks + gh) ^ cl; oW[ks][0] = cl * 256 + (x << 4) + 8 * (g & 1); oW[ks][1] = cl * 256 + ((x ^ 2) << 4) + 8 * (g & 1); }
#pragma unroll
        for (int ks = 0; ks < 2; ++ks) { const int x = (4 * ks + gh) ^ (cl >> 1); oH[ks][0] = cl * 128 + (x << 4) + 8 * (g & 1); oH[ks][1] = cl * 128 + ((x ^ 2) << 4) + 8 * (g & 1); }
        u32x2 uf[4];
#pragma unroll
        for (int t = 0; t < 4; ++t) uf[t] = *(const u32x2*)(buf + SC_U + ((wave & 3) * 8 + 2 * t + (lane2 >> 5)) * 256 + (lane2 & 31) * 8);
        const float glast = BCAST_LANE(glv, n);
        bf16x8 Bs[4];
#pragma unroll
        for (int ks = 0; ks < 4; ++ks) Bs[ks] = pack_b(S[2 * ks], S[2 * ks + 1]);
        bf16x8 fa[4][4];
#pragma unroll
        for (int t = 0; t < 4; ++t)
#pragma unroll
            for (int ks = 0; ks < 4; ++ks) fa[t][ks] = ld_frag(buf + SC_W + t * 4096, oW[ks][0], oW[ks][1]);
        SCHED_BARRIER();
        f32x4 vn[4];
#pragma unroll
        for (int t = 0; t < 4; ++t) vn[t] = (f32x4){0.f, 0.f, 0.f, 0.f};
#pragma unroll
        for (int ks = 0; ks < (SV == 3 ? 0 : 4); ++ks)
#pragma unroll
            for (int t = 0; t < 4; ++t) vn[t] = MFMA16(fa[t][ks], Bs[ks], vn[t]);
#pragma unroll
        for (int t = 0; t < 4; ++t) { const f32x4 u = (f32x4){bflo(uf[t].x), bfhi(uf[t].x), bflo(uf[t].y), bfhi(uf[t].y)}; vn[t] = u - vn[t]; }
        SCHED_BARRIER();
        bf16x8 fk[8][2];
#pragma unroll
        for (int m = 0; m < 8; ++m)
#pragma unroll
            for (int ks = 0; ks < 2; ++ks) fk[m][ks] = ld_frag(buf + SC_KDT + m * 2048, oH[ks][0], oH[ks][1]);
        SCHED_BARRIER();
        bf16x8 Vb[2];
        Vb[0] = pack_b(vn[0], vn[1]); Vb[1] = pack_b(vn[2], vn[3]);
#pragma unroll
        for (int m = 0; m < 8; ++m) S[m] = S[m] * glast;
#pragma unroll
        for (int ks = 0; ks < 2; ++ks)
#pragma unroll
            for (int m = 0; m < 8; ++m) S[m] = MFMA16(fk[m][ks], Vb[ks], S[m]);
#pragma unroll
        for (int t = 0; t < 4; ++t)
#pragma unroll
            for (int ks = 0; ks < 4; ++ks) fa[t][ks] = ld_frag(buf + SC_QD + t * 4096, oW[ks][0], oW[ks][1]);
        bf16x8 fi[4][2];
#pragma unroll
        for (int t = 0; t < 4; ++t)
#pragma unroll
            for (int ks = 0; ks < 2; ++ks) fi[t][ks] = ld_frag(buf + SC_IA + t * 2048, oH[ks][0], oH[ks][1]);
        SCHED_BARRIER();
        f32x4 oa[4];
#pragma unroll
        for (int t = 0; t < 4; ++t) oa[t] = (f32x4){0.f, 0.f, 0.f, 0.f};
        if (SV != 2) {
#pragma unroll
        for (int ks = 0; ks < 4; ++ks)
#pragma unroll
            for (int t = 0; t < 4; ++t) oa[t] = MFMA16(fa[t][ks], Bs[ks], oa[t]);
#pragma unroll
        for (int ks = 0; ks < 2; ++ks)
#pragma unroll
            for (int t = 0; t < 4; ++t) oa[t] = MFMA16(fi[t][ks], Vb[ks], oa[t]);
#pragma unroll
        for (int t = 0; t < 4; ++t) {
            u32x2 w; w.x = cvtpk(oa[t][0], oa[t][1]); w.y = cvtpk(oa[t][2], oa[t][3]);
            if (SV == 4) { asm volatile("" :: "v"(w.x), "v"(w.y)); } else
            *(u32x2*)(fp + (size_t)n * CSTEP + t * TSTEP) = w;
        }
        }
        WAIT_VM(4);
        }
        LBAR();
    }
    if (!loader && (wstate || SV != 0)) {
    float* so = SV != 0 ? (float*)(p.ws + WS_XB) + (size_t)grp * A_DK * A_DV : p.out + O_PDELTA + (((size_t)li * BATCH + s) * A_HEADS + h) * A_DK * A_DV;
#pragma unroll
    for (int m = 0; m < 8; ++m)
#pragma unroll
        for (int e = 0; e < 4; ++e) so[(size_t)(16 * m + 4 * (lane >> 4) + e) * A_DV + 16 * cw + (lane & 15)] = S[m][e];
    }
    LBAR();
}
constexpr int NM_PART = 0, NM_OST = 2048;
struct NormRaw { u32x2 of[4]; u32x4 z0, z1; };
__device__ __forceinline__ void norm_load(PrmRef p, int item, int tid, NormRaw& q) {
    const unsigned char* PROJ = (const unsigned char*)(p.ws + WS_PROJ);
    const int n = item % NCPS, grp = item / NCPS, h = grp % A_HEADS, s = grp / A_HEADS, R0 = s * SEQ + n * CHUNK;
    const int lane = tid & 63, wave = tid >> 6, r = tid >> 3, seg = tid & 7;
    const unsigned char* fp = PROJ + ((size_t)(R0 + wave * 8 + (lane >> 5)) * PLD + 2 * A_QK + h * A_DV) * 2 + (lane & 31) * 8;
#pragma unroll
    for (int t = 0; t < 4; ++t) q.of[t] = *(const u32x2*)(fp + (size_t)t * 2 * PLD * 2);
    const u32x4* zp = (const u32x4*)(PROJ + ((size_t)(R0 + r) * PLD + CONV_DIM + h * A_DV + 16 * seg) * 2); q.z0 = zp[0]; q.z1 = zp[1];
}
__device__ __forceinline__ void delta_norm_item(PrmRef p, int li, int item, int next_item, int tid, unsigned char* lds, NormRaw& raw) {
    unsigned char* PROJ = (unsigned char*)(p.ws + WS_PROJ);
    const int n = item % NCPS, grp = item / NCPS, h = grp % A_HEADS, s = grp / A_HEADS, R0 = s * SEQ + n * CHUNK;
    const int lane = tid & 63, wave = tid >> 6, g = lane >> 4, cl = lane & 15, r = tid >> 3, seg = tid & 7;
    float* PART = (float*)(lds + NM_PART);
    const float nw = p.a_norm_w[li * A_DV + 16 * wave + cl];
    const u32x4 z0 = raw.z0, z1 = raw.z1;
    f32x4 oa[4];
#pragma unroll
    for (int t = 0; t < 4; ++t) {
        oa[t] = (f32x4){bflo(raw.of[t].x), bfhi(raw.of[t].x), bflo(raw.of[t].y), bfhi(raw.of[t].y)};
        f32x4 q4;
#pragma unroll
        for (int e = 0; e < 4; ++e) q4[e] = sum16(oa[t][e] * oa[t][e]);
        if (cl < 4) PART[(16 * t + 4 * g + cl) * 8 + wave] = cl == 0 ? q4[0] : cl == 1 ? q4[1] : cl == 2 ? q4[2] : q4[3];
    }
    if (next_item >= 0) norm_load(p, next_item, tid, raw);
    LBAR();
#pragma unroll
    for (int t = 0; t < 4; ++t)
#pragma unroll
        for (int e = 0; e < 4; ++e) {
            const int row = 16 * t + 4 * g + e;
            const f32x4 p0 = *(const f32x4*)(PART + row * 8), p1 = *(const f32x4*)(PART + row * 8 + 4);
            const float ss = ((p0[0] + p0[1]) + (p0[2] + p0[3])) + ((p1[0] + p1[1]) + (p1[2] + p1[3]));
            *(bf16*)(lds + NM_OST + row * 272 + (16 * wave + cl) * 2) = (bf16)(cvtpk(oa[t][e] * fast_rsq(ss * (1.f / A_DV) + RMS_EPS) * nw, 0.f) & 0xffffu);
        }
    LBAR();
    {
        const u32x4 o0 = *(const u32x4*)(lds + NM_OST + r * 272 + 32 * seg), o1 = *(const u32x4*)(lds + NM_OST + r * 272 + 32 * seg + 16);
        u32x4 w0, w1;
#pragma unroll
        for (int e = 0; e < 4; ++e) {
            w0[e] = cvtpk(bflo(o0[e]) * fsilu(bflo(z0[e])), bfhi(o0[e]) * fsilu(bfhi(z0[e])));
            w1[e] = cvtpk(bflo(o1[e]) * fsilu(bflo(z1[e])), bfhi(o1[e]) * fsilu(bfhi(z1[e])));
        }
        u32x4* dst = (u32x4*)(PROJ + ((size_t)(R0 + r) * PLD + 2 * A_QK + h * A_DV + 16 * seg) * 2); dst[0] = w0; dst[1] = w1;
    }
    LBAR();
}
__device__ __forceinline__ void ph_a_norm(PrmRef p, const Ctx& c, int li, unsigned char* lds) {
    NormRaw raw;
    if (c.bid < NPI) norm_load(p, c.bid, c.tid, raw);
    for (int item = c.bid; item < NPI; item += c.nblk) delta_norm_item(p, li, item, item + c.nblk < NPI ? item + c.nblk : -1, c.tid, lds, raw);
    bf16* PROJ = (bf16*)(p.ws + WS_PROJ);
    sgemm_rows(p, PROJ + 2 * A_QK, PLD, (const bf16*)(p.ws + WS_WAOUT) + (size_t)li * D_MODEL * A_VW, A_VW, PROJ, PLD, PT, ST, D_MODEL, c, NPI, lds);
}
__device__ __forceinline__ void sample_conv(PrmRef p, const Ctx& c, int li) {
    bf16* PROJ = (bf16*)(p.ws + WS_PROJ);
    const float* cw = p.a_conv_w + (size_t)li * CONV_W * CONV_DIM;
    for (int it = c.gtid; it < DEC_BATCH * CONV_DIM; it += c.nthreads) {
        const int ch = it % CONV_DIM, b = it / CONV_DIM;
        const float* sp = p.state_conv + (((size_t)li * DEC_BATCH + b) * 3) * CONV_DIM + ch;
        float h0 = sp[0], h1 = sp[CONV_DIM], h2 = sp[2 * CONV_DIM];
        const float w0 = cw[ch], w1 = cw[CONV_DIM + ch], w2 = cw[2 * CONV_DIM + ch], w3 = cw[3 * CONV_DIM + ch];
        bf16* e0 = PROJ + (size_t)(PT + b * DEC_SEQ) * PLD + ch;
        bf16 xv[DEC_SEQ];
#pragma unroll
        for (int t = 0; t < DEC_SEQ; ++t) xv[t] = e0[(size_t)t * PLD];
#pragma unroll
        for (int t = 0; t < DEC_SEQ; ++t) {
            const float x = bf2f(xv[t]);
            const float y = w0 * h0 + w1 * h1 + w2 * h2 + w3 * x;
            e0[(size_t)t * PLD] = (bf16)(cvtpk(fsilu(y), 0.f) & 0xffffu); h0 = h1; h1 = h2; h2 = x;
        }
        float* so = p.out + O_SCONV + (((size_t)li * DEC_BATCH + b) * 3) * CONV_DIM + ch;
        so[0] = h0; so[CONV_DIM] = h1; so[2 * CONV_DIM] = h2;
    }
}
__device__ __forceinline__ void sample_scan_group(PrmRef p, int li, int sg, int tid, unsigned char* lds, bool wstate = true) {
    bf16* PROJ = (bf16*)(p.ws + WS_PROJ); const float* GB = (const float*)(p.ws + WS_GB);
    float* kq = (float*)lds;
    const int b = sg / A_HEADS, h = sg % A_HEADS, r0 = PT + b * DEC_SEQ, col = tid >> 2, part = tid & 3, lane = tid & 63, wave = tid >> 6;
    float S[32];
    const float* s0 = p.state_delta + (((size_t)li * DEC_BATCH + b) * A_HEADS + h) * A_DK * A_DV;
#pragma unroll
    for (int k = 0; k < 32; ++k) S[k] = s0[(size_t)(part * 32 + k) * A_DV + col];
    for (int t = 0; t < DEC_SEQ; ++t) {
        const size_t rb = (size_t)(r0 + t) * PLD;
        __syncthreads();
        if (wave < 2) {
            const bf16* e = PROJ + rb + (wave == 0 ? A_QK : 0) + h * A_DK + 2 * lane;
            const float a = bf2f(e[0]), bb = bf2f(e[1]);
            const float sc = (1.f / sqrtf(wave_sum(a * a + bb * bb) + RMS_EPS)) * (wave == 0 ? 1.f : 0.08838834764831845f);
            kq[wave * 128 + 2 * lane] = a * sc; kq[wave * 128 + 2 * lane + 1] = bb * sc;
        }
        __syncthreads();
        const float gg = GB[((size_t)(r0 + t) * A_HEADS + h) * 2], beta = GB[((size_t)(r0 + t) * A_HEADS + h) * 2 + 1];
        const float eg = expf(gg); const float v = bf2f(PROJ[rb + 2 * A_QK + h * A_DV + col]);
        const float* kk = kq + part * 32; const float* qq = kq + 128 + part * 32;
        float ks = 0.f;
#pragma unroll
        for (int k = 0; k < 32; ++k) { S[k] *= eg; ks += kk[k] * S[k]; }
        ks += __shfl_xor(ks, 1); ks += __shfl_xor(ks, 2);
        const float vn = (v - ks) * beta; float o = 0.f;
#pragma unroll
        for (int k = 0; k < 32; ++k) { S[k] += kk[k] * vn; o += qq[k] * S[k]; }
        o += __shfl_xor(o, 1); o += __shfl_xor(o, 2);
        if (part == 0) PROJ[rb + 2 * A_QK + h * A_DV + col] = (bf16)f2bf(o);
    }
    float* so = p.out + O_SDELTA + (((size_t)li * DEC_BATCH + b) * A_HEADS + h) * A_DK * A_DV;
    if (wstate) {
#pragma unroll
    for (int k = 0; k < 32; ++k) so[(size_t)(part * 32 + k) * A_DV + col] = S[k];
    }
    __syncthreads();
    const float* nw = p.a_norm_w + (size_t)li * A_DV;
#pragma unroll 1
    for (int i = 0; i < 4; ++i) {
        const int row = r0 + wave * 4 + i;
        bf16* e = PROJ + (size_t)row * PLD + 2 * A_QK + h * A_DV + 2 * lane; const bf16* z = PROJ + (size_t)row * PLD + CONV_DIM + h * A_DV + 2 * lane;
        const float a = bf2f(e[0]), bb = bf2f(e[1]);
        const float r = 1.f / sqrtf(wave_sum(a * a + bb * bb) * (1.f / A_DV) + RMS_EPS);
        e[0] = (bf16)f2bf(a * r * nw[2 * lane] * siluf(bf2f(z[0]))); e[1] = (bf16)f2bf(bb * r * nw[2 * lane + 1] * siluf(bf2f(z[1])));
    }
    __syncthreads();
}
template <int VAR = 0> __device__ __forceinline__ void ph_a_pre(PrmRef p, const Ctx& c, int li, unsigned char* lds) {
    RawTile xr;
    if (c.bid < NPI) { prepass_load_raw(p, c.bid, c.tid, xr); if (c.wave == 1) prepass_gcum(p, c.bid, c.lane, (float*)(lds + PP_GC)); }
    int prev = -1, pb = 0, cur_h = -1;
    for (int item = c.bid; item < NPI; item += c.nblk) {
        const int h = (item / NCPS) % A_HEADS;
        if (h != cur_h) {
            LBAR();
            for (int i = c.tid; i < 3 * 4 * 128; i += NTHR) { const int X = i / 512, j = (i / 128) & 3, ch = i & 127; ((float*)(lds + PP_CW))[i] = p.a_conv_w[((size_t)li * CONV_W + j) * CONV_DIM + X * A_QK + h * A_DK + ch]; }
            LBAR(); cur_h = h;
        }
        delta_prepass_item<VAR>(p, li, item, item + c.nblk < NPI ? item + c.nblk : -1, prev, pb, c.tid, lds, xr); prev = item; pb ^= 1;
    }
    if (prev >= 0) prepass_store_w(p, prev, c.tid, lds);
    LBAR();
    if (VAR == 0) sample_conv(p, c, li);
}
template <int SV = 0> __device__ __forceinline__ void ph_a_scan2(PrmRef p, const Ctx& c, int li, unsigned char* lds, bool wstate = true, bool do_prompt = true, bool do_sample = true) {
    const int v = (c.bid + c.nblk - ((2 * NPG) % c.nblk)) % c.nblk;
    if (do_sample) for (int sg = v; sg < NSG; sg += c.nblk) sample_scan_group(p, li, sg, c.tid, lds, wstate);
    if (SV == 0) {
        const int nfree = c.nblk > 2 * NPG ? c.nblk - 2 * NPG : 0;
        if (nfree == 0) weights_deferred(p, c, li, lds, c.gwave, c.nwaves); else if (v < nfree) weights_deferred(p, c, li, lds, v * (NTHR / 64) + c.wave, nfree * (NTHR / 64));
        LBAR();
    }
    if (do_prompt) for (int it = c.bid; it < 2 * NPG; it += c.nblk) delta_scan_group<SV>(p, li, it, c.tid, lds, wstate);
}

__device__ __forceinline__ void ph_ln(PrmRef p, const Ctx& c, const bf16* OUT, int ldo, const float* g, const float* b, bool last) {
    bf16* XB = (bf16*)(p.ws + WS_XB);
    constexpr int PER = D_MODEL / 64;
    constexpr int RB = 3;
    static_assert(PER % 8 == 0, "ln vector width");
    const int col0 = c.lane * PER;
    f32x4 gv[PER / 4], bv[PER / 4];
#pragma unroll
    for (int j = 0; j < PER / 4; ++j) { gv[j] = *(const f32x4*)(g + col0 + 4 * j); bv[j] = *(const f32x4*)(b + col0 + 4 * j); }
    for (int row0 = c.gwave; row0 < MT; row0 += RB * c.nwaves) {
        u32x4 xa[RB][PER / 8], oa[RB][PER / 8];
#pragma unroll
        for (int r = 0; r < RB; ++r) { const int row = row0 + r * c.nwaves;
            if (row < MT) {
#pragma unroll
                for (int j = 0; j < PER / 8; ++j) { xa[r][j] = *(const u32x4*)(XB + (size_t)row * D_MODEL + col0 + 8 * j); oa[r][j] = *(const u32x4*)(OUT + (size_t)row * ldo + col0 + 8 * j); } } }
#pragma unroll
        for (int r = 0; r < RB; ++r) { const int row = row0 + r * c.nwaves;
            if (row < MT) {
                float v[PER]; float s = 0.f;
#pragma unroll
                for (int j = 0; j < PER / 8; ++j)
#pragma unroll
                    for (int e = 0; e < 4; ++e) { v[8 * j + 2 * e] = DN_ALPHA * bflo(xa[r][j][e]) + bflo(oa[r][j][e]); v[8 * j + 2 * e + 1] = DN_ALPHA * bfhi(xa[r][j][e]) + bfhi(oa[r][j][e]); }
#pragma unroll
                for (int j = 0; j < PER; ++j) s += v[j];
                const float mean = wave_sum(s) * (1.f / D_MODEL); float q = 0.f;
#pragma unroll
                for (int j = 0; j < PER; ++j) { v[j] -= mean; q += v[j] * v[j]; }
                const float rstd = fast_rsq(wave_sum(q) * (1.f / D_MODEL) + LN_EPS);
#pragma unroll
                for (int j = 0; j < PER; ++j) v[j] = v[j] * rstd * gv[j >> 2][j & 3] + bv[j >> 2][j & 3];
#pragma unroll
                for (int j = 0; j < PER / 8; ++j) { u32x4 o;
#pragma unroll
                    for (int e = 0; e < 4; ++e) o[e] = cvtpk(v[8 * j + 2 * e], v[8 * j + 2 * e + 1]);
                    *(u32x4*)(XB + (size_t)row * D_MODEL + col0 + 8 * j) = o; }
                if (last) { float* yo = row < PT ? p.out + O_YP + (size_t)row * D_MODEL + col0 : p.out + O_YS + (size_t)(row - PT) * D_MODEL + col0;
#pragma unroll
                    for (int j = 0; j < PER; j += 4) *(f32x4*)(yo + j) = (f32x4){v[j], v[j + 1], v[j + 2], v[j + 3]}; }
            } }
    }
}
__device__ __forceinline__ float fast_exp2(float x) {
#ifdef EMU
    return exp2f(x);
#else
    return __builtin_amdgcn_exp2f(x);
#endif
}
__device__ __forceinline__ void b_cache_copies(PrmRef p, const Ctx& c) {
    bf16* CK = (bf16*)(p.ws + WS_CK); bf16* CVT = (bf16*)(p.ws + WS_CVT);
    for (int it = c.gtid; it < DEC_BATCH * WINDOW * B_KVW; it += c.nthreads) {
        const int dd = it % B_KVW, w = (it / B_KVW) % WINDOW, b = it / (B_KVW * WINDOW), kvh = dd / B_HD, d = dd % B_HD;
        CK[(((size_t)b * B_KV_HEADS + kvh) * WINDOW + w) * B_HD + d] = (bf16)f2bf(p.cache_k[it]);
        CVT[(((size_t)b * B_KV_HEADS + kvh) * B_HD + d) * WINDOW + w] = (bf16)f2bf(p.cache_v[it]);
    }
}
__device__ __forceinline__ void ph_b_gemm(PrmRef p, const Ctx& c, int lj, unsigned char* lds) {
    const bf16* XB = (const bf16*)(p.ws + WS_XB); bf16* PROJ = (bf16*)(p.ws + WS_PROJ); const bf16* Wt = (const bf16*)(p.ws + WS_WBIN) + (size_t)lj * B_N0 * D_MODEL;
    const int N = lj == 0 ? B_N0 : B_IN;
    pg8::Gemm g{XB, D_MODEL, Wt, PT, N, D_MODEL}; pg8::StaticOrder S; S.init(PT, N, c.nblk, c.bid);
    pg8::EpiBIn E{PROJ, PLD, (const float*)(p.ws + WS_ROPE), (bf16*)(p.ws + WS_VT)};
    __syncthreads();
    pg8::gemm_phase<pg8::EpiBIn, pg8::StaticOrder, true>((LAS unsigned char*)lds, g, S, E, c.tid);
    __syncthreads();
    sgemm_rows<2>(p, XB, D_MODEL, Wt, D_MODEL, PROJ, PLD, PT, ST, N, c, lj == 0 ? (PT / 256) * (B_N0 / 256) : 0, lds, true);
    if (lj == 0) b_cache_copies(p, c);
}
constexpr int AT_KPITCH = 144, AT_VPITCH = 392, AT_K = 0, AT_V = 192 * AT_KPITCH, AT_O = AT_V + 64 * AT_VPITCH + 64  , AT_OPITCH = 144;
static_assert(2 * SC_BUF <= 163840 - 64, "scan LDS");
static_assert(AT_O % 16 == 0 && AT_O + 256 * AT_OPITCH <= 131072, "attention LDS");
struct AttRaw { u32x4 k[3], v[3]; bf16x8 q[4]; };
__device__ __forceinline__ void att_load(PrmRef p, int ck, int kvh, int tid, AttRaw& raw) {
    const unsigned char* PROJ = (const unsigned char*)(p.ws + WS_PROJ); const unsigned char* VT = (const unsigned char*)(p.ws + WS_VT);
    const unsigned char* CK = (const unsigned char*)(p.ws + WS_CK); const unsigned char* CVT = (const unsigned char*)(p.ws + WS_CVT);
    const int lane = tid & 63, wave = tid >> 6, l31 = lane & 31, hi = lane >> 5;
    const bool smp = ck >= NCP; const int r0 = chunk_row0(ck);
    const int nc = smp ? 0 : ck % NCPS, nblk = smp ? 0 : (nc >= 2 ? 3 : nc + 1);
    if (!smp) {
        const int kfirst = r0 - (nblk - 1) * CHUNK;
#pragma unroll
        for (int j = 0; j < 3; ++j) if (j < nblk) { const int idx = tid + NTHR * j, key = idx >> 3, pc = idx & 7, d = (idx >> 3) & 63;
            raw.k[j] = *(const u32x4*)(PROJ + ((size_t)(kfirst + key) * PLD + B_IN + kvh * B_HD) * 2 + pc * 16);
            raw.v[j] = *(const u32x4*)(VT + ((((size_t)(ck - (nblk - 1) + j) * B_KV_HEADS + kvh) * B_HD + d) * 64) * 2 + pc * 16); }
    } else {
        const int b = ck - NCP;
#pragma unroll
        for (int j = 0; j < 3; ++j) { const int idx = tid + NTHR * j;
            if (idx < 160 * 8) { const int key = idx >> 3, pc = idx & 7;
                raw.k[j] = *(const u32x4*)(key < WINDOW ? CK + ((((size_t)b * B_KV_HEADS + kvh) * WINDOW + key) * B_HD) * 2 + pc * 16 : PROJ + ((size_t)(r0 + key - WINDOW) * PLD + B_IN + kvh * B_HD) * 2 + pc * 16); }
            if (idx < 64 * 20) { const int d = idx / 20, pc = idx % 20;
                raw.v[j] = *(const u32x4*)(pc < 16 ? CVT + ((((size_t)b * B_KV_HEADS + kvh) * B_HD + d) * WINDOW) * 2 + pc * 16 : VT + ((((size_t)ck * B_KV_HEADS + kvh) * B_HD + d) * 64) * 2 + (pc - 16) * 16); } }
    }
    const bool active = smp ? wave < 4 : true;
    const int hq = kvh * B_GROUP + (smp ? wave : (wave >> 1)), qrow0 = smp ? 0 : 32 * (wave & 1);
    if (active) {
#pragma unroll
        for (int ks = 0; ks < 4; ++ks) raw.q[ks] = *(const bf16x8*)(PROJ + ((size_t)(r0 + qrow0 + l31) * PLD + hq * B_HD + 16 * ks + 8 * hi) * 2);
    }
}
__device__ __forceinline__ void att_item(PrmRef p, int lj, int ck, int kvh, int nck, int nkvh, int tid, unsigned char* lds, AttRaw& raw) {
#ifndef EMU
    asm volatile("" : "+v"(tid));
#endif
    unsigned char* PROJ = (unsigned char*)(p.ws + WS_PROJ);
    const int lane = tid & 63, wave = READFIRSTLANE(tid >> 6), l31 = lane & 31, hi = lane >> 5;
    const bool smp = ck >= NCP; const int r0 = chunk_row0(ck);
    const int nc = smp ? 0 : ck % NCPS, nblk = smp ? 0 : (nc >= 2 ? 3 : nc + 1);
    const int nkt = smp ? 5 : 2 * nblk;
    if (!smp) {
#pragma unroll
        for (int j = 0; j < 3; ++j) if (j < nblk) { const int idx = tid + NTHR * j, key = idx >> 3, pc = idx & 7, d = (idx >> 3) & 63;
            *(u32x4*)(lds + AT_K + key * AT_KPITCH + pc * 16) = raw.k[j];
            unsigned char* dst = lds + AT_V + d * AT_VPITCH + j * 128 + pc * 16; *(u32x2*)dst = (u32x2){raw.v[j].x, raw.v[j].y}; *(u32x2*)(dst + 8) = (u32x2){raw.v[j].z, raw.v[j].w}; }
    } else {
#pragma unroll
        for (int j = 0; j < 3; ++j) { const int idx = tid + NTHR * j;
            if (idx < 160 * 8) { const int key = idx >> 3, pc = idx & 7; *(u32x4*)(lds + AT_K + key * AT_KPITCH + pc * 16) = raw.k[j]; }
            if (idx < 64 * 20) { const int d = idx / 20, pc = idx % 20; unsigned char* dst = lds + AT_V + d * AT_VPITCH + pc * 16; *(u32x2*)dst = (u32x2){raw.v[j].x, raw.v[j].y}; *(u32x2*)(dst + 8) = (u32x2){raw.v[j].z, raw.v[j].w}; } }
    }
    const bool active = smp ? wave < 4 : true;
    const int hq = kvh * B_GROUP + (smp ? wave : (wave >> 1));
    bf16x8 qf[4];
#pragma unroll
    for (int ks = 0; ks < 4; ++ks) qf[ks] = raw.q[ks];
    LBAR();
    if (nck >= 0) att_load(p, nck, nkvh, tid, raw);
    const int nrows = smp ? 128 : 256;
    u32x4 zr[4];
    if (active) {
        f32x16 sc[6];
#pragma unroll
        for (int kt = 0; kt < 6; ++kt) {
#pragma unroll
            for (int e = 0; e < 16; ++e) sc[kt][e] = 0.f;
            if (kt < nkt) {
#pragma unroll
                for (int ks = 0; ks < 4; ++ks) sc[kt] = MFMA32(*(const bf16x8*)(lds + AT_K + (32 * kt + l31) * AT_KPITCH + 32 * ks + 16 * hi), qf[ks], sc[kt]);
            }
        }
        const float sink = p.b_sinks[lj * B_Q_HEADS + hq];
        float m = sink;
#pragma unroll
        for (int kt = 0; kt < 6; ++kt) if (kt < nkt) {
#pragma unroll
            for (int e = 0; e < 16; ++e) m = fmaxf(m, sc[kt][e]); }
        m = fmaxf(m, __shfl_xor(m, 32));
        float l = 0.f; const float ml2 = m * 1.4426950408889634f;
#pragma unroll
        for (int kt = 0; kt < 6; ++kt) if (kt < nkt) {
#pragma unroll
            for (int e = 0; e < 16; ++e) { const float pe = fast_exp2(sc[kt][e] * 1.4426950408889634f - ml2); sc[kt][e] = pe; l += pe; } }
        l += __shfl_xor(l, 32);
        l += fast_exp2(sink * 1.4426950408889634f - ml2);
        f32x16 o[2];
#pragma unroll
        for (int e = 0; e < 16; ++e) { o[0][e] = 0.f; o[1][e] = 0.f; }
#pragma unroll
        for (int kt = 0; kt < 6; ++kt) if (kt < nkt) {
#pragma unroll
            for (int s = 0; s < 2; ++s) {
                u32x4 pw; pw.x = cvtpk(sc[kt][8 * s], sc[kt][8 * s + 1]); pw.y = cvtpk(sc[kt][8 * s + 2], sc[kt][8 * s + 3]); pw.z = cvtpk(sc[kt][8 * s + 4], sc[kt][8 * s + 5]); pw.w = cvtpk(sc[kt][8 * s + 6], sc[kt][8 * s + 7]);
                const bf16x8 pb = __builtin_bit_cast(bf16x8, pw);
#pragma unroll
                for (int mt = 0; mt < 2; ++mt) {
                    const unsigned char* vp = lds + AT_V + (32 * mt + l31) * AT_VPITCH + (32 * kt + 16 * s + 4 * hi) * 2;
                    const u32x2 a0 = *(const u32x2*)vp, a1 = *(const u32x2*)(vp + 16);
                    u32x4 aw; aw.x = a0.x; aw.y = a0.y; aw.z = a1.x; aw.w = a1.y;
                    o[mt] = MFMA32(__builtin_bit_cast(bf16x8, aw), pb, o[mt]);
                }
            }
        }
        const float il = fast_rcp(l);
        unsigned char* orow = lds + AT_O + (32 * wave + l31) * AT_OPITCH;
#pragma unroll
        for (int mt = 0; mt < 2; ++mt)
#pragma unroll
            for (int cg4 = 0; cg4 < 4; ++cg4) {
                u32x2 w2; w2.x = cvtpk(o[mt][4 * cg4] * il, o[mt][4 * cg4 + 1] * il); w2.y = cvtpk(o[mt][4 * cg4 + 2] * il, o[mt][4 * cg4 + 3] * il);
                *(u32x2*)(orow + (32 * mt + 8 * cg4 + 4 * hi) * 2) = w2;
            }
    }
#pragma unroll
    for (int i = 0; i < 4; ++i) { const int idx = tid + NTHR * i;
        if (idx < nrows * 8) { const int qr = idx >> 3, pc = idx & 7, w = qr >> 5, hq2 = kvh * B_GROUP + (smp ? w : (w >> 1)), row = r0 + (smp ? 0 : 32 * (w & 1)) + (qr & 31);
            zr[i] = *(const u32x4*)(PROJ + ((size_t)row * PLD + B_QW + hq2 * B_HD) * 2 + pc * 16); } }
    LBAR();
#pragma unroll
    for (int i = 0; i < 4; ++i) { const int idx = tid + NTHR * i;
        if (idx < nrows * 8) { const int qr = idx >> 3, pc = idx & 7, w = qr >> 5, hq2 = kvh * B_GROUP + (smp ? w : (w >> 1)), row = r0 + (smp ? 0 : 32 * (w & 1)) + (qr & 31);
            const u32x4 ov = *(const u32x4*)(lds + AT_O + qr * AT_OPITCH + pc * 16); const u32x4 zv = zr[i];
            u32x4 r;
#pragma unroll
            for (int e = 0; e < 4; ++e) r[e] = cvtpk(bflo(ov[e]) * fsilu(bflo(zv[e])), bfhi(ov[e]) * fsilu(bfhi(zv[e])));
            *(u32x4*)(PROJ + ((size_t)row * PLD + hq2 * B_HD) * 2 + pc * 16) = r; } }
    LBAR();
}
__device__ __forceinline__ void ph_b_att2(PrmRef p, const Ctx& c, int lj, bool first, unsigned char* lds) {
    AttRaw raw;
    if (c.bid < NCH * B_KV_HEADS) att_load(p, c.bid / B_KV_HEADS, c.bid % B_KV_HEADS, c.tid, raw);
    for (int it = c.bid; it < NCH * B_KV_HEADS; it += c.nblk) { const int nx = it + c.nblk < NCH * B_KV_HEADS ? it + c.nblk : -1;
        att_item(p, lj, it / B_KV_HEADS, it % B_KV_HEADS, nx < 0 ? -1 : nx / B_KV_HEADS, nx < 0 ? 0 : nx % B_KV_HEADS, c.tid, lds, raw); }
    if (first) {
        const bf16* PROJ = (const bf16*)(p.ws + WS_PROJ);
        for (int it = c.gtid; it < (BATCH + DEC_BATCH) * WINDOW * B_KVW; it += c.nthreads) {
            const int e = it % B_KVW, w = (it / B_KVW) % WINDOW, s = it / (B_KVW * WINDOW);
            if (s < BATCH) { const int row = s * SEQ + SEQ - WINDOW + w; const bf16* kp = PROJ + (size_t)row * PLD + B_IN;
                p.out[O_PK + ((size_t)s * WINDOW + w) * B_KVW + e] = bf2f(kp[e]); p.out[O_PV + ((size_t)s * WINDOW + w) * B_KVW + e] = bf2f(kp[B_KVW + e]); }
            else { const int b = s - BATCH; float kx, vx;
                if (w < WINDOW - DEC_SEQ) { kx = p.cache_k[((size_t)b * WINDOW + w + DEC_SEQ) * B_KVW + e]; vx = p.cache_v[((size_t)b * WINDOW + w + DEC_SEQ) * B_KVW + e]; }
                else { const int row = PT + b * DEC_SEQ + (w - (WINDOW - DEC_SEQ)); const bf16* kp = PROJ + (size_t)row * PLD + B_IN; kx = bf2f(kp[e]); vx = bf2f(kp[B_KVW + e]); }
                p.out[O_SK + ((size_t)b * WINDOW + w) * B_KVW + e] = kx; p.out[O_SV + ((size_t)b * WINDOW + w) * B_KVW + e] = vx; }
        }
    }
}

#ifndef EMU
#define XB_TMO      128
#define XB_XCNT(j)  (256  + 64 * (j))
#define XB_XSUB(j)  (1280 + 64 * (j))
#define XB_XGEN(j)  (2304 + 64 * (j))
#define XB_TOP      3328
#define XB_TOPGEN   3392
#define XCD_BAR_WORDS 3456
#define XB_SPIN_CAP (1u << 20)
__device__ __forceinline__ unsigned xb_ld(unsigned* p)              { return __hip_atomic_load(p, __ATOMIC_RELAXED, __HIP_MEMORY_SCOPE_AGENT); }
__device__ __forceinline__ unsigned xb_add(unsigned* p, unsigned v) { return __hip_atomic_fetch_add(p, v, __ATOMIC_RELAXED, __HIP_MEMORY_SCOPE_AGENT); }
__device__ __forceinline__ unsigned xb_xcc_id() { return (unsigned)__builtin_amdgcn_s_getreg((3 << 11) | 20) & 0xFu; }
#define XB_SPIN(cond, bar) do { unsigned _sp = 0; while (cond) { __builtin_amdgcn_s_sleep(1); \
    if ((++_sp & 255u) == 0u) { if (xb_ld(&(bar)[XB_TMO])) break; if (_sp > XB_SPIN_CAP) { atomicAdd(&(bar)[XB_TMO], 1u); break; } } } } while (0)
__device__ __forceinline__ void xcd_barrier_complete(unsigned* bar, unsigned x, unsigned& nloc, unsigned& nx) {
    const unsigned G = gridDim.x * gridDim.y * gridDim.z;
    unsigned sum, cnt, mine, sp = 0u;
    for (;;) {
        sum = 0u; cnt = 0u; mine = 0u;
#pragma unroll
        for (unsigned j = 0; j < 16; ++j) { const unsigned c = xb_ld(&bar[XB_XCNT(j)]); sum += c; cnt += (c > 0u) ? 1u : 0u; mine = (j == x) ? c : mine; }
        if (sum == G) break;
        __builtin_amdgcn_s_sleep(1);
        if ((++sp & 255u) == 0u) { if (xb_ld(&bar[XB_TMO])) break; if (sp > XB_SPIN_CAP) { atomicAdd(&bar[XB_TMO], 1u); break; } }
    }
    nloc = mine > 0u ? mine : 1u; nx = cnt > 0u ? cnt : 1u;
}
__device__ __forceinline__ void xcd_barrier(unsigned* bar, volatile LAS unsigned* st, const int tid) {
    asm volatile("s_waitcnt vmcnt(0)" ::: "memory");
    __syncthreads();
    if (tid == 0) {
        __builtin_amdgcn_s_waitcnt(0);
        const unsigned x = xb_xcc_id();
        unsigned nloc = st[0], nx = st[1];
        if (nloc == 0u) { xcd_barrier_complete(bar, x, nloc, nx); st[0] = nloc; st[1] = nx; }
        const unsigned old = xb_add(&bar[XB_XSUB(x)], 1u);
        const unsigned gen = old / nloc;
        if (old + 1u == (gen + 1u) * nloc) {
            __builtin_amdgcn_fence(__ATOMIC_RELEASE, "agent");
            asm volatile("s_waitcnt vmcnt(0)" ::: "memory");
            const unsigned og = xb_add(&bar[XB_TOP], 1u);
            const unsigned tg = og / nx;
            if (og + 1u == (tg + 1u) * nx) xb_add(&bar[XB_TOPGEN], 1u);
            else XB_SPIN(xb_ld(&bar[XB_TOPGEN]) == tg, bar);
            __builtin_amdgcn_fence(__ATOMIC_ACQUIRE, "agent");
            xb_add(&bar[XB_XGEN(x)], 1u);
            asm volatile("s_waitcnt vmcnt(0)" ::: "memory");
        } else {
            XB_SPIN(xb_ld(&bar[XB_XGEN(x)]) == gen, bar);
            __builtin_amdgcn_fence(__ATOMIC_ACQUIRE, "agent");
            asm volatile("s_waitcnt vmcnt(0)" ::: "memory");
        }
    }
    __syncthreads();
}
#endif
constexpr int PH_A0 = 1, PH_APER = 6, PH_B0 = PH_A0 + N_A * PH_APER, PH_BPER = 4, N_PHASES = PH_B0 + N_B * PH_BPER;
constexpr int LDS_BAR_OFF = 163840 - 64;
constexpr int LDS_BYTES = 163840;
#ifdef EMU
#define DECL_LDS(name) unsigned char* name = emu::blk()->lds
#else
#define DECL_LDS(name) extern __shared__ __attribute__((aligned(16))) unsigned char name[]
#endif

#ifdef EMU
#define PH_PROLOGUE() PrmRef p = p_; int tid_ = threadIdx.x, bid_ = blockIdx.x;
#define GRID_SYNC()
#else
#define PH_PROLOGUE() const __attribute__((address_space(4))) Prm* pp = (const __attribute__((address_space(4))) Prm*)__builtin_amdgcn_kernarg_segment_ptr(); \
    int tid_ = wave_s_ * 64 + (int)__builtin_amdgcn_mbcnt_hi(~0u, __builtin_amdgcn_mbcnt_lo(~0u, 0u)), bid_ = blockIdx.x; asm volatile("" : "+s"(pp), "+v"(tid_), "+s"(bid_)); PrmRef p = *pp;
#define GRID_SYNC() xcd_barrier((unsigned*)(p.ws + WS_CTL), (volatile LAS unsigned*)(lds + LDS_BAR_OFF), c.tid)
#endif
#define PHASE(k, ...) if (ph_lo <= (k) && (k) < ph_hi) { PH_PROLOGUE() \
        Ctx c; c.tid = tid_; c.lane = c.tid & 63; c.wave = c.tid >> 6; c.bid = bid_; c.nblk = gridDim.x; \
        c.gtid = c.bid * NTHR + c.tid; c.nthreads = c.nblk * NTHR; c.gwave = c.bid * (NTHR / 64) + c.wave; c.nwaves = c.nblk * (NTHR / 64); \
        bf16* PROJ = (bf16*)(p.ws + WS_PROJ); const bf16* XB = (const bf16*)(p.ws + WS_XB); (void)PROJ; (void)XB; \
        __VA_ARGS__; \
        if ((k) + 1 < ph_hi) { GRID_SYNC(); } }
#define A_LAYER(li) \
    PHASE(PH_A0 + (li) * PH_APER + 0, ph_a_gemm(p, c, li, lds)) \
    PHASE(PH_A0 + (li) * PH_APER + 1, ph_a_pre(p, c, li, lds)) \
    PHASE(PH_A0 + (li) * PH_APER + 2, ph_a_scan2(p, c, li, lds)) \
    PHASE(PH_A0 + (li) * PH_APER + 3, ph_a_norm(p, c, li, lds)) \
    PHASE(PH_A0 + (li) * PH_APER + 4, gemm_mfma(PROJ + 2 * A_QK, PLD, (const bf16*)(p.ws + WS_WAOUT) + (size_t)(li) * D_MODEL * A_VW, PROJ, PLD, PT, D_MODEL, A_VW, c, lds)) \
    PHASE(PH_A0 + (li) * PH_APER + 5, ph_ln(p, c, PROJ, PLD, p.a_ln_g + (size_t)(li) * D_MODEL, p.a_ln_b + (size_t)(li) * D_MODEL, false))
#define B_LAYER(lj) \
    PHASE(PH_B0 + (lj) * PH_BPER + 0, ph_b_gemm(p, c, lj, lds)) \
    PHASE(PH_B0 + (lj) * PH_BPER + 1, ph_b_att2(p, c, lj, (lj) == 0, lds)) \
    PHASE(PH_B0 + (lj) * PH_BPER + 2, gemm_mfma(PROJ, PLD, (const bf16*)(p.ws + WS_WBOUT) + (size_t)(lj) * D_MODEL * B_QW, PROJ + B_QW, PLD, PT, D_MODEL, B_QW, c, lds); \
        sgemm_rows(p, PROJ, PLD, (const bf16*)(p.ws + WS_WBOUT) + (size_t)(lj) * D_MODEL * B_QW, B_QW, PROJ + B_QW, PLD, PT, ST, D_MODEL, c, 0, lds)) \
    PHASE(PH_B0 + (lj) * PH_BPER + 3, ph_ln(p, c, PROJ + B_QW, PLD, p.b_ln_g + (size_t)(lj) * D_MODEL, p.b_ln_b + (size_t)(lj) * D_MODEL, (lj) == N_B - 1))

__global__ void __launch_bounds__(NTHR, 2) fwd_kernel(Prm p_, int ph_lo, int ph_hi) {
    DECL_LDS(lds);
#ifndef EMU
    const int wave_s_ = __builtin_amdgcn_readfirstlane((int)threadIdx.x >> 6);
    {
        if (threadIdx.x < 2) ((volatile LAS unsigned*)(lds + LDS_BAR_OFF))[threadIdx.x] = 0u;
        if (threadIdx.x == 0) (void)xb_add((unsigned*)(p_.ws + WS_CTL) + XB_XCNT(xb_xcc_id()), 1u);
        __syncthreads();
    }
#endif
    PHASE(0, ph_init(p, c); ph_weights(p, c, lds))
    A_LAYER(0)
    A_LAYER(1)
    B_LAYER(0)
    B_LAYER(1)
#ifdef PROBE_TAIL
    PROBE_TAIL
#endif
}

extern "C" void kernel_launch(void* const* d_in, const int* in_sizes, int n_in, void* d_out, int out_size, void* d_ws, size_t ws_size, hipStream_t stream) {
    if (n_in != 20 || (size_t)out_size != O_END || ws_size < WS_NEED) { fprintf(stderr, "kernel_launch: unexpected sizes n_in=%d out=%d ws=%zu (need %zu, out %zu)\n", n_in, out_size, ws_size, (size_t)WS_END, (size_t)O_END); return; }
    Prm p{};
    const float** pp = (const float**)&p;
    for (int i = 0; i < 20; ++i) pp[i] = (const float*)d_in[i];
    p.out = (float*)d_out; p.ws = (unsigned char*)d_ws;
#ifdef EMU
    const int grid = 8;
    const int stop = getenv("EMU_STOP") ? atoi(getenv("EMU_STOP")) : N_PHASES;
    for (int ph = 0; ph < N_PHASES && ph < stop; ++ph) { emu::launch([=]() { fwd_kernel(p, ph, ph + 1); }, dim3(grid), dim3(NTHR), LDS_BYTES); fprintf(stderr, "phase %d done\n", ph); }
#else
    static int grid = 0;
    if (grid == 0) {
        int dev = 0, cus = 0, per_cu = 0;
        (void)hipGetDevice(&dev); (void)hipDeviceGetAttribute(&cus, hipDeviceAttributeMultiprocessorCount, dev);
        (void)hipFuncSetAttribute((const void*)fwd_kernel, hipFuncAttributeMaxDynamicSharedMemorySize, LDS_BYTES);
        (void)hipOccupancyMaxActiveBlocksPerMultiprocessor(&per_cu, (const void*)fwd_kernel, NTHR, LDS_BYTES);
        if (per_cu < 1) { fprintf(stderr, "kernel_launch: occupancy query says %d blocks per CU\n", per_cu); per_cu = 1; }
        grid = cus;
    }
    (void)hipMemsetAsync((char*)d_ws + WS_CTL, 0, 65536, stream);
#ifdef PROBE_TAIL
    int lo = 0, hi = N_PHASES + PROBE_NTAIL;
#else
    int lo = 0, hi = N_PHASES;
#endif
    void* args[] = {(void*)&p, (void*)&lo, (void*)&hi};
    hipError_t e = hipLaunchCooperativeKernel((const void*)fwd_kernel, dim3(grid), dim3(NTHR), args, LDS_BYTES, stream);
    if (e != hipSuccess) fprintf(stderr, "cooperative launch failed: %s (grid %d)\n", hipGetErrorString(e), grid);
#endif
}
```

```cpp
#ifdef EMU
#include "hip_emu.h"
#else
#include <hip/hip_runtime.h>
#include <hip/hip_cooperative_groups.h>
namespace cg = cooperative_groups;
#endif
#include <cstdint>
#include <cstddef>
#include <cstdio>

typedef short bf16x8 __attribute__((ext_vector_type(8)));
typedef float f32x4 __attribute__((ext_vector_type(4)));
typedef float f32x16 __attribute__((ext_vector_type(16)));
typedef unsigned u32x4 __attribute__((ext_vector_type(4)));
typedef unsigned u32x2 __attribute__((ext_vector_type(2)));
#ifdef EMU
#define LAS
#define WAVE_SYNC() emu::wave_sync()
#define GLDS16(gp, lp) memcpy((unsigned char*)(lp) + emu::lane_id() * 16, (const void*)(gp), 16)
typedef const unsigned char* BufRes;
#define MAKE_RES(p) ((const unsigned char*)(p))
#define BLDS16(res, voff, soff, lp) memcpy((unsigned char*)(lp) + emu::lane_id() * 16, (res) + (voff) + (soff), 16)
#define MFMA16(a, b, c) emu_mfma_16x16x32_bf16(a, b, c)
#define MFMA32(a, b, c) emu_mfma_32x32x16_bf16(a, b, c)
#define MFMAF(a, b, c) emu_mfma_16x16x4_f32(a, b, c)
#define SETPRIO(n)
#define SCHED_BARRIER()
#define S_BARRIER() emu::block_sync()
#define WAIT_VM(n)
#define WAIT_LGKM(n)
#define READFIRSTLANE(x) (x)
#define BCAST_LANE(v, n) __shfl(v, n)
#define LBAR() emu::block_sync()
#else
#define LAS __attribute__((address_space(3)))
#define WAVE_SYNC() asm volatile("s_waitcnt lgkmcnt(0)" ::: "memory")
#define GLDS16(gp, lp) __builtin_amdgcn_global_load_lds((const unsigned*)(gp), (LAS unsigned*)(lp), 16, 0, 0)
typedef __amdgpu_buffer_rsrc_t BufRes;
#define MAKE_RES(p) __builtin_amdgcn_make_buffer_rsrc((void*)(p), 0, 0x7fffffff, 0x00020000)
#define BLDS16(res, voff, soff, lp) __builtin_amdgcn_raw_ptr_buffer_load_lds(res, (LAS unsigned*)(lp), 16, (int)(voff), (int)(soff), 0, 0)
#define MFMA16(a, b, c) __builtin_amdgcn_mfma_f32_16x16x32_bf16(a, b, c, 0, 0, 0)
#define MFMA32(a, b, c) __builtin_amdgcn_mfma_f32_32x32x16_bf16(a, b, c, 0, 0, 0)
#define MFMAF(a, b, c) __builtin_amdgcn_mfma_f32_16x16x4f32(a, b, c, 0, 0, 0)
#define SETPRIO(n) __builtin_amdgcn_s_setprio(n)
#define SCHED_BARRIER() __builtin_amdgcn_sched_barrier(0)
#define S_BARRIER() __builtin_amdgcn_s_barrier()
#define WAIT_VM(n) asm volatile("s_waitcnt vmcnt(" #n ")" ::: "memory")
#define WAIT_LGKM(n) asm volatile("s_waitcnt lgkmcnt(" #n ")" ::: "memory")
#define READFIRSTLANE(x) __builtin_amdgcn_readfirstlane(x)
#define BCAST_LANE(v, n) __builtin_bit_cast(float, __builtin_amdgcn_readlane(__builtin_bit_cast(int, v), n))
#define LBAR() do { asm volatile("s_waitcnt lgkmcnt(0)" ::: "memory"); __builtin_amdgcn_s_barrier(); asm volatile("" ::: "memory"); } while (0)
#endif

#ifdef CFG_SMALL
constexpr int D_MODEL = 512, BATCH = 2, SEQ = 256, DEC_BATCH = 8, DEC_SEQ = 32, A_HEADS = 4, B_Q_HEADS = 8, B_KV_HEADS = 2;
#else
constexpr int D_MODEL = 1024, BATCH = 8, SEQ = 2048, DEC_BATCH = 16, DEC_SEQ = 32, A_HEADS = 8, B_Q_HEADS = 16, B_KV_HEADS = 4;
#endif
constexpr int PAST_LEN = 4096, CHUNK = 64, N_A = 2, N_B = 2, DEPTH = 4;
constexpr int A_DK = 128, A_DV = 128, A_QK = A_HEADS * A_DK, A_VW = A_HEADS * A_DV, CONV_W = 4, CONV_DIM = 2 * A_QK + A_VW;
constexpr int A_IN = CONV_DIM + A_VW + 2 * A_HEADS, A_MAIN = CONV_DIM + A_VW;
constexpr int B_GROUP = B_Q_HEADS / B_KV_HEADS, B_HD = 64, B_QW = B_Q_HEADS * B_HD, B_KVW = B_KV_HEADS * B_HD, B_IN = 2 * B_QW;
constexpr int WINDOW = 128, ROPE_DIMS = 16, ROPE_HALF = 8;
constexpr float LN_EPS = 1e-5f, RMS_EPS = 1e-6f;
constexpr float DN_ALPHA = 1.681792830507429f;
constexpr int PT = BATCH * SEQ, ST = DEC_BATCH * DEC_SEQ, MT = PT + ST, NSEQ = BATCH + DEC_BATCH;
constexpr int NCPS = SEQ / CHUNK, NCP = BATCH * NCPS, NCH = NCP + DEC_BATCH;
constexpr int PLD = A_MAIN > B_IN + 2 * B_KVW ? A_MAIN : B_IN + 2 * B_KVW;
static_assert(B_GROUP == 4, "attention wave map");
static_assert(PT % 256 == 0 && ST % 64 == 0 && D_MODEL % 256 == 0 && A_VW % 256 == 0 && B_QW % 256 == 0 && A_MAIN % 256 == 0 && D_MODEL % 256 == 0 && B_IN % 256 == 0 && (2 * B_KVW) % 256 == 0 && D_MODEL % 128 == 0 && D_MODEL >= 256, "gemm tiles");
static_assert(DEC_SEQ == 32 && WINDOW == 128 && CHUNK == 64, "fixed");

constexpr size_t O_YP = 0, O_YS = O_YP + (size_t)PT * D_MODEL, O_PDELTA = O_YS + (size_t)ST * D_MODEL;
constexpr size_t O_PCONV = O_PDELTA + (size_t)N_A * BATCH * A_HEADS * A_DK * A_DV, O_PK = O_PCONV + (size_t)N_A * BATCH * 3 * CONV_DIM;
constexpr size_t O_PV = O_PK + (size_t)BATCH * WINDOW * B_KVW, O_SDELTA = O_PV + (size_t)BATCH * WINDOW * B_KVW;
constexpr size_t O_SCONV = O_SDELTA + (size_t)N_A * DEC_BATCH * A_HEADS * A_DK * A_DV, O_SK = O_SCONV + (size_t)N_A * DEC_BATCH * 3 * CONV_DIM;
constexpr size_t O_SV = O_SK + (size_t)DEC_BATCH * WINDOW * B_KVW, O_END = O_SV + (size_t)DEC_BATCH * WINDOW * B_KVW;

constexpr size_t al256(size_t x) { return (x + 255) & ~(size_t)255; }
constexpr size_t WS_CTL = 0, WS_ROPE = 1u << 20;
constexpr size_t WS_GB = al256(WS_ROPE + (size_t)(SEQ + DEC_SEQ) * ROPE_HALF * 2 * 4);
constexpr size_t WS_HALO = al256(WS_GB + (size_t)MT * A_HEADS * 2 * 4);
constexpr size_t WS_XB = al256(WS_HALO + (size_t)NCH * 3 * CONV_DIM * 2);
constexpr size_t WS_PROJ = al256(WS_XB + (size_t)MT * D_MODEL * 2);
constexpr size_t WS_WAIN = al256(WS_PROJ + (size_t)MT * PLD * 2);
constexpr int A_NG = A_MAIN + 256;
constexpr size_t WS_WAOUT = al256(WS_WAIN + (size_t)N_A * A_NG * D_MODEL * 2);
constexpr int B_N0 = B_IN + 2 * B_KVW;
constexpr size_t WS_WBIN = al256(WS_WAOUT + (size_t)N_A * D_MODEL * A_VW * 2);
constexpr size_t WS_WBOUT = al256(WS_WBIN + (size_t)(B_N0 + B_IN) * D_MODEL * 2);
constexpr size_t WS_WB = al256(WS_WBOUT + (size_t)N_B * D_MODEL * B_QW * 2);
constexpr size_t WS_IA = al256(WS_WB + (size_t)PT * A_QK * 2);
constexpr size_t WS_GL = al256(WS_IA + (size_t)BATCH * A_HEADS * (SEQ / CHUNK) * 64 * 64 * 2);
constexpr size_t WS_END = al256(WS_GL + (size_t)BATCH * A_HEADS * (SEQ / CHUNK) * 4);
static_assert(WS_END <= ((size_t)256 << 20), "workspace");
constexpr size_t WS_VT = WS_WB, WS_CK = al256(WS_VT + (size_t)NCH * B_KV_HEADS * 64 * 64 * 2), WS_CVT = al256(WS_CK + (size_t)DEC_BATCH * B_KV_HEADS * 128 * 64 * 2);
constexpr size_t WS_BEND = al256(WS_CVT + (size_t)DEC_BATCH * B_KV_HEADS * 128 * 64 * 2), WS_NEED = WS_BEND > WS_END ? WS_BEND : WS_END;
static_assert(WS_NEED <= ((size_t)256 << 20), "workspace (B-layer buffers overlay the A-layer WB | IA | GL region)");

static_assert(N_B == 2, "weight map");

typedef unsigned short bf16;
constexpr int NTHR = 512;

struct Prm {
    const float *x_prompt, *x_sample, *state_delta, *state_conv, *cache_k, *cache_v, *a_w_in, *a_conv_w, *a_log, *a_dt_bias, *a_norm_w, *a_w_out, *a_ln_g, *a_ln_b,
        *b_w_kv, *b_w_in, *b_sinks, *b_w_out, *b_ln_g, *b_ln_b;
    float* out; unsigned char* ws;
};

__device__ __forceinline__ unsigned f2bf(float f) { unsigned u = __builtin_bit_cast(unsigned, f); return (u + 0x7fffu + ((u >> 16) & 1u)) >> 16; }
__device__ __forceinline__ float bf2f(bf16 h) { return __builtin_bit_cast(float, (unsigned)h << 16); }
__device__ __forceinline__ float siluf(float x) { return x / (1.f + expf(-x)); }
__device__ __forceinline__ float sigmoidf_(float x) { return 1.f / (1.f + expf(-x)); }
__device__ __forceinline__ float softplusf_(float x) { return x > 20.f ? x : log1pf(expf(x)); }
__device__ __forceinline__ float wave_sum(float v) {
#pragma unroll
    for (int o = 1; o < 64; o <<= 1) v += __shfl_xor(v, o);
    return v;
}

#ifdef EMU
__device__ __forceinline__ float fast_rcp(float x) { return 1.f / x; }
__device__ __forceinline__ float fast_rsq(float x) { return 1.f / sqrtf(x); }
__device__ __forceinline__ float fast_ex2(float x) { return exp2f(x); }
__device__ __forceinline__ unsigned cvtpk(float lo, float hi) { return f2bf(lo) | (f2bf(hi) << 16); }
__device__ __forceinline__ float dpp_xor1(float v) { return __shfl(v, emu::lane_id() ^ 1); }
__device__ __forceinline__ float dpp_xor2(float v) { return __shfl(v, emu::lane_id() ^ 2); }
__device__ __forceinline__ float dpp_hmirror(float v) { const int l = emu::lane_id(); return __shfl(v, (l & ~7) | (7 - (l & 7))); }
__device__ __forceinline__ float dpp_mirror(float v) { const int l = emu::lane_id(); return __shfl(v, (l & ~15) | (15 - (l & 15))); }
#else
__device__ __forceinline__ float fast_rcp(float x) { return __builtin_amdgcn_rcpf(x); }
__device__ __forceinline__ float fast_rsq(float x) { return __builtin_amdgcn_rsqf(x); }
__device__ __forceinline__ float fast_ex2(float x) { return __builtin_amdgcn_exp2f(x); }
__device__ __forceinline__ unsigned cvtpk(float lo, float hi) { typedef float f2_t __attribute__((ext_vector_type(2))); typedef __bf16 b2_t __attribute__((ext_vector_type(2)));
    f2_t v = {lo, hi}; b2_t b = __builtin_convertvector(v, b2_t); return __builtin_bit_cast(unsigned, b); }
template <int CTRL> __device__ __forceinline__ float dpp_mov(float v) { return __builtin_bit_cast(float, __builtin_amdgcn_update_dpp(0, __builtin_bit_cast(int, v), CTRL, 0xf, 0xf, true)); }
__device__ __forceinline__ float dpp_xor1(float v) { return dpp_mov<0xB1>(v); }
__device__ __forceinline__ float dpp_xor2(float v) { return dpp_mov<0x4E>(v); }
__device__ __forceinline__ float dpp_hmirror(float v) { return dpp_mov<0x141>(v); }
__device__ __forceinline__ float dpp_mirror(float v) { return dpp_mov<0x140>(v); }
#endif
__device__ __forceinline__ float sum8(float v) { v += dpp_xor1(v); v += dpp_xor2(v); v += dpp_hmirror(v); return v; }
__device__ __forceinline__ float sum16(float v) { v = sum8(v); v += dpp_mirror(v); return v; }
__device__ __forceinline__ float fsilu(float x) { return x * fast_rcp(1.f + fast_ex2(-1.4426950408889634f * x)); }
__device__ __forceinline__ float fexp(float x) { return fast_ex2(1.4426950408889634f * x); }
__device__ __forceinline__ float bflo(unsigned u) { return __builtin_bit_cast(float, u << 16); }
__device__ __forceinline__ float bfhi(unsigned u) { return __builtin_bit_cast(float, u & 0xffff0000u); }
__device__ __forceinline__ int seq_row0(int s) { return s < BATCH ? s * SEQ : PT + (s - BATCH) * DEC_SEQ; }
__device__ __forceinline__ int seq_len(int s) { return s < BATCH ? SEQ : DEC_SEQ; }
__device__ __forceinline__ int chunk_row0(int c) { return c < NCP ? c * CHUNK : PT + (c - NCP) * DEC_SEQ; }
__device__ __forceinline__ int chunk_len(int c) { return c < NCP ? CHUNK : DEC_SEQ; }
__device__ __forceinline__ int row_posidx(int row) { return row < PT ? (row % SEQ) : SEQ + ((row - PT) % DEC_SEQ); }

#ifdef EMU
typedef const Prm& PrmRef;
#else
typedef const __attribute__((address_space(4))) Prm& PrmRef;
#endif
struct Ctx { int tid, lane, wave, gtid, gwave, nthreads, nwaves, bid, nblk; };

namespace pg8 {
constexpr int BM = 256, BK = 64, HALF = 128, HTB = HALF * BK * 2  , STAGE_BYTES = 8 * HTB, NXCD = 8, WGM = 8;
__host__ __device__ __forceinline__ int lds_byte(int r, int c) { const int st = (r >> 4) * 2 + (c >> 5), rr = r & 15, cc = c & 31, ob = rr * 64 + cc * 2; return st * 1024 + (ob ^ (((ob >> 9) & 1) << 5)); }
__host__ __device__ __forceinline__ void stage_rc(int b, int& R, int& C) { const int st = b / 1024, sb = b % 1024, swz = sb ^ (((sb >> 9) & 1) << 5); R = (st >> 1) * 16 + swz / 64; C = (st & 1) * 32 + (swz % 64) / 2; }
__host__ __device__ __forceinline__ int perm32(int rho) { const int n = rho >> 4, i = rho & 15; return 8 * (i >> 2) + 4 * n + (i & 3); }
struct Unit { int pm, pn; };
struct Gemm { const bf16* A; int lda; const bf16* Bt; int M, N, K; };
struct StaticOrder {
    int nM, nN, nwg, G, c;
    __host__ __device__ void init(int M, int N, int G_, int c_) { nM = M / BM; nN = N / BM; nwg = nM * nN; G = G_; c = c_; }
    __host__ __device__ bool next(int i, Unit& u) const {
        const long L = (long)i * G + c; if (L >= nwg) return false;
        int wgid = (int)L; { const int q = nwg / NXCD, r = nwg % NXCD, xcd = wgid % NXCD, off = wgid / NXCD; wgid = (xcd < r ? xcd * (q + 1) : r * (q + 1) + (xcd - r) * q) + off; }
        const int nig = WGM * nN, gid = wgid / nig, fm = gid * WGM, gsz = (nM - fm) < WGM ? (nM - fm) : WGM;
        u.pm = fm + ((wgid % nig) % gsz); u.pn = (wgid % nig) / gsz; return true;
    }
};
__device__ __forceinline__ unsigned cvt_pk_bf16(float lo, float hi) {
#ifdef EMU
    return f2bf(lo) | (f2bf(hi) << 16);
#else
    unsigned r; asm volatile("v_cvt_pk_bf16_f32 %0, %1, %2" : "=v"(r) : "v"(lo), "v"(hi)); return r;
#endif
}
struct EpiBf16 {
    static constexpr bool PERM = true;
    bf16* O; int ldc;
    __device__ __forceinline__ void operator()(const f32x4 (&acc)[2][2][4][2], const Unit& u, int wr, int wc, int fr, int fq) const {
        int fr_ = fr, fq_ = fq;
#ifndef EMU
        asm volatile("" : "+v"(fr_), "+v"(fq_));
#endif
        const int row0 = u.pm * BM + wr * 64 + fr_, col0 = u.pn * BM + wc * 32 + 8 * fq_;
#pragma unroll
        for (int ai = 0; ai < 2; ++ai)
#pragma unroll
            for (int m = 0; m < 4; ++m) { bf16* rowp = O + (size_t)(row0 + ai * HALF + m * 16) * ldc + col0;
#pragma unroll
                for (int bj = 0; bj < 2; ++bj) { const f32x4 v0 = acc[ai][bj][m][0], v1 = acc[ai][bj][m][1];
                    u32x4 w; w.x = cvt_pk_bf16(v0[0], v0[1]); w.y = cvt_pk_bf16(v0[2], v0[3]); w.z = cvt_pk_bf16(v1[0], v1[1]); w.w = cvt_pk_bf16(v1[2], v1[3]);
                    *(u32x4*)(rowp + bj * HALF) = w; } }
    }
};
struct EpiAIn {
    static constexpr bool PERM = true;
    bf16* O; int ldc; bf16* HALO; float* pconv;
    __device__ __forceinline__ void operator()(const f32x4 (&acc)[2][2][4][2], const Unit& u, int wr, int wc, int fr, int fq) const {
        int fr_ = fr, fq_ = fq;
#ifndef EMU
        asm volatile("" : "+v"(fr_), "+v"(fq_));
#endif
        const int row0 = u.pm * BM + wr * 64 + fr_, col0 = u.pn * BM + wc * 32 + 8 * fq_;
#pragma unroll
        for (int ai = 0; ai < 2; ++ai)
#pragma unroll
            for (int m = 0; m < 4; ++m) { const int row = row0 + ai * HALF + m * 16; bf16* rowp = O + (size_t)row * ldc + col0;
#pragma unroll
                for (int bj = 0; bj < 2; ++bj) { const f32x4 v0 = acc[ai][bj][m][0], v1 = acc[ai][bj][m][1];
                    u32x4 w; w.x = cvt_pk_bf16(v0[0], v0[1]); w.y = cvt_pk_bf16(v0[2], v0[3]); w.z = cvt_pk_bf16(v1[0], v1[1]); w.w = cvt_pk_bf16(v1[2], v1[3]);
                    *(u32x4*)(rowp + bj * HALF) = w;
                    if (m == 3 && fr_ >= 13 && col0 + bj * HALF < CONV_DIM) {
                        const int ck = row >> 6, hr = fr_ - 13, col = col0 + bj * HALF;
                        *(u32x4*)(HALO + ((size_t)ck * 3 + hr) * CONV_DIM + col) = w;
                        if (ck % NCPS == NCPS - 1) { float* dst = pconv + ((size_t)(ck / NCPS) * 3 + hr) * CONV_DIM + col; *(f32x4*)dst = v0; *(f32x4*)(dst + 4) = v1; }
                    } } }
    }
};
struct EpiBIn {
    static constexpr bool PERM = true;
    bf16* O; int ldc; const float* rope; bf16* VT;
    __device__ __forceinline__ void operator()(const f32x4 (&acc)[2][2][4][2], const Unit& u, int wr, int wc, int fr, int fq) const {
        int fr_ = fr, fq_ = fq;
#ifndef EMU
        asm volatile("" : "+v"(fr_), "+v"(fq_));
#endif
        static_assert(B_QW % 128 == 0 && B_KVW % 128 == 0, "a 128-column half tile has one kind");
        const int ct = u.pn * BM;
        int kinds[2]; bool ropes[2];
#pragma unroll
        for (int bj = 0; bj < 2; ++bj) { const int cc = ct + bj * HALF; kinds[bj] = cc < B_QW ? 0 : cc < B_IN ? 1 : cc < B_IN + B_KVW ? 2 : 3;
            ropes[bj] = (kinds[bj] == 0 || kinds[bj] == 2) && (wc & 1) == 0; }
        const int row0 = u.pm * BM + wr * 64 + fr_, col0 = ct + wc * 32 + 8 * fq_;
#pragma unroll
        for (int ai = 0; ai < 2; ++ai)
#pragma unroll
            for (int m = 0; m < 4; ++m) { const int row = row0 + ai * HALF + m * 16; bf16* rowp = O + (size_t)row * ldc + col0;
                f32x4 cs[4];
                if (ropes[0] || ropes[1]) { const f32x4* rp = (const f32x4*)(rope + (size_t)(row % SEQ) * ROPE_HALF * 2);
#pragma unroll
                    for (int q4 = 0; q4 < 4; ++q4) cs[q4] = rp[q4]; }
#pragma unroll
                for (int bj = 0; bj < 2; ++bj) { f32x4 v0 = acc[ai][bj][m][0], v1 = acc[ai][bj][m][1]; const int kind = kinds[bj]; const float sc = kind == 0 ? 0.125f : 1.f;
                    if (ropes[bj]) {
                        float x[8] = {v0[0], v0[1], v0[2], v0[3], v1[0], v1[1], v1[2], v1[3]}, o[8];
#pragma unroll
                        for (int j = 0; j < 8; ++j) o[j] = __shfl_xor(x[j], 16);
                        if (fq_ < 2) {
#pragma unroll
                            for (int j = 0; j < 8; ++j) { const float c_ = cs[j >> 1][2 * (j & 1)], s_ = cs[j >> 1][2 * (j & 1) + 1]; x[j] = fq_ == 0 ? x[j] * c_ - o[j] * s_ : x[j] * c_ + o[j] * s_; }
                        }
                        v0 = (f32x4){x[0], x[1], x[2], x[3]}; v1 = (f32x4){x[4], x[5], x[6], x[7]};
                    }
                    v0 = v0 * sc; v1 = v1 * sc;
                    u32x4 w; w.x = cvt_pk_bf16(v0[0], v0[1]); w.y = cvt_pk_bf16(v0[2], v0[3]); w.z = cvt_pk_bf16(v1[0], v1[1]); w.w = cvt_pk_bf16(v1[2], v1[3]);
                    *(u32x4*)(rowp + bj * HALF) = w;
                    if (kind == 3) { const int dd = col0 + bj * HALF - (B_IN + B_KVW), kvh = dd / B_HD, d = dd % B_HD; bf16* vt = VT + (((size_t)(row >> 6) * B_KV_HEADS + kvh) * B_HD + d) * 64 + (row & 63);
                        vt[0] = (bf16)(w.x & 0xffffu); vt[64] = (bf16)(w.x >> 16); vt[128] = (bf16)(w.y & 0xffffu); vt[192] = (bf16)(w.y >> 16);
                        vt[256] = (bf16)(w.z & 0xffffu); vt[320] = (bf16)(w.z >> 16); vt[384] = (bf16)(w.w & 0xffffu); vt[448] = (bf16)(w.w >> 16); }
                } }
    }
};
template <class Epi, class Sched, bool ALIGN_EPI>
__device__ __forceinline__ void gemm_phase(LAS unsigned char* lds, const Gemm g, const Sched& S, const Epi& E, const int tid) {
    const int wid = READFIRSTLANE(tid >> 6), lane = tid & 63, wr = wid >> 2, wc = wid & 3, fr = lane & 15, fq = lane >> 4;
    const int K = g.K, nt = K / BK;
    unsigned voffA[2], voffB[2];
#pragma unroll
    for (int i = 0; i < 2; ++i) { int R, C; stage_rc(tid * 16 + i * 8192, R, C); const int Rb = Epi::PERM ? ((R & ~31) + perm32(R & 31)) : R;
        voffA[i] = (unsigned)(R * g.lda + C) * 2u; voffB[i] = (unsigned)(Rb * K + C) * 2u; }
    const unsigned kstep = (unsigned)(BK * 2);
    const unsigned hstepA = (unsigned)HALF * (unsigned)g.lda * 2u, hstepB = (unsigned)HALF * (unsigned)K * 2u;
    const unsigned tstepA = 2 * hstepA, tstepB = 2 * hstepB;
    const BufRes rA = MAKE_RES(g.A), rB = MAKE_RES(g.Bt);
    const unsigned ldsw = (unsigned)wid * 1024u;
    const int aoff = lds_byte(wr * 64 + fr, fq * 8), boff = lds_byte(wc * 32 + fr, fq * 8);
#define PG8_SA(b, h) (((b) * 2 + (h)) * HTB)
#define PG8_SB(b, h) ((4 + (b) * 2 + (h)) * HTB)
#define PG8_STAGE(bufoff, res, soff, voff) do { _Pragma("unroll") for (int _i = 0; _i < 2; ++_i) \
        BLDS16(res, (voff)[_i], soff, lds + (bufoff) + ldsw + _i * 8192); } while (0)
#define PG8_LDA(dst, b, h) do { _Pragma("unroll") for (int m = 0; m < 4; ++m) _Pragma("unroll") for (int k = 0; k < 2; ++k) dst[m][k] = *(const LAS bf16x8*)(lds + PG8_SA(b, h) + aoff + m * 2048 + k * 1024); } while (0)
#define PG8_LDB(dst, b, h) do { _Pragma("unroll") for (int n = 0; n < 2; ++n) _Pragma("unroll") for (int k = 0; k < 2; ++k) dst[n][k] = *(const LAS bf16x8*)(lds + PG8_SB(b, h) + boff + n * 2048 + k * 1024); } while (0)
#define PG8_MMA(ai, bj, At, Bt) do { SETPRIO(1); _Pragma("unroll") for (int m = 0; m < 4; ++m) _Pragma("unroll") for (int n = 0; n < 2; ++n) _Pragma("unroll") for (int k = 0; k < 2; ++k) \
        acc[ai][bj][m][n] = MFMA16(Bt[n][k], At[m][k], acc[ai][bj][m][n]); SETPRIO(0); } while (0)
#define PG8_MMAZ(ai, bj, At, Bt) do { SETPRIO(1); _Pragma("unroll") for (int m = 0; m < 4; ++m) _Pragma("unroll") for (int n = 0; n < 2; ++n) { \
        acc[ai][bj][m][n] = MFMA16(Bt[n][0], At[m][0], ((f32x4){0.f, 0.f, 0.f, 0.f})); acc[ai][bj][m][n] = MFMA16(Bt[n][1], At[m][1], acc[ai][bj][m][n]); } SETPRIO(0); } while (0)
    Unit cur, nxt; int ui = 0;
    if (!S.next(0, cur)) return;
    f32x4 acc[2][2][4][2];
#pragma unroll
    for (int a = 0; a < 2; ++a)
#pragma unroll
        for (int b = 0; b < 2; ++b)
#pragma unroll
            for (int m = 0; m < 4; ++m)
#pragma unroll
                for (int n = 0; n < 2; ++n) acc[a][b][m][n] = (f32x4){0.f, 0.f, 0.f, 0.f};
    bf16x8 At[4][2], B0[2][2], B1[2][2];
    unsigned cA = (unsigned)cur.pm * tstepA, cB = (unsigned)cur.pn * tstepB;
    PG8_STAGE(PG8_SB(0, 0), rB, cB, voffB); PG8_STAGE(PG8_SB(0, 1), rB, cB + hstepB, voffB); PG8_STAGE(PG8_SA(0, 0), rA, cA, voffA); PG8_STAGE(PG8_SA(0, 1), rA, cA + hstepA, voffA);
    if (wr == 1) S_BARRIER();
    WAIT_VM(2); S_BARRIER();
    PG8_STAGE(PG8_SB(1, 0), rB, cB + kstep, voffB); PG8_STAGE(PG8_SA(1, 0), rA, cA + kstep, voffA); PG8_STAGE(PG8_SB(1, 1), rB, cB + hstepB + kstep, voffB);
    WAIT_VM(6); S_BARRIER();
    for (;;) {
        const bool has_next = S.next(ui + 1, nxt);
        const unsigned nA = has_next ? (unsigned)nxt.pm * tstepA : cA, nB = has_next ? (unsigned)nxt.pn * tstepB : cB;
#define PG8_TRIP(W, LAST, MM) do { \
            const unsigned a1 = cA + (unsigned)(t + 1) * kstep; \
            const unsigned a2 = (LAST) ? nA : cA + (unsigned)(t + 2) * kstep, b2 = (LAST) ? nB : cB + (unsigned)(t + 2) * kstep; \
            const unsigned a3 = a2 + kstep, b3 = b2 + kstep; \
            PG8_LDB(B0, 0, 0); PG8_LDB(B1, 0, 1); SCHED_BARRIER(); PG8_LDA(At, 0, 0); PG8_STAGE(PG8_SA(1, 1), rA, a1 + hstepA, voffA); \
            WAIT_VM(W); WAIT_LGKM(0); S_BARRIER(); MM(0, 0, At, B0); MM(0, 1, At, B1); S_BARRIER(); SCHED_BARRIER(); \
            PG8_LDA(At, 0, 1); PG8_STAGE(PG8_SB(0, 0), rB, b2, voffB); PG8_STAGE(PG8_SB(0, 1), rB, b2 + hstepB, voffB); PG8_STAGE(PG8_SA(0, 0), rA, a2, voffA); \
            WAIT_VM(W); WAIT_LGKM(0); S_BARRIER(); MM(1, 0, At, B0); MM(1, 1, At, B1); S_BARRIER(); SCHED_BARRIER(); \
            PG8_LDB(B0, 1, 0); PG8_LDB(B1, 1, 1); SCHED_BARRIER(); PG8_LDA(At, 1, 0); PG8_STAGE(PG8_SA(0, 1), rA, a2 + hstepA, voffA); \
            WAIT_VM(8); WAIT_LGKM(0); S_BARRIER(); PG8_MMA(0, 0, At, B0); PG8_MMA(0, 1, At, B1); S_BARRIER(); SCHED_BARRIER(); \
            PG8_LDA(At, 1, 1); PG8_STAGE(PG8_SB(1, 0), rB, b3, voffB); PG8_STAGE(PG8_SB(1, 1), rB, b3 + hstepB, voffB); PG8_STAGE(PG8_SA(1, 0), rA, a3, voffA); \
            WAIT_VM(8); WAIT_LGKM(0); S_BARRIER(); PG8_MMA(1, 0, At, B0); PG8_MMA(1, 1, At, B1); S_BARRIER(); SCHED_BARRIER(); } while (0)
        int t = 0;
        if (ui > 0) { PG8_TRIP(24, false, PG8_MMAZ); t = 2; }
        for (; t < nt; t += 2) { const bool last = (t == nt - 2); PG8_TRIP(8, last, PG8_MMA); }
#undef PG8_TRIP
        if constexpr (ALIGN_EPI) { if (wr == 0) S_BARRIER(); }
        E(acc, cur, wr, wc, fr, fq);
        if (!has_next) break;
        cur = nxt; cA = nA; cB = nB; ++ui;
        if constexpr (ALIGN_EPI) { if (wr == 1) S_BARRIER(); }
    }
    WAIT_VM(0);
    if constexpr (!ALIGN_EPI) { if (wr == 0) S_BARRIER(); }
    S_BARRIER();
#undef PG8_SA
#undef PG8_SB
#undef PG8_STAGE
#undef PG8_LDA
#undef PG8_LDB
#undef PG8_MMA
#undef PG8_MMAZ
}
}
__device__ __forceinline__ void gemm_mfma(const bf16* A, int lda, const bf16* Bt, bf16* C, int ldc, int M, int N, int K, const Ctx& c, unsigned char* lds) {
    pg8::Gemm g{A, lda, Bt, M, N, K}; pg8::StaticOrder S; S.init(M, N, c.nblk, c.bid); pg8::EpiBf16 E{C, ldc};
    __syncthreads();
    pg8::gemm_phase<pg8::EpiBf16, pg8::StaticOrder, true>((LAS unsigned char*)lds, g, S, E, c.tid);
    __syncthreads();
}
__device__ __forceinline__ void transpose_item(const float* W, int ldw, int K, int N, bf16* WT, int row_off, float* scr, int item, int lane) {
    const int nblk = N / 64, kb = item / nblk, nb = item % nblk, k0 = 64 * kb, n0 = 64 * nb;
#pragma unroll 8
    for (int kk = 0; kk < 64; ++kk) scr[kk * 65 + lane] = W[(size_t)(k0 + kk) * ldw + n0 + lane];
    WAVE_SYNC();
    const int cc = lane & 7;
#pragma unroll
    for (int j = 0; j < 8; ++j) { const int n = (lane >> 3) + 8 * j; const float* sp = scr + (8 * cc) * 65 + n;
        u32x4 o; o.x = cvtpk(sp[0 * 65], sp[1 * 65]); o.y = cvtpk(sp[2 * 65], sp[3 * 65]); o.z = cvtpk(sp[4 * 65], sp[5 * 65]); o.w = cvtpk(sp[6 * 65], sp[7 * 65]);
        *(u32x4*)(WT + (size_t)(row_off + n0 + n) * K + k0 + 8 * cc) = o; }
    WAVE_SYNC();
}
constexpr int WI_AIN = (D_MODEL / 64) * (A_MAIN / 64), WI_AOUT = (A_VW / 64) * (D_MODEL / 64), WI_BIN = (D_MODEL / 64) * (B_IN / 64), WI_BKV = (D_MODEL / 64) * (2 * B_KVW / 64), WI_BOUT = (B_QW / 64) * (D_MODEL / 64);
constexpr int WI_A_END = N_A * (WI_AIN + WI_AOUT), WI_ALL = WI_A_END + N_B * (WI_BIN + WI_BOUT) + WI_BKV;
__device__ __forceinline__ void weights_range(PrmRef p, int lane, int wave, unsigned char* lds, int vw, int nvw, int lo, int hi) {
    float* scr = (float*)lds + wave * (64 * 65);
    bf16* WAIN = (bf16*)(p.ws + WS_WAIN); bf16* WAOUT = (bf16*)(p.ws + WS_WAOUT); bf16* WBIN = (bf16*)(p.ws + WS_WBIN); bf16* WBOUT = (bf16*)(p.ws + WS_WBOUT);
    for (int it = lo + vw; it < hi; it += nvw) {
        int r = it;
        if (r < N_A * WI_AIN) { const int li = r / WI_AIN; transpose_item(p.a_w_in + (size_t)li * D_MODEL * A_IN, A_IN, D_MODEL, A_MAIN, WAIN + (size_t)li * A_NG * D_MODEL, 0, scr, r % WI_AIN, lane); continue; } r -= N_A * WI_AIN;
        if (r < N_A * WI_AOUT) { const int li = r / WI_AOUT; transpose_item(p.a_w_out + (size_t)li * A_VW * D_MODEL, D_MODEL, A_VW, D_MODEL, WAOUT + (size_t)li * D_MODEL * A_VW, 0, scr, r % WI_AOUT, lane); continue; } r -= N_A * WI_AOUT;
        if (r < N_B * WI_BIN) { const int lj = r / WI_BIN; transpose_item(p.b_w_in + (size_t)lj * D_MODEL * B_IN, B_IN, D_MODEL, B_IN, WBIN + (size_t)lj * B_N0 * D_MODEL, 0, scr, r % WI_BIN, lane); continue; } r -= N_B * WI_BIN;
        if (r < N_B * WI_BOUT) { const int lj = r / WI_BOUT; transpose_item(p.b_w_out + (size_t)lj * B_QW * D_MODEL, D_MODEL, B_QW, D_MODEL, WBOUT + (size_t)lj * D_MODEL * B_QW, 0, scr, r % WI_BOUT, lane); continue; } r -= N_B * WI_BOUT;
        transpose_item(p.b_w_kv, 2 * B_KVW, D_MODEL, 2 * B_KVW, WBIN, B_IN, scr, r, lane);
    }
}
__device__ __forceinline__ void ph_weights(PrmRef p, const Ctx& c, unsigned char* lds) {
    weights_range(p, c.lane, c.wave, lds, c.gwave, c.nwaves, 0, WI_AIN);
    bf16* WAIN = (bf16*)(p.ws + WS_WAIN);
    for (int it = c.gtid; it < N_A * 256 * D_MODEL; it += c.nthreads) {
        const int k = it % D_MODEL, j = (it / D_MODEL) % 256, li = it / (256 * D_MODEL);
        WAIN[((size_t)li * A_NG + A_MAIN + j) * D_MODEL + k] = j < 2 * A_HEADS ? (bf16)f2bf(p.a_w_in[((size_t)li * D_MODEL + k) * A_IN + A_MAIN + j]) : (bf16)0;
    }
}
__device__ __forceinline__ void weights_deferred(PrmRef p, const Ctx& c, int li, unsigned char* lds, int vw, int nvw) {
    static_assert(N_A == 2, "deferred weight conversion schedule");
    if (li == 0) weights_range(p, c.lane, c.wave, lds, vw, nvw, WI_AIN, WI_A_END); else weights_range(p, c.lane, c.wave, lds, vw, nvw, WI_A_END, WI_ALL);
}

__device__ __forceinline__ void ph_init(PrmRef p, const Ctx& c) {
    bf16* XB = (bf16*)(p.ws + WS_XB);
    for (size_t i8 = c.gtid; i8 < (size_t)MT * D_MODEL / 8; i8 += c.nthreads) {
        const size_t i = i8 * 8; const float* src = i < (size_t)PT * D_MODEL ? p.x_prompt + i : p.x_sample + (i - (size_t)PT * D_MODEL);
        const f32x4 a = *(const f32x4*)src, b = *(const f32x4*)(src + 4);
        u32x4 o; o.x = cvtpk(a[0], a[1]); o.y = cvtpk(a[2], a[3]); o.z = cvtpk(b[0], b[1]); o.w = cvtpk(b[2], b[3]);
        *(u32x4*)(XB + i) = o;
    }
    float* rope = (float*)(p.ws + WS_ROPE);
    for (int i = c.gtid; i < (SEQ + DEC_SEQ) * ROPE_HALF; i += c.nthreads) {
        const int pi = i / ROPE_HALF, f = i % ROPE_HALF; const float pos = pi < SEQ ? (float)pi : (float)(PAST_LEN + pi - SEQ);
        const float inv = f == 0 ? 1.0f : f == 1 ? 0.1939227432012558f : f == 2 ? 0.03760603070259094f : f == 3 ? 0.007292664609849453f : f == 4 ? 0.0014142135623842478f
                        : f == 5 ? 0.00027424818836152554f : f == 6 ? 5.3182957344688475e-05f : 1.0313385246263351e-05f;
        const float ang = pos * inv;
        rope[2 * i] = cosf(ang); rope[2 * i + 1] = sinf(ang);
    }
}

constexpr int SS_KC = 128, SS_STB = 32768, SS_BOFF = 16384;
template <int MODE> __device__ __forceinline__ void ss_issue(const bf16* A, int lda, const bf16* Bt, int K, int row0, int col0, int cidx, int q, int lw, int lane, unsigned char* lds) {
    const unsigned char* sa = (const unsigned char*)(A + (size_t)row0 * lda + cidx * SS_KC); const unsigned char* sb = (const unsigned char*)(Bt + (size_t)col0 * K + cidx * SS_KC);
    unsigned char* st = lds + (q & 3) * SS_STB;
#pragma unroll
    for (int i = 0; i < 4; ++i) { const int row = (lw * 4 + i) * 4 + (lane >> 4), pc = (lane & 15) ^ (row & 15);
        GLDS16(sa + (unsigned)row * (unsigned)(lda * 2) + (unsigned)pc * 16u, st + (lw * 4 + i) * 1024);
        if (MODE != 1) GLDS16(sb + (unsigned)row * (unsigned)(K * 2) + (unsigned)pc * 16u, st + SS_BOFF + (lw * 4 + i) * 1024); }
    if (MODE == 1) { const int row = lw * 4 + (lane >> 4), pc = (lane & 15) ^ (row & 15); GLDS16(sb + (unsigned)row * (unsigned)(K * 2) + (unsigned)pc * 16u, st + SS_BOFF + lw * 1024); }
}
template <int MODE> __device__ __forceinline__ void sgemm_stream(PrmRef p, int li, const bf16* A, int lda, const bf16* Bt, int K, bf16* C, int ldc, int row_begin, int col_base, int tn, int it0, int itstep, int nitems, int tid, unsigned char* lds) {
    const int lane = tid & 63, wave = READFIRSTLANE(tid >> 6), nkc = K / SS_KC;
    const int nmine = it0 < nitems ? (nitems - it0 + itstep - 1) / itstep : 0, Q = nmine * nkc;
    LBAR();
    if (Q == 0) return;
    if (wave >= 4) {
        const int lw = wave - 4;
        int it = it0, cidx = 0, row0 = row_begin + (it / tn) * 64, col0 = col_base + (it % tn) * 64;
#define SS_NEXT() do { if (++cidx == nkc) { cidx = 0; it += itstep; row0 = row_begin + (it / tn) * 64; col0 = col_base + (it % tn) * 64; } } while (0)
        ss_issue<MODE>(A, lda, Bt, K, row0, col0, cidx, 0, lw, lane, lds); SS_NEXT();
        if (Q > 1) { ss_issue<MODE>(A, lda, Bt, K, row0, col0, cidx, 1, lw, lane, lds); SS_NEXT(); }
        if (Q > 2) { ss_issue<MODE>(A, lda, Bt, K, row0, col0, cidx, 2, lw, lane, lds); SS_NEXT(); }
        for (int q = 0; q < Q; ++q) {
            if (q + 2 < Q) { if (MODE == 1) { WAIT_VM(10); } else { WAIT_VM(16); } } else { WAIT_VM(0); }
            LBAR();
            if (q + 3 < Q) { ss_issue<MODE>(A, lda, Bt, K, row0, col0, cidx, q + 3, lw, lane, lds); SS_NEXT(); }
        }
#undef SS_NEXT
    } else {
        const int r = lane & 15, g = lane >> 4;
        f32x4 acc[4];
#pragma unroll
        for (int nt = 0; nt < 4; ++nt) acc[nt] = (f32x4){0.f, 0.f, 0.f, 0.f};
        int it = it0, cidx = 0;
        for (int q = 0; q < Q; ++q) {
            LBAR();
            const unsigned char* ap = lds + (q & 3) * SS_STB + (16 * wave + r) * 256; const unsigned char* bp = lds + (q & 3) * SS_STB + SS_BOFF + r * 256;
#pragma unroll
            for (int ks = 0; ks < 4; ++ks) { const int po = ((4 * ks + g) ^ r) << 4; const bf16x8 a = *(const bf16x8*)(ap + po);
#pragma unroll
                for (int nt = 0; nt < (MODE == 1 ? 1 : 4); ++nt) { const bf16x8 b = *(const bf16x8*)(bp + nt * 4096 + po); acc[nt] = MFMA16(b, a, acc[nt]); } }
            if (++cidx == nkc) {
                const int row0 = row_begin + (it / tn) * 64, col0 = col_base + (it % tn) * 64, row = row0 + 16 * wave + r;
                if (MODE == 1) {
                    static_assert(2 * A_HEADS <= 16, "gate columns");
                    float* GB = (float*)(p.ws + WS_GB);
#pragma unroll
                    for (int e = 0; e < 4; ++e) { const int col = 4 * g + e; const float v = acc[0][e];
                        if (col < A_HEADS) GB[((size_t)row * A_HEADS + col) * 2] = -expf(p.a_log[li * A_HEADS + col]) * softplusf_(v + p.a_dt_bias[li * A_HEADS + col]);
                        else if (col < 2 * A_HEADS) GB[((size_t)row * A_HEADS + (col - A_HEADS)) * 2 + 1] = sigmoidf_(v); }
                } else {
                    if (MODE == 2) {
                        const int kind = col0 < B_QW ? 0 : col0 < B_IN ? 1 : col0 < B_IN + B_KVW ? 2 : 3, srow = row - PT;
                        if (kind == 0 || kind == 2) {
                            const float* rp = (const float*)(p.ws + WS_ROPE) + ((size_t)(SEQ + srow % DEC_SEQ) * ROPE_HALF + 4 * (g & 1)) * 2;
                            const f32x4 cs0 = *(const f32x4*)rp, cs1 = *(const f32x4*)(rp + 4);
#pragma unroll
                            for (int e = 0; e < 4; ++e) { const float x = acc[0][e], o = __shfl_xor(x, 32), c_ = e < 2 ? cs0[2 * e] : cs1[2 * e - 4], s_ = e < 2 ? cs0[2 * e + 1] : cs1[2 * e - 3];
                                acc[0][e] = g < 2 ? x * c_ - o * s_ : x * c_ + o * s_; }
                        }
                        if (kind == 0) {
#pragma unroll
                            for (int nt = 0; nt < 4; ++nt) acc[nt] = acc[nt] * 0.125f; }
                        if (kind == 3) { bf16* VT = (bf16*)(p.ws + WS_VT); const int kvh = (col0 - (B_IN + B_KVW)) / B_HD, ck = NCP + srow / DEC_SEQ, key = srow % DEC_SEQ;
#pragma unroll
                            for (int nt = 0; nt < 4; ++nt)
#pragma unroll
                                for (int e = 0; e < 4; ++e) VT[(((size_t)ck * B_KV_HEADS + kvh) * B_HD + 16 * nt + 4 * g + e) * 64 + key] = (bf16)(cvtpk(acc[nt][e], 0.f) & 0xffffu); }
                    }
                    bf16* cp = C + (size_t)row * ldc + col0 + 4 * g;
#pragma unroll
                    for (int nt = 0; nt < 4; ++nt) { u32x2 w; w.x = cvtpk(acc[nt][0], acc[nt][1]); w.y = cvtpk(acc[nt][2], acc[nt][3]); *(u32x2*)(cp + 16 * nt) = w; }
                }
#pragma unroll
                for (int nt = 0; nt < 4; ++nt) acc[nt] = (f32x4){0.f, 0.f, 0.f, 0.f};
                cidx = 0; it += itstep;
            }
        }
    }
    LBAR();
}
template <int MODE = 0> __device__ __forceinline__ void sgemm_rows(PrmRef p, const bf16* A, int lda, const bf16* Bt, int K, bf16* C, int ldc, int row_begin, int nrows, int N, const Ctx& c, int first_wg, unsigned char* lds, bool only_tail = false) {
    const int tn = N / 64, nt = (nrows / 64) * tn;
    const int f = first_wg % c.nblk, np = (only_tail && f > 0) ? c.nblk - f : c.nblk;
    const int v = only_tail && f > 0 ? c.bid - f : (c.bid + c.nblk - f) % c.nblk;
    sgemm_stream<MODE>(p, 0, A, lda, Bt, K, C, ldc, row_begin, 0, tn, v >= 0 ? v : nt, np, nt, c.tid, lds);
}
__device__ __forceinline__ void ph_a_gemm(PrmRef p, const Ctx& c, int li, unsigned char* lds) {
    const bf16* XB = (const bf16*)(p.ws + WS_XB); bf16* PROJ = (bf16*)(p.ws + WS_PROJ); const bf16* Wt = (const bf16*)(p.ws + WS_WAIN) + (size_t)li * A_NG * D_MODEL;
    pg8::Gemm g{XB, D_MODEL, Wt, PT, A_MAIN, D_MODEL}; pg8::StaticOrder S; S.init(PT, A_MAIN, c.nblk, c.bid);
    pg8::EpiAIn E{PROJ, PLD, (bf16*)(p.ws + WS_HALO), p.out + O_PCONV + (size_t)li * BATCH * 3 * CONV_DIM};
    __syncthreads();
    pg8::gemm_phase<pg8::EpiAIn, pg8::StaticOrder, true>((LAS unsigned char*)lds, g, S, E, c.tid);
    __syncthreads();
    sgemm_stream<1>(p, li, XB, D_MODEL, Wt, D_MODEL, nullptr, 0, 0, A_MAIN, 1, c.bid, c.nblk, MT / 64, c.tid, lds);
    sgemm_rows(p, XB, D_MODEL, Wt, D_MODEL, PROJ, PLD, PT, ST, A_MAIN, c, MT / 64, lds);
}
constexpr int NPG = BATCH * A_HEADS, NSG = DEC_BATCH * A_HEADS, NPI = NPG * NCPS;
__device__ __forceinline__ unsigned pk2bf(float lo, float hi) { return cvtpk(lo, hi); }
constexpr int PP_KN = 0, PP_QN = 17408, PP_KF = 34816, PP_VF = 67584, PP_GC = 100352, PP_LN = 102400, PP_LNP = 68, PP_TI = PP_LN + 64 * PP_LNP * 4, PP_WST = PP_TI + 4 * 16 * 17 * 4, PP_CW = PP_WST + 17408, PP_END = PP_CW + 3 * 4 * 128 * 4;
static_assert(PP_END <= 163840 - 64 && PP_TI % 16 == 0 && PP_WST % 16 == 0 && PP_CW % 16 == 0, "prepass LDS");
typedef u32x4 RawTile[3][4][2];
__device__ __forceinline__ void prepass_load_raw(PrmRef p, int item, int tid, RawTile& xr) {
    const bf16* PROJ = (const bf16*)(p.ws + WS_PROJ); const bf16* HALO = (const bf16*)(p.ws + WS_HALO);
    const int n = item % NCPS, grp = item / NCPS, h = grp % A_HEADS, s = grp / A_HEADS, R0 = s * SEQ + n * CHUNK, r = tid >> 3, seg = tid & 7;
#pragma unroll
    for (int X = 0; X < 3; ++X) {
        const int cb = X * A_QK + h * A_DK + 16 * seg;
#pragma unroll
        for (int j = 0; j < 4; ++j) {
            const int rr = r - 3 + j;
            if (rr >= 0) { const u32x4* src = (const u32x4*)(PROJ + (size_t)(R0 + rr) * PLD + cb); xr[X][j][0] = src[0]; xr[X][j][1] = src[1]; }
            else if (n > 0) { const u32x4* src = (const u32x4*)(HALO + ((size_t)(s * NCPS + n - 1) * 3 + (3 + rr)) * CONV_DIM + cb); xr[X][j][0] = src[0]; xr[X][j][1] = src[1]; }
            else { xr[X][j][0] = (u32x4){0u, 0u, 0u, 0u}; xr[X][j][1] = xr[X][j][0]; }
        }
    }
}
__device__ __forceinline__ void prepass_gcum(PrmRef p, int item, int lane, float* GC) {
    const float* GB = (const float*)(p.ws + WS_GB); float* GL = (float*)(p.ws + WS_GL);
    const int n = item % NCPS, grp = item / NCPS, h = grp % A_HEADS, s = grp / A_HEADS, R0 = s * SEQ + n * CHUNK;
    const float g = GB[((size_t)(R0 + lane) * A_HEADS + h) * 2], bt = GB[((size_t)(R0 + lane) * A_HEADS + h) * 2 + 1];
    float cs = g;
#pragma unroll
    for (int d = 1; d < 64; d <<= 1) { const float o = __shfl(cs, lane >= d ? lane - d : lane); if (lane >= d) cs += o; }
    const float gl = __shfl(cs, 63);
    GC[lane] = cs; GC[64 + lane] = bt; GC[128 + lane] = fexp(cs); GC[192 + lane] = fexp(gl - cs);
    if (lane == 0) GL[item] = fexp(gl);
}
__device__ __forceinline__ void prepass_store_w(PrmRef p, int item, int tid, const unsigned char* lds) {
    bf16* WB = (bf16*)(p.ws + WS_WB); const bf16* WST = (const bf16*)(lds + PP_WST);
    const int n = item % NCPS, grp = item / NCPS, h = grp % A_HEADS, s = grp / A_HEADS, R0 = s * SEQ + n * CHUNK, r = tid >> 3, seg = tid & 7;
    const u32x4 w0 = *(const u32x4*)(WST + r * 136 + 16 * seg), w1 = *(const u32x4*)(WST + r * 136 + 16 * seg + 8);
    u32x4* dst = (u32x4*)(WB + (size_t)(R0 + r) * A_QK + h * A_DK + 16 * seg); dst[0] = w0; dst[1] = w1;
}
template <int VAR = 0> __device__ __forceinline__ void delta_prepass_item(PrmRef p, int li, int item, int next_item, int prev_item, int pb, int tid, unsigned char* lds, RawTile& xr) {
#ifndef EMU
    asm volatile("" : "+v"(tid));
#endif
    bf16* PROJ = (bf16*)(p.ws + WS_PROJ); bf16* IA = (bf16*)(p.ws + WS_IA);
    const int n = item % NCPS, grp = item / NCPS, h = grp % A_HEADS, s = grp / A_HEADS;
    const int R0 = s * SEQ + n * CHUNK, lane = tid & 63, wave = READFIRSTLANE(tid >> 6);
    bf16* KN = (bf16*)(lds + PP_KN); bf16* QN = (bf16*)(lds + PP_QN); bf16* VN = (bf16*)(lds + PP_KF);
    float* GC = (float*)(lds + PP_GC) + pb * 256; float* BT = GC + 64; float* EG = GC + 128; float* KD = GC + 192;
    float* LN = (float*)(lds + PP_LN);
    float* TI = (float*)(lds + PP_TI);
    bf16* WST = (bf16*)(lds + PP_WST);
    if (prev_item >= 0) prepass_store_w(p, prev_item, tid, lds);
    const int r = tid >> 3, seg = tid & 7;
    float qf[16];
#pragma unroll
    for (int X = 0; X < 3; ++X) {
        const int cb = X * A_QK + h * A_DK + 16 * seg;
        float acc[16];
#pragma unroll
        for (int e = 0; e < 16; ++e) acc[e] = 0.f;
#pragma unroll
        for (int j = 0; j < 4; ++j) {
            const f32x4* wp = (const f32x4*)(lds + PP_CW) + ((X * 4 + j) * 128 + 16 * seg) / 4;
#pragma unroll
            for (int e = 0; e < 4; ++e) {
                const f32x4 w4 = wp[e]; const unsigned a = xr[X][j][e >> 1][2 * (e & 1)], b = xr[X][j][e >> 1][2 * (e & 1) + 1];
                acc[4 * e] += w4[0] * bflo(a); acc[4 * e + 1] += w4[1] * bfhi(a); acc[4 * e + 2] += w4[2] * bflo(b); acc[4 * e + 3] += w4[3] * bfhi(b);
            }
        }
        float ss = 0.f;
#pragma unroll
        for (int e = 0; e < 16; ++e) { acc[e] = fsilu(acc[e]); ss += acc[e] * acc[e]; }
        if (X < 2) {
            ss = sum8(ss);
            const float rs = fast_rsq(ss + RMS_EPS) * (X == 0 ? 0.08838834764831845f : 1.f);
#pragma unroll
            for (int e = 0; e < 16; ++e) acc[e] *= rs;
        }
        if (X == 0) {
#pragma unroll
            for (int e = 0; e < 16; ++e) qf[e] = acc[e];
            u32x4 o0, o1;
#pragma unroll
            for (int e = 0; e < 4; ++e) { o0[e] = cvtpk(acc[2 * e], acc[2 * e + 1]); o1[e] = cvtpk(acc[8 + 2 * e], acc[8 + 2 * e + 1]); }
            *(u32x4*)(QN + r * 136 + 16 * seg) = o0; *(u32x4*)(QN + r * 136 + 16 * seg + 8) = o1;
        } else if (X == 1) {
            u32x4 o0, o1;
#pragma unroll
            for (int e = 0; e < 4; ++e) { o0[e] = cvtpk(acc[2 * e], acc[2 * e + 1]); o1[e] = cvtpk(acc[8 + 2 * e], acc[8 + 2 * e + 1]); }
            *(u32x4*)(KN + r * 136 + 16 * seg) = o0; *(u32x4*)(KN + r * 136 + 16 * seg + 8) = o1;
        } else {
            u32x4 o0, o1;
#pragma unroll
            for (int e = 0; e < 4; ++e) { o0[e] = cvtpk(acc[2 * e], acc[2 * e + 1]); o1[e] = cvtpk(acc[8 + 2 * e], acc[8 + 2 * e + 1]); }
            *(u32x4*)(VN + r * 136 + 16 * seg) = o0; *(u32x4*)(VN + r * 136 + 16 * seg + 8) = o1;
        }
    }
    LBAR();
    if (next_item >= 0) prepass_load_raw(p, next_item, tid, xr);
    {
        const float eg = EG[r]; u32x4 o0, o1;
#pragma unroll
        for (int e = 0; e < 4; ++e) { o0[e] = cvtpk(qf[2 * e] * eg, qf[2 * e + 1] * eg); o1[e] = cvtpk(qf[8 + 2 * e] * eg, qf[8 + 2 * e + 1] * eg); }
        u32x4* dst = (u32x4*)(PROJ + (size_t)(R0 + r) * PLD + h * A_DK + 16 * seg); dst[0] = o0; dst[1] = o1;
    }
    if (VAR != 4) {
        const int kind = wave >> 2, ti = (wave >> 1) & 1, tj = wave & 1, l31 = lane & 31, hi = lane >> 5;
        if (wave == 1) {
            if (next_item >= 0) prepass_gcum(p, next_item, lane, (float*)(lds + PP_GC) + (pb ^ 1) * 256);
#pragma unroll
            for (int e = 0; e < 16; ++e) LN[((e & 3) + 8 * (e >> 2) + 4 * hi) * PP_LNP + 32 + l31] = 0.f;
        } else {
            f32x16 acc;
#pragma unroll
            for (int e = 0; e < 16; ++e) acc[e] = 0.f;
            const unsigned char* ap = (const unsigned char*)(kind == 0 ? KN : QN) + (32 * ti + l31) * 272 + 16 * hi;
            const unsigned char* bp = (const unsigned char*)KN + (32 * tj + l31) * 272 + 16 * hi;
            if (ti >= tj) {
#pragma unroll
                for (int ks = 0; ks < 8; ++ks) { const bf16x8 a = *(const bf16x8*)(ap + 32 * ks), b = *(const bf16x8*)(bp + 32 * ks); acc = MFMA32(a, b, acc); }
            }
            const int col = 32 * tj + l31; const float gcc = GC[col];
#pragma unroll
            for (int e = 0; e < 16; ++e) {
                const int row = 32 * ti + (e & 3) + 8 * (e >> 2) + 4 * hi;
                if (kind == 0) LN[row * PP_LNP + col] = row > col ? -(BT[row] * acc[e] * fexp(GC[row] - gcc)) : 0.f;
                else IA[((size_t)item * 64 + row) * 64 + col] = (bf16)f2bf(row >= col ? acc[e] * fexp(GC[row] - gcc) : 0.f);
            }
            if (wave == 0 || wave == 3) {
                WAVE_SYNC();
                if (lane < 32) {
                    const int b = (wave == 3 ? 2 : 0) + (lane >> 4), j = lane & 15; float t[16];
#pragma unroll
                    for (int i = 0; i < 16; ++i) {
                        float v = i == j ? 1.f : 0.f;
#pragma unroll
                        for (int k = 0; k < i; ++k) v += LN[(16 * b + i) * PP_LNP + 16 * b + k] * t[k];
                        t[i] = v;
                    }
#pragma unroll
                    for (int i = 0; i < 16; ++i) TI[(b * 16 + i) * 17 + j] = t[i];
                }
            } else if (wave >= 4) {
                const int u = tid - 256, m = u & 127, half = u >> 7;
                unsigned char* dst = (unsigned char*)PROJ + ((size_t)(R0 + (m >> 1)) * PLD + A_QK + h * A_DK) * 2 + (m & 1) * 128 + half * 64;
#pragma unroll
                for (int q4 = 0; q4 < 4; ++q4) {
                    u32x4 o;
#pragma unroll
                    for (int e = 0; e < 4; ++e) { const int j = 32 * half + 8 * q4 + 2 * e; o[e] = cvtpk(bf2f(KN[j * 136 + m]) * KD[j], bf2f(KN[(j + 1) * 136 + m]) * KD[j + 1]); }
                    *(u32x4*)(dst + 16 * q4) = o;
                }
            }
        }
    }
    LBAR();
    if (VAR != 4 && VAR != 1) {
        const int g = lane >> 4, cl = lane & 15;
        f32x4 XU[4], XW[4];
#pragma unroll
        for (int b = 0; b < 4; ++b) {
            f32x4 yu, yw;
#pragma unroll
            for (int e = 0; e < 4; ++e) { const int row = 16 * b + 4 * g + e; const float bt = BT[row]; yu[e] = bf2f(VN[row * 136 + 16 * wave + cl]) * bt; yw[e] = bf2f(KN[row * 136 + 16 * wave + cl]) * (bt * EG[row]); }
            float la[12], ta[4];
#pragma unroll
            for (int c = 0; c < b; ++c)
#pragma unroll
                for (int ks = 0; ks < 4; ++ks) la[4 * c + ks] = LN[(16 * b + cl) * PP_LNP + 16 * c + 4 * g + ks];
#pragma unroll
            for (int ks = 0; ks < 4; ++ks) ta[ks] = TI[(b * 16 + cl) * 17 + 4 * g + ks];
            SCHED_BARRIER();
#pragma unroll
            for (int c = 0; c < b; ++c)
#pragma unroll
                for (int ks = 0; ks < 4; ++ks) { yu = MFMAF(la[4 * c + ks], XU[c][ks], yu); yw = MFMAF(la[4 * c + ks], XW[c][ks], yw); }
            f32x4 xu = (f32x4){0.f, 0.f, 0.f, 0.f}, xw = xu;
#pragma unroll
            for (int ks = 0; ks < 4; ++ks) { xu = MFMAF(ta[ks], yu[ks], xu); xw = MFMAF(ta[ks], yw[ks], xw); }
            XU[b] = xu; XW[b] = xw;
            u32x2 o; o.x = cvtpk(xu[0], xu[1]); o.y = cvtpk(xu[2], xu[3]);
            *(u32x2*)((unsigned char*)PROJ + ((size_t)(R0 + wave * 8 + 2 * b + (lane >> 5)) * PLD + 2 * A_QK + h * A_DV) * 2 + (lane & 31) * 8) = o;
#pragma unroll
            for (int e = 0; e < 4; ++e) WST[(16 * b + 4 * g + e) * 136 + 16 * wave + cl] = (bf16)(cvtpk(xw[e], 0.f) & 0xffffu);
        }
    }
    LBAR();
}

__device__ __forceinline__ bf16x8 pack_b(const f32x4 a, const f32x4 b) {
    u32x4 o; o.x = pk2bf(a[0], a[1]); o.y = pk2bf(a[2], a[3]); o.z = pk2bf(b[0], b[1]); o.w = pk2bf(b[2], b[3]); return __builtin_bit_cast(bf16x8, o);
}
__device__ __forceinline__ bf16x8 ld_frag(const unsigned char* base, int off0, int off1) {
    const u32x2 lo = *(const u32x2*)(base + off0), hi = *(const u32x2*)(base + off1);
    u32x4 o; o.x = lo.x; o.y = lo.y; o.z = hi.x; o.w = hi.y; return __builtin_bit_cast(bf16x8, o);
}
constexpr int SC_BUF = 65536, SC_W = 0, SC_QD = 16384, SC_KDT = 32768, SC_IA = 49152, SC_U = 57344;
__device__ __forceinline__ void scan_dma(PrmRef p, int grp, int half, int n, int lw, int lane, unsigned char* buf) {
    const unsigned char* PROJ = (const unsigned char*)(p.ws + WS_PROJ); const unsigned char* WB = (const unsigned char*)(p.ws + WS_WB); const unsigned char* IA = (const unsigned char*)(p.ws + WS_IA);
    const int h = grp % A_HEADS, s = grp / A_HEADS, R0 = s * SEQ + n * CHUNK;
    const unsigned char* bW = WB + ((size_t)R0 * A_QK + h * A_DK) * 2;
    const unsigned char* bQ = PROJ + ((size_t)R0 * PLD + h * A_DK) * 2;
    const unsigned char* bK = PROJ + ((size_t)R0 * PLD + A_QK + h * A_DK) * 2;
    const unsigned char* bU = PROJ + ((size_t)(R0 + 32 * half) * PLD + 2 * A_QK + h * A_DV) * 2;
    const unsigned char* bI = IA + (size_t)(grp * NCPS + n) * 8192;
#pragma unroll
    for (int j = 0; j < 4; ++j) {
        const int ip = lw + 4 * j, sg = ip * 64 + lane;
        { const int row = sg >> 4, pc = (sg & 15) ^ (row & 15);
          GLDS16(bW + (unsigned)row * (unsigned)(A_QK * 2) + (unsigned)pc * 16u, buf + SC_W + ip * 1024);
          GLDS16(bQ + (unsigned)row * (unsigned)(PLD * 2) + (unsigned)pc * 16u, buf + SC_QD + ip * 1024); }
        { const int m = sg >> 3, pc = (sg & 7) ^ ((m >> 1) & 7);
          GLDS16(bK + (unsigned)(m >> 1) * (unsigned)(PLD * 2) + (unsigned)(m & 1) * 128u + (unsigned)pc * 16u, buf + SC_KDT + ip * 1024); }
        if (j < 2) {
          { const int row = sg >> 3, pc = (sg & 7) ^ ((row >> 1) & 7); GLDS16(bI + (unsigned)row * 128u + (unsigned)pc * 16u, buf + SC_IA + ip * 1024); }
          GLDS16(bU + (unsigned)(sg >> 4) * (unsigned)(PLD * 2) + (unsigned)(sg & 15) * 16u, buf + SC_U + ip * 1024);
        }
    }
}
template <int SV = 0> __device__ __forceinline__ void delta_scan_group(PrmRef p, int li, int item, int tid, unsigned char* lds, bool wstate = true) {
    unsigned char* PROJ = (unsigned char*)(p.ws + WS_PROJ); const float* GL = (const float*)(p.ws + WS_GL);
    const int grp = item >> 1, half = item & 1;
    const int h = grp % A_HEADS, s = grp / A_HEADS, lane = tid & 63, wave = READFIRSTLANE(tid >> 6);
    const bool loader = wave >= 4; const int cw = 4 * half + (wave & 3);
    f32x4 S[8];
#pragma unroll
    for (int m = 0; m < 8; ++m) S[m] = (f32x4){0.f, 0.f, 0.f, 0.f};
    unsigned char* fp = PROJ + ((size_t)(s * SEQ + cw * 8 + (lane >> 5)) * PLD + 2 * A_QK + h * A_DV) * 2 + (lane & 31) * 8;
    constexpr size_t TSTEP = (size_t)2 * PLD * 2, CSTEP = (size_t)CHUNK * PLD * 2;
    static_assert(NCPS <= 64, "glast per lane");
    const float glv = GL[grp * NCPS + (lane < NCPS ? lane : 0)];
    if (loader) { if (SV != 1) scan_dma(p, grp, half, 0, wave - 4, lane, lds); }
    WAIT_VM(0); LBAR();
    for (int n = 0; n < NCPS; ++n) {
        unsigned char* buf = lds + (n & 1) * SC_BUF;
        if (loader) {
            if (n + 1 < NCPS) { if (SV != 1) scan_dma(p, grp, half, n + 1, wave - 4, lane, lds + ((n + 1) & 1) * SC_BUF); }
            WAIT_VM(0);
        } else {
        int lane2 = lane;
#ifndef EMU
        asm volatile("" : "+v"(lane2));
#endif
        const int g = lane2 >> 4, cl = lane2 & 15, gh = g >> 1;
        int oW[4][2], oH[2][2];
#pragma unroll
        for (int ks = 0; ks < 4; ++ks) { const int x = (4 * ks + gh) ^ cl; oW[ks][0] = cl * 256 + (x << 4) + 8 * (g & 1); oW[ks][1] = cl * 256 + ((x ^ 2) << 4) + 8 * (g & 1); }
#pragma unroll
        for (int ks = 0; ks < 2; ++ks) { const int x = (4 * ks + gh) ^ (cl >> 1); oH[ks][0] = cl * 128 + (x << 4) + 8 * (g & 1); oH[ks][1] = cl * 128 + ((x ^ 2) << 4) + 8 * (g & 1); }
        u32x2 uf[4];
#pragma unroll
        for (int t = 0; t < 4; ++t) uf[t] = *(const u32x2*)(buf + SC_U + ((wave & 3) * 8 + 2 * t + (lane2 >> 5)) * 256 + (lane2 & 31) * 8);
        const float glast = BCAST_LANE(glv, n);
        bf16x8 Bs[4];
#pragma unroll
        for (int ks = 0; ks < 4; ++ks) Bs[ks] = pack_b(S[2 * ks], S[2 * ks + 1]);
        bf16x8 fa[4][4];
#pragma unroll
        for (int t = 0; t < 4; ++t)
#pragma unroll
            for (int ks = 0; ks < 4; ++ks) fa[t][ks] = ld_frag(buf + SC_W + t * 4096, oW[ks][0], oW[ks][1]);
        SCHED_BARRIER();
        f32x4 vn[4];
#pragma unroll
        for (int t = 0; t < 4; ++t) vn[t] = (f32x4){0.f, 0.f, 0.f, 0.f};
#pragma unroll
        for (int ks = 0; ks < (SV == 3 ? 0 : 4); ++ks)
#pragma unroll
            for (int t = 0; t < 4; ++t) vn[t] = MFMA16(fa[t][ks], Bs[ks], vn[t]);
#pragma unroll
        for (int t = 0; t < 4; ++t) { const f32x4 u = (f32x4){bflo(uf[t].x), bfhi(uf[t].x), bflo(uf[t].y), bfhi(uf[t].y)}; vn[t] = u - vn[t]; }
        SCHED_BARRIER();
        bf16x8 fk[8][2];
#pragma unroll
        for (int m = 0; m < 8; ++m)
#pragma unroll
            for (int ks = 0; ks < 2; ++ks) fk[m][ks] = ld_frag(buf + SC_KDT + m * 2048, oH[ks][0], oH[ks][1]);
        SCHED_BARRIER();
        bf16x8 Vb[2];
        Vb[0] = pack_b(vn[0], vn[1]); Vb[1] = pack_b(vn[2], vn[3]);
#pragma unroll
        for (int m = 0; m < 8; ++m) S[m] = S[m] * glast;
#pragma unroll
        for (int ks = 0; ks < 2; ++ks)
#pragma unroll
            for (int m = 0; m < 8; ++m) S[m] = MFMA16(fk[m][ks], Vb[ks], S[m]);
#pragma unroll
        for (int t = 0; t < 4; ++t)
#pragma unroll
            for (int ks = 0; ks < 4; ++ks) fa[t][ks] = ld_frag(buf + SC_QD + t * 4096, oW[ks][0], oW[ks][1]);
        bf16x8 fi[4][2];
#pragma unroll
        for (int t = 0; t < 4; ++t)
#pragma unroll
            for (int ks = 0; ks < 2; ++ks) fi[t][ks] = ld_frag(buf + SC_IA + t * 2048, oH[ks][0], oH[ks][1]);
        SCHED_BARRIER();
        f32x4 oa[4];
#pragma unroll
        for (int t = 0; t < 4; ++t) oa[t] = (f32x4){0.f, 0.f, 0.f, 0.f};
        if (SV != 2) {
#pragma unroll
        for (int ks = 0; ks < 4; ++ks)
#pragma unroll
            for (int t = 0; t < 4; ++t) oa[t] = MFMA16(fa[t][ks], Bs[ks], oa[t]);
#pragma unroll
        for (int ks = 0; ks < 2; ++ks)
#pragma unroll
            for (int t = 0; t < 4; ++t) oa[t] = MFMA16(fi[t][ks], Vb[ks], oa[t]);
#pragma unroll
        for (int t = 0; t < 4; ++t) {
            u32x2 w; w.x = cvtpk(oa[t][0], oa[t][1]); w.y = cvtpk(oa[t][2], oa[t][3]);
            if (SV == 4) { asm volatile("" :: "v"(w.x), "v"(w.y)); } else
            *(u32x2*)(fp + (size_t)n * CSTEP + t * TSTEP) = w;
        }
        }
        WAIT_VM(4);
        }
        LBAR();
    }
    if (!loader && (wstate || SV != 0)) {
    float* so = SV != 0 ? (float*)(p.ws + WS_XB) + (size_t)grp * A_DK * A_DV : p.out + O_PDELTA + (((size_t)li * BATCH + s) * A_HEADS + h) * A_DK * A_DV;
#pragma unroll
    for (int m = 0; m < 8; ++m)
#pragma unroll
        for (int e = 0; e < 4; ++e) so[(size_t)(16 * m + 4 * (lane >> 4) + e) * A_DV + 16 * cw + (lane & 15)] = S[m][e];
    }
    LBAR();
}
constexpr int NM_PART = 0, NM_OST = 2048;
struct NormRaw { u32x2 of[4]; u32x4 z0, z1; };
__device__ __forceinline__ void norm_load(PrmRef p, int item, int tid, NormRaw& q) {
    const unsigned char* PROJ = (const unsigned char*)(p.ws + WS_PROJ);
    const int n = item % NCPS, grp = item / NCPS, h = grp % A_HEADS, s = grp / A_HEADS, R0 = s * SEQ + n * CHUNK;
    const int lane = tid & 63, wave = tid >> 6, r = tid >> 3, seg = tid & 7;
    const unsigned char* fp = PROJ + ((size_t)(R0 + wave * 8 + (lane >> 5)) * PLD + 2 * A_QK + h * A_DV) * 2 + (lane & 31) * 8;
#pragma unroll
    for (int t = 0; t < 4; ++t) q.of[t] = *(const u32x2*)(fp + (size_t)t * 2 * PLD * 2);
    const u32x4* zp = (const u32x4*)(PROJ + ((size_t)(R0 + r) * PLD + CONV_DIM + h * A_DV + 16 * seg) * 2); q.z0 = zp[0]; q.z1 = zp[1];
}
__device__ __forceinline__ void delta_norm_item(PrmRef p, int li, int item, int next_item, int tid, unsigned char* lds, NormRaw& raw) {
    unsigned char* PROJ = (unsigned char*)(p.ws + WS_PROJ);
    const int n = item % NCPS, grp = item / NCPS, h = grp % A_HEADS, s = grp / A_HEADS, R0 = s * SEQ + n * CHUNK;
    const int lane = tid & 63, wave = tid >> 6, g = lane >> 4, cl = lane & 15, r = tid >> 3, seg = tid & 7;
    float* PART = (float*)(lds + NM_PART);
    const float nw = p.a_norm_w[li * A_DV + 16 * wave + cl];
    const u32x4 z0 = raw.z0, z1 = raw.z1;
    f32x4 oa[4];
#pragma unroll
    for (int t = 0; t < 4; ++t) {
        oa[t] = (f32x4){bflo(raw.of[t].x), bfhi(raw.of[t].x), bflo(raw.of[t].y), bfhi(raw.of[t].y)};
        f32x4 q4;
#pragma unroll
        for (int e = 0; e < 4; ++e) q4[e] = sum16(oa[t][e] * oa[t][e]);
        if (cl < 4) PART[(16 * t + 4 * g + cl) * 8 + wave] = cl == 0 ? q4[0] : cl == 1 ? q4[1] : cl == 2 ? q4[2] : q4[3];
    }
    if (next_item >= 0) norm_load(p, next_item, tid, raw);
    LBAR();
#pragma unroll
    for (int t = 0; t < 4; ++t)
#pragma unroll
        for (int e = 0; e < 4; ++e) {
            const int row = 16 * t + 4 * g + e;
            const f32x4 p0 = *(const f32x4*)(PART + row * 8), p1 = *(const f32x4*)(PART + row * 8 + 4);
            const float ss = ((p0[0] + p0[1]) + (p0[2] + p0[3])) + ((p1[0] + p1[1]) + (p1[2] + p1[3]));
            *(bf16*)(lds + NM_OST + row * 272 + (16 * wave + cl) * 2) = (bf16)(cvtpk(oa[t][e] * fast_rsq(ss * (1.f / A_DV) + RMS_EPS) * nw, 0.f) & 0xffffu);
        }
    LBAR();
    {
        const u32x4 o0 = *(const u32x4*)(lds + NM_OST + r * 272 + 32 * seg), o1 = *(const u32x4*)(lds + NM_OST + r * 272 + 32 * seg + 16);
        u32x4 w0, w1;
#pragma unroll
        for (int e = 0; e < 4; ++e) {
            w0[e] = cvtpk(bflo(o0[e]) * fsilu(bflo(z0[e])), bfhi(o0[e]) * fsilu(bfhi(z0[e])));
            w1[e] = cvtpk(bflo(o1[e]) * fsilu(bflo(z1[e])), bfhi(o1[e]) * fsilu(bfhi(z1[e])));
        }
        u32x4* dst = (u32x4*)(PROJ + ((size_t)(R0 + r) * PLD + 2 * A_QK + h * A_DV + 16 * seg) * 2); dst[0] = w0; dst[1] = w1;
    }
    LBAR();
}
__device__ __forceinline__ void ph_a_norm(PrmRef p, const Ctx& c, int li, unsigned char* lds) {
    NormRaw raw;
    if (c.bid < NPI) norm_load(p, c.bid, c.tid, raw);
    for (int item = c.bid; item < NPI; item += c.nblk) delta_norm_item(p, li, item, item + c.nblk < NPI ? item + c.nblk : -1, c.tid, lds, raw);
    bf16* PROJ = (bf16*)(p.ws + WS_PROJ);
    sgemm_rows(p, PROJ + 2 * A_QK, PLD, (const bf16*)(p.ws + WS_WAOUT) + (size_t)li * D_MODEL * A_VW, A_VW, PROJ, PLD, PT, ST, D_MODEL, c, NPI, lds);
}
__device__ __forceinline__ void sample_conv(PrmRef p, const Ctx& c, int li) {
    bf16* PROJ = (bf16*)(p.ws + WS_PROJ);
    const float* cw = p.a_conv_w + (size_t)li * CONV_W * CONV_DIM;
    for (int it = c.gtid; it < DEC_BATCH * CONV_DIM; it += c.nthreads) {
        const int ch = it % CONV_DIM, b = it / CONV_DIM;
        const float* sp = p.state_conv + (((size_t)li * DEC_BATCH + b) * 3) * CONV_DIM + ch;
        float h0 = sp[0], h1 = sp[CONV_DIM], h2 = sp[2 * CONV_DIM];
        const float w0 = cw[ch], w1 = cw[CONV_DIM + ch], w2 = cw[2 * CONV_DIM + ch], w3 = cw[3 * CONV_DIM + ch];
        bf16* e0 = PROJ + (size_t)(PT + b * DEC_SEQ) * PLD + ch;
        bf16 xv[DEC_SEQ];
#pragma unroll
        for (int t = 0; t < DEC_SEQ; ++t) xv[t] = e0[(size_t)t * PLD];
#pragma unroll
        for (int t = 0; t < DEC_SEQ; ++t) {
            const float x = bf2f(xv[t]);
            const float y = w0 * h0 + w1 * h1 + w2 * h2 + w3 * x;
            e0[(size_t)t * PLD] = (bf16)(cvtpk(fsilu(y), 0.f) & 0xffffu); h0 = h1; h1 = h2; h2 = x;
        }
        float* so = p.out + O_SCONV + (((size_t)li * DEC_BATCH + b) * 3) * CONV_DIM + ch;
        so[0] = h0; so[CONV_DIM] = h1; so[2 * CONV_DIM] = h2;
    }
}
__device__ __forceinline__ void sample_scan_group(PrmRef p, int li, int sg, int tid, unsigned char* lds, bool wstate = true) {
    bf16* PROJ = (bf16*)(p.ws + WS_PROJ); const float* GB = (const float*)(p.ws + WS_GB);
    float* kq = (float*)lds;
    const int b = sg / A_HEADS, h = sg % A_HEADS, r0 = PT + b * DEC_SEQ, col = tid >> 2, part = tid & 3, lane = tid & 63, wave = tid >> 6;
    float S[32];
    const float* s0 = p.state_delta + (((size_t)li * DEC_BATCH + b) * A_HEADS + h) * A_DK * A_DV;
#pragma unroll
    for (int k = 0; k < 32; ++k) S[k] = s0[(size_t)(part * 32 + k) * A_DV + col];
    for (int t = 0; t < DEC_SEQ; ++t) {
        const size_t rb = (size_t)(r0 + t) * PLD;
        __syncthreads();
        if (wave < 2) {
            const bf16* e = PROJ + rb + (wave == 0 ? A_QK : 0) + h * A_DK + 2 * lane;
            const float a = bf2f(e[0]), bb = bf2f(e[1]);
            const float sc = (1.f / sqrtf(wave_sum(a * a + bb * bb) + RMS_EPS)) * (wave == 0 ? 1.f : 0.08838834764831845f);
            kq[wave * 128 + 2 * lane] = a * sc; kq[wave * 128 + 2 * lane + 1] = bb * sc;
        }
        __syncthreads();
        const float gg = GB[((size_t)(r0 + t) * A_HEADS + h) * 2], beta = GB[((size_t)(r0 + t) * A_HEADS + h) * 2 + 1];
        const float eg = expf(gg); const float v = bf2f(PROJ[rb + 2 * A_QK + h * A_DV + col]);
        const float* kk = kq + part * 32; const float* qq = kq + 128 + part * 32;
        float ks = 0.f;
#pragma unroll
        for (int k = 0; k < 32; ++k) { S[k] *= eg; ks += kk[k] * S[k]; }
        ks += __shfl_xor(ks, 1); ks += __shfl_xor(ks, 2);
        const float vn = (v - ks) * beta; float o = 0.f;
#pragma unroll
        for (int k = 0; k < 32; ++k) { S[k] += kk[k] * vn; o += qq[k] * S[k]; }
        o += __shfl_xor(o, 1); o += __shfl_xor(o, 2);
        if (part == 0) PROJ[rb + 2 * A_QK + h * A_DV + col] = (bf16)f2bf(o);
    }
    float* so = p.out + O_SDELTA + (((size_t)li * DEC_BATCH + b) * A_HEADS + h) * A_DK * A_DV;
    if (wstate) {
#pragma unroll
    for (int k = 0; k < 32; ++k) so[(size_t)(part * 32 + k) * A_DV + col] = S[k];
    }
    __syncthreads();
    const float* nw = p.a_norm_w + (size_t)li * A_DV;
#pragma unroll 1
    for (int i = 0; i < 4; ++i) {
        const int row = r0 + wave * 4 + i;
        bf16* e = PROJ + (size_t)row * PLD + 2 * A_QK + h * A_DV + 2 * lane; const bf16* z = PROJ + (size_t)row * PLD + CONV_DIM + h * A_DV + 2 * lane;
        const float a = bf2f(e[0]), bb = bf2f(e[1]);
        const float r = 1.f / sqrtf(wave_sum(a * a + bb * bb) * (1.f / A_DV) + RMS_EPS);
        e[0] = (bf16)f2bf(a * r * nw[2 * lane] * siluf(bf2f(z[0]))); e[1] = (bf16)f2bf(bb * r * nw[2 * lane + 1] * siluf(bf2f(z[1])));
    }
    __syncthreads();
}
template <int VAR = 0> __device__ __forceinline__ void ph_a_pre(PrmRef p, const Ctx& c, int li, unsigned char* lds) {
    RawTile xr;
    if (c.bid < NPI) { prepass_load_raw(p, c.bid, c.tid, xr); if (c.wave == 1) prepass_gcum(p, c.bid, c.lane, (float*)(lds + PP_GC)); }
    int prev = -1, pb = 0, cur_h = -1;
    for (int item = c.bid; item < NPI; item += c.nblk) {
        const int h = (item / NCPS) % A_HEADS;
        if (h != cur_h) {
            LBAR();
            for (int i = c.tid; i < 3 * 4 * 128; i += NTHR) { const int X = i / 512, j = (i / 128) & 3, ch = i & 127; ((float*)(lds + PP_CW))[i] = p.a_conv_w[((size_t)li * CONV_W + j) * CONV_DIM + X * A_QK + h * A_DK + ch]; }
            LBAR(); cur_h = h;
        }
        delta_prepass_item<VAR>(p, li, item, item + c.nblk < NPI ? item + c.nblk : -1, prev, pb, c.tid, lds, xr); prev = item; pb ^= 1;
    }
    if (prev >= 0) prepass_store_w(p, prev, c.tid, lds);
    LBAR();
    if (VAR == 0) sample_conv(p, c, li);
}
template <int SV = 0> __device__ __forceinline__ void ph_a_scan2(PrmRef p, const Ctx& c, int li, unsigned char* lds, bool wstate = true, bool do_prompt = true, bool do_sample = true) {
    const int v = (c.bid + c.nblk - ((2 * NPG) % c.nblk)) % c.nblk;
    if (do_sample) for (int sg = v; sg < NSG; sg += c.nblk) sample_scan_group(p, li, sg, c.tid, lds, wstate);
    if (SV == 0) {
        const int nfree = c.nblk > 2 * NPG ? c.nblk - 2 * NPG : 0;
        if (nfree == 0) weights_deferred(p, c, li, lds, c.gwave, c.nwaves); else if (v < nfree) weights_deferred(p, c, li, lds, v * (NTHR / 64) + c.wave, nfree * (NTHR / 64));
        LBAR();
    }
    if (do_prompt) for (int it = c.bid; it < 2 * NPG; it += c.nblk) delta_scan_group<SV>(p, li, it, c.tid, lds, wstate);
}

__device__ __forceinline__ void ph_ln(PrmRef p, const Ctx& c, const bf16* OUT, int ldo, const float* g, const float* b, bool last) {
    bf16* XB = (bf16*)(p.ws + WS_XB);
    constexpr int PER = D_MODEL / 64;
    constexpr int RB = 3;
    static_assert(PER % 8 == 0, "ln vector width");
    const int col0 = c.lane * PER;
    f32x4 gv[PER / 4], bv[PER / 4];
#pragma unroll
    for (int j = 0; j < PER / 4; ++j) { gv[j] = *(const f32x4*)(g + col0 + 4 * j); bv[j] = *(const f32x4*)(b + col0 + 4 * j); }
    for (int row0 = c.gwave; row0 < MT; row0 += RB * c.nwaves) {
        u32x4 xa[RB][PER / 8], oa[RB][PER / 8];
#pragma unroll
        for (int r = 0; r < RB; ++r) { const int row = row0 + r * c.nwaves;
            if (row < MT) {
#pragma unroll
                for (int j = 0; j < PER / 8; ++j) { xa[r][j] = *(const u32x4*)(XB + (size_t)row * D_MODEL + col0 + 8 * j); oa[r][j] = *(const u32x4*)(OUT + (size_t)row * ldo + col0 + 8 * j); } } }
#pragma unroll
        for (int r = 0; r < RB; ++r) { const int row = row0 + r * c.nwaves;
            if (row < MT) {
                float v[PER]; float s = 0.f;
#pragma unroll
                for (int j = 0; j < PER / 8; ++j)
#pragma unroll
                    for (int e = 0; e < 4; ++e) { v[8 * j + 2 * e] = DN_ALPHA * bflo(xa[r][j][e]) + bflo(oa[r][j][e]); v[8 * j + 2 * e + 1] = DN_ALPHA * bfhi(xa[r][j][e]) + bfhi(oa[r][j][e]); }
#pragma unroll
                for (int j = 0; j < PER; ++j) s += v[j];
                const float mean = wave_sum(s) * (1.f / D_MODEL); float q = 0.f;
#pragma unroll
                for (int j = 0; j < PER; ++j) { v[j] -= mean; q += v[j] * v[j]; }
                const float rstd = fast_rsq(wave_sum(q) * (1.f / D_MODEL) + LN_EPS);
#pragma unroll
                for (int j = 0; j < PER; ++j) v[j] = v[j] * rstd * gv[j >> 2][j & 3] + bv[j >> 2][j & 3];
#pragma unroll
                for (int j = 0; j < PER / 8; ++j) { u32x4 o;
#pragma unroll
                    for (int e = 0; e < 4; ++e) o[e] = cvtpk(v[8 * j + 2 * e], v[8 * j + 2 * e + 1]);
                    *(u32x4*)(XB + (size_t)row * D_MODEL + col0 + 8 * j) = o; }
                if (last) { float* yo = row < PT ? p.out + O_YP + (size_t)row * D_MODEL + col0 : p.out + O_YS + (size_t)(row - PT) * D_MODEL + col0;
#pragma unroll
                    for (int j = 0; j < PER; j += 4) *(f32x4*)(yo + j) = (f32x4){v[j], v[j + 1], v[j + 2], v[j + 3]}; }
            } }
    }
}
__device__ __forceinline__ float fast_exp2(float x) {
#ifdef EMU
    return exp2f(x);
#else
    return __builtin_amdgcn_exp2f(x);
#endif
}
__device__ __forceinline__ void b_cache_copies(PrmRef p, const Ctx& c) {
    bf16* CK = (bf16*)(p.ws + WS_CK); bf16* CVT = (bf16*)(p.ws + WS_CVT);
    for (int it = c.gtid; it < DEC_BATCH * WINDOW * B_KVW; it += c.nthreads) {
        const int dd = it % B_KVW, w = (it / B_KVW) % WINDOW, b = it / (B_KVW * WINDOW), kvh = dd / B_HD, d = dd % B_HD;
        CK[(((size_t)b * B_KV_HEADS + kvh) * WINDOW + w) * B_HD + d] = (bf16)f2bf(p.cache_k[it]);
        CVT[(((size_t)b * B_KV_HEADS + kvh) * B_HD + d) * WINDOW + w] = (bf16)f2bf(p.cache_v[it]);
    }
}
__device__ __forceinline__ void ph_b_gemm(PrmRef p, const Ctx& c, int lj, unsigned char* lds) {
    const bf16* XB = (const bf16*)(p.ws + WS_XB); bf16* PROJ = (bf16*)(p.ws + WS_PROJ); const bf16* Wt = (const bf16*)(p.ws + WS_WBIN) + (size_t)lj * B_N0 * D_MODEL;
    const int N = lj == 0 ? B_N0 : B_IN;
    pg8::Gemm g{XB, D_MODEL, Wt, PT, N, D_MODEL}; pg8::StaticOrder S; S.init(PT, N, c.nblk, c.bid);
    pg8::EpiBIn E{PROJ, PLD, (const float*)(p.ws + WS_ROPE), (bf16*)(p.ws + WS_VT)};
    __syncthreads();
    pg8::gemm_phase<pg8::EpiBIn, pg8::StaticOrder, true>((LAS unsigned char*)lds, g, S, E, c.tid);
    __syncthreads();
    sgemm_rows<2>(p, XB, D_MODEL, Wt, D_MODEL, PROJ, PLD, PT, ST, N, c, lj == 0 ? (PT / 256) * (B_N0 / 256) : 0, lds, true);
    if (lj == 0) b_cache_copies(p, c);
}
constexpr int AT_KPITCH = 144, AT_VPITCH = 392, AT_K = 0, AT_V = 192 * AT_KPITCH, AT_O = AT_V + 64 * AT_VPITCH + 64  , AT_OPITCH = 144;
static_assert(2 * SC_BUF <= 163840 - 64, "scan LDS");
static_assert(AT_O % 16 == 0 && AT_O + 256 * AT_OPITCH <= 131072, "attention LDS");
struct AttRaw { u32x4 k[3], v[3]; bf16x8 q[4]; };
__device__ __forceinline__ void att_load(PrmRef p, int ck, int kvh, int tid, AttRaw& raw) {
    const unsigned char* PROJ = (const unsigned char*)(p.ws + WS_PROJ); const unsigned char* VT = (const unsigned char*)(p.ws + WS_VT);
    const unsigned char* CK = (const unsigned char*)(p.ws + WS_CK); const unsigned char* CVT = (const unsigned char*)(p.ws + WS_CVT);
    const int lane = tid & 63, wave = tid >> 6, l31 = lane & 31, hi = lane >> 5;
    const bool smp = ck >= NCP; const int r0 = chunk_row0(ck);
    const int nc = smp ? 0 : ck % NCPS, nblk = smp ? 0 : (nc >= 2 ? 3 : nc + 1);
    if (!smp) {
        const int kfirst = r0 - (nblk - 1) * CHUNK;
#pragma unroll
        for (int j = 0; j < 3; ++j) if (j < nblk) { const int idx = tid + NTHR * j, key = idx >> 3, pc = idx & 7, d = (idx >> 3) & 63;
            raw.k[j] = *(const u32x4*)(PROJ + ((size_t)(kfirst + key) * PLD + B_IN + kvh * B_HD) * 2 + pc * 16);
            raw.v[j] = *(const u32x4*)(VT + ((((size_t)(ck - (nblk - 1) + j) * B_KV_HEADS + kvh) * B_HD + d) * 64) * 2 + pc * 16); }
    } else {
        const int b = ck - NCP;
#pragma unroll
        for (int j = 0; j < 3; ++j) { const int idx = tid + NTHR * j;
            if (idx < 160 * 8) { const int key = idx >> 3, pc = idx & 7;
                raw.k[j] = *(const u32x4*)(key < WINDOW ? CK + ((((size_t)b * B_KV_HEADS + kvh) * WINDOW + key) * B_HD) * 2 + pc * 16 : PROJ + ((size_t)(r0 + key - WINDOW) * PLD + B_IN + kvh * B_HD) * 2 + pc * 16); }
            if (idx < 64 * 20) { const int d = idx / 20, pc = idx % 20;
                raw.v[j] = *(const u32x4*)(pc < 16 ? CVT + ((((size_t)b * B_KV_HEADS + kvh) * B_HD + d) * WINDOW) * 2 + pc * 16 : VT + ((((size_t)ck * B_KV_HEADS + kvh) * B_HD + d) * 64) * 2 + (pc - 16) * 16); } }
    }
    const bool active = smp ? wave < 4 : true;
    const int hq = kvh * B_GROUP + (smp ? wave : (wave >> 1)), qrow0 = smp ? 0 : 32 * (wave & 1);
    if (active) {
#pragma unroll
        for (int ks = 0; ks < 4; ++ks) raw.q[ks] = *(const bf16x8*)(PROJ + ((size_t)(r0 + qrow0 + l31) * PLD + hq * B_HD + 16 * ks + 8 * hi) * 2);
    }
}
__device__ __forceinline__ void att_item(PrmRef p, int lj, int ck, int kvh, int nck, int nkvh, int tid, unsigned char* lds, AttRaw& raw) {
#ifndef EMU
    asm volatile("" : "+v"(tid));
#endif
    unsigned char* PROJ = (unsigned char*)(p.ws + WS_PROJ);
    const int lane = tid & 63, wave = READFIRSTLANE(tid >> 6), l31 = lane & 31, hi = lane >> 5;
    const bool smp = ck >= NCP; const int r0 = chunk_row0(ck);
    const int nc = smp ? 0 : ck % NCPS, nblk = smp ? 0 : (nc >= 2 ? 3 : nc + 1);
    const int nkt = smp ? 5 : 2 * nblk;
    if (!smp) {
#pragma unroll
        for (int j = 0; j < 3; ++j) if (j < nblk) { const int idx = tid + NTHR * j, key = idx >> 3, pc = idx & 7, d = (idx >> 3) & 63;
            *(u32x4*)(lds + AT_K + key * AT_KPITCH + pc * 16) = raw.k[j];
            unsigned char* dst = lds + AT_V + d * AT_VPITCH + j * 128 + pc * 16; *(u32x2*)dst = (u32x2){raw.v[j].x, raw.v[j].y}; *(u32x2*)(dst + 8) = (u32x2){raw.v[j].z, raw.v[j].w}; }
    } else {
#pragma unroll
        for (int j = 0; j < 3; ++j) { const int idx = tid + NTHR * j;
            if (idx < 160 * 8) { const int key = idx >> 3, pc = idx & 7; *(u32x4*)(lds + AT_K + key * AT_KPITCH + pc * 16) = raw.k[j]; }
            if (idx < 64 * 20) { const int d = idx / 20, pc = idx % 20; unsigned char* dst = lds + AT_V + d * AT_VPITCH + pc * 16; *(u32x2*)dst = (u32x2){raw.v[j].x, raw.v[j].y}; *(u32x2*)(dst + 8) = (u32x2){raw.v[j].z, raw.v[j].w}; } }
    }
    const bool active = smp ? wave < 4 : true;
    const int hq = kvh * B_GROUP + (smp ? wave : (wave >> 1));
    bf16x8 qf[4];
#pragma unroll
    for (int ks = 0; ks < 4; ++ks) qf[ks] = raw.q[ks];
    LBAR();
    if (nck >= 0) att_load(p, nck, nkvh, tid, raw);
    const int nrows = smp ? 128 : 256;
    u32x4 zr[4];
    if (active) {
        f32x16 sc[6];
#pragma unroll
        for (int kt = 0; kt < 6; ++kt) {
#pragma unroll
            for (int e = 0; e < 16; ++e) sc[kt][e] = 0.f;
            if (kt < nkt) {
#pragma unroll
                for (int ks = 0; ks < 4; ++ks) sc[kt] = MFMA32(*(const bf16x8*)(lds + AT_K + (32 * kt + l31) * AT_KPITCH + 32 * ks + 16 * hi), qf[ks], sc[kt]);
            }
        }
        const float sink = p.b_sinks[lj * B_Q_HEADS + hq];
        float m = sink;
#pragma unroll
        for (int kt = 0; kt < 6; ++kt) if (kt < nkt) {
#pragma unroll
            for (int e = 0; e < 16; ++e) m = fmaxf(m, sc[kt][e]); }
        m = fmaxf(m, __shfl_xor(m, 32));
        float l = 0.f; const float ml2 = m * 1.4426950408889634f;
#pragma unroll
        for (int kt = 0; kt < 6; ++kt) if (kt < nkt) {
#pragma unroll
            for (int e = 0; e < 16; ++e) { const float pe = fast_exp2(sc[kt][e] * 1.4426950408889634f - ml2); sc[kt][e] = pe; l += pe; } }
        l += __shfl_xor(l, 32);
        l += fast_exp2(sink * 1.4426950408889634f - ml2);
        f32x16 o[2];
#pragma unroll
        for (int e = 0; e < 16; ++e) { o[0][e] = 0.f; o[1][e] = 0.f; }
#pragma unroll
        for (int kt = 0; kt < 6; ++kt) if (kt < nkt) {
#pragma unroll
            for (int s = 0; s < 2; ++s) {
                u32x4 pw; pw.x = cvtpk(sc[kt][8 * s], sc[kt][8 * s + 1]); pw.y = cvtpk(sc[kt][8 * s + 2], sc[kt][8 * s + 3]); pw.z = cvtpk(sc[kt][8 * s + 4], sc[kt][8 * s + 5]); pw.w = cvtpk(sc[kt][8 * s + 6], sc[kt][8 * s + 7]);
                const bf16x8 pb = __builtin_bit_cast(bf16x8, pw);
#pragma unroll
                for (int mt = 0; mt < 2; ++mt) {
                    const unsigned char* vp = lds + AT_V + (32 * mt + l31) * AT_VPITCH + (32 * kt + 16 * s + 4 * hi) * 2;
                    const u32x2 a0 = *(const u32x2*)vp, a1 = *(const u32x2*)(vp + 16);
                    u32x4 aw; aw.x = a0.x; aw.y = a0.y; aw.z = a1.x; aw.w = a1.y;
                    o[mt] = MFMA32(__builtin_bit_cast(bf16x8, aw), pb, o[mt]);
                }
            }
        }
        const float il = fast_rcp(l);
        unsigned char* orow = lds + AT_O + (32 * wave + l31) * AT_OPITCH;
#pragma unroll
        for (int mt = 0; mt < 2; ++mt)
#pragma unroll
            for (int cg4 = 0; cg4 < 4; ++cg4) {
                u32x2 w2; w2.x = cvtpk(o[mt][4 * cg4] * il, o[mt][4 * cg4 + 1] * il); w2.y = cvtpk(o[mt][4 * cg4 + 2] * il, o[mt][4 * cg4 + 3] * il);
                *(u32x2*)(orow + (32 * mt + 8 * cg4 + 4 * hi) * 2) = w2;
            }
    }
#pragma unroll
    for (int i = 0; i < 4; ++i) { const int idx = tid + NTHR * i;
        if (idx < nrows * 8) { const int qr = idx >> 3, pc = idx & 7, w = qr >> 5, hq2 = kvh * B_GROUP + (smp ? w : (w >> 1)), row = r0 + (smp ? 0 : 32 * (w & 1)) + (qr & 31);
            zr[i] = *(const u32x4*)(PROJ + ((size_t)row * PLD + B_QW + hq2 * B_HD) * 2 + pc * 16); } }
    LBAR();
#pragma unroll
    for (int i = 0; i < 4; ++i) { const int idx = tid + NTHR * i;
        if (idx < nrows * 8) { const int qr = idx >> 3, pc = idx & 7, w = qr >> 5, hq2 = kvh * B_GROUP + (smp ? w : (w >> 1)), row = r0 + (smp ? 0 : 32 * (w & 1)) + (qr & 31);
            const u32x4 ov = *(const u32x4*)(lds + AT_O + qr * AT_OPITCH + pc * 16); const u32x4 zv = zr[i];
            u32x4 r;
#pragma unroll
            for (int e = 0; e < 4; ++e) r[e] = cvtpk(bflo(ov[e]) * fsilu(bflo(zv[e])), bfhi(ov[e]) * fsilu(bfhi(zv[e])));
            *(u32x4*)(PROJ + ((size_t)row * PLD + hq2 * B_HD) * 2 + pc * 16) = r; } }
    LBAR();
}
__device__ __forceinline__ void ph_b_att2(PrmRef p, const Ctx& c, int lj, bool first, unsigned char* lds) {
    AttRaw raw;
    if (c.bid < NCH * B_KV_HEADS) att_load(p, c.bid / B_KV_HEADS, c.bid % B_KV_HEADS, c.tid, raw);
    for (int it = c.bid; it < NCH * B_KV_HEADS; it += c.nblk) { const int nx = it + c.nblk < NCH * B_KV_HEADS ? it + c.nblk : -1;
        att_item(p, lj, it / B_KV_HEADS, it % B_KV_HEADS, nx < 0 ? -1 : nx / B_KV_HEADS, nx < 0 ? 0 : nx % B_KV_HEADS, c.tid, lds, raw); }
    if (first) {
        const bf16* PROJ = (const bf16*)(p.ws + WS_PROJ);
        for (int it = c.gtid; it < (BATCH + DEC_BATCH) * WINDOW * B_KVW; it += c.nthreads) {
            const int e = it % B_KVW, w = (it / B_KVW) % WINDOW, s = it / (B_KVW * WINDOW);
            if (s < BATCH) { const int row = s * SEQ + SEQ - WINDOW + w; const bf16* kp = PROJ + (size_t)row * PLD + B_IN;
                p.out[O_PK + ((size_t)s * WINDOW + w) * B_KVW + e] = bf2f(kp[e]); p.out[O_PV + ((size_t)s * WINDOW + w) * B_KVW + e] = bf2f(kp[B_KVW + e]); }
            else { const int b = s - BATCH; float kx, vx;
                if (w < WINDOW - DEC_SEQ) { kx = p.cache_k[((size_t)b * WINDOW + w + DEC_SEQ) * B_KVW + e]; vx = p.cache_v[((size_t)b * WINDOW + w + DEC_SEQ) * B_KVW + e]; }
                else { const int row = PT + b * DEC_SEQ + (w - (WINDOW - DEC_SEQ)); const bf16* kp = PROJ + (size_t)row * PLD + B_IN; kx = bf2f(kp[e]); vx = bf2f(kp[B_KVW + e]); }
                p.out[O_SK + ((size_t)b * WINDOW + w) * B_KVW + e] = kx; p.out[O_SV + ((size_t)b * WINDOW + w) * B_KVW + e] = vx; }
        }
    }
}

#ifndef EMU
#define XB_TMO      128
#define XB_XCNT(j)  (256  + 64 * (j))
#define XB_XSUB(j)  (1280 + 64 * (j))
#define XB_XGEN(j)  (2304 + 64 * (j))
#define XB_TOP      3328
#define XB_TOPGEN   3392
#define XCD_BAR_WORDS 3456
#define XB_SPIN_CAP (1u << 20)
__device__ __forceinline__ unsigned xb_ld(unsigned* p)              { return __hip_atomic_load(p, __ATOMIC_RELAXED, __HIP_MEMORY_SCOPE_AGENT); }
__device__ __forceinline__ unsigned xb_add(unsigned* p, unsigned v) { return __hip_atomic_fetch_add(p, v, __ATOMIC_RELAXED, __HIP_MEMORY_SCOPE_AGENT); }
__device__ __forceinline__ unsigned xb_xcc_id() { return (unsigned)__builtin_amdgcn_s_getreg((3 << 11) | 20) & 0xFu; }
#define XB_SPIN(cond, bar) do { unsigned _sp = 0; while (cond) { __builtin_amdgcn_s_sleep(1); \
    if ((++_sp & 255u) == 0u) { if (xb_ld(&(bar)[XB_TMO])) break; if (_sp > XB_SPIN_CAP) { atomicAdd(&(bar)[XB_TMO], 1u); break; } } } } while (0)
__device__ __forceinline__ void xcd_barrier_complete(unsigned* bar, unsigned x, unsigned& nloc, unsigned& nx) {
    const unsigned G = gridDim.x * gridDim.y * gridDim.z;
    unsigned sum, cnt, mine, sp = 0u;
    for (;;) {
        sum = 0u; cnt = 0u; mine = 0u;
#pragma unroll
        for (unsigned j = 0; j < 16; ++j) { const unsigned c = xb_ld(&bar[XB_XCNT(j)]); sum += c; cnt += (c > 0u) ? 1u : 0u; mine = (j == x) ? c : mine; }
        if (sum == G) break;
        __builtin_amdgcn_s_sleep(1);
        if ((++sp & 255u) == 0u) { if (xb_ld(&bar[XB_TMO])) break; if (sp > XB_SPIN_CAP) { atomicAdd(&bar[XB_TMO], 1u); break; } }
    }
    nloc = mine > 0u ? mine : 1u; nx = cnt > 0u ? cnt : 1u;
}
__device__ __forceinline__ void xcd_barrier(unsigned* bar, volatile LAS unsigned* st, const int tid) {
    asm volatile("s_waitcnt vmcnt(0)" ::: "memory");
    __syncthreads();
    if (tid == 0) {
        __builtin_amdgcn_s_waitcnt(0);
        const unsigned x = xb_xcc_id();
        unsigned nloc = st[0], nx = st[1];
        if (nloc == 0u) { xcd_barrier_complete(bar, x, nloc, nx); st[0] = nloc; st[1] = nx; }
        const unsigned old = xb_add(&bar[XB_XSUB(x)], 1u);
        const unsigned gen = old / nloc;
        if (old + 1u == (gen + 1u) * nloc) {
            __builtin_amdgcn_fence(__ATOMIC_RELEASE, "agent");
            asm volatile("s_waitcnt vmcnt(0)" ::: "memory");
            const unsigned og = xb_add(&bar[XB_TOP], 1u);
            const unsigned tg = og / nx;
            if (og + 1u == (tg + 1u) * nx) xb_add(&bar[XB_TOPGEN], 1u);
            else XB_SPIN(xb_ld(&bar[XB_TOPGEN]) == tg, bar);
            __builtin_amdgcn_fence(__ATOMIC_ACQUIRE, "agent");
            xb_add(&bar[XB_XGEN(x)], 1u);
            asm volatile("s_waitcnt vmcnt(0)" ::: "memory");
        } else {
            XB_SPIN(xb_ld(&bar[XB_XGEN(x)]) == gen, bar);
            __builtin_amdgcn_fence(__ATOMIC_ACQUIRE, "agent");
            asm volatile("s_waitcnt vmcnt(0)" ::: "memory");
        }
    }
    __syncthreads();
}
#endif
constexpr int PH_A0 = 1, PH_APER = 6, PH_B0 = PH_A0 + N_A * PH_APER, PH_BPER = 4, N_PHASES = PH_B0 + N_B * PH_BPER;
constexpr int LDS_BAR_OFF = 163840 - 64;
constexpr int LDS_BYTES = 163840;
#ifdef EMU
#define DECL_LDS(name) unsigned char* name = emu::blk()->lds
#else
#define DECL_LDS(name) extern __shared__ __attribute__((aligned(16))) unsigned char name[]
#endif

#ifdef EMU
#define PH_PROLOGUE() PrmRef p = p_; int tid_ = threadIdx.x, bid_ = blockIdx.x;
#define GRID_SYNC()
#else
#define PH_PROLOGUE() const __attribute__((address_space(4))) Prm* pp = (const __attribute__((address_space(4))) Prm*)__builtin_amdgcn_kernarg_segment_ptr(); \
    int tid_ = wave_s_ * 64 + (int)__builtin_amdgcn_mbcnt_hi(~0u, __builtin_amdgcn_mbcnt_lo(~0u, 0u)), bid_ = blockIdx.x; asm volatile("" : "+s"(pp), "+v"(tid_), "+s"(bid_)); PrmRef p = *pp;
#define GRID_SYNC() xcd_barrier((unsigned*)(p.ws + WS_CTL), (volatile LAS unsigned*)(lds + LDS_BAR_OFF), c.tid)
#endif
#define PHASE(k, ...) if (ph_lo <= (k) && (k) < ph_hi) { PH_PROLOGUE() \
        Ctx c; c.tid = tid_; c.lane = c.tid & 63; c.wave = c.tid >> 6; c.bid = bid_; c.nblk = gridDim.x; \
        c.gtid = c.bid * NTHR + c.tid; c.nthreads = c.nblk * NTHR; c.gwave = c.bid * (NTHR / 64) + c.wave; c.nwaves = c.nblk * (NTHR / 64); \
        bf16* PROJ = (bf16*)(p.ws + WS_PROJ); const bf16* XB = (const bf16*)(p.ws + WS_XB); (void)PROJ; (void)XB; \
        __VA_ARGS__; \
        if ((k) + 1 < ph_hi) { GRID_SYNC(); } }
#define A_LAYER(li) \
    PHASE(PH_A0 + (li) * PH_APER + 0, ph_a_gemm(p, c, li, lds)) \
    PHASE(PH_A0 + (li) * PH_APER + 1, ph_a_pre(p, c, li, lds)) \
    PHASE(PH_A0 + (li) * PH_APER + 2, ph_a_scan2(p, c, li, lds)) \
    PHASE(PH_A0 + (li) * PH_APER + 3, ph_a_norm(p, c, li, lds)) \
    PHASE(PH_A0 + (li) * PH_APER + 4, gemm_mfma(PROJ + 2 * A_QK, PLD, (const bf16*)(p.ws + WS_WAOUT) + (size_t)(li) * D_MODEL * A_VW, PROJ, PLD, PT, D_MODEL, A_VW, c, lds)) \
    PHASE(PH_A0 + (li) * PH_APER + 5, ph_ln(p, c, PROJ, PLD, p.a_ln_g + (size_t)(li) * D_MODEL, p.a_ln_b + (size_t)(li) * D_MODEL, false))
#define B_LAYER(lj) \
    PHASE(PH_B0 + (lj) * PH_BPER + 0, ph_b_gemm(p, c, lj, lds)) \
    PHASE(PH_B0 + (lj) * PH_BPER + 1, ph_b_att2(p, c, lj, (lj) == 0, lds)) \
    PHASE(PH_B0 + (lj) * PH_BPER + 2, gemm_mfma(PROJ, PLD, (const bf16*)(p.ws + WS_WBOUT) + (size_t)(lj) * D_MODEL * B_QW, PROJ + B_QW, PLD, PT, D_MODEL, B_QW, c, lds); \
        sgemm_rows(p, PROJ, PLD, (const bf16*)(p.ws + WS_WBOUT) + (size_t)(lj) * D_MODEL * B_QW, B_QW, PROJ + B_QW, PLD, PT, ST, D_MODEL, c, 0, lds)) \
    PHASE(PH_B0 + (lj) * PH_BPER + 3, ph_ln(p, c, PROJ + B_QW, PLD, p.b_ln_g + (size_t)(lj) * D_MODEL, p.b_ln_b + (size_t)(lj) * D_MODEL, (lj) == N_B - 1))

__global__ void __launch_bounds__(NTHR, 2) fwd_kernel(Prm p_, int ph_lo, int ph_hi) {
    DECL_LDS(lds);
#ifndef EMU
    const int wave_s_ = __builtin_amdgcn_readfirstlane((int)threadIdx.x >> 6);
    {
        if (threadIdx.x < 2) ((volatile LAS unsigned*)(lds + LDS_BAR_OFF))[threadIdx.x] = 0u;
        if (threadIdx.x == 0) (void)xb_add((unsigned*)(p_.ws + WS_CTL) + XB_XCNT(xb_xcc_id()), 1u);
        __syncthreads();
    }
#endif
    PHASE(0, ph_init(p, c); ph_weights(p, c, lds))
    A_LAYER(0)
    A_LAYER(1)
    B_LAYER(0)
    B_LAYER(1)
#ifdef PROBE_TAIL
    PROBE_TAIL
#endif
}

extern "C" void kernel_launch(void* const* d_in, const int* in_sizes, int n_in, void* d_out, int out_size, void* d_ws, size_t ws_size, hipStream_t stream) {
    if (n_in != 20 || (size_t)out_size != O_END || ws_size < WS_NEED) { fprintf(stderr, "kernel_launch: unexpected sizes n_in=%d out=%d ws=%zu (need %zu, out %zu)\n", n_in, out_size, ws_size, (size_t)WS_END, (size_t)O_END); return; }
    Prm p{};
    const float** pp = (const float**)&p;
    for (int i = 0; i < 20; ++i) pp[i] = (const float*)d_in[i];
    p.out = (float*)d_out; p.ws = (unsigned char*)d_ws;
#ifdef EMU
    const int grid = 8;
    const int stop = getenv("EMU_STOP") ? atoi(getenv("EMU_STOP")) : N_PHASES;
    for (int ph = 0; ph < N_PHASES && ph < stop; ++ph) { emu::launch([=]() { fwd_kernel(p, ph, ph + 1); }, dim3(grid), dim3(NTHR), LDS_BYTES); fprintf(stderr, "phase %d done\n", ph); }
#else
    static int grid = 0;
    if (grid == 0) {
        int dev = 0, cus = 0, per_cu = 0;
        (void)hipGetDevice(&dev); (void)hipDeviceGetAttribute(&cus, hipDeviceAttributeMultiprocessorCount, dev);
        (void)hipFuncSetAttribute((const void*)fwd_kernel, hipFuncAttributeMaxDynamicSharedMemorySize, LDS_BYTES);
        (void)hipOccupancyMaxActiveBlocksPerMultiprocessor(&per_cu, (const void*)fwd_kernel, NTHR, LDS_BYTES);
        if (per_cu < 1) { fprintf(stderr, "kernel_launch: occupancy query says %d blocks per CU\n", per_cu); per_cu = 1; }
        grid = cus;
    }
    (void)hipMemsetAsync((char*)d_ws + WS_CTL, 0, 65536, stream);
#ifdef PROBE_TAIL
    int lo = 0, hi = N_PHASES + PROBE_NTAIL;
#else
    int lo = 0, hi = N_PHASES;
#endif
    void* args[] = {(void*)&p, (void*)&lo, (void*)&hi};
    hipError_t e = hipLaunchCooperativeKernel((const void*)fwd_kernel, dim3(grid), dim3(NTHR), args, LDS_BYTES, stream);
    if (e != hipSuccess) fprintf(stderr, "cooperative launch failed: %s (grid %d)\n", hipGetErrorString(e), grid);
#endif
}
```

```cpp
#ifdef EMU
#include "hip_emu.h"
#else
#include <hip/hip_runtime.h>
#include <hip/hip_cooperative_groups.h>
namespace cg = cooperative_groups;
#endif
#include <cstdint>
#include <cstddef>
#include <cstdio>

typedef short bf16x8 __attribute__((ext_vector_type(8)));
typedef float f32x4 __attribute__((ext_vector_type(4)));
typedef float f32x16 __attribute__((ext_vector_type(16)));
typedef unsigned u32x4 __attribute__((ext_vector_type(4)));
typedef unsigned u32x2 __attribute__((ext_vector_type(2)));
#ifdef EMU
#define LAS
#define WAVE_SYNC() emu::wave_sync()
#define GLDS16(gp, lp) memcpy((unsigned char*)(lp) + emu::lane_id() * 16, (const void*)(gp), 16)
typedef const unsigned char* BufRes;
#define MAKE_RES(p) ((const unsigned char*)(p))
#define BLDS16(res, voff, soff, lp) memcpy((unsigned char*)(lp) + emu::lane_id() * 16, (res) + (voff) + (soff), 16)
#define MFMA16(a, b, c) emu_mfma_16x16x32_bf16(a, b, c)
#define MFMA32(a, b, c) emu_mfma_32x32x16_bf16(a, b, c)
#define MFMAF(a, b, c) emu_mfma_16x16x4_f32(a, b, c)
#define SETPRIO(n)
#define SCHED_BARRIER()
#define S_BARRIER() emu::block_sync()
#define WAIT_VM(n)
#define WAIT_LGKM(n)
#define READFIRSTLANE(x) (x)
#define BCAST_LANE(v, n) __shfl(v, n)
#define LBAR() emu::block_sync()
#else
#define LAS __attribute__((address_space(3)))
#define WAVE_SYNC() asm volatile("s_waitcnt lgkmcnt(0)" ::: "memory")
#define GLDS16(gp, lp) __builtin_amdgcn_global_load_lds((const unsigned*)(gp), (LAS unsigned*)(lp), 16, 0, 0)
typedef __amdgpu_buffer_rsrc_t BufRes;
#define MAKE_RES(p) __builtin_amdgcn_make_buffer_rsrc((void*)(p), 0, 0x7fffffff, 0x00020000)
#define BLDS16(res, voff, soff, lp) __builtin_amdgcn_raw_ptr_buffer_load_lds(res, (LAS unsigned*)(lp), 16, (int)(voff), (int)(soff), 0, 0)
#define MFMA16(a, b, c) __builtin_amdgcn_mfma_f32_16x16x32_bf16(a, b, c, 0, 0, 0)
#define MFMA32(a, b, c) __builtin_amdgcn_mfma_f32_32x32x16_bf16(a, b, c, 0, 0, 0)
#define MFMAF(a, b, c) __builtin_amdgcn_mfma_f32_16x16x4f32(a, b, c, 0, 0, 0)
#define SETPRIO(n) __builtin_amdgcn_s_setprio(n)
#define SCHED_BARRIER() __builtin_amdgcn_sched_barrier(0)
#define S_BARRIER() __builtin_amdgcn_s_barrier()
#define WAIT_VM(n) asm volatile("s_waitcnt vmcnt(" #n ")" ::: "memory")
#define WAIT_LGKM(n) asm volatile("s_waitcnt lgkmcnt(" #n ")" ::: "memory")
#define READFIRSTLANE(x) __builtin_amdgcn_readfirstlane(x)
#define BCAST_LANE(v, n) __builtin_bit_cast(float, __builtin_amdgcn_readlane(__builtin_bit_cast(int, v), n))
#define LBAR() do { asm volatile("s_waitcnt lgkmcnt(0)" ::: "memory"); __builtin_amdgcn_s_barrier(); asm volatile("" ::: "memory"); } while (0)
#endif

#ifdef CFG_SMALL
constexpr int D_MODEL = 512, BATCH = 2, SEQ = 256, DEC_BATCH = 8, DEC_SEQ = 32, A_HEADS = 4, B_Q_HEADS = 8, B_KV_HEADS = 2;
#else
constexpr int D_MODEL = 1024, BATCH = 8, SEQ = 2048, DEC_BATCH = 16, DEC_SEQ = 32, A_HEADS = 8, B_Q_HEADS = 16, B_KV_HEADS = 4;
#endif
constexpr int PAST_LEN = 4096, CHUNK = 64, N_A = 2, N_B = 2, DEPTH = 4;
constexpr int A_DK = 128, A_DV = 128, A_QK = A_HEADS * A_DK, A_VW = A_HEADS * A_DV, CONV_W = 4, CONV_DIM = 2 * A_QK + A_VW;
constexpr int A_IN = CONV_DIM + A_VW + 2 * A_HEADS, A_MAIN = CONV_DIM + A_VW;
constexpr int B_GROUP = B_Q_HEADS / B_KV_HEADS, B_HD = 64, B_QW = B_Q_HEADS * B_HD, B_KVW = B_KV_HEADS * B_HD, B_IN = 2 * B_QW;
constexpr int WINDOW = 128, ROPE_DIMS = 16, ROPE_HALF = 8;
constexpr float LN_EPS = 1e-5f, RMS_EPS = 1e-6f;
constexpr float DN_ALPHA = 1.681792830507429f;
constexpr int PT = BATCH * SEQ, ST = DEC_BATCH * DEC_SEQ, MT = PT + ST, NSEQ = BATCH + DEC_BATCH;
constexpr int NCPS = SEQ / CHUNK, NCP = BATCH * NCPS, NCH = NCP + DEC_BATCH;
constexpr int PLD = A_MAIN > B_IN + 2 * B_KVW ? A_MAIN : B_IN + 2 * B_KVW;
static_assert(B_GROUP == 4, "attention wave map");
static_assert(PT % 256 == 0 && ST % 64 == 0 && D_MODEL % 256 == 0 && A_VW % 256 == 0 && B_QW % 256 == 0 && A_MAIN % 256 == 0 && D_MODEL % 256 == 0 && B_IN % 256 == 0 && (2 * B_KVW) % 256 == 0 && D_MODEL % 128 == 0 && D_MODEL >= 256, "gemm tiles");
static_assert(DEC_SEQ == 32 && WINDOW == 128 && CHUNK == 64, "fixed");

constexpr size_t O_YP = 0, O_YS = O_YP + (size_t)PT * D_MODEL, O_PDELTA = O_YS + (size_t)ST * D_MODEL;
constexpr size_t O_PCONV = O_PDELTA + (size_t)N_A * BATCH * A_HEADS * A_DK * A_DV, O_PK = O_PCONV + (size_t)N_A * BATCH * 3 * CONV_DIM;
constexpr size_t O_PV = O_PK + (size_t)BATCH * WINDOW * B_KVW, O_SDELTA = O_PV + (size_t)BATCH * WINDOW * B_KVW;
constexpr size_t O_SCONV = O_SDELTA + (size_t)N_A * DEC_BATCH * A_HEADS * A_DK * A_DV, O_SK = O_SCONV + (size_t)N_A * DEC_BATCH * 3 * CONV_DIM;
constexpr size_t O_SV = O_SK + (size_t)DEC_BATCH * WINDOW * B_KVW, O_END = O_SV + (size_t)DEC_BATCH * WINDOW * B_KVW;

constexpr size_t al256(size_t x) { return (x + 255) & ~(size_t)255; }
constexpr size_t WS_CTL = 0, WS_ROPE = 1u << 20;
constexpr size_t WS_GB = al256(WS_ROPE + (size_t)(SEQ + DEC_SEQ) * ROPE_HALF * 2 * 4);
constexpr size_t WS_HALO = al256(WS_GB + (size_t)MT * A_HEADS * 2 * 4);
constexpr size_t WS_XB = al256(WS_HALO + (size_t)NCH * 3 * CONV_DIM * 2);
constexpr size_t WS_PROJ = al256(WS_XB + (size_t)MT * D_MODEL * 2);
constexpr size_t WS_WAIN = al256(WS_PROJ + (size_t)MT * PLD * 2);
constexpr int A_NG = A_MAIN + 256;
constexpr size_t WS_WAOUT = al256(WS_WAIN + (size_t)N_A * A_NG * D_MODEL * 2);
constexpr int B_N0 = B_IN + 2 * B_KVW;
constexpr size_t WS_WBIN = al256(WS_WAOUT + (size_t)N_A * D_MODEL * A_VW * 2);
constexpr size_t WS_WBOUT = al256(WS_WBIN + (size_t)(B_N0 + B_IN) * D_MODEL * 2);
constexpr size_t WS_WB = al256(WS_WBOUT + (size_t)N_B * D_MODEL * B_QW * 2);
constexpr size_t WS_IA = al256(WS_WB + (size_t)PT * A_QK * 2);
constexpr size_t WS_GL = al256(WS_IA + (size_t)BATCH * A_HEADS * (SEQ / CHUNK) * 64 * 64 * 2);
constexpr size_t WS_END = al256(WS_GL + (size_t)BATCH * A_HEADS * (SEQ / CHUNK) * 4);
static_assert(WS_END <= ((size_t)256 << 20), "workspace");
constexpr size_t WS_VT = WS_WB, WS_CK = al256(WS_VT + (size_t)NCH * B_KV_HEADS * 64 * 64 * 2), WS_CVT = al256(WS_CK + (size_t)DEC_BATCH * B_KV_HEADS * 128 * 64 * 2);
constexpr size_t WS_BEND = al256(WS_CVT + (size_t)DEC_BATCH * B_KV_HEADS * 128 * 64 * 2), WS_NEED = WS_BEND > WS_END ? WS_BEND : WS_END;
static_assert(WS_NEED <= ((size_t)256 << 20), "workspace (B-layer buffers overlay the A-layer WB | IA | GL region)");

static_assert(N_B == 2, "weight map");

typedef unsigned short bf16;
constexpr int NTHR = 512;

struct Prm {
    const float *x_prompt, *x_sample, *state_delta, *state_conv, *cache_k, *cache_v, *a_w_in, *a_conv_w, *a_log, *a_dt_bias, *a_norm_w, *a_w_out, *a_ln_g, *a_ln_b,
        *b_w_kv, *b_w_in, *b_sinks, *b_w_out, *b_ln_g, *b_ln_b;
    float* out; unsigned char* ws;
};

__device__ __forceinline__ unsigned f2bf(float f) { unsigned u = __builtin_bit_cast(unsigned, f); return (u + 0x7fffu + ((u >> 16) & 1u)) >> 16; }
__device__ __forceinline__ float bf2f(bf16 h) { return __builtin_bit_cast(float, (unsigned)h << 16); }
__device__ __forceinline__ float siluf(float x) { return x / (1.f + expf(-x)); }
__device__ __forceinline__ float sigmoidf_(float x) { return 1.f / (1.f + expf(-x)); }
__device__ __forceinline__ float softplusf_(float x) { return x > 20.f ? x : log1pf(expf(x)); }
__device__ __forceinline__ float wave_sum(float v) {
#pragma unroll
    for (int o = 1; o < 64; o <<= 1) v += __shfl_xor(v, o);
    return v;
}

#ifdef EMU
__device__ __forceinline__ float fast_rcp(float x) { return 1.f / x; }
__device__ __forceinline__ float fast_rsq(float x) { return 1.f / sqrtf(x); }
__device__ __forceinline__ float fast_ex2(float x) { return exp2f(x); }
__device__ __forceinline__ unsigned cvtpk(float lo, float hi) { return f2bf(lo) | (f2bf(hi) << 16); }
__device__ __forceinline__ float dpp_xor1(float v) { return __shfl(v, emu::lane_id() ^ 1); }
__device__ __forceinline__ float dpp_xor2(float v) { return __shfl(v, emu::lane_id() ^ 2); }
__device__ __forceinline__ float dpp_hmirror(float v) { const int l = emu::lane_id(); return __shfl(v, (l & ~7) | (7 - (l & 7))); }
__device__ __forceinline__ float dpp_mirror(float v) { const int l = emu::lane_id(); return __shfl(v, (l & ~15) | (15 - (l & 15))); }
#else
__device__ __forceinline__ float fast_rcp(float x) { return __builtin_amdgcn_rcpf(x); }
__device__ __forceinline__ float fast_rsq(float x) { return __builtin_amdgcn_rsqf(x); }
__device__ __forceinline__ float fast_ex2(float x) { return __builtin_amdgcn_exp2f(x); }
__device__ __forceinline__ unsigned cvtpk(float lo, float hi) { typedef float f2_t __attribute__((ext_vector_type(2))); typedef __bf16 b2_t __attribute__((ext_vector_type(2)));
    f2_t v = {lo, hi}; b2_t b = __builtin_convertvector(v, b2_t); return __builtin_bit_cast(unsigned, b); }
template <int CTRL> __device__ __forceinline__ float dpp_mov(float v) { return __builtin_bit_cast(float, __builtin_amdgcn_update_dpp(0, __builtin_bit_cast(int, v), CTRL, 0xf, 0xf, true)); }
__device__ __forceinline__ float dpp_xor1(float v) { return dpp_mov<0xB1>(v); }
__device__ __forceinline__ float dpp_xor2(float v) { return dpp_mov<0x4E>(v); }
__device__ __forceinline__ float dpp_hmirror(float v) { return dpp_mov<0x141>(v); }
__device__ __forceinline__ float dpp_mirror(float v) { return dpp_mov<0x140>(v); }
#endif
__device__ __forceinline__ float sum8(float v) { v += dpp_xor1(v); v += dpp_xor2(v); v += dpp_hmirror(v); return v; }
__device__ __forceinline__ float sum16(float v) { v = sum8(v); v += dpp_mirror(v); return v; }
__device__ __forceinline__ float fsilu(float x) { return x * fast_rcp(1.f + fast_ex2(-1.4426950408889634f * x)); }
__device__ __forceinline__ float fexp(float x) { return fast_ex2(1.4426950408889634f * x); }
__device__ __forceinline__ float bflo(unsigned u) { return __builtin_bit_cast(float, u << 16); }
__device__ __forceinline__ float bfhi(unsigned u) { return __builtin_bit_cast(float, u & 0xffff0000u); }
__device__ __forceinline__ int seq_row0(int s) { return s < BATCH ? s * SEQ : PT + (s - BATCH) * DEC_SEQ; }
__device__ __forceinline__ int seq_len(int s) { return s < BATCH ? SEQ : DEC_SEQ; }
__device__ __forceinline__ int chunk_row0(int c) { return c < NCP ? c * CHUNK : PT + (c - NCP) * DEC_SEQ; }
__device__ __forceinline__ int chunk_len(int c) { return c < NCP ? CHUNK : DEC_SEQ; }
__device__ __forceinline__ int row_posidx(int row) { return row < PT ? (row % SEQ) : SEQ + ((row - PT) % DEC_SEQ); }

#ifdef EMU
typedef const Prm& PrmRef;
#else
typedef const __attribute__((address_space(4))) Prm& PrmRef;
#endif
struct Ctx { int tid, lane, wave, gtid, gwave, nthreads, nwaves, bid, nblk; };

namespace pg8 {
constexpr int BM = 256, BK = 64, HALF = 128, HTB = HALF * BK * 2  , STAGE_BYTES = 8 * HTB, NXCD = 8, WGM = 8;
__host__ __device__ __forceinline__ int lds_byte(int r, int c) { const int st = (r >> 4) * 2 + (c >> 5), rr = r & 15, cc = c & 31, ob = rr * 64 + cc * 2; return st * 1024 + (ob ^ (((ob >> 9) & 1) << 5)); }
__host__ __device__ __forceinline__ void stage_rc(int b, int& R, int& C) { const int st = b / 1024, sb = b % 1024, swz = sb ^ (((sb >> 9) & 1) << 5); R = (st >> 1) * 16 + swz / 64; C = (st & 1) * 32 + (swz % 64) / 2; }
__host__ __device__ __forceinline__ int perm32(int rho) { const int n = rho >> 4, i = rho & 15; return 8 * (i >> 2) + 4 * n + (i & 3); }
struct Unit { int pm, pn; };
struct Gemm { const bf16* A; int lda; const bf16* Bt; int M, N, K; };
struct StaticOrder {
    int nM, nN, nwg, G, c;
    __host__ __device__ void init(int M, int N, int G_, int c_) { nM = M / BM; nN = N / BM; nwg = nM * nN; G = G_; c = c_; }
    __host__ __device__ bool next(int i, Unit& u) const {
        const long L = (long)i * G + c; if (L >= nwg) return false;
        int wgid = (int)L; { const int q = nwg / NXCD, r = nwg % NXCD, xcd = wgid % NXCD, off = wgid / NXCD; wgid = (xcd < r ? xcd * (q + 1) : r * (q + 1) + (xcd - r) * q) + off; }
        const int nig = WGM * nN, gid = wgid / nig, fm = gid * WGM, gsz = (nM - fm) < WGM ? (nM - fm) : WGM;
        u.pm = fm + ((wgid % nig) % gsz); u.pn = (wgid % nig) / gsz; return true;
    }
};
__device__ __forceinline__ unsigned cvt_pk_bf16(float lo, float hi) {
#ifdef EMU
    return f2bf(lo) | (f2bf(hi) << 16);
#else
    unsigned r; asm volatile("v_cvt_pk_bf16_f32 %0, %1, %2" : "=v"(r) : "v"(lo), "v"(hi)); return r;
#endif
}
struct EpiBf16 {
    static constexpr bool PERM = true;
    bf16* O; int ldc;
    __device__ __forceinline__ void operator()(const f32x4 (&acc)[2][2][4][2], const Unit& u, int wr, int wc, int fr, int fq) const {
        int fr_ = fr, fq_ = fq;
#ifndef EMU
        asm volatile("" : "+v"(fr_), "+v"(fq_));
#endif
        const int row0 = u.pm * BM + wr * 64 + fr_, col0 = u.pn * BM + wc * 32 + 8 * fq_;
#pragma unroll
        for (int ai = 0; ai < 2; ++ai)
#pragma unroll
            for (int m = 0; m < 4; ++m) { bf16* rowp = O + (size_t)(row0 + ai * HALF + m * 16) * ldc + col0;
#pragma unroll
                for (int bj = 0; bj < 2; ++bj) { const f32x4 v0 = acc[ai][bj][m][0], v1 = acc[ai][bj][m][1];
                    u32x4 w; w.x = cvt_pk_bf16(v0[0], v0[1]); w.y = cvt_pk_bf16(v0[2], v0[3]); w.z = cvt_pk_bf16(v1[0], v1[1]); w.w = cvt_pk_bf16(v1[2], v1[3]);
                    *(u32x4*)(rowp + bj * HALF) = w; } }
    }
};
struct EpiAIn {
    static constexpr bool PERM = true;
    bf16* O; int ldc; bf16* HALO; float* pconv;
    __device__ __forceinline__ void operator()(const f32x4 (&acc)[2][2][4][2], const Unit& u, int wr, int wc, int fr, int fq) const {
        int fr_ = fr, fq_ = fq;
#ifndef EMU
        asm volatile("" : "+v"(fr_), "+v"(fq_));
#endif
        const int row0 = u.pm * BM + wr * 64 + fr_, col0 = u.pn * BM + wc * 32 + 8 * fq_;
#pragma unroll
        for (int ai = 0; ai < 2; ++ai)
#pragma unroll
            for (int m = 0; m < 4; ++m) { const int row = row0 + ai * HALF + m * 16; bf16* rowp = O + (size_t)row * ldc + col0;
#pragma unroll
                for (int bj = 0; bj < 2; ++bj) { const f32x4 v0 = acc[ai][bj][m][0], v1 = acc[ai][bj][m][1];
                    u32x4 w; w.x = cvt_pk_bf16(v0[0], v0[1]); w.y = cvt_pk_bf16(v0[2], v0[3]); w.z = cvt_pk_bf16(v1[0], v1[1]); w.w = cvt_pk_bf16(v1[2], v1[3]);
                    *(u32x4*)(rowp + bj * HALF) = w;
                    if (m == 3 && fr_ >= 13 && col0 + bj * HALF < CONV_DIM) {
                        const int ck = row >> 6, hr = fr_ - 13, col = col0 + bj * HALF;
                        *(u32x4*)(HALO + ((size_t)ck * 3 + hr) * CONV_DIM + col) = w;
                        if (ck % NCPS == NCPS - 1) { float* dst = pconv + ((size_t)(ck / NCPS) * 3 + hr) * CONV_DIM + col; *(f32x4*)dst = v0; *(f32x4*)(dst + 4) = v1; }
                    } } }
    }
};
struct EpiBIn {
    static constexpr bool PERM = true;
    bf16* O; int ldc; const float* rope; bf16* VT;
    __device__ __forceinline__ void operator()(const f32x4 (&acc)[2][2][4][2], const Unit& u, int wr, int wc, int fr, int fq) const {
        int fr_ = fr, fq_ = fq;
#ifndef EMU
        asm volatile("" : "+v"(fr_), "+v"(fq_));
#endif
        static_assert(B_QW % 128 == 0 && B_KVW % 128 == 0, "a 128-column half tile has one kind");
        const int ct = u.pn * BM;
        int kinds[2]; bool ropes[2];
#pragma unroll
        for (int bj = 0; bj < 2; ++bj) { const int cc = ct + bj * HALF; kinds[bj] = cc < B_QW ? 0 : cc < B_IN ? 1 : cc < B_IN + B_KVW ? 2 : 3;
            ropes[bj] = (kinds[bj] == 0 || kinds[bj] == 2) && (wc & 1) == 0; }
        const int row0 = u.pm * BM + wr * 64 + fr_, col0 = ct + wc * 32 + 8 * fq_;
#pragma unroll
        for (int ai = 0; ai < 2; ++ai)
#pragma unroll
            for (int m = 0; m < 4; ++m) { const int row = row0 + ai * HALF + m * 16; bf16* rowp = O + (size_t)row * ldc + col0;
                f32x4 cs[4];
                if (ropes[0] || ropes[1]) { const f32x4* rp = (const f32x4*)(rope + (size_t)(row % SEQ) * ROPE_HALF * 2);
#pragma unroll
                    for (int q4 = 0; q4 < 4; ++q4) cs[q4] = rp[q4]; }
#pragma unroll
                for (int bj = 0; bj < 2; ++bj) { f32x4 v0 = acc[ai][bj][m][0], v1 = acc[ai][bj][m][1]; const int kind = kinds[bj]; const float sc = kind == 0 ? 0.125f : 1.f;
                    if (ropes[bj]) {
                        float x[8] = {v0[0], v0[1], v0[2], v0[3], v1[0], v1[1], v1[2], v1[3]}, o[8];
#pragma unroll
                        for (int j = 0; j < 8; ++j) o[j] = __shfl_xor(x[j], 16);
                        if (fq_ < 2) {
#pragma unroll
                            for (int j = 0; j < 8; ++j) { const float c_ = cs[j >> 1][2 * (j & 1)], s_ = cs[j >> 1][2 * (j & 1) + 1]; x[j] = fq_ == 0 ? x[j] * c_ - o[j] * s_ : x[j] * c_ + o[j] * s_; }
                        }
                        v0 = (f32x4){x[0], x[1], x[2], x[3]}; v1 = (f32x4){x[4], x[5], x[6], x[7]};
                    }
                    v0 = v0 * sc; v1 = v1 * sc;
                    u32x4 w; w.x = cvt_pk_bf16(v0[0], v0[1]); w.y = cvt_pk_bf16(v0[2], v0[3]); w.z = cvt_pk_bf16(v1[0], v1[1]); w.w = cvt_pk_bf16(v1[2], v1[3]);
                    *(u32x4*)(rowp + bj * HALF) = w;
                    if (kind == 3) { const int dd = col0 + bj * HALF - (B_IN + B_KVW), kvh = dd / B_HD, d = dd % B_HD; bf16* vt = VT + (((size_t)(row >> 6) * B_KV_HEADS + kvh) * B_HD + d) * 64 + (row & 63);
                        vt[0] = (bf16)(w.x & 0xffffu); vt[64] = (bf16)(w.x >> 16); vt[128] = (bf16)(w.y & 0xffffu); vt[192] = (bf16)(w.y >> 16);
                        vt[256] = (bf16)(w.z & 0xffffu); vt[320] = (bf16)(w.z >> 16); vt[384] = (bf16)(w.w & 0xffffu); vt[448] = (bf16)(w.w >> 16); }
                } }
    }
};
template <class Epi, class Sched, bool ALIGN_EPI>
__device__ __forceinline__ void gemm_phase(LAS unsigned char* lds, const Gemm g, const Sched& S, const Epi& E, const int tid) {
    const int wid = READFIRSTLANE(tid >> 6), lane = tid & 63, wr = wid >> 2, wc = wid & 3, fr = lane & 15, fq = lane >> 4;
    const int K = g.K, nt = K / BK;
    unsigned voffA[2], voffB[2];
#pragma unroll
    for (int i = 0; i < 2; ++i) { int R, C; stage_rc(tid * 16 + i * 8192, R, C); const int Rb = Epi::PERM ? ((R & ~31) + perm32(R & 31)) : R;
        voffA[i] = (unsigned)(R * g.lda + C) * 2u; voffB[i] = (unsigned)(Rb * K + C) * 2u; }
    const unsigned kstep = (unsigned)(BK * 2);
    const unsigned hstepA = (unsigned)HALF * (unsigned)g.lda * 2u, hstepB = (unsigned)HALF * (unsigned)K * 2u;
    const unsigned tstepA = 2 * hstepA, tstepB = 2 * hstepB;
    const BufRes rA = MAKE_RES(g.A), rB = MAKE_RES(g.Bt);
    const unsigned ldsw = (unsigned)wid * 1024u;
    const int aoff = lds_byte(wr * 64 + fr, fq * 8), boff = lds_byte(wc * 32 + fr, fq * 8);
#define PG8_SA(b, h) (((b) * 2 + (h)) * HTB)
#define PG8_SB(b, h) ((4 + (b) * 2 + (h)) * HTB)
#define PG8_STAGE(bufoff, res, soff, voff) do { _Pragma("unroll") for (int _i = 0; _i < 2; ++_i) \
        BLDS16(res, (voff)[_i], soff, lds + (bufoff) + ldsw + _i * 8192); } while (0)
#define PG8_LDA(dst, b, h) do { _Pragma("unroll") for (int m = 0; m < 4; ++m) _Pragma("unroll") for (int k = 0; k < 2; ++k) dst[m][k] = *(const LAS bf16x8*)(lds + PG8_SA(b, h) + aoff + m * 2048 + k * 1024); } while (0)
#define PG8_LDB(dst, b, h) do { _Pragma("unroll") for (int n = 0; n < 2; ++n) _Pragma("unroll") for (int k = 0; k < 2; ++k) dst[n][k] = *(const LAS bf16x8*)(lds + PG8_SB(b, h) + boff + n * 2048 + k * 1024); } while (0)
#define PG8_MMA(ai, bj, At, Bt) do { SETPRIO(1); _Pragma("unroll") for (int m = 0; m < 4; ++m) _Pragma("unroll") for (int n = 0; n < 2; ++n) _Pragma("unroll") for (int k = 0; k < 2; ++k) \
        acc[ai][bj][m][n] = MFMA16(Bt[n][k], At[m][k], acc[ai][bj][m][n]); SETPRIO(0); } while (0)
#define PG8_MMAZ(ai, bj, At, Bt) do { SETPRIO(1); _Pragma("unroll") for (int m = 0; m < 4; ++m) _Pragma("unroll") for (int n = 0; n < 2; ++n) { \
        acc[ai][bj][m][n] = MFMA16(Bt[n][0], At[m][0], ((f32x4){0.f, 0.f, 0.f, 0.f})); acc[ai][bj][m][n] = MFMA16(Bt[n][1], At[m][1], acc[ai][bj][m][n]); } SETPRIO(0); } while (0)
    Unit cur, nxt; int ui = 0;
    if (!S.next(0, cur)) return;
    f32x4 acc[2][2][4][2];
#pragma unroll
    for (int a = 0; a < 2; ++a)
#pragma unroll
        for (int b = 0; b < 2; ++b)
#pragma unroll
            for (int m = 0; m < 4; ++m)
#pragma unroll
                for (int n = 0; n < 2; ++n) acc[a][b][m][n] = (f32x4){0.f, 0.f, 0.f, 0.f};
    bf16x8 At[4][2], B0[2][2], B1[2][2];
    unsigned cA = (unsigned)cur.pm * tstepA, cB = (unsigned)cur.pn * tstepB;
    PG8_STAGE(PG8_SB(0, 0), rB, cB, voffB); PG8_STAGE(PG8_SB(0, 1), rB, cB + hstepB, voffB); PG8_STAGE(PG8_SA(0, 0), rA, cA, voffA); PG8_STAGE(PG8_SA(0, 1), rA, cA + hstepA, voffA);
    if (wr == 1) S_BARRIER();
    WAIT_VM(2); S_BARRIER();
    PG8_STAGE(PG8_SB(1, 0), rB, cB + kstep, voffB); PG8_STAGE(PG8_SA(1, 0), rA, cA + kstep, voffA); PG8_STAGE(PG8_SB(1, 1), rB, cB + hstepB + kstep, voffB);
    WAIT_VM(6); S_BARRIER();
    for (;;) {
        const bool has_next = S.next(ui + 1, nxt);
        const unsigned nA = has_next ? (unsigned)nxt.pm * tstepA : cA, nB = has_next ? (unsigned)nxt.pn * tstepB : cB;
#define PG8_TRIP(W, LAST, MM) do { \
            const unsigned a1 = cA + (unsigned)(t + 1) * kstep; \
            const unsigned a2 = (LAST) ? nA : cA + (unsigned)(t + 2) * kstep, b2 = (LAST) ? nB : cB + (unsigned)(t + 2) * kstep; \
            const unsigned a3 = a2 + kstep, b3 = b2 + kstep; \
            PG8_LDB(B0, 0, 0); PG8_LDB(B1, 0, 1); SCHED_BARRIER(); PG8_LDA(At, 0, 0); PG8_STAGE(PG8_SA(1, 1), rA, a1 + hstepA, voffA); \
            WAIT_VM(W); WAIT_LGKM(0); S_BARRIER(); MM(0, 0, At, B0); MM(0, 1, At, B1); S_BARRIER(); SCHED_BARRIER(); \
            PG8_LDA(At, 0, 1); PG8_STAGE(PG8_SB(0, 0), rB, b2, voffB); PG8_STAGE(PG8_SB(0, 1), rB, b2 + hstepB, voffB); PG8_STAGE(PG8_SA(0, 0), rA, a2, voffA); \
            WAIT_VM(W); WAIT_LGKM(0); S_BARRIER(); MM(1, 0, At, B0); MM(1, 1, At, B1); S_BARRIER(); SCHED_BARRIER(); \
            PG8_LDB(B0, 1, 0); PG8_LDB(B1, 1, 1); SCHED_BARRIER(); PG8_LDA(At, 1, 0); PG8_STAGE(PG8_SA(0, 1), rA, a2 + hstepA, voffA); \
            WAIT_VM(8); WAIT_LGKM(0); S_BARRIER(); PG8_MMA(0, 0, At, B0); PG8_MMA(0, 1, At, B1); S_BARRIER(); SCHED_BARRIER(); \
            PG8_LDA(At, 1, 1); PG8_STAGE(PG8_SB(1, 0), rB, b3, voffB); PG8_STAGE(PG8_SB(1, 1), rB, b3 + hstepB, voffB); PG8_STAGE(PG8_SA(1, 0), rA, a3, voffA); \
            WAIT_VM(8); WAIT_LGKM(0); S_BARRIER(); PG8_MMA(1, 0, At, B0); PG8_MMA(1, 1, At, B1); S_BARRIER(); SCHED_BARRIER(); } while (0)
        int t = 0;
        if (ui > 0) { PG8_TRIP(24, false, PG8_MMAZ); t = 2; }
        for (; t < nt; t += 2) { const bool last = (t == nt - 2); PG8_TRIP(8, last, PG8_MMA); }
#undef PG8_TRIP
        if constexpr (ALIGN_EPI) { if (wr == 0) S_BARRIER(); }
        E(acc, cur, wr, wc, fr, fq);
        if (!has_next) break;
        cur = nxt; cA = nA; cB = nB; ++ui;
        if constexpr (ALIGN_EPI) { if (wr == 1) S_BARRIER(); }
    }
    WAIT_VM(0);
    if constexpr (!ALIGN_EPI) { if (wr == 0) S_BARRIER(); }
    S_BARRIER();
#undef PG8_SA
#undef PG8_SB
#undef PG8_STAGE
#undef PG8_LDA
#undef PG8_LDB
#undef PG8_MMA
#undef PG8_MMAZ
}
}
__device__ __forceinline__ void gemm_mfma(const bf16* A, int lda, const bf16* Bt, bf16* C, int ldc, int M, int N, int K, const Ctx& c, unsigned char* lds) {
    pg8::Gemm g{A, lda, Bt, M, N, K}; pg8::StaticOrder S; S.init(M, N, c.nblk, c.bid); pg8::EpiBf16 E{C, ldc};
    __syncthreads();
    pg8::gemm_phase<pg8::EpiBf16, pg8::StaticOrder, true>((LAS unsigned char*)lds, g, S, E, c.tid);
    __syncthreads();
}
__device__ __forceinline__ void transpose_item(const float* W, int ldw, int K, int N, bf16* WT, int row_off, float* scr, int item, int lane) {
    const int nblk = N / 64, kb = item / nblk, nb = item % nblk, k0 = 64 * kb, n0 = 64 * nb;
#pragma unroll 8
    for (int kk = 0; kk < 64; ++kk) scr[kk * 65 + lane] = W[(size_t)(k0 + kk) * ldw + n0 + lane];
    WAVE_SYNC();
    const int cc = lane & 7;
#pragma unroll
    for (int j = 0; j < 8; ++j) { const int n = (lane >> 3) + 8 * j; const float* sp = scr + (8 * cc) * 65 + n;
        u32x4 o; o.x = cvtpk(sp[0 * 65], sp[1 * 65]); o.y = cvtpk(sp[2 * 65], sp[3 * 65]); o.z = cvtpk(sp[4 * 65], sp[5 * 65]); o.w = cvtpk(sp[6 * 65], sp[7 * 65]);
        *(u32x4*)(WT + (size_t)(row_off + n0 + n) * K + k0 + 8 * cc) = o; }
    WAVE_SYNC();
}
constexpr int WI_AIN = (D_MODEL / 64) * (A_MAIN / 64), WI_AOUT = (A_VW / 64) * (D_MODEL / 64), WI_BIN = (D_MODEL / 64) * (B_IN / 64), WI_BKV = (D_MODEL / 64) * (2 * B_KVW / 64), WI_BOUT = (B_QW / 64) * (D_MODEL / 64);
constexpr int WI_A_END = N_A * (WI_AIN + WI_AOUT), WI_ALL = WI_A_END + N_B * (WI_BIN + WI_BOUT) + WI_BKV;
__device__ __forceinline__ void weights_range(PrmRef p, int lane, int wave, unsigned char* lds, int vw, int nvw, int lo, int hi) {
    float* scr = (float*)lds + wave * (64 * 65);
    bf16* WAIN = (bf16*)(p.ws + WS_WAIN); bf16* WAOUT = (bf16*)(p.ws + WS_WAOUT); bf16* WBIN = (bf16*)(p.ws + WS_WBIN); bf16* WBOUT = (bf16*)(p.ws + WS_WBOUT);
    for (int it = lo + vw; it < hi; it += nvw) {
        int r = it;
        if (r < N_A * WI_AIN) { const int li = r / WI_AIN; transpose_item(p.a_w_in + (size_t)li * D_MODEL * A_IN, A_IN, D_MODEL, A_MAIN, WAIN + (size_t)li * A_NG * D_MODEL, 0, scr, r % WI_AIN, lane); continue; } r -= N_A * WI_AIN;
        if (r < N_A * WI_AOUT) { const int li = r / WI_AOUT; transpose_item(p.a_w_out + (size_t)li * A_VW * D_MODEL, D_MODEL, A_VW, D_MODEL, WAOUT + (size_t)li * D_MODEL * A_VW, 0, scr, r % WI_AOUT, lane); continue; } r -= N_A * WI_AOUT;
        if (r < N_B * WI_BIN) { const int lj = r / WI_BIN; transpose_item(p.b_w_in + (size_t)lj * D_MODEL * B_IN, B_IN, D_MODEL, B_IN, WBIN + (size_t)lj * B_N0 * D_MODEL, 0, scr, r % WI_BIN, lane); continue; } r -= N_B * WI_BIN;
        if (r < N_B * WI_BOUT) { const int lj = r / WI_BOUT; transpose_item(p.b_w_out + (size_t)lj * B_QW * D_MODEL, D_MODEL, B_QW, D_MODEL, WBOUT + (size_t)lj * D_MODEL * B_QW, 0, scr, r % WI_BOUT, lane); continue; } r -= N_B * WI_BOUT;
        transpose_item(p.b_w_kv, 2 * B_KVW, D_MODEL, 2 * B_KVW, WBIN, B_IN, scr, r, lane);
    }
}
__device__ __forceinline__ void ph_weights(PrmRef p, const Ctx& c, unsigned char* lds) {
    weights_range(p, c.lane, c.wave, lds, c.gwave, c.nwaves, 0, WI_AIN);
    bf16* WAIN = (bf16*)(p.ws + WS_WAIN);
    for (int it = c.gtid; it < N_A * 256 * D_MODEL; it += c.nthreads) {
        const int k = it % D_MODEL, j = (it / D_MODEL) % 256, li = it / (256 * D_MODEL);
        WAIN[((size_t)li * A_NG + A_MAIN + j) * D_MODEL + k] = j < 2 * A_HEADS ? (bf16)f2bf(p.a_w_in[((size_t)li * D_MODEL + k) * A_IN + A_MAIN + j]) : (bf16)0;
    }
}
__device__ __forceinline__ void weights_deferred(PrmRef p, int lane, int wave, int li, unsigned char* lds, int vw, int nvw) {
    static_assert(N_A == 2, "deferred weight conversion schedule");
    if (li == 0) weights_range(p, lane, wave, lds, vw, nvw, WI_AIN, WI_A_END); else weights_range(p, lane, wave, lds, vw, nvw, WI_A_END, WI_ALL);
}

__device__ __forceinline__ void ph_init(PrmRef p, const Ctx& c) {
    bf16* XB = (bf16*)(p.ws + WS_XB);
    for (size_t i8 = c.gtid; i8 < (size_t)MT * D_MODEL / 8; i8 += c.nthreads) {
        const size_t i = i8 * 8; const float* src = i < (size_t)PT * D_MODEL ? p.x_prompt + i : p.x_sample + (i - (size_t)PT * D_MODEL);
        const f32x4 a = *(const f32x4*)src, b = *(const f32x4*)(src + 4);
        u32x4 o; o.x = cvtpk(a[0], a[1]); o.y = cvtpk(a[2], a[3]); o.z = cvtpk(b[0], b[1]); o.w = cvtpk(b[2], b[3]);
        *(u32x4*)(XB + i) = o;
    }
    float* rope = (float*)(p.ws + WS_ROPE);
    for (int i = c.gtid; i < (SEQ + DEC_SEQ) * ROPE_HALF; i += c.nthreads) {
        const int pi = i / ROPE_HALF, f = i % ROPE_HALF; const float pos = pi < SEQ ? (float)pi : (float)(PAST_LEN + pi - SEQ);
        const float inv = f == 0 ? 1.0f : f == 1 ? 0.1939227432012558f : f == 2 ? 0.03760603070259094f : f == 3 ? 0.007292664609849453f : f == 4 ? 0.0014142135623842478f
                        : f == 5 ? 0.00027424818836152554f : f == 6 ? 5.3182957344688475e-05f : 1.0313385246263351e-05f;
        const float ang = pos * inv;
        rope[2 * i] = cosf(ang); rope[2 * i + 1] = sinf(ang);
    }
}

constexpr int SS_KC = 128, SS_STB = 32768, SS_BOFF = 16384;
template <int MODE> __device__ __forceinline__ void ss_issue(const bf16* A, int lda, const bf16* Bt, int K, int row0, int col0, int cidx, int q, int lw, int lane, unsigned char* lds) {
    const unsigned char* sa = (const unsigned char*)(A + (size_t)row0 * lda + cidx * SS_KC); const unsigned char* sb = (const unsigned char*)(Bt + (size_t)col0 * K + cidx * SS_KC);
    unsigned char* st = lds + (q & 3) * SS_STB;
#pragma unroll
    for (int i = 0; i < 4; ++i) { const int row = (lw * 4 + i) * 4 + (lane >> 4), pc = (lane & 15) ^ (row & 15);
        GLDS16(sa + (unsigned)row * (unsigned)(lda * 2) + (unsigned)pc * 16u, st + (lw * 4 + i) * 1024);
        if (MODE != 1) GLDS16(sb + (unsigned)row * (unsigned)(K * 2) + (unsigned)pc * 16u, st + SS_BOFF + (lw * 4 + i) * 1024); }
    if (MODE == 1) { const int row = lw * 4 + (lane >> 4), pc = (lane & 15) ^ (row & 15); GLDS16(sb + (unsigned)row * (unsigned)(K * 2) + (unsigned)pc * 16u, st + SS_BOFF + lw * 1024); }
}
template <int MODE> __device__ __forceinline__ void sgemm_stream(PrmRef p, int li, const bf16* A, int lda, const bf16* Bt, int K, bf16* C, int ldc, int row_begin, int col_base, int tn, int it0, int itstep, int nitems, int tid, unsigned char* lds) {
    const int lane = tid & 63, wave = READFIRSTLANE(tid >> 6), nkc = K / SS_KC;
    const int nmine = it0 < nitems ? (nitems - it0 + itstep - 1) / itstep : 0, Q = nmine * nkc;
    LBAR();
    if (Q == 0) return;
    if (wave >= 4) {
        const int lw = wave - 4;
        int it = it0, cidx = 0, row0 = row_begin + (it / tn) * 64, col0 = col_base + (it % tn) * 64;
#define SS_NEXT() do { if (++cidx == nkc) { cidx = 0; it += itstep; row0 = row_begin + (it / tn) * 64; col0 = col_base + (it % tn) * 64; } } while (0)
        ss_issue<MODE>(A, lda, Bt, K, row0, col0, cidx, 0, lw, lane, lds); SS_NEXT();
        if (Q > 1) { ss_issue<MODE>(A, lda, Bt, K, row0, col0, cidx, 1, lw, lane, lds); SS_NEXT(); }
        if (Q > 2) { ss_issue<MODE>(A, lda, Bt, K, row0, col0, cidx, 2, lw, lane, lds); SS_NEXT(); }
        for (int q = 0; q < Q; ++q) {
            if (q + 2 < Q) { if (MODE == 1) { WAIT_VM(10); } else { WAIT_VM(16); } } else { WAIT_VM(0); }
            LBAR();
            if (q + 3 < Q) { ss_issue<MODE>(A, lda, Bt, K, row0, col0, cidx, q + 3, lw, lane, lds); SS_NEXT(); }
        }
#undef SS_NEXT
    } else {
        const int r = lane & 15, g = lane >> 4;
        f32x4 acc[4];
#pragma unroll
        for (int nt = 0; nt < 4; ++nt) acc[nt] = (f32x4){0.f, 0.f, 0.f, 0.f};
        int it = it0, cidx = 0;
        for (int q = 0; q < Q; ++q) {
            LBAR();
            const unsigned char* ap = lds + (q & 3) * SS_STB + (16 * wave + r) * 256; const unsigned char* bp = lds + (q & 3) * SS_STB + SS_BOFF + r * 256;
#pragma unroll
            for (int ks = 0; ks < 4; ++ks) { const int po = ((4 * ks + g) ^ r) << 4; const bf16x8 a = *(const bf16x8*)(ap + po);
#pragma unroll
                for (int nt = 0; nt < (MODE == 1 ? 1 : 4); ++nt) { const bf16x8 b = *(const bf16x8*)(bp + nt * 4096 + po); acc[nt] = MFMA16(b, a, acc[nt]); } }
            if (++cidx == nkc) {
                const int row0 = row_begin + (it / tn) * 64, col0 = col_base + (it % tn) * 64, row = row0 + 16 * wave + r;
                if (MODE == 1) {
                    static_assert(2 * A_HEADS <= 16, "gate columns");
                    float* GB = (float*)(p.ws + WS_GB);
#pragma unroll
                    for (int e = 0; e < 4; ++e) { const int col = 4 * g + e; const float v = acc[0][e];
                        if (col < A_HEADS) GB[((size_t)row * A_HEADS + col) * 2] = -expf(p.a_log[li * A_HEADS + col]) * softplusf_(v + p.a_dt_bias[li * A_HEADS + col]);
                        else if (col < 2 * A_HEADS) GB[((size_t)row * A_HEADS + (col - A_HEADS)) * 2 + 1] = sigmoidf_(v); }
                } else {
                    if (MODE == 2) {
                        const int kind = col0 < B_QW ? 0 : col0 < B_IN ? 1 : col0 < B_IN + B_KVW ? 2 : 3, srow = row - PT;
                        if (kind == 0 || kind == 2) {
                            const float* rp = (const float*)(p.ws + WS_ROPE) + ((size_t)(SEQ + srow % DEC_SEQ) * ROPE_HALF + 4 * (g & 1)) * 2;
                            const f32x4 cs0 = *(const f32x4*)rp, cs1 = *(const f32x4*)(rp + 4);
#pragma unroll
                            for (int e = 0; e < 4; ++e) { const float x = acc[0][e], o = __shfl_xor(x, 32), c_ = e < 2 ? cs0[2 * e] : cs1[2 * e - 4], s_ = e < 2 ? cs0[2 * e + 1] : cs1[2 * e - 3];
                                acc[0][e] = g < 2 ? x * c_ - o * s_ : x * c_ + o * s_; }
                        }
                        if (kind == 0) {
#pragma unroll
                            for (int nt = 0; nt < 4; ++nt) acc[nt] = acc[nt] * 0.125f; }
                        if (kind == 3) { bf16* VT = (bf16*)(p.ws + WS_VT); const int kvh = (col0 - (B_IN + B_KVW)) / B_HD, ck = NCP + srow / DEC_SEQ, key = srow % DEC_SEQ;
#pragma unroll
                            for (int nt = 0; nt < 4; ++nt)
#pragma unroll
                                for (int e = 0; e < 4; ++e) VT[(((size_t)ck * B_KV_HEADS + kvh) * B_HD + 16 * nt + 4 * g + e) * 64 + key] = (bf16)(cvtpk(acc[nt][e], 0.f) & 0xffffu); }
                    }
                    bf16* cp = C + (size_t)row * ldc + col0 + 4 * g;
#pragma unroll
                    for (int nt = 0; nt < 4; ++nt) { u32x2 w; w.x = cvtpk(acc[nt][0], acc[nt][1]); w.y = cvtpk(acc[nt][2], acc[nt][3]); *(u32x2*)(cp + 16 * nt) = w; }
                }
#pragma unroll
                for (int nt = 0; nt < 4; ++nt) acc[nt] = (f32x4){0.f, 0.f, 0.f, 0.f};
                cidx = 0; it += itstep;
            }
        }
    }
    LBAR();
}
template <int MODE = 0> __device__ __forceinline__ void sgemm_rows(PrmRef p, const bf16* A, int lda, const bf16* Bt, int K, bf16* C, int ldc, int row_begin, int nrows, int N, const Ctx& c, int first_wg, unsigned char* lds, bool only_tail = false) {
    const int tn = N / 64, nt = (nrows / 64) * tn;
    const int f = first_wg % c.nblk, np = (only_tail && f > 0) ? c.nblk - f : c.nblk;
    const int v = only_tail && f > 0 ? c.bid - f : (c.bid + c.nblk - f) % c.nblk;
    sgemm_stream<MODE>(p, 0, A, lda, Bt, K, C, ldc, row_begin, 0, tn, v >= 0 ? v : nt, np, nt, c.tid, lds);
}
__device__ __forceinline__ void ph_a_gemm(PrmRef p, const Ctx& c, int li, unsigned char* lds) {
    const bf16* XB = (const bf16*)(p.ws + WS_XB); bf16* PROJ = (bf16*)(p.ws + WS_PROJ); const bf16* Wt = (const bf16*)(p.ws + WS_WAIN) + (size_t)li * A_NG * D_MODEL;
    pg8::Gemm g{XB, D_MODEL, Wt, PT, A_MAIN, D_MODEL}; pg8::StaticOrder S; S.init(PT, A_MAIN, c.nblk, c.bid);
    pg8::EpiAIn E{PROJ, PLD, (bf16*)(p.ws + WS_HALO), p.out + O_PCONV + (size_t)li * BATCH * 3 * CONV_DIM};
    __syncthreads();
    pg8::gemm_phase<pg8::EpiAIn, pg8::StaticOrder, true>((LAS unsigned char*)lds, g, S, E, c.tid);
    __syncthreads();
    sgemm_stream<1>(p, li, XB, D_MODEL, Wt, D_MODEL, nullptr, 0, 0, A_MAIN, 1, c.bid, c.nblk, MT / 64, c.tid, lds);
    sgemm_rows(p, XB, D_MODEL, Wt, D_MODEL, PROJ, PLD, PT, ST, A_MAIN, c, MT / 64, lds);
}
constexpr int NPG = BATCH * A_HEADS, NSG = DEC_BATCH * A_HEADS, NPI = NPG * NCPS;
__device__ __forceinline__ unsigned pk2bf(float lo, float hi) { return cvtpk(lo, hi); }
__device__ __forceinline__ int p32(int d) { return (d & ~31) | (((d >> 2) & 3) << 3) | (((d >> 4) & 1) << 2) | (d & 3); }
constexpr int PP_KN = 0, PP_QN = 17408, PP_KF = 34816, PP_VF = 67584, PP_GC = 100352, PP_LN = 102400, PP_LNP = 68, PP_TI = PP_LN + 64 * PP_LNP * 4, PP_WST = PP_TI + 4 * 16 * 17 * 4, PP_CW = PP_WST + 17408, PP_END = PP_CW + 3 * 4 * 128 * 4;
static_assert(PP_END <= 163840 - 64 && PP_TI % 16 == 0 && PP_WST % 16 == 0 && PP_CW % 16 == 0, "prepass LDS");
typedef u32x4 RawTile[3][4][2];
__device__ __forceinline__ void prepass_load_raw(PrmRef p, int item, int tid, RawTile& xr) {
    const bf16* PROJ = (const bf16*)(p.ws + WS_PROJ); const bf16* HALO = (const bf16*)(p.ws + WS_HALO);
    const int n = item % NCPS, grp = item / NCPS, h = grp % A_HEADS, s = grp / A_HEADS, R0 = s * SEQ + n * CHUNK, r = tid >> 3, seg = tid & 7;
#pragma unroll
    for (int X = 0; X < 3; ++X) {
        const int cb = X * A_QK + h * A_DK + 16 * seg;
#pragma unroll
        for (int j = 0; j < 4; ++j) {
            const int rr = r - 3 + j;
            if (rr >= 0) { const u32x4* src = (const u32x4*)(PROJ + (size_t)(R0 + rr) * PLD + cb); xr[X][j][0] = src[0]; xr[X][j][1] = src[1]; }
            else if (n > 0) { const u32x4* src = (const u32x4*)(HALO + ((size_t)(s * NCPS + n - 1) * 3 + (3 + rr)) * CONV_DIM + cb); xr[X][j][0] = src[0]; xr[X][j][1] = src[1]; }
            else { xr[X][j][0] = (u32x4){0u, 0u, 0u, 0u}; xr[X][j][1] = xr[X][j][0]; }
        }
    }
}
__device__ __forceinline__ void prepass_gcum(PrmRef p, int item, int lane, float* GC) {
    const float* GB = (const float*)(p.ws + WS_GB); float* GL = (float*)(p.ws + WS_GL);
    const int n = item % NCPS, grp = item / NCPS, h = grp % A_HEADS, s = grp / A_HEADS, R0 = s * SEQ + n * CHUNK;
    const float g = GB[((size_t)(R0 + lane) * A_HEADS + h) * 2], bt = GB[((size_t)(R0 + lane) * A_HEADS + h) * 2 + 1];
    float cs = g;
#pragma unroll
    for (int d = 1; d < 64; d <<= 1) { const float o = __shfl(cs, lane >= d ? lane - d : lane); if (lane >= d) cs += o; }
    const float gl = __shfl(cs, 63);
    GC[lane] = cs; GC[64 + lane] = bt; GC[128 + lane] = fexp(cs); GC[192 + lane] = fexp(gl - cs);
    if (lane == 0) GL[item] = fexp(gl);
}
__device__ __forceinline__ void prepass_store_w(PrmRef p, int item, int tid, const unsigned char* lds) {
    bf16* WB = (bf16*)(p.ws + WS_WB); const bf16* WST = (const bf16*)(lds + PP_WST);
    const int n = item % NCPS, grp = item / NCPS, h = grp % A_HEADS, s = grp / A_HEADS, R0 = s * SEQ + n * CHUNK, r = tid >> 3, seg = tid & 7;
    const u32x4 w0 = *(const u32x4*)(WST + r * 136 + 16 * seg), w1 = *(const u32x4*)(WST + r * 136 + 16 * seg + 8);
    u32x4* dst = (u32x4*)(WB + (size_t)(R0 + r) * A_QK + h * A_DK + 16 * seg); dst[0] = w0; dst[1] = w1;
}
template <int VAR = 0> __device__ __forceinline__ void delta_prepass_item(PrmRef p, int li, int item, int next_item, int prev_item, int pb, int tid, unsigned char* lds, RawTile& xr) {
#ifndef EMU
    asm volatile("" : "+v"(tid));
#endif
    bf16* PROJ = (bf16*)(p.ws + WS_PROJ); bf16* IA = (bf16*)(p.ws + WS_IA);
    const int n = item % NCPS, grp = item / NCPS, h = grp % A_HEADS, s = grp / A_HEADS;
    const int R0 = s * SEQ + n * CHUNK, lane = tid & 63, wave = READFIRSTLANE(tid >> 6);
    bf16* KN = (bf16*)(lds + PP_KN); bf16* QN = (bf16*)(lds + PP_QN); bf16* VN = (bf16*)(lds + PP_KF);
    float* GC = (float*)(lds + PP_GC) + pb * 256; float* BT = GC + 64; float* EG = GC + 128; float* KD = GC + 192;
    float* LN = (float*)(lds + PP_LN);
    float* TI = (float*)(lds + PP_TI);
    bf16* WST = (bf16*)(lds + PP_WST);
    if (prev_item >= 0) prepass_store_w(p, prev_item, tid, lds);
    const int r = tid >> 3, seg = tid & 7;
    float qf[16];
#pragma unroll
    for (int X = 0; X < 3; ++X) {
        const int cb = X * A_QK + h * A_DK + 16 * seg;
        float acc[16];
#pragma unroll
        for (int e = 0; e < 16; ++e) acc[e] = 0.f;
#pragma unroll
        for (int j = 0; j < 4; ++j) {
            const f32x4* wp = (const f32x4*)(lds + PP_CW) + ((X * 4 + j) * 128 + 16 * seg) / 4;
#pragma unroll
            for (int e = 0; e < 4; ++e) {
                const f32x4 w4 = wp[e]; const unsigned a = xr[X][j][e >> 1][2 * (e & 1)], b = xr[X][j][e >> 1][2 * (e & 1) + 1];
                acc[4 * e] += w4[0] * bflo(a); acc[4 * e + 1] += w4[1] * bfhi(a); acc[4 * e + 2] += w4[2] * bflo(b); acc[4 * e + 3] += w4[3] * bfhi(b);
            }
        }
        float ss = 0.f;
#pragma unroll
        for (int e = 0; e < 16; ++e) { acc[e] = fsilu(acc[e]); ss += acc[e] * acc[e]; }
        if (X < 2) {
            ss = sum8(ss);
            const float rs = fast_rsq(ss + RMS_EPS) * (X == 0 ? 0.08838834764831845f : 1.f);
#pragma unroll
            for (int e = 0; e < 16; ++e) acc[e] *= rs;
        }
        if (X == 0) {
#pragma unroll
            for (int e = 0; e < 16; ++e) qf[e] = acc[e];
            u32x4 o0, o1;
#pragma unroll
            for (int e = 0; e < 4; ++e) { o0[e] = cvtpk(acc[2 * e], acc[2 * e + 1]); o1[e] = cvtpk(acc[8 + 2 * e], acc[8 + 2 * e + 1]); }
            *(u32x4*)(QN + r * 136 + 16 * seg) = o0; *(u32x4*)(QN + r * 136 + 16 * seg + 8) = o1;
        } else if (X == 1) {
            u32x4 o0, o1;
#pragma unroll
            for (int e = 0; e < 4; ++e) { o0[e] = cvtpk(acc[2 * e], acc[2 * e + 1]); o1[e] = cvtpk(acc[8 + 2 * e], acc[8 + 2 * e + 1]); }
            *(u32x4*)(KN + r * 136 + 16 * seg) = o0; *(u32x4*)(KN + r * 136 + 16 * seg + 8) = o1;
        } else {
            u32x4 o0, o1;
#pragma unroll
            for (int e = 0; e < 4; ++e) { o0[e] = cvtpk(acc[2 * e], acc[2 * e + 1]); o1[e] = cvtpk(acc[8 + 2 * e], acc[8 + 2 * e + 1]); }
            *(u32x4*)(VN + r * 136 + 16 * seg) = o0; *(u32x4*)(VN + r * 136 + 16 * seg + 8) = o1;
        }
    }
    LBAR();
    if (next_item >= 0) prepass_load_raw(p, next_item, tid, xr);
    {
        const float eg = EG[r];
        bf16* dst = PROJ + (size_t)(R0 + r) * PLD + h * A_DK + 32 * (seg >> 1) + 4 * (seg & 1);
#pragma unroll
        for (int gq = 0; gq < 4; ++gq) { u32x2 o; o.x = cvtpk(qf[4 * gq] * eg, qf[4 * gq + 1] * eg); o.y = cvtpk(qf[4 * gq + 2] * eg, qf[4 * gq + 3] * eg); *(u32x2*)(dst + 8 * gq) = o; }
    }
    if (VAR != 4) {
        const int kind = wave >> 2, ti = (wave >> 1) & 1, tj = wave & 1, l31 = lane & 31, hi = lane >> 5;
        if (wave == 1) {
            if (next_item >= 0) prepass_gcum(p, next_item, lane, (float*)(lds + PP_GC) + (pb ^ 1) * 256);
#pragma unroll
            for (int e = 0; e < 16; ++e) LN[((e & 3) + 8 * (e >> 2) + 4 * hi) * PP_LNP + 32 + l31] = 0.f;
        } else {
            f32x16 acc;
#pragma unroll
            for (int e = 0; e < 16; ++e) acc[e] = 0.f;
            const unsigned char* ap = (const unsigned char*)(kind == 0 ? KN : QN) + (32 * ti + l31) * 272 + 16 * hi;
            const unsigned char* bp = (const unsigned char*)KN + (32 * tj + l31) * 272 + 16 * hi;
            if (ti >= tj) {
#pragma unroll
                for (int ks = 0; ks < 8; ++ks) { const bf16x8 a = *(const bf16x8*)(ap + 32 * ks), b = *(const bf16x8*)(bp + 32 * ks); acc = MFMA32(a, b, acc); }
            }
            const int col = 32 * tj + l31; const float gcc = GC[col];
#pragma unroll
            for (int e = 0; e < 16; ++e) {
                const int row = 32 * ti + (e & 3) + 8 * (e >> 2) + 4 * hi;
                if (kind == 0) LN[row * PP_LNP + col] = row > col ? -(BT[row] * acc[e] * fexp(GC[row] - gcc)) : 0.f;
                else IA[((size_t)item * 64 + row) * 64 + p32(col)] = (bf16)f2bf(row >= col ? acc[e] * fexp(GC[row] - gcc) : 0.f);
            }
            if (wave == 0 || wave == 3) {
                WAVE_SYNC();
                if (lane < 32) {
                    const int b = (wave == 3 ? 2 : 0) + (lane >> 4), j = lane & 15; float t[16];
#pragma unroll
                    for (int i = 0; i < 16; ++i) {
                        float v = i == j ? 1.f : 0.f;
#pragma unroll
                        for (int k = 0; k < i; ++k) v += LN[(16 * b + i) * PP_LNP + 16 * b + k] * t[k];
                        t[i] = v;
                    }
#pragma unroll
                    for (int i = 0; i < 16; ++i) TI[(b * 16 + i) * 17 + j] = t[i];
                }
            } else if (wave >= 4) {
                const int u = tid - 256, m = u & 127, half = u >> 7;
                unsigned char* dst = (unsigned char*)PROJ + ((size_t)(R0 + (m >> 1)) * PLD + A_QK + h * A_DK) * 2 + (m & 1) * 128 + half * 64;
#pragma unroll
                for (int q4 = 0; q4 < 4; ++q4) {
                    u32x4 o;
#pragma unroll
                    for (int e = 0; e < 4; ++e) { const int j = 32 * half + 4 * q4 + 16 * (e >> 1) + 2 * (e & 1); o[e] = cvtpk(bf2f(KN[j * 136 + m]) * KD[j], bf2f(KN[(j + 1) * 136 + m]) * KD[j + 1]); }
                    *(u32x4*)(dst + 16 * q4) = o;
                }
            }
        }
    }
    LBAR();
    if (VAR != 4 && VAR != 1) {
        const int g = lane >> 4, cl = lane & 15;
        f32x4 XU[4], XW[4];
#pragma unroll
        for (int b = 0; b < 4; ++b) {
            f32x4 yu, yw;
#pragma unroll
            for (int e = 0; e < 4; ++e) { const int row = 16 * b + 4 * g + e; const float bt = BT[row]; yu[e] = bf2f(VN[row * 136 + 16 * wave + cl]) * bt; yw[e] = bf2f(KN[row * 136 + 16 * wave + cl]) * (bt * EG[row]); }
            float la[12], ta[4];
#pragma unroll
            for (int c = 0; c < b; ++c)
#pragma unroll
                for (int ks = 0; ks < 4; ++ks) la[4 * c + ks] = LN[(16 * b + cl) * PP_LNP + 16 * c + 4 * g + ks];
#pragma unroll
            for (int ks = 0; ks < 4; ++ks) ta[ks] = TI[(b * 16 + cl) * 17 + 4 * g + ks];
            SCHED_BARRIER();
#pragma unroll
            for (int c = 0; c < b; ++c)
#pragma unroll
                for (int ks = 0; ks < 4; ++ks) { yu = MFMAF(la[4 * c + ks], XU[c][ks], yu); yw = MFMAF(la[4 * c + ks], XW[c][ks], yw); }
            f32x4 xu = (f32x4){0.f, 0.f, 0.f, 0.f}, xw = xu;
#pragma unroll
            for (int ks = 0; ks < 4; ++ks) { xu = MFMAF(ta[ks], yu[ks], xu); xw = MFMAF(ta[ks], yw[ks], xw); }
            XU[b] = xu; XW[b] = xw;
            u32x2 o; o.x = cvtpk(xu[0], xu[1]); o.y = cvtpk(xu[2], xu[3]);
            *(u32x2*)((unsigned char*)PROJ + ((size_t)(R0 + wave * 8 + 2 * b + (lane >> 5)) * PLD + 2 * A_QK + h * A_DV) * 2 + (lane & 31) * 8) = o;
#pragma unroll
            for (int e = 0; e < 4; ++e) WST[(16 * b + 4 * g + e) * 136 + p32(16 * wave + cl)] = (bf16)(cvtpk(xw[e], 0.f) & 0xffffu);
        }
    }
    LBAR();
}

__device__ __forceinline__ bf16x8 pack_b(const f32x4 a, const f32x4 b) {
    u32x4 o; o.x = pk2bf(a[0], a[1]); o.y = pk2bf(a[2], a[3]); o.z = pk2bf(b[0], b[1]); o.w = pk2bf(b[2], b[3]); return __builtin_bit_cast(bf16x8, o);
}
constexpr int SC_BUF = 65536, SC_W = 0, SC_QD = 16384, SC_KDT = 32768, SC_IA = 49152, SC_U = 57344;
__device__ __forceinline__ void scan_dma(PrmRef p, int grp, int half, int n, int lw, int lane, unsigned char* buf) {
    const int h = grp % A_HEADS, s = grp / A_HEADS, R0 = s * SEQ + n * CHUNK;
    const BufRes rs = MAKE_RES(p.ws);
    const unsigned sW = (unsigned)(WS_WB + ((size_t)R0 * A_QK + h * A_DK) * 2);
    const unsigned sQ = (unsigned)(WS_PROJ + ((size_t)R0 * PLD + h * A_DK) * 2);
    const unsigned sK = (unsigned)(WS_PROJ + ((size_t)R0 * PLD + A_QK + h * A_DK) * 2);
    const unsigned sU = (unsigned)(WS_PROJ + ((size_t)(R0 + 32 * half) * PLD + 2 * A_QK + h * A_DV) * 2);
    const unsigned sI = (unsigned)(WS_IA + (size_t)(grp * NCPS + n) * 8192);
#pragma unroll
    for (int j = 0; j < 4; ++j) {
        const int ip = lw + 4 * j, sg = ip * 64 + lane;
        { const int row = sg >> 4, pc = (sg & 15) ^ (row & 15);
          BLDS16(rs, (unsigned)row * (unsigned)(A_QK * 2) + (unsigned)pc * 16u, sW, buf + SC_W + ip * 1024);
          BLDS16(rs, (unsigned)row * (unsigned)(PLD * 2) + (unsigned)pc * 16u, sQ, buf + SC_QD + ip * 1024); }
        { const int m = sg >> 3, pc = (sg & 7) ^ ((m >> 1) & 7);
          BLDS16(rs, (unsigned)(m >> 1) * (unsigned)(PLD * 2) + (unsigned)(m & 1) * 128u + (unsigned)pc * 16u, sK, buf + SC_KDT + ip * 1024); }
        if (j < 2) {
          { const int row = sg >> 3, pc = (sg & 7) ^ ((row >> 1) & 7); BLDS16(rs, (unsigned)row * 128u + (unsigned)pc * 16u, sI, buf + SC_IA + ip * 1024); }
          BLDS16(rs, (unsigned)(sg >> 4) * (unsigned)(PLD * 2) + (unsigned)(sg & 15) * 16u, sU, buf + SC_U + ip * 1024);
        }
    }
}
constexpr int SC_PF = 2 * SC_BUF, SC_PFD = 2;
static_assert(SC_PF + 1024 <= 163840 - 64, "scan LDS");
__device__ __forceinline__ void scan_prefetch(PrmRef p, int grp, int half, int n, int lw, int lane, unsigned char* lds) {
    const int h = grp % A_HEADS, s = grp / A_HEADS, R0 = s * SEQ + n * CHUNK;
    const BufRes rs = MAKE_RES(p.ws);
    const unsigned s0 = lw == 0 ? (unsigned)(WS_WB + ((size_t)R0 * A_QK + h * A_DK) * 2) : lw == 1 ? (unsigned)(WS_PROJ + ((size_t)R0 * PLD + h * A_DK) * 2)
                      : lw == 2 ? (unsigned)(WS_PROJ + ((size_t)R0 * PLD + A_QK + h * A_DK) * 2) : (unsigned)(WS_IA + (size_t)(grp * NCPS + n) * 8192);
    const unsigned s1 = lw == 3 ? (unsigned)(WS_PROJ + ((size_t)(R0 + 32 * half) * PLD + 2 * A_QK + h * A_DV) * 2) : s0 + 32u * (lw == 0 ? (unsigned)(A_QK * 2) : (unsigned)(PLD * 2));
    const unsigned pitch = lw == 0 ? (unsigned)(A_QK * 2) : (unsigned)(PLD * 2);
    const unsigned orow = (unsigned)(lane >> 1) * pitch + (unsigned)(lane & 1) * 128u;
    BLDS16(rs, lw == 3 ? (unsigned)lane * 128u : orow, s0, lds + SC_PF); BLDS16(rs, orow, s1, lds + SC_PF);
}
template <int SV = 0> __device__ __forceinline__ void delta_scan_group(PrmRef p, int li, int item, int tid, unsigned char* lds, bool wstate = true) {
    unsigned char* PROJ = (unsigned char*)(p.ws + WS_PROJ); const float* GL = (const float*)(p.ws + WS_GL);
    const int grp = item >> 1, half = item & 1;
    const int h = grp % A_HEADS, s = grp / A_HEADS, lane = tid & 63, wave = READFIRSTLANE(tid >> 6);
    const bool loader = wave >= 4; const int cw = 4 * half + (wave & 3);
    f32x4 S[8];
#pragma unroll
    for (int m = 0; m < 8; ++m) S[m] = (f32x4){0.f, 0.f, 0.f, 0.f};
    unsigned char* fp = PROJ + ((size_t)(s * SEQ + cw * 8 + (lane >> 5)) * PLD + 2 * A_QK + h * A_DV) * 2 + (lane & 31) * 8;
    constexpr size_t TSTEP = (size_t)2 * PLD * 2, CSTEP = (size_t)CHUNK * PLD * 2;
    static_assert(NCPS <= 64, "glast per lane");
    const float glv = GL[grp * NCPS + (lane < NCPS ? lane : 0)];
    if (loader) { if (SV != 1) { scan_dma(p, grp, half, 0, wave - 4, lane, lds);
#pragma unroll
        for (int d = 1; d < SC_PFD; ++d) scan_prefetch(p, grp, half, d, wave - 4, lane, lds); } }
    WAIT_VM(0); LBAR();
    for (int n = 0; n < NCPS; ++n) {
        unsigned char* buf = lds + (n & 1) * SC_BUF;
        if (loader) {
            if (n + 1 < NCPS) { if (SV != 1) scan_dma(p, grp, half, n + 1, wave - 4, lane, lds + ((n + 1) & 1) * SC_BUF); }
            if (SV != 1 && n + SC_PFD < NCPS) { scan_prefetch(p, grp, half, n + SC_PFD, wave - 4, lane, lds); WAIT_VM(2); }
            else { WAIT_VM(0); }
        } else {
        int lane2 = lane;
#ifndef EMU
        asm volatile("" : "+v"(lane2));
#endif
        const int g = lane2 >> 4, cl = lane2 & 15;
        int oW[4], oH[2];
#pragma unroll
        for (int ks = 0; ks < 4; ++ks) oW[ks] = cl * 256 + (((4 * ks + g) ^ cl) << 4);
#pragma unroll
        for (int ks = 0; ks < 2; ++ks) oH[ks] = cl * 128 + (((4 * ks + g) ^ (cl >> 1)) << 4);
        u32x2 uf[4];
#pragma unroll
        for (int t = 0; t < 4; ++t) uf[t] = *(const u32x2*)(buf + SC_U + ((wave & 3) * 8 + 2 * t + (lane2 >> 5)) * 256 + (lane2 & 31) * 8);
        const float glast = BCAST_LANE(glv, n);
        bf16x8 Bs[4];
#pragma unroll
        for (int ks = 0; ks < 4; ++ks) Bs[ks] = pack_b(S[2 * ks], S[2 * ks + 1]);
        bf16x8 fa[4][4];
#pragma unroll
        for (int t = 0; t < 4; ++t)
#pragma unroll
            for (int ks = 0; ks < 4; ++ks) fa[t][ks] = *(const bf16x8*)(buf + SC_W + t * 4096 + oW[ks]);
        SCHED_BARRIER();
        f32x4 vn[4];
#pragma unroll
        for (int t = 0; t < 4; ++t) vn[t] = (f32x4){0.f, 0.f, 0.f, 0.f};
#pragma unroll
        for (int ks = 0; ks < (SV == 3 ? 0 : 4); ++ks)
#pragma unroll
            for (int t = 0; t < 4; ++t) vn[t] = MFMA16(fa[t][ks], Bs[ks], vn[t]);
#pragma unroll
        for (int t = 0; t < 4; ++t) { const f32x4 u = (f32x4){bflo(uf[t].x), bfhi(uf[t].x), bflo(uf[t].y), bfhi(uf[t].y)}; vn[t] = u - vn[t]; }
        SCHED_BARRIER();
        bf16x8 fk[8][2];
#pragma unroll
        for (int m = 0; m < 8; ++m)
#pragma unroll
            for (int ks = 0; ks < 2; ++ks) fk[m][ks] = *(const bf16x8*)(buf + SC_KDT + m * 2048 + oH[ks]);
        SCHED_BARRIER();
        bf16x8 Vb[2];
        Vb[0] = pack_b(vn[0], vn[1]); Vb[1] = pack_b(vn[2], vn[3]);
#pragma unroll
        for (int m = 0; m < 8; ++m) S[m] = S[m] * glast;
#pragma unroll
        for (int ks = 0; ks < 2; ++ks)
#pragma unroll
            for (int m = 0; m < 8; ++m) S[m] = MFMA16(fk[m][ks], Vb[ks], S[m]);
#pragma unroll
        for (int t = 0; t < 4; ++t)
#pragma unroll
            for (int ks = 0; ks < 4; ++ks) fa[t][ks] = *(const bf16x8*)(buf + SC_QD + t * 4096 + oW[ks]);
        bf16x8 fi[4][2];
#pragma unroll
        for (int t = 0; t < 4; ++t)
#pragma unroll
            for (int ks = 0; ks < 2; ++ks) fi[t][ks] = *(const bf16x8*)(buf + SC_IA + t * 2048 + oH[ks]);
        SCHED_BARRIER();
        f32x4 oa[4];
#pragma unroll
        for (int t = 0; t < 4; ++t) oa[t] = (f32x4){0.f, 0.f, 0.f, 0.f};
        if (SV != 2) {
#pragma unroll
        for (int ks = 0; ks < 4; ++ks)
#pragma unroll
            for (int t = 0; t < 4; ++t) oa[t] = MFMA16(fa[t][ks], Bs[ks], oa[t]);
#pragma unroll
        for (int ks = 0; ks < 2; ++ks)
#pragma unroll
            for (int t = 0; t < 4; ++t) oa[t] = MFMA16(fi[t][ks], Vb[ks], oa[t]);
#pragma unroll
        for (int t = 0; t < 4; ++t) {
            u32x2 w; w.x = cvtpk(oa[t][0], oa[t][1]); w.y = cvtpk(oa[t][2], oa[t][3]);
            if (SV == 4) { asm volatile("" :: "v"(w.x), "v"(w.y)); } else
            *(u32x2*)(fp + (size_t)n * CSTEP + t * TSTEP) = w;
        }
        }
        WAIT_VM(4);
        }
        LBAR();
    }
    if (!loader && (wstate || SV != 0)) {
    float* so = SV != 0 ? (float*)(p.ws + WS_XB) + (size_t)grp * A_DK * A_DV : p.out + O_PDELTA + (((size_t)li * BATCH + s) * A_HEADS + h) * A_DK * A_DV;
#pragma unroll
    for (int m = 0; m < 8; ++m)
#pragma unroll
        for (int e = 0; e < 4; ++e) so[(size_t)(16 * m + 4 * (lane >> 4) + e) * A_DV + 16 * cw + (lane & 15)] = S[m][e];
    }
    LBAR();
}
constexpr int NM_PART = 0, NM_OST = 2048;
struct NormRaw { u32x2 of[4]; u32x4 z0, z1; };
__device__ __forceinline__ void norm_load(PrmRef p, int item, int tid, NormRaw& q) {
    const unsigned char* PROJ = (const unsigned char*)(p.ws + WS_PROJ);
    const int n = item % NCPS, grp = item / NCPS, h = grp % A_HEADS, s = grp / A_HEADS, R0 = s * SEQ + n * CHUNK;
    const int lane = tid & 63, wave = tid >> 6, r = tid >> 3, seg = tid & 7;
    const unsigned char* fp = PROJ + ((size_t)(R0 + wave * 8 + (lane >> 5)) * PLD + 2 * A_QK + h * A_DV) * 2 + (lane & 31) * 8;
#pragma unroll
    for (int t = 0; t < 4; ++t) q.of[t] = *(const u32x2*)(fp + (size_t)t * 2 * PLD * 2);
    const u32x4* zp = (const u32x4*)(PROJ + ((size_t)(R0 + r) * PLD + CONV_DIM + h * A_DV + 16 * seg) * 2); q.z0 = zp[0]; q.z1 = zp[1];
}
__device__ __forceinline__ void delta_norm_item(PrmRef p, int li, int item, int next_item, int tid, unsigned char* lds, NormRaw& raw) {
    unsigned char* PROJ = (unsigned char*)(p.ws + WS_PROJ);
    const int n = item % NCPS, grp = item / NCPS, h = grp % A_HEADS, s = grp / A_HEADS, R0 = s * SEQ + n * CHUNK;
    const int lane = tid & 63, wave = tid >> 6, g = lane >> 4, cl = lane & 15, r = tid >> 3, seg = tid & 7;
    float* PART = (float*)(lds + NM_PART);
    const float nw = p.a_norm_w[li * A_DV + 16 * wave + cl];
    const u32x4 z0 = raw.z0, z1 = raw.z1;
    f32x4 oa[4];
#pragma unroll
    for (int t = 0; t < 4; ++t) {
        oa[t] = (f32x4){bflo(raw.of[t].x), bfhi(raw.of[t].x), bflo(raw.of[t].y), bfhi(raw.of[t].y)};
        f32x4 q4;
#pragma unroll
        for (int e = 0; e < 4; ++e) q4[e] = sum16(oa[t][e] * oa[t][e]);
        if (cl < 4) PART[(16 * t + 4 * g + cl) * 8 + wave] = cl == 0 ? q4[0] : cl == 1 ? q4[1] : cl == 2 ? q4[2] : q4[3];
    }
    if (next_item >= 0) norm_load(p, next_item, tid, raw);
    LBAR();
#pragma unroll
    for (int t = 0; t < 4; ++t)
#pragma unroll
        for (int e = 0; e < 4; ++e) {
            const int row = 16 * t + 4 * g + e;
            const f32x4 p0 = *(const f32x4*)(PART + row * 8), p1 = *(const f32x4*)(PART + row * 8 + 4);
            const float ss = ((p0[0] + p0[1]) + (p0[2] + p0[3])) + ((p1[0] + p1[1]) + (p1[2] + p1[3]));
            *(bf16*)(lds + NM_OST + row * 272 + (16 * wave + cl) * 2) = (bf16)(cvtpk(oa[t][e] * fast_rsq(ss * (1.f / A_DV) + RMS_EPS) * nw, 0.f) & 0xffffu);
        }
    LBAR();
    {
        const u32x4 o0 = *(const u32x4*)(lds + NM_OST + r * 272 + 32 * seg), o1 = *(const u32x4*)(lds + NM_OST + r * 272 + 32 * seg + 16);
        u32x4 w0, w1;
#pragma unroll
        for (int e = 0; e < 4; ++e) {
            w0[e] = cvtpk(bflo(o0[e]) * fsilu(bflo(z0[e])), bfhi(o0[e]) * fsilu(bfhi(z0[e])));
            w1[e] = cvtpk(bflo(o1[e]) * fsilu(bflo(z1[e])), bfhi(o1[e]) * fsilu(bfhi(z1[e])));
        }
        u32x4* dst = (u32x4*)(PROJ + ((size_t)(R0 + r) * PLD + 2 * A_QK + h * A_DV + 16 * seg) * 2); dst[0] = w0; dst[1] = w1;
    }
    LBAR();
}
__device__ __forceinline__ void ph_a_norm(PrmRef p, const Ctx& c, int li, unsigned char* lds) {
    NormRaw raw;
    if (c.bid < NPI) norm_load(p, c.bid, c.tid, raw);
    for (int item = c.bid; item < NPI; item += c.nblk) delta_norm_item(p, li, item, item + c.nblk < NPI ? item + c.nblk : -1, c.tid, lds, raw);
    bf16* PROJ = (bf16*)(p.ws + WS_PROJ);
    sgemm_rows(p, PROJ + 2 * A_QK, PLD, (const bf16*)(p.ws + WS_WAOUT) + (size_t)li * D_MODEL * A_VW, A_VW, PROJ, PLD, PT, ST, D_MODEL, c, NPI, lds);
}
__device__ __forceinline__ void sample_conv(PrmRef p, const Ctx& c, int li) {
    bf16* PROJ = (bf16*)(p.ws + WS_PROJ);
    const float* cw = p.a_conv_w + (size_t)li * CONV_W * CONV_DIM;
    for (int it = c.gtid; it < DEC_BATCH * CONV_DIM; it += c.nthreads) {
        const int ch = it % CONV_DIM, b = it / CONV_DIM;
        const float* sp = p.state_conv + (((size_t)li * DEC_BATCH + b) * 3) * CONV_DIM + ch;
        float h0 = sp[0], h1 = sp[CONV_DIM], h2 = sp[2 * CONV_DIM];
        const float w0 = cw[ch], w1 = cw[CONV_DIM + ch], w2 = cw[2 * CONV_DIM + ch], w3 = cw[3 * CONV_DIM + ch];
        bf16* e0 = PROJ + (size_t)(PT + b * DEC_SEQ) * PLD + ch;
        bf16 xv[DEC_SEQ];
#pragma unroll
        for (int t = 0; t < DEC_SEQ; ++t) xv[t] = e0[(size_t)t * PLD];
#pragma unroll
        for (int t = 0; t < DEC_SEQ; ++t) {
            const float x = bf2f(xv[t]);
            const float y = w0 * h0 + w1 * h1 + w2 * h2 + w3 * x;
            e0[(size_t)t * PLD] = (bf16)(cvtpk(fsilu(y), 0.f) & 0xffffu); h0 = h1; h1 = h2; h2 = x;
        }
        float* so = p.out + O_SCONV + (((size_t)li * DEC_BATCH + b) * 3) * CONV_DIM + ch;
        so[0] = h0; so[CONV_DIM] = h1; so[2 * CONV_DIM] = h2;
    }
}
constexpr int SS2_KQ = 0, SS2_V = 32768, SS2_GE = 49152, SS2_O = 49408;
__device__ __forceinline__ void sample_scan_group(PrmRef p, int li, int sg, int tid, unsigned char* lds, bool wstate = true) {
    bf16* PROJ = (bf16*)(p.ws + WS_PROJ); const float* GB = (const float*)(p.ws + WS_GB);
    float* KQ = (float*)(lds + SS2_KQ); float* V = (float*)(lds + SS2_V); float* GE = (float*)(lds + SS2_GE); float* O = (float*)(lds + SS2_O);
    const int b = sg / A_HEADS, h = sg % A_HEADS, r0 = PT + b * DEC_SEQ, col = tid >> 2, part = tid & 3, lane = tid & 63, wave = tid >> 6;
    __syncthreads();
    float S[32];
    const float* s0 = p.state_delta + (((size_t)li * DEC_BATCH + b) * A_HEADS + h) * A_DK * A_DV;
#pragma unroll
    for (int k = 0; k < 32; ++k) S[k] = s0[(size_t)(part * 32 + k) * A_DV + col];
    {
        float a[8], bb[8];
#pragma unroll
        for (int i = 0; i < 8; ++i) { const int row = wave * 8 + i, t = row >> 1, kind = row & 1; const bf16* e = PROJ + (size_t)(r0 + t) * PLD + (kind == 0 ? A_QK : 0) + h * A_DK + 2 * lane; a[i] = bf2f(e[0]); bb[i] = bf2f(e[1]); }
#pragma unroll
        for (int i = 0; i < 8; ++i) { const int row = wave * 8 + i, kind = row & 1;
            const float sc = (1.f / sqrtf(wave_sum(a[i] * a[i] + bb[i] * bb[i]) + RMS_EPS)) * (kind == 0 ? 1.f : 0.08838834764831845f);
            KQ[row * 128 + 2 * lane] = a[i] * sc; KQ[row * 128 + 2 * lane + 1] = bb[i] * sc; }
#pragma unroll
        for (int i = 0; i < 8; ++i) { const int t = part * 8 + i; V[t * 128 + col] = bf2f(PROJ[(size_t)(r0 + t) * PLD + 2 * A_QK + h * A_DV + col]); }
        if (tid < DEC_SEQ) { GE[2 * tid] = expf(GB[((size_t)(r0 + tid) * A_HEADS + h) * 2]); GE[2 * tid + 1] = GB[((size_t)(r0 + tid) * A_HEADS + h) * 2 + 1]; }
    }
    __syncthreads();
    for (int t = 0; t < DEC_SEQ; ++t) {
        const float eg = GE[2 * t], beta = GE[2 * t + 1], v = V[t * 128 + col];
        const f32x4* kk = (const f32x4*)(KQ + (2 * t) * 128 + part * 32); const f32x4* qq = (const f32x4*)(KQ + (2 * t + 1) * 128 + part * 32);
        float ks = 0.f;
#pragma unroll
        for (int k4 = 0; k4 < 8; ++k4) { const f32x4 kv = kk[k4];
#pragma unroll
            for (int e = 0; e < 4; ++e) { S[4 * k4 + e] *= eg; ks += kv[e] * S[4 * k4 + e]; } }
        ks += __shfl_xor(ks, 1); ks += __shfl_xor(ks, 2);
        const float vn = (v - ks) * beta; float o = 0.f;
#pragma unroll
        for (int k4 = 0; k4 < 8; ++k4) { const f32x4 kv = kk[k4], qv = qq[k4];
#pragma unroll
            for (int e = 0; e < 4; ++e) { S[4 * k4 + e] += kv[e] * vn; o += qv[e] * S[4 * k4 + e]; } }
        o += __shfl_xor(o, 1); o += __shfl_xor(o, 2);
        if (part == 0) O[t * 128 + col] = bf2f((bf16)f2bf(o));
    }
    float* so = p.out + O_SDELTA + (((size_t)li * DEC_BATCH + b) * A_HEADS + h) * A_DK * A_DV;
    if (wstate) {
#pragma unroll
    for (int k = 0; k < 32; ++k) so[(size_t)(part * 32 + k) * A_DV + col] = S[k];
    }
    __syncthreads();
    const float* nw = p.a_norm_w + (size_t)li * A_DV;
#pragma unroll
    for (int i = 0; i < 4; ++i) {
        const int t = wave * 4 + i, row = r0 + t;
        bf16* e = PROJ + (size_t)row * PLD + 2 * A_QK + h * A_DV + 2 * lane; const bf16* z = PROJ + (size_t)row * PLD + CONV_DIM + h * A_DV + 2 * lane;
        const float a = O[t * 128 + 2 * lane], bb = O[t * 128 + 2 * lane + 1];
        const float r = 1.f / sqrtf(wave_sum(a * a + bb * bb) * (1.f / A_DV) + RMS_EPS);
        e[0] = (bf16)f2bf(a * r * nw[2 * lane] * siluf(bf2f(z[0]))); e[1] = (bf16)f2bf(bb * r * nw[2 * lane + 1] * siluf(bf2f(z[1])));
    }
    __syncthreads();
}
template <int VAR = 0> __device__ __forceinline__ void ph_a_pre(PrmRef p, const Ctx& c, int li, unsigned char* lds) {
    RawTile xr;
    if (c.bid < NPI) { prepass_load_raw(p, c.bid, c.tid, xr); if (c.wave == 1) prepass_gcum(p, c.bid, c.lane, (float*)(lds + PP_GC)); }
    int prev = -1, pb = 0, cur_h = -1;
    for (int item = c.bid; item < NPI; item += c.nblk) {
        const int h = (item / NCPS) % A_HEADS;
        if (h != cur_h) {
            LBAR();
            for (int i = c.tid; i < 3 * 4 * 128; i += NTHR) { const int X = i / 512, j = (i / 128) & 3, ch = i & 127; ((float*)(lds + PP_CW))[i] = p.a_conv_w[((size_t)li * CONV_W + j) * CONV_DIM + X * A_QK + h * A_DK + ch]; }
            LBAR(); cur_h = h;
        }
        delta_prepass_item<VAR>(p, li, item, item + c.nblk < NPI ? item + c.nblk : -1, prev, pb, c.tid, lds, xr); prev = item; pb ^= 1;
    }
    if (prev >= 0) prepass_store_w(p, prev, c.tid, lds);
    LBAR();
    if (VAR == 0) sample_conv(p, c, li);
}
template <int SV = 0> __device__ __forceinline__ void ph_a_scan2(PrmRef p, const Ctx& c, int li, unsigned char* lds, bool wstate = true, bool do_prompt = true, bool do_sample = true) {
    const int v = (c.bid + c.nblk - ((2 * NPG) % c.nblk)) % c.nblk;
    if (do_sample) for (int sg = v; sg < NSG; sg += c.nblk) sample_scan_group(p, li, sg, c.tid, lds, wstate);
    const int nfree = c.nblk > 2 * NPG ? c.nblk - 2 * NPG : 0;
    const int lane_s = c.lane, wave_s = READFIRSTLANE(c.wave), gw_s = READFIRSTLANE(c.gwave), nw_s = c.nwaves;
    if (SV == 0 && nfree > 0 && v < nfree) { weights_deferred(p, lane_s, wave_s, li, lds, v * (NTHR / 64) + wave_s, nfree * (NTHR / 64)); LBAR(); }
    if (do_prompt) for (int it = c.bid; it < 2 * NPG; it += c.nblk) delta_scan_group<SV>(p, li, it, c.tid, lds, wstate);
    if (SV == 0 && nfree == 0) { weights_deferred(p, lane_s, wave_s, li, lds, gw_s, nw_s); LBAR(); }
}

__device__ __forceinline__ void ph_ln(PrmRef p, const Ctx& c, const bf16* OUT, int ldo, const float* g, const float* b, bool last) {
    bf16* XB = (bf16*)(p.ws + WS_XB);
    constexpr int PER = D_MODEL / 64;
    constexpr int RB = 3;
    static_assert(PER % 8 == 0, "ln vector width");
    const int col0 = c.lane * PER;
    f32x4 gv[PER / 4], bv[PER / 4];
#pragma unroll
    for (int j = 0; j < PER / 4; ++j) { gv[j] = *(const f32x4*)(g + col0 + 4 * j); bv[j] = *(const f32x4*)(b + col0 + 4 * j); }
    for (int row0 = c.gwave; row0 < MT; row0 += RB * c.nwaves) {
        u32x4 xa[RB][PER / 8], oa[RB][PER / 8];
#pragma unroll
        for (int r = 0; r < RB; ++r) { const int row = row0 + r * c.nwaves;
            if (row < MT) {
#pragma unroll
                for (int j = 0; j < PER / 8; ++j) { xa[r][j] = *(const u32x4*)(XB + (size_t)row * D_MODEL + col0 + 8 * j); oa[r][j] = *(const u32x4*)(OUT + (size_t)row * ldo + col0 + 8 * j); } } }
#pragma unroll
        for (int r = 0; r < RB; ++r) { const int row = row0 + r * c.nwaves;
            if (row < MT) {
                float v[PER]; float s = 0.f;
#pragma unroll
                for (int j = 0; j < PER / 8; ++j)
#pragma unroll
                    for (int e = 0; e < 4; ++e) { v[8 * j + 2 * e] = DN_ALPHA * bflo(xa[r][j][e]) + bflo(oa[r][j][e]); v[8 * j + 2 * e + 1] = DN_ALPHA * bfhi(xa[r][j][e]) + bfhi(oa[r][j][e]); }
#pragma unroll
                for (int j = 0; j < PER; ++j) s += v[j];
                const float mean = wave_sum(s) * (1.f / D_MODEL); float q = 0.f;
#pragma unroll
                for (int j = 0; j < PER; ++j) { v[j] -= mean; q += v[j] * v[j]; }
                const float rstd = fast_rsq(wave_sum(q) * (1.f / D_MODEL) + LN_EPS);
#pragma unroll
                for (int j = 0; j < PER; ++j) v[j] = v[j] * rstd * gv[j >> 2][j & 3] + bv[j >> 2][j & 3];
#pragma unroll
                for (int j = 0; j < PER / 8; ++j) { u32x4 o;
#pragma unroll
                    for (int e = 0; e < 4; ++e) o[e] = cvtpk(v[8 * j + 2 * e], v[8 * j + 2 * e + 1]);
                    *(u32x4*)(XB + (size_t)row * D_MODEL + col0 + 8 * j) = o; }
                if (last) { float* yo = row < PT ? p.out + O_YP + (size_t)row * D_MODEL + col0 : p.out + O_YS + (size_t)(row - PT) * D_MODEL + col0;
#pragma unroll
                    for (int j = 0; j < PER; j += 4) *(f32x4*)(yo + j) = (f32x4){v[j], v[j + 1], v[j + 2], v[j + 3]}; }
            } }
    }
}
__device__ __forceinline__ float fast_exp2(float x) {
#ifdef EMU
    return exp2f(x);
#else
    return __builtin_amdgcn_exp2f(x);
#endif
}
__device__ __forceinline__ void b_cache_copies(PrmRef p, const Ctx& c) {
    bf16* CK = (bf16*)(p.ws + WS_CK); bf16* CVT = (bf16*)(p.ws + WS_CVT);
    for (int it = c.gtid; it < DEC_BATCH * WINDOW * B_KVW; it += c.nthreads) {
        const int dd = it % B_KVW, w = (it / B_KVW) % WINDOW, b = it / (B_KVW * WINDOW), kvh = dd / B_HD, d = dd % B_HD;
        CK[(((size_t)b * B_KV_HEADS + kvh) * WINDOW + w) * B_HD + d] = (bf16)f2bf(p.cache_k[it]);
        CVT[(((size_t)b * B_KV_HEADS + kvh) * B_HD + d) * WINDOW + w] = (bf16)f2bf(p.cache_v[it]);
    }
}
__device__ __forceinline__ void ph_b_gemm(PrmRef p, const Ctx& c, int lj, unsigned char* lds) {
    const bf16* XB = (const bf16*)(p.ws + WS_XB); bf16* PROJ = (bf16*)(p.ws + WS_PROJ); const bf16* Wt = (const bf16*)(p.ws + WS_WBIN) + (size_t)lj * B_N0 * D_MODEL;
    const int N = lj == 0 ? B_N0 : B_IN;
    pg8::Gemm g{XB, D_MODEL, Wt, PT, N, D_MODEL}; pg8::StaticOrder S; S.init(PT, N, c.nblk, c.bid);
    pg8::EpiBIn E{PROJ, PLD, (const float*)(p.ws + WS_ROPE), (bf16*)(p.ws + WS_VT)};
    __syncthreads();
    pg8::gemm_phase<pg8::EpiBIn, pg8::StaticOrder, true>((LAS unsigned char*)lds, g, S, E, c.tid);
    __syncthreads();
    sgemm_rows<2>(p, XB, D_MODEL, Wt, D_MODEL, PROJ, PLD, PT, ST, N, c, lj == 0 ? (PT / 256) * (B_N0 / 256) : 0, lds, true);
    if (lj == 0) b_cache_copies(p, c);
}
constexpr int AT_KPITCH = 144, AT_VPITCH = 400, AT_K = 0, AT_V = 192 * AT_KPITCH, AT_O = AT_V + 64 * AT_VPITCH + 64  , AT_OPITCH = 144;
static_assert(2 * SC_BUF <= 163840 - 64, "scan LDS");
static_assert(AT_O % 16 == 0 && AT_O + 256 * AT_OPITCH <= 131072, "attention LDS");
struct AttRaw { u32x4 k[3], v[3]; bf16x8 q[4]; };
__device__ __forceinline__ void att_load(PrmRef p, int ck, int kvh, int tid, AttRaw& raw) {
    const unsigned char* PROJ = (const unsigned char*)(p.ws + WS_PROJ); const unsigned char* VT = (const unsigned char*)(p.ws + WS_VT);
    const unsigned char* CK = (const unsigned char*)(p.ws + WS_CK); const unsigned char* CVT = (const unsigned char*)(p.ws + WS_CVT);
    const int lane = tid & 63, wave = tid >> 6, l31 = lane & 31, hi = lane >> 5;
    const bool smp = ck >= NCP; const int r0 = chunk_row0(ck);
    const int nc = smp ? 0 : ck % NCPS, nblk = smp ? 0 : (nc >= 2 ? 3 : nc + 1);
    if (!smp) {
        const int kfirst = r0 - (nblk - 1) * CHUNK;
#pragma unroll
        for (int j = 0; j < 3; ++j) if (j < nblk) { const int idx = tid + NTHR * j, key = idx >> 3, pc = idx & 7, d = (idx >> 3) & 63;
            raw.k[j] = *(const u32x4*)(PROJ + ((size_t)(kfirst + key) * PLD + B_IN + kvh * B_HD) * 2 + pc * 16);
            raw.v[j] = *(const u32x4*)(VT + ((((size_t)(ck - (nblk - 1) + j) * B_KV_HEADS + kvh) * B_HD + d) * 64) * 2 + pc * 16); }
    } else {
        const int b = ck - NCP;
#pragma unroll
        for (int j = 0; j < 3; ++j) { const int idx = tid + NTHR * j;
            if (idx < 160 * 8) { const int key = idx >> 3, pc = idx & 7;
                raw.k[j] = *(const u32x4*)(key < WINDOW ? CK + ((((size_t)b * B_KV_HEADS + kvh) * WINDOW + key) * B_HD) * 2 + pc * 16 : PROJ + ((size_t)(r0 + key - WINDOW) * PLD + B_IN + kvh * B_HD) * 2 + pc * 16); }
            if (idx < 64 * 20) { const int d = idx / 20, pc = idx % 20;
                raw.v[j] = *(const u32x4*)(pc < 16 ? CVT + ((((size_t)b * B_KV_HEADS + kvh) * B_HD + d) * WINDOW) * 2 + pc * 16 : VT + ((((size_t)ck * B_KV_HEADS + kvh) * B_HD + d) * 64) * 2 + (pc - 16) * 16); } }
    }
    const bool active = smp ? wave < 4 : true;
    const int hq = kvh * B_GROUP + (smp ? wave : (wave >> 1)), qrow0 = smp ? 0 : 32 * (wave & 1);
    if (active) {
#pragma unroll
        for (int ks = 0; ks < 4; ++ks) raw.q[ks] = *(const bf16x8*)(PROJ + ((size_t)(r0 + qrow0 + l31) * PLD + hq * B_HD + 16 * ks + 8 * hi) * 2);
    }
}
__device__ __forceinline__ void att_item(PrmRef p, int lj, int ck, int kvh, int nck, int nkvh, int tid, unsigned char* lds, AttRaw& raw) {
#ifndef EMU
    asm volatile("" : "+v"(tid));
#endif
    unsigned char* PROJ = (unsigned char*)(p.ws + WS_PROJ);
    const int lane = tid & 63, wave = READFIRSTLANE(tid >> 6), l31 = lane & 31, hi = lane >> 5;
    const bool smp = ck >= NCP; const int r0 = chunk_row0(ck);
    const int nc = smp ? 0 : ck % NCPS, nblk = smp ? 0 : (nc >= 2 ? 3 : nc + 1);
    const int nkt = smp ? 5 : 2 * nblk;
    if (!smp) {
#pragma unroll
        for (int j = 0; j < 3; ++j) if (j < nblk) { const int idx = tid + NTHR * j, key = idx >> 3, pc = idx & 7, d = (idx >> 3) & 63;
            *(u32x4*)(lds + AT_K + key * AT_KPITCH + pc * 16) = raw.k[j];
            unsigned char* dst = lds + AT_V + d * AT_VPITCH + j * 128 + (pc >> 1) * 32 + (pc & 1) * 8; *(u32x2*)dst = (u32x2){raw.v[j].x, raw.v[j].y}; *(u32x2*)(dst + 16) = (u32x2){raw.v[j].z, raw.v[j].w}; }
    } else {
#pragma unroll
        for (int j = 0; j < 3; ++j) { const int idx = tid + NTHR * j;
            if (idx < 160 * 8) { const int key = idx >> 3, pc = idx & 7; *(u32x4*)(lds + AT_K + key * AT_KPITCH + pc * 16) = raw.k[j]; }
            if (idx < 64 * 20) { const int d = idx / 20, pc = idx % 20; unsigned char* dst = lds + AT_V + d * AT_VPITCH + (pc >> 1) * 32 + (pc & 1) * 8; *(u32x2*)dst = (u32x2){raw.v[j].x, raw.v[j].y}; *(u32x2*)(dst + 16) = (u32x2){raw.v[j].z, raw.v[j].w}; } }
    }
    const bool active = smp ? wave < 4 : true;
    const int hq = kvh * B_GROUP + (smp ? wave : (wave >> 1));
    bf16x8 qf[4];
#pragma unroll
    for (int ks = 0; ks < 4; ++ks) qf[ks] = raw.q[ks];
    LBAR();
    if (nck >= 0) att_load(p, nck, nkvh, tid, raw);
    const int nrows = smp ? 128 : 256;
    u32x4 zr[4];
    if (active) {
        f32x16 sc[6];
#pragma unroll
        for (int kt = 0; kt < 6; ++kt) {
#pragma unroll
            for (int e = 0; e < 16; ++e) sc[kt][e] = 0.f;
            if (kt < nkt) {
#pragma unroll
                for (int ks = 0; ks < 4; ++ks) sc[kt] = MFMA32(*(const bf16x8*)(lds + AT_K + (32 * kt + l31) * AT_KPITCH + 32 * ks + 16 * hi), qf[ks], sc[kt]);
            }
        }
        const float sink = p.b_sinks[lj * B_Q_HEADS + hq];
        float m = sink;
#pragma unroll
        for (int kt = 0; kt < 6; ++kt) if (kt < nkt) {
#pragma unroll
            for (int e = 0; e < 16; ++e) m = fmaxf(m, sc[kt][e]); }
        m = fmaxf(m, __shfl_xor(m, 32));
        float l = 0.f; const float ml2 = m * 1.4426950408889634f;
#pragma unroll
        for (int kt = 0; kt < 6; ++kt) if (kt < nkt) {
#pragma unroll
            for (int e = 0; e < 16; ++e) { const float pe = fast_exp2(sc[kt][e] * 1.4426950408889634f - ml2); sc[kt][e] = pe; l += pe; } }
        l += __shfl_xor(l, 32);
        l += fast_exp2(sink * 1.4426950408889634f - ml2);
        f32x16 o[2];
#pragma unroll
        for (int e = 0; e < 16; ++e) { o[0][e] = 0.f; o[1][e] = 0.f; }
#pragma unroll
        for (int kt = 0; kt < 6; ++kt) if (kt < nkt) {
#pragma unroll
            for (int s = 0; s < 2; ++s) {
                u32x4 pw; pw.x = cvtpk(sc[kt][8 * s], sc[kt][8 * s + 1]); pw.y = cvtpk(sc[kt][8 * s + 2], sc[kt][8 * s + 3]); pw.z = cvtpk(sc[kt][8 * s + 4], sc[kt][8 * s + 5]); pw.w = cvtpk(sc[kt][8 * s + 6], sc[kt][8 * s + 7]);
                const bf16x8 pb = __builtin_bit_cast(bf16x8, pw);
#pragma unroll
                for (int mt = 0; mt < 2; ++mt) {
                    o[mt] = MFMA32(*(const bf16x8*)(lds + AT_V + (32 * mt + l31) * AT_VPITCH + (32 * kt + 16 * s) * 2 + 16 * hi), pb, o[mt]);
                }
            }
        }
        const float il = fast_rcp(l);
        unsigned char* orow = lds + AT_O + (32 * wave + l31) * AT_OPITCH;
#pragma unroll
        for (int mt = 0; mt < 2; ++mt)
#pragma unroll
            for (int cg4 = 0; cg4 < 4; ++cg4) {
                u32x2 w2; w2.x = cvtpk(o[mt][4 * cg4] * il, o[mt][4 * cg4 + 1] * il); w2.y = cvtpk(o[mt][4 * cg4 + 2] * il, o[mt][4 * cg4 + 3] * il);
                *(u32x2*)(orow + (32 * mt + 8 * cg4 + 4 * hi) * 2) = w2;
            }
    }
#pragma unroll
    for (int i = 0; i < 4; ++i) { const int idx = tid + NTHR * i;
        if (idx < nrows * 8) { const int qr = idx >> 3, pc = idx & 7, w = qr >> 5, hq2 = kvh * B_GROUP + (smp ? w : (w >> 1)), row = r0 + (smp ? 0 : 32 * (w & 1)) + (qr & 31);
            zr[i] = *(const u32x4*)(PROJ + ((size_t)row * PLD + B_QW + hq2 * B_HD) * 2 + pc * 16); } }
    LBAR();
#pragma unroll
    for (int i = 0; i < 4; ++i) { const int idx = tid + NTHR * i;
        if (idx < nrows * 8) { const int qr = idx >> 3, pc = idx & 7, w = qr >> 5, hq2 = kvh * B_GROUP + (smp ? w : (w >> 1)), row = r0 + (smp ? 0 : 32 * (w & 1)) + (qr & 31);
            const u32x4 ov = *(const u32x4*)(lds + AT_O + qr * AT_OPITCH + pc * 16); const u32x4 zv = zr[i];
            u32x4 r;
#pragma unroll
            for (int e = 0; e < 4; ++e) r[e] = cvtpk(bflo(ov[e]) * fsilu(bflo(zv[e])), bfhi(ov[e]) * fsilu(bfhi(zv[e])));
            *(u32x4*)(PROJ + ((size_t)row * PLD + hq2 * B_HD) * 2 + pc * 16) = r; } }
    LBAR();
}
__device__ __forceinline__ void ph_b_att2(PrmRef p, const Ctx& c, int lj, bool first, unsigned char* lds) {
    AttRaw raw;
    if (c.bid < NCH * B_KV_HEADS) att_load(p, c.bid / B_KV_HEADS, c.bid % B_KV_HEADS, c.tid, raw);
    for (int it = c.bid; it < NCH * B_KV_HEADS; it += c.nblk) { const int nx = it + c.nblk < NCH * B_KV_HEADS ? it + c.nblk : -1;
        att_item(p, lj, it / B_KV_HEADS, it % B_KV_HEADS, nx < 0 ? -1 : nx / B_KV_HEADS, nx < 0 ? 0 : nx % B_KV_HEADS, c.tid, lds, raw); }
    if (first) {
        const bf16* PROJ = (const bf16*)(p.ws + WS_PROJ);
        for (int it = c.gtid; it < (BATCH + DEC_BATCH) * WINDOW * B_KVW; it += c.nthreads) {
            const int e = it % B_KVW, w = (it / B_KVW) % WINDOW, s = it / (B_KVW * WINDOW);
            if (s < BATCH) { const int row = s * SEQ + SEQ - WINDOW + w; const bf16* kp = PROJ + (size_t)row * PLD + B_IN;
                p.out[O_PK + ((size_t)s * WINDOW + w) * B_KVW + e] = bf2f(kp[e]); p.out[O_PV + ((size_t)s * WINDOW + w) * B_KVW + e] = bf2f(kp[B_KVW + e]); }
            else { const int b = s - BATCH; float kx, vx;
                if (w < WINDOW - DEC_SEQ) { kx = p.cache_k[((size_t)b * WINDOW + w + DEC_SEQ) * B_KVW + e]; vx = p.cache_v[((size_t)b * WINDOW + w + DEC_SEQ) * B_KVW + e]; }
                else { const int row = PT + b * DEC_SEQ + (w - (WINDOW - DEC_SEQ)); const bf16* kp = PROJ + (size_t)row * PLD + B_IN; kx = bf2f(kp[e]); vx = bf2f(kp[B_KVW + e]); }
                p.out[O_SK + ((size_t)b * WINDOW + w) * B_KVW + e] = kx; p.out[O_SV + ((size_t)b * WINDOW + w) * B_KVW + e] = vx; }
        }
    }
}

#ifndef EMU
#define XB_TMO      128
#define XB_XCNT(j)  (256  + 64 * (j))
#define XB_XSUB(j)  (1280 + 64 * (j))
#define XB_XGEN(j)  (2304 + 64 * (j))
#define XB_TOP      3328
#define XB_TOPGEN   3392
#define XCD_BAR_WORDS 3456
#define XB_SPIN_CAP (1u << 20)
__device__ __forceinline__ unsigned xb_ld(unsigned* p)              { return __hip_atomic_load(p, __ATOMIC_RELAXED, __HIP_MEMORY_SCOPE_AGENT); }
__device__ __forceinline__ unsigned xb_add(unsigned* p, unsigned v) { return __hip_atomic_fetch_add(p, v, __ATOMIC_RELAXED, __HIP_MEMORY_SCOPE_AGENT); }
__device__ __forceinline__ unsigned xb_xcc_id() { return (unsigned)__builtin_amdgcn_s_getreg((3 << 11) | 20) & 0xFu; }
#define XB_SPIN(cond, bar) do { unsigned _sp = 0; while (cond) { __builtin_amdgcn_s_sleep(1); \
    if ((++_sp & 255u) == 0u) { if (xb_ld(&(bar)[XB_TMO])) break; if (_sp > XB_SPIN_CAP) { atomicAdd(&(bar)[XB_TMO], 1u); break; } } } } while (0)
__device__ __forceinline__ void xcd_barrier_complete(unsigned* bar, unsigned x, unsigned& nloc, unsigned& nx) {
    const unsigned G = gridDim.x * gridDim.y * gridDim.z;
    unsigned sum, cnt, mine, sp = 0u;
    for (;;) {
        sum = 0u; cnt = 0u; mine = 0u;
#pragma unroll
        for (unsigned j = 0; j < 16; ++j) { const unsigned c = xb_ld(&bar[XB_XCNT(j)]); sum += c; cnt += (c > 0u) ? 1u : 0u; mine = (j == x) ? c : mine; }
        if (sum == G) break;
        __builtin_amdgcn_s_sleep(1);
        if ((++sp & 255u) == 0u) { if (xb_ld(&bar[XB_TMO])) break; if (sp > XB_SPIN_CAP) { atomicAdd(&bar[XB_TMO], 1u); break; } }
    }
    nloc = mine > 0u ? mine : 1u; nx = cnt > 0u ? cnt : 1u;
}
__device__ __forceinline__ void xcd_barrier(unsigned* bar, volatile LAS unsigned* st, const int tid) {
    asm volatile("s_waitcnt vmcnt(0)" ::: "memory");
    __syncthreads();
    if (tid == 0) {
        __builtin_amdgcn_s_waitcnt(0);
        const unsigned x = xb_xcc_id();
        unsigned nloc = st[0], nx = st[1];
        if (nloc == 0u) { xcd_barrier_complete(bar, x, nloc, nx); st[0] = nloc; st[1] = nx; }
        const unsigned old = xb_add(&bar[XB_XSUB(x)], 1u);
        const unsigned gen = old / nloc;
        if (old + 1u == (gen + 1u) * nloc) {
            __builtin_amdgcn_fence(__ATOMIC_RELEASE, "agent");
            asm volatile("s_waitcnt vmcnt(0)" ::: "memory");
            const unsigned og = xb_add(&bar[XB_TOP], 1u);
            const unsigned tg = og / nx;
            if (og + 1u == (tg + 1u) * nx) xb_add(&bar[XB_TOPGEN], 1u);
            else XB_SPIN(xb_ld(&bar[XB_TOPGEN]) == tg, bar);
            __builtin_amdgcn_fence(__ATOMIC_ACQUIRE, "agent");
            xb_add(&bar[XB_XGEN(x)], 1u);
            asm volatile("s_waitcnt vmcnt(0)" ::: "memory");
        } else {
            XB_SPIN(xb_ld(&bar[XB_XGEN(x)]) == gen, bar);
            __builtin_amdgcn_fence(__ATOMIC_ACQUIRE, "agent");
            asm volatile("s_waitcnt vmcnt(0)" ::: "memory");
        }
    }
    __syncthreads();
}
#endif
constexpr int PH_A0 = 1, PH_APER = 6, PH_B0 = PH_A0 + N_A * PH_APER, PH_BPER = 4, N_PHASES = PH_B0 + N_B * PH_BPER;
constexpr int LDS_BAR_OFF = 163840 - 64;
constexpr int LDS_BYTES = 163840;
#ifdef EMU
#define DECL_LDS(name) unsigned char* name = emu::blk()->lds
#else
#define DECL_LDS(name) extern __shared__ __attribute__((aligned(16))) unsigned char name[]
#endif

#ifdef EMU
#define PH_PROLOGUE() PrmRef p = p_; int tid_ = threadIdx.x, bid_ = blockIdx.x;
#define GRID_SYNC()
#else
#define PH_PROLOGUE() const __attribute__((address_space(4))) Prm* pp = (const __attribute__((address_space(4))) Prm*)__builtin_amdgcn_kernarg_segment_ptr(); \
    int tid_ = wave_s_ * 64 + (int)__builtin_amdgcn_mbcnt_hi(~0u, __builtin_amdgcn_mbcnt_lo(~0u, 0u)), bid_ = blockIdx.x; asm volatile("" : "+s"(pp), "+v"(tid_), "+s"(bid_)); PrmRef p = *pp;
#define GRID_SYNC() xcd_barrier((unsigned*)(p.ws + WS_CTL), (volatile LAS unsigned*)(lds + LDS_BAR_OFF), c.tid)
#endif
#define PHASE(k, ...) if (ph_lo <= (k) && (k) < ph_hi) { PH_PROLOGUE() \
        Ctx c; c.tid = tid_; c.lane = c.tid & 63; c.wave = c.tid >> 6; c.bid = bid_; c.nblk = gridDim.x; \
        c.gtid = c.bid * NTHR + c.tid; c.nthreads = c.nblk * NTHR; c.gwave = c.bid * (NTHR / 64) + c.wave; c.nwaves = c.nblk * (NTHR / 64); \
        bf16* PROJ = (bf16*)(p.ws + WS_PROJ); const bf16* XB = (const bf16*)(p.ws + WS_XB); (void)PROJ; (void)XB; \
        __VA_ARGS__; \
        if ((k) + 1 < ph_hi) { GRID_SYNC(); } }
#define A_LAYER(li) \
    PHASE(PH_A0 + (li) * PH_APER + 0, ph_a_gemm(p, c, li, lds)) \
    PHASE(PH_A0 + (li) * PH_APER + 1, ph_a_pre(p, c, li, lds)) \
    PHASE(PH_A0 + (li) * PH_APER + 2, ph_a_scan2(p, c, li, lds)) \
    PHASE(PH_A0 + (li) * PH_APER + 3, ph_a_norm(p, c, li, lds)) \
    PHASE(PH_A0 + (li) * PH_APER + 4, gemm_mfma(PROJ + 2 * A_QK, PLD, (const bf16*)(p.ws + WS_WAOUT) + (size_t)(li) * D_MODEL * A_VW, PROJ, PLD, PT, D_MODEL, A_VW, c, lds)) \
    PHASE(PH_A0 + (li) * PH_APER + 5, ph_ln(p, c, PROJ, PLD, p.a_ln_g + (size_t)(li) * D_MODEL, p.a_ln_b + (size_t)(li) * D_MODEL, false))
#define B_LAYER(lj) \
    PHASE(PH_B0 + (lj) * PH_BPER + 0, ph_b_gemm(p, c, lj, lds)) \
    PHASE(PH_B0 + (lj) * PH_BPER + 1, ph_b_att2(p, c, lj, (lj) == 0, lds)) \
    PHASE(PH_B0 + (lj) * PH_BPER + 2, gemm_mfma(PROJ, PLD, (const bf16*)(p.ws + WS_WBOUT) + (size_t)(lj) * D_MODEL * B_QW, PROJ + B_QW, PLD, PT, D_MODEL, B_QW, c, lds); \
        sgemm_rows(p, PROJ, PLD, (const bf16*)(p.ws + WS_WBOUT) + (size_t)(lj) * D_MODEL * B_QW, B_QW, PROJ + B_QW, PLD, PT, ST, D_MODEL, c, 0, lds)) \
    PHASE(PH_B0 + (lj) * PH_BPER + 3, ph_ln(p, c, PROJ + B_QW, PLD, p.b_ln_g + (size_t)(lj) * D_MODEL, p.b_ln_b + (size_t)(lj) * D_MODEL, (lj) == N_B - 1))

__global__ void __launch_bounds__(NTHR, 2) fwd_kernel(Prm p_, int ph_lo, int ph_hi) {
    DECL_LDS(lds);
#ifndef EMU
    const int wave_s_ = __builtin_amdgcn_readfirstlane((int)threadIdx.x >> 6);
    {
        if (threadIdx.x < 2) ((volatile LAS unsigned*)(lds + LDS_BAR_OFF))[threadIdx.x] = 0u;
        if (threadIdx.x == 0) (void)xb_add((unsigned*)(p_.ws + WS_CTL) + XB_XCNT(xb_xcc_id()), 1u);
        __syncthreads();
    }
#endif
    PHASE(0, ph_init(p, c); ph_weights(p, c, lds))
    A_LAYER(0)
    A_LAYER(1)
    B_LAYER(0)
    B_LAYER(1)
#ifdef PROBE_TAIL
    PROBE_TAIL
#endif
}

extern "C" void kernel_launch(void* const* d_in, const int* in_sizes, int n_in, void* d_out, int out_size, void* d_ws, size_t ws_size, hipStream_t stream) {
    if (n_in != 20 || (size_t)out_size != O_END || ws_size < WS_NEED) { fprintf(stderr, "kernel_launch: unexpected sizes n_in=%d out=%d ws=%zu (need %zu, out %zu)\n", n_in, out_size, ws_size, (size_t)WS_END, (size_t)O_END); return; }
    Prm p{};
    const float** pp = (const float**)&p;
    for (int i = 0; i < 20; ++i) pp[i] = (const float*)d_in[i];
    p.out = (float*)d_out; p.ws = (unsigned char*)d_ws;
#ifdef EMU
    const int grid = 8;
    const int stop = getenv("EMU_STOP") ? atoi(getenv("EMU_STOP")) : N_PHASES;
    for (int ph = 0; ph < N_PHASES && ph < stop; ++ph) { emu::launch([=]() { fwd_kernel(p, ph, ph + 1); }, dim3(grid), dim3(NTHR), LDS_BYTES); fprintf(stderr, "phase %d done\n", ph); }
#else
    static int grid = 0;
    if (grid == 0) {
        int dev = 0, cus = 0, per_cu = 0;
        (void)hipGetDevice(&dev); (void)hipDeviceGetAttribute(&cus, hipDeviceAttributeMultiprocessorCount, dev);
        (void)hipFuncSetAttribute((const void*)fwd_kernel, hipFuncAttributeMaxDynamicSharedMemorySize, LDS_BYTES);
        (void)hipOccupancyMaxActiveBlocksPerMultiprocessor(&per_cu, (const void*)fwd_kernel, NTHR, LDS_BYTES);
        if (per_cu < 1) { fprintf(stderr, "kernel_launch: occupancy query says %d blocks per CU\n", per_cu); per_cu = 1; }
        grid = cus;
    }
    (void)hipMemsetAsync((char*)d_ws + WS_CTL, 0, 65536, stream);
#ifdef PROBE_TAIL
    int lo = 0, hi = N_PHASES + PROBE_NTAIL;
#else
    int lo = 0, hi = N_PHASES;
#endif
    void* args[] = {(void*)&p, (void*)&lo, (void*)&hi};
    hipError_t e = hipLaunchCooperativeKernel((const void*)fwd_kernel, dim3(grid), dim3(NTHR), args, LDS_BYTES, stream);
    if (e != hipSuccess) fprintf(stderr, "cooperative launch failed: %s (grid %d)\n", hipGetErrorString(e), grid);
#endif
}
```

```cpp
#ifdef EMU
#include "hip_emu.h"
#else
#include <hip/hip_runtime.h>
#include <hip/hip_cooperative_groups.h>
namespace cg = cooperative_groups;
#endif
#include <cstdint>
#include <cstddef>
#include <cstdio>

typedef short bf16x8 __attribute__((ext_vector_type(8)));
typedef float f32x4 __attribute__((ext_vector_type(4)));
typedef float f32x16 __attribute__((ext_vector_type(16)));
typedef unsigned u32x4 __attribute__((ext_vector_type(4)));
typedef unsigned u32x2 __attribute__((ext_vector_type(2)));
#ifdef EMU
#define LAS
#define WAVE_SYNC() emu::wave_sync()
#define GLDS16(gp, lp) memcpy((unsigned char*)(lp) + emu::lane_id() * 16, (const void*)(gp), 16)
typedef const unsigned char* BufRes;
#define MAKE_RES(p) ((const unsigned char*)(p))
#define BLDS16(res, voff, soff, lp) memcpy((unsigned char*)(lp) + emu::lane_id() * 16, (res) + (voff) + (soff), 16)
#define MFMA16(a, b, c) emu_mfma_16x16x32_bf16(a, b, c)
#define MFMA32(a, b, c) emu_mfma_32x32x16_bf16(a, b, c)
#define MFMAF(a, b, c) emu_mfma_16x16x4_f32(a, b, c)
#define SETPRIO(n)
#define SCHED_BARRIER()
#define S_BARRIER() emu::block_sync()
#define WAIT_VM(n)
#define WAIT_LGKM(n)
#define READFIRSTLANE(x) (x)
#define BCAST_LANE(v, n) __shfl(v, n)
#define LBAR() emu::block_sync()
typedef short s16x4 __attribute__((ext_vector_type(4)));
inline s16x4 emu_ds_read_tr16(const void* pp) { s16x4 mine = *(const s16x4*)pp, r; const int l = emu::lane_id(), i = l & 15;
    for (int e = 0; e < 4; ++e) { const s16x4 o = emu::shfl_idx(mine, (l & ~15) + 4 * e + (i >> 2)); r[e] = o[i & 3]; } return r; }
#define LDS_TR16(ptr) emu_ds_read_tr16(ptr)
#else
#define LAS __attribute__((address_space(3)))
#define WAVE_SYNC() asm volatile("s_waitcnt lgkmcnt(0)" ::: "memory")
#define GLDS16(gp, lp) __builtin_amdgcn_global_load_lds((const unsigned*)(gp), (LAS unsigned*)(lp), 16, 0, 0)
typedef __amdgpu_buffer_rsrc_t BufRes;
#define MAKE_RES(p) __builtin_amdgcn_make_buffer_rsrc((void*)(p), 0, 0x7fffffff, 0x00020000)
#define BLDS16(res, voff, soff, lp) __builtin_amdgcn_raw_ptr_buffer_load_lds(res, (LAS unsigned*)(lp), 16, (int)(voff), (int)(soff), 0, 0)
#define MFMA16(a, b, c) __builtin_amdgcn_mfma_f32_16x16x32_bf16(a, b, c, 0, 0, 0)
#define MFMA32(a, b, c) __builtin_amdgcn_mfma_f32_32x32x16_bf16(a, b, c, 0, 0, 0)
#define MFMAF(a, b, c) __builtin_amdgcn_mfma_f32_16x16x4f32(a, b, c, 0, 0, 0)
#define SETPRIO(n) __builtin_amdgcn_s_setprio(n)
#define SCHED_BARRIER() __builtin_amdgcn_sched_barrier(0)
#define S_BARRIER() __builtin_amdgcn_s_barrier()
#define WAIT_VM(n) asm volatile("s_waitcnt vmcnt(" #n ")" ::: "memory")
#define WAIT_LGKM(n) asm volatile("s_waitcnt lgkmcnt(" #n ")" ::: "memory")
#define READFIRSTLANE(x) __builtin_amdgcn_readfirstlane(x)
#define BCAST_LANE(v, n) __builtin_bit_cast(float, __builtin_amdgcn_readlane(__builtin_bit_cast(int, v), n))
typedef short s16x4 __attribute__((ext_vector_type(4)));
#define LDS_TR16(ptr) __builtin_amdgcn_ds_read_tr16_b64_v4i16((LAS s16x4*)(ptr))
#define LBAR() do { asm volatile("s_waitcnt lgkmcnt(0)" ::: "memory"); __builtin_amdgcn_s_barrier(); asm volatile("" ::: "memory"); } while (0)
#endif

#ifdef CFG_SMALL
constexpr int D_MODEL = 512, BATCH = 2, SEQ = 256, DEC_BATCH = 8, DEC_SEQ = 32, A_HEADS = 4, B_Q_HEADS = 8, B_KV_HEADS = 2;
#else
constexpr int D_MODEL = 1024, BATCH = 8, SEQ = 2048, DEC_BATCH = 16, DEC_SEQ = 32, A_HEADS = 8, B_Q_HEADS = 16, B_KV_HEADS = 4;
#endif
constexpr int PAST_LEN = 4096, CHUNK = 64, N_A = 2, N_B = 2, DEPTH = 4;
constexpr int A_DK = 128, A_DV = 128, A_QK = A_HEADS * A_DK, A_VW = A_HEADS * A_DV, CONV_W = 4, CONV_DIM = 2 * A_QK + A_VW;
constexpr int A_IN = CONV_DIM + A_VW + 2 * A_HEADS, A_MAIN = CONV_DIM + A_VW;
constexpr int B_GROUP = B_Q_HEADS / B_KV_HEADS, B_HD = 64, B_QW = B_Q_HEADS * B_HD, B_KVW = B_KV_HEADS * B_HD, B_IN = 2 * B_QW;
constexpr int WINDOW = 128, ROPE_DIMS = 16, ROPE_HALF = 8;
constexpr float LN_EPS = 1e-5f, RMS_EPS = 1e-6f;
constexpr float DN_ALPHA = 1.681792830507429f;
constexpr int PT = BATCH * SEQ, ST = DEC_BATCH * DEC_SEQ, MT = PT + ST, NSEQ = BATCH + DEC_BATCH;
constexpr int NCPS = SEQ / CHUNK, NCP = BATCH * NCPS, NCH = NCP + DEC_BATCH;
constexpr int PLD = A_MAIN > B_IN + 2 * B_KVW ? A_MAIN : B_IN + 2 * B_KVW;
static_assert(B_GROUP == 4, "attention wave map");
static_assert(PT % 256 == 0 && ST % 64 == 0 && D_MODEL % 256 == 0 && A_VW % 256 == 0 && B_QW % 256 == 0 && A_MAIN % 256 == 0 && D_MODEL % 256 == 0 && B_IN % 256 == 0 && (2 * B_KVW) % 256 == 0 && D_MODEL % 128 == 0 && D_MODEL >= 256, "gemm tiles");
static_assert(DEC_SEQ == 32 && WINDOW == 128 && CHUNK == 64, "fixed");

constexpr size_t O_YP = 0, O_YS = O_YP + (size_t)PT * D_MODEL, O_PDELTA = O_YS + (size_t)ST * D_MODEL;
constexpr size_t O_PCONV = O_PDELTA + (size_t)N_A * BATCH * A_HEADS * A_DK * A_DV, O_PK = O_PCONV + (size_t)N_A * BATCH * 3 * CONV_DIM;
constexpr size_t O_PV = O_PK + (size_t)BATCH * WINDOW * B_KVW, O_SDELTA = O_PV + (size_t)BATCH * WINDOW * B_KVW;
constexpr size_t O_SCONV = O_SDELTA + (size_t)N_A * DEC_BATCH * A_HEADS * A_DK * A_DV, O_SK = O_SCONV + (size_t)N_A * DEC_BATCH * 3 * CONV_DIM;
constexpr size_t O_SV = O_SK + (size_t)DEC_BATCH * WINDOW * B_KVW, O_END = O_SV + (size_t)DEC_BATCH * WINDOW * B_KVW;

constexpr size_t al256(size_t x) { return (x + 255) & ~(size_t)255; }
constexpr size_t WS_CTL = 0, WS_ROPE = 1u << 20;
constexpr size_t WS_GB = al256(WS_ROPE + (size_t)(SEQ + DEC_SEQ) * ROPE_HALF * 2 * 4);
constexpr size_t WS_HALO = al256(WS_GB + (size_t)MT * A_HEADS * 2 * 4);
constexpr size_t WS_XB = al256(WS_HALO + (size_t)NCH * 3 * CONV_DIM * 2);
constexpr size_t WS_PROJ = al256(WS_XB + (size_t)MT * D_MODEL * 2);
constexpr size_t WS_WAIN = al256(WS_PROJ + (size_t)MT * PLD * 2);
constexpr int A_NG = A_MAIN + 256;
constexpr size_t WS_WAOUT = al256(WS_WAIN + (size_t)N_A * A_NG * D_MODEL * 2);
constexpr int B_N0 = B_IN + 2 * B_KVW;
constexpr size_t WS_WBIN = al256(WS_WAOUT + (size_t)N_A * D_MODEL * A_VW * 2);
constexpr size_t WS_WBOUT = al256(WS_WBIN + (size_t)(B_N0 + B_IN) * D_MODEL * 2);
constexpr size_t WS_WB = al256(WS_WBOUT + (size_t)N_B * D_MODEL * B_QW * 2);
constexpr size_t WS_IA = al256(WS_WB + (size_t)PT * A_QK * 2);
constexpr size_t WS_GL = al256(WS_IA + (size_t)BATCH * A_HEADS * (SEQ / CHUNK) * 64 * 64 * 2);
constexpr size_t WS_END = al256(WS_GL + (size_t)BATCH * A_HEADS * (SEQ / CHUNK) * 4);
static_assert(WS_END <= ((size_t)256 << 20), "workspace");
constexpr size_t WS_VT = WS_WB, WS_CK = al256(WS_VT + (size_t)NCH * B_KV_HEADS * 64 * 64 * 2), WS_CVT = al256(WS_CK + (size_t)DEC_BATCH * B_KV_HEADS * 128 * 64 * 2);
constexpr size_t WS_BEND = al256(WS_CVT + (size_t)DEC_BATCH * B_KV_HEADS * 128 * 64 * 2), WS_NEED = WS_BEND > WS_END ? WS_BEND : WS_END;
static_assert(WS_NEED <= ((size_t)256 << 20), "workspace (B-layer buffers overlay the A-layer WB | IA | GL region)");

static_assert(N_B == 2, "weight map");

typedef unsigned short bf16;
constexpr int NTHR = 512;

struct Prm {
    const float *x_prompt, *x_sample, *state_delta, *state_conv, *cache_k, *cache_v, *a_w_in, *a_conv_w, *a_log, *a_dt_bias, *a_norm_w, *a_w_out, *a_ln_g, *a_ln_b,
        *b_w_kv, *b_w_in, *b_sinks, *b_w_out, *b_ln_g, *b_ln_b;
    float* out; unsigned char* ws;
};

__device__ __forceinline__ unsigned f2bf(float f) { unsigned u = __builtin_bit_cast(unsigned, f); return (u + 0x7fffu + ((u >> 16) & 1u)) >> 16; }
__device__ __forceinline__ float bf2f(bf16 h) { return __builtin_bit_cast(float, (unsigned)h << 16); }
__device__ __forceinline__ float siluf(float x) { return x / (1.f + expf(-x)); }
__device__ __forceinline__ float sigmoidf_(float x) { return 1.f / (1.f + expf(-x)); }
__device__ __forceinline__ float softplusf_(float x) { return x > 20.f ? x : log1pf(expf(x)); }
__device__ __forceinline__ float wave_sum(float v) {
#pragma unroll
    for (int o = 1; o < 64; o <<= 1) v += __shfl_xor(v, o);
    return v;
}

#ifdef EMU
__device__ __forceinline__ float fast_rcp(float x) { return 1.f / x; }
__device__ __forceinline__ float fast_rsq(float x) { return 1.f / sqrtf(x); }
__device__ __forceinline__ float fast_ex2(float x) { return exp2f(x); }
__device__ __forceinline__ unsigned cvtpk(float lo, float hi) { return f2bf(lo) | (f2bf(hi) << 16); }
__device__ __forceinline__ float dpp_xor1(float v) { return __shfl(v, emu::lane_id() ^ 1); }
__device__ __forceinline__ float dpp_xor2(float v) { return __shfl(v, emu::lane_id() ^ 2); }
__device__ __forceinline__ float dpp_hmirror(float v) { const int l = emu::lane_id(); return __shfl(v, (l & ~7) | (7 - (l & 7))); }
__device__ __forceinline__ float dpp_mirror(float v) { const int l = emu::lane_id(); return __shfl(v, (l & ~15) | (15 - (l & 15))); }
#else
__device__ __forceinline__ float fast_rcp(float x) { return __builtin_amdgcn_rcpf(x); }
__device__ __forceinline__ float fast_rsq(float x) { return __builtin_amdgcn_rsqf(x); }
__device__ __forceinline__ float fast_ex2(float x) { return __builtin_amdgcn_exp2f(x); }
__device__ __forceinline__ unsigned cvtpk(float lo, float hi) { typedef float f2_t __attribute__((ext_vector_type(2))); typedef __bf16 b2_t __attribute__((ext_vector_type(2)));
    f2_t v = {lo, hi}; b2_t b = __builtin_convertvector(v, b2_t); return __builtin_bit_cast(unsigned, b); }
template <int CTRL> __device__ __forceinline__ float dpp_mov(float v) { return __builtin_bit_cast(float, __builtin_amdgcn_update_dpp(0, __builtin_bit_cast(int, v), CTRL, 0xf, 0xf, true)); }
__device__ __forceinline__ float dpp_xor1(float v) { return dpp_mov<0xB1>(v); }
__device__ __forceinline__ float dpp_xor2(float v) { return dpp_mov<0x4E>(v); }
__device__ __forceinline__ float dpp_hmirror(float v) { return dpp_mov<0x141>(v); }
__device__ __forceinline__ float dpp_mirror(float v) { return dpp_mov<0x140>(v); }
#endif
__device__ __forceinline__ float sum8(float v) { v += dpp_xor1(v); v += dpp_xor2(v); v += dpp_hmirror(v); return v; }
__device__ __forceinline__ float sum16(float v) { v = sum8(v); v += dpp_mirror(v); return v; }
__device__ __forceinline__ float fsilu(float x) { return x * fast_rcp(1.f + fast_ex2(-1.4426950408889634f * x)); }
__device__ __forceinline__ float fexp(float x) { return fast_ex2(1.4426950408889634f * x); }
__device__ __forceinline__ float bflo(unsigned u) { return __builtin_bit_cast(float, u << 16); }
__device__ __forceinline__ float bfhi(unsigned u) { return __builtin_bit_cast(float, u & 0xffff0000u); }
__device__ __forceinline__ int seq_row0(int s) { return s < BATCH ? s * SEQ : PT + (s - BATCH) * DEC_SEQ; }
__device__ __forceinline__ int seq_len(int s) { return s < BATCH ? SEQ : DEC_SEQ; }
__device__ __forceinline__ int chunk_row0(int c) { return c < NCP ? c * CHUNK : PT + (c - NCP) * DEC_SEQ; }
__device__ __forceinline__ int chunk_len(int c) { return c < NCP ? CHUNK : DEC_SEQ; }
__device__ __forceinline__ int row_posidx(int row) { return row < PT ? (row % SEQ) : SEQ + ((row - PT) % DEC_SEQ); }

#ifdef EMU
typedef const Prm& PrmRef;
#else
typedef const __attribute__((address_space(4))) Prm& PrmRef;
#endif
struct Ctx { int tid, lane, wave, gtid, gwave, nthreads, nwaves, bid, nblk; };

namespace pg8 {
constexpr int BM = 256, BK = 64, HALF = 128, HTB = HALF * BK * 2  , STAGE_BYTES = 8 * HTB, NXCD = 8, WGM = 8;
__host__ __device__ __forceinline__ int lds_byte(int r, int c) { const int st = (r >> 4) * 2 + (c >> 5), rr = r & 15, cc = c & 31, ob = rr * 64 + cc * 2; return st * 1024 + (ob ^ (((ob >> 9) & 1) << 5)); }
__host__ __device__ __forceinline__ void stage_rc(int b, int& R, int& C) { const int st = b / 1024, sb = b % 1024, swz = sb ^ (((sb >> 9) & 1) << 5); R = (st >> 1) * 16 + swz / 64; C = (st & 1) * 32 + (swz % 64) / 2; }
__host__ __device__ __forceinline__ int perm32(int rho) { const int n = rho >> 4, i = rho & 15; return 8 * (i >> 2) + 4 * n + (i & 3); }
struct Unit { int pm, pn; };
struct Gemm { const bf16* A; int lda; const bf16* Bt; int M, N, K; };
struct StaticOrder {
    int nM, nN, nwg, G, c;
    __host__ __device__ void init(int M, int N, int G_, int c_) { nM = M / BM; nN = N / BM; nwg = nM * nN; G = G_; c = c_; }
    __host__ __device__ bool next(int i, Unit& u) const {
        const long L = (long)i * G + c; if (L >= nwg) return false;
        int wgid = (int)L; { const int q = nwg / NXCD, r = nwg % NXCD, xcd = wgid % NXCD, off = wgid / NXCD; wgid = (xcd < r ? xcd * (q + 1) : r * (q + 1) + (xcd - r) * q) + off; }
        const int nig = WGM * nN, gid = wgid / nig, fm = gid * WGM, gsz = (nM - fm) < WGM ? (nM - fm) : WGM;
        u.pm = fm + ((wgid % nig) % gsz); u.pn = (wgid % nig) / gsz; return true;
    }
};
__device__ __forceinline__ unsigned cvt_pk_bf16(float lo, float hi) {
#ifdef EMU
    return f2bf(lo) | (f2bf(hi) << 16);
#else
    unsigned r; asm volatile("v_cvt_pk_bf16_f32 %0, %1, %2" : "=v"(r) : "v"(lo), "v"(hi)); return r;
#endif
}
struct EpiBf16 {
    static constexpr bool PERM = true;
    bf16* O; int ldc;
    __device__ __forceinline__ void operator()(const f32x4 (&acc)[2][2][4][2], const Unit& u, int wr, int wc, int fr, int fq) const {
        int fr_ = fr, fq_ = fq;
#ifndef EMU
        asm volatile("" : "+v"(fr_), "+v"(fq_));
#endif
        const int row0 = u.pm * BM + wr * 64 + fr_, col0 = u.pn * BM + wc * 32 + 8 * fq_;
#pragma unroll
        for (int ai = 0; ai < 2; ++ai)
#pragma unroll
            for (int m = 0; m < 4; ++m) { bf16* rowp = O + (size_t)(row0 + ai * HALF + m * 16) * ldc + col0;
#pragma unroll
                for (int bj = 0; bj < 2; ++bj) { const f32x4 v0 = acc[ai][bj][m][0], v1 = acc[ai][bj][m][1];
                    u32x4 w; w.x = cvt_pk_bf16(v0[0], v0[1]); w.y = cvt_pk_bf16(v0[2], v0[3]); w.z = cvt_pk_bf16(v1[0], v1[1]); w.w = cvt_pk_bf16(v1[2], v1[3]);
                    *(u32x4*)(rowp + bj * HALF) = w; } }
    }
};
struct EpiAIn {
    static constexpr bool PERM = true;
    bf16* O; int ldc; bf16* HALO; float* pconv;
    __device__ __forceinline__ void operator()(const f32x4 (&acc)[2][2][4][2], const Unit& u, int wr, int wc, int fr, int fq) const {
        int fr_ = fr, fq_ = fq;
#ifndef EMU
        asm volatile("" : "+v"(fr_), "+v"(fq_));
#endif
        const int row0 = u.pm * BM + wr * 64 + fr_, col0 = u.pn * BM + wc * 32 + 8 * fq_;
#pragma unroll
        for (int ai = 0; ai < 2; ++ai)
#pragma unroll
            for (int m = 0; m < 4; ++m) { const int row = row0 + ai * HALF + m * 16; bf16* rowp = O + (size_t)row * ldc + col0;
#pragma unroll
                for (int bj = 0; bj < 2; ++bj) { const f32x4 v0 = acc[ai][bj][m][0], v1 = acc[ai][bj][m][1];
                    u32x4 w; w.x = cvt_pk_bf16(v0[0], v0[1]); w.y = cvt_pk_bf16(v0[2], v0[3]); w.z = cvt_pk_bf16(v1[0], v1[1]); w.w = cvt_pk_bf16(v1[2], v1[3]);
                    *(u32x4*)(rowp + bj * HALF) = w;
                    if (m == 3 && fr_ >= 13 && col0 + bj * HALF < CONV_DIM) {
                        const int ck = row >> 6, hr = fr_ - 13, col = col0 + bj * HALF;
                        *(u32x4*)(HALO + ((size_t)ck * 3 + hr) * CONV_DIM + col) = w;
                        if (ck % NCPS == NCPS - 1) { float* dst = pconv + ((size_t)(ck / NCPS) * 3 + hr) * CONV_DIM + col; *(f32x4*)dst = v0; *(f32x4*)(dst + 4) = v1; }
                    } } }
    }
};
struct EpiBIn {
    static constexpr bool PERM = true;
    bf16* O; int ldc; const float* rope; bf16* VT;
    __device__ __forceinline__ void operator()(const f32x4 (&acc)[2][2][4][2], const Unit& u, int wr, int wc, int fr, int fq) const {
        int fr_ = fr, fq_ = fq;
#ifndef EMU
        asm volatile("" : "+v"(fr_), "+v"(fq_));
#endif
        static_assert(B_QW % 128 == 0 && B_KVW % 128 == 0, "a 128-column half tile has one kind");
        const int ct = u.pn * BM;
        int kinds[2]; bool ropes[2];
#pragma unroll
        for (int bj = 0; bj < 2; ++bj) { const int cc = ct + bj * HALF; kinds[bj] = cc < B_QW ? 0 : cc < B_IN ? 1 : cc < B_IN + B_KVW ? 2 : 3;
            ropes[bj] = (kinds[bj] == 0 || kinds[bj] == 2) && (wc & 1) == 0; }
        const int row0 = u.pm * BM + wr * 64 + fr_, col0 = ct + wc * 32 + 8 * fq_;
#pragma unroll
        for (int ai = 0; ai < 2; ++ai)
#pragma unroll
            for (int m = 0; m < 4; ++m) { const int row = row0 + ai * HALF + m * 16; bf16* rowp = O + (size_t)row * ldc + col0;
                f32x4 cs[4];
                if (ropes[0] || ropes[1]) { const f32x4* rp = (const f32x4*)(rope + (size_t)(row % SEQ) * ROPE_HALF * 2);
#pragma unroll
                    for (int q4 = 0; q4 < 4; ++q4) cs[q4] = rp[q4]; }
#pragma unroll
                for (int bj = 0; bj < 2; ++bj) { f32x4 v0 = acc[ai][bj][m][0], v1 = acc[ai][bj][m][1]; const int kind = kinds[bj]; const float sc = kind == 0 ? 0.125f : 1.f;
                    if (ropes[bj]) {
                        float x[8] = {v0[0], v0[1], v0[2], v0[3], v1[0], v1[1], v1[2], v1[3]}, o[8];
#pragma unroll
                        for (int j = 0; j < 8; ++j) o[j] = __shfl_xor(x[j], 16);
                        if (fq_ < 2) {
#pragma unroll
                            for (int j = 0; j < 8; ++j) { const float c_ = cs[j >> 1][2 * (j & 1)], s_ = cs[j >> 1][2 * (j & 1) + 1]; x[j] = fq_ == 0 ? x[j] * c_ - o[j] * s_ : x[j] * c_ + o[j] * s_; }
                        }
                        v0 = (f32x4){x[0], x[1], x[2], x[3]}; v1 = (f32x4){x[4], x[5], x[6], x[7]};
                    }
                    v0 = v0 * sc; v1 = v1 * sc;
                    u32x4 w; w.x = cvt_pk_bf16(v0[0], v0[1]); w.y = cvt_pk_bf16(v0[2], v0[3]); w.z = cvt_pk_bf16(v1[0], v1[1]); w.w = cvt_pk_bf16(v1[2], v1[3]);
                    *(u32x4*)(rowp + bj * HALF) = w;
                    if (kind == 3) { const int dd = col0 + bj * HALF - (B_IN + B_KVW), kvh = dd / B_HD, d = dd % B_HD; bf16* vt = VT + (((size_t)(row >> 6) * B_KV_HEADS + kvh) * B_HD + d) * 64 + (row & 63);
                        vt[0] = (bf16)(w.x & 0xffffu); vt[64] = (bf16)(w.x >> 16); vt[128] = (bf16)(w.y & 0xffffu); vt[192] = (bf16)(w.y >> 16);
                        vt[256] = (bf16)(w.z & 0xffffu); vt[320] = (bf16)(w.z >> 16); vt[384] = (bf16)(w.w & 0xffffu); vt[448] = (bf16)(w.w >> 16); }
                } }
    }
};
template <class Epi, class Sched, bool ALIGN_EPI>
__device__ __forceinline__ void gemm_phase(LAS unsigned char* lds, const Gemm g, const Sched& S, const Epi& E, const int tid) {
    const int wid = READFIRSTLANE(tid >> 6), lane = tid & 63, wr = wid >> 2, wc = wid & 3, fr = lane & 15, fq = lane >> 4;
    const int K = g.K, nt = K / BK;
    unsigned voffA[2], voffB[2];
#pragma unroll
    for (int i = 0; i < 2; ++i) { int R, C; stage_rc(tid * 16 + i * 8192, R, C); const int Rb = Epi::PERM ? ((R & ~31) + perm32(R & 31)) : R;
        voffA[i] = (unsigned)(R * g.lda + C) * 2u; voffB[i] = (unsigned)(Rb * K + C) * 2u; }
    const unsigned kstep = (unsigned)(BK * 2);
    const unsigned hstepA = (unsigned)HALF * (unsigned)g.lda * 2u, hstepB = (unsigned)HALF * (unsigned)K * 2u;
    const unsigned tstepA = 2 * hstepA, tstepB = 2 * hstepB;
    const BufRes rA = MAKE_RES(g.A), rB = MAKE_RES(g.Bt);
    const unsigned ldsw = (unsigned)wid * 1024u;
    const int aoff = lds_byte(wr * 64 + fr, fq * 8), boff = lds_byte(wc * 32 + fr, fq * 8);
#define PG8_SA(b, h) (((b) * 2 + (h)) * HTB)
#define PG8_SB(b, h) ((4 + (b) * 2 + (h)) * HTB)
#define PG8_STAGE(bufoff, res, soff, voff) do { _Pragma("unroll") for (int _i = 0; _i < 2; ++_i) \
        BLDS16(res, (voff)[_i], soff, lds + (bufoff) + ldsw + _i * 8192); } while (0)
#define PG8_LDA(dst, b, h) do { _Pragma("unroll") for (int m = 0; m < 4; ++m) _Pragma("unroll") for (int k = 0; k < 2; ++k) dst[m][k] = *(const LAS bf16x8*)(lds + PG8_SA(b, h) + aoff + m * 2048 + k * 1024); } while (0)
#define PG8_LDB(dst, b, h) do { _Pragma("unroll") for (int n = 0; n < 2; ++n) _Pragma("unroll") for (int k = 0; k < 2; ++k) dst[n][k] = *(const LAS bf16x8*)(lds + PG8_SB(b, h) + boff + n * 2048 + k * 1024); } while (0)
#define PG8_MMA(ai, bj, At, Bt) do { SETPRIO(1); _Pragma("unroll") for (int m = 0; m < 4; ++m) _Pragma("unroll") for (int n = 0; n < 2; ++n) _Pragma("unroll") for (int k = 0; k < 2; ++k) \
        acc[ai][bj][m][n] = MFMA16(Bt[n][k], At[m][k], acc[ai][bj][m][n]); SETPRIO(0); } while (0)
#define PG8_MMAZ(ai, bj, At, Bt) do { SETPRIO(1); _Pragma("unroll") for (int m = 0; m < 4; ++m) _Pragma("unroll") for (int n = 0; n < 2; ++n) { \
        acc[ai][bj][m][n] = MFMA16(Bt[n][0], At[m][0], ((f32x4){0.f, 0.f, 0.f, 0.f})); acc[ai][bj][m][n] = MFMA16(Bt[n][1], At[m][1], acc[ai][bj][m][n]); } SETPRIO(0); } while (0)
    Unit cur, nxt; int ui = 0;
    if (!S.next(0, cur)) return;
    f32x4 acc[2][2][4][2];
#pragma unroll
    for (int a = 0; a < 2; ++a)
#pragma unroll
        for (int b = 0; b < 2; ++b)
#pragma unroll
            for (int m = 0; m < 4; ++m)
#pragma unroll
                for (int n = 0; n < 2; ++n) acc[a][b][m][n] = (f32x4){0.f, 0.f, 0.f, 0.f};
    bf16x8 At[4][2], B0[2][2], B1[2][2];
    unsigned cA = (unsigned)cur.pm * tstepA, cB = (unsigned)cur.pn * tstepB;
    PG8_STAGE(PG8_SB(0, 0), rB, cB, voffB); PG8_STAGE(PG8_SB(0, 1), rB, cB + hstepB, voffB); PG8_STAGE(PG8_SA(0, 0), rA, cA, voffA); PG8_STAGE(PG8_SA(0, 1), rA, cA + hstepA, voffA);
    if (wr == 1) S_BARRIER();
    WAIT_VM(2); S_BARRIER();
    PG8_STAGE(PG8_SB(1, 0), rB, cB + kstep, voffB); PG8_STAGE(PG8_SA(1, 0), rA, cA + kstep, voffA); PG8_STAGE(PG8_SB(1, 1), rB, cB + hstepB + kstep, voffB);
    WAIT_VM(6); S_BARRIER();
    for (;;) {
        const bool has_next = S.next(ui + 1, nxt);
        const unsigned nA = has_next ? (unsigned)nxt.pm * tstepA : cA, nB = has_next ? (unsigned)nxt.pn * tstepB : cB;
#define PG8_TRIP(W, LAST, MM) do { \
            const unsigned a1 = cA + (unsigned)(t + 1) * kstep; \
            const unsigned a2 = (LAST) ? nA : cA + (unsigned)(t + 2) * kstep, b2 = (LAST) ? nB : cB + (unsigned)(t + 2) * kstep; \
            const unsigned a3 = a2 + kstep, b3 = b2 + kstep; \
            PG8_LDB(B0, 0, 0); PG8_LDB(B1, 0, 1); SCHED_BARRIER(); PG8_LDA(At, 0, 0); PG8_STAGE(PG8_SA(1, 1), rA, a1 + hstepA, voffA); \
            WAIT_VM(W); WAIT_LGKM(0); S_BARRIER(); MM(0, 0, At, B0); MM(0, 1, At, B1); S_BARRIER(); SCHED_BARRIER(); \
            PG8_LDA(At, 0, 1); PG8_STAGE(PG8_SB(0, 0), rB, b2, voffB); PG8_STAGE(PG8_SB(0, 1), rB, b2 + hstepB, voffB); PG8_STAGE(PG8_SA(0, 0), rA, a2, voffA); \
            WAIT_VM(W); WAIT_LGKM(0); S_BARRIER(); MM(1, 0, At, B0); MM(1, 1, At, B1); S_BARRIER(); SCHED_BARRIER(); \
            PG8_LDB(B0, 1, 0); PG8_LDB(B1, 1, 1); SCHED_BARRIER(); PG8_LDA(At, 1, 0); PG8_STAGE(PG8_SA(0, 1), rA, a2 + hstepA, voffA); \
            WAIT_VM(8); WAIT_LGKM(0); S_BARRIER(); PG8_MMA(0, 0, At, B0); PG8_MMA(0, 1, At, B1); S_BARRIER(); SCHED_BARRIER(); \
            PG8_LDA(At, 1, 1); PG8_STAGE(PG8_SB(1, 0), rB, b3, voffB); PG8_STAGE(PG8_SB(1, 1), rB, b3 + hstepB, voffB); PG8_STAGE(PG8_SA(1, 0), rA, a3, voffA); \
            WAIT_VM(8); WAIT_LGKM(0); S_BARRIER(); PG8_MMA(1, 0, At, B0); PG8_MMA(1, 1, At, B1); S_BARRIER(); SCHED_BARRIER(); } while (0)
        int t = 0;
        if (ui > 0) { PG8_TRIP(24, false, PG8_MMAZ); t = 2; }
        for (; t < nt; t += 2) { const bool last = (t == nt - 2); PG8_TRIP(8, last, PG8_MMA); }
#undef PG8_TRIP
        if constexpr (ALIGN_EPI) { if (wr == 0) S_BARRIER(); }
        E(acc, cur, wr, wc, fr, fq);
        if (!has_next) break;
        cur = nxt; cA = nA; cB = nB; ++ui;
        if constexpr (ALIGN_EPI) { if (wr == 1) S_BARRIER(); }
    }
    WAIT_VM(0);
    if constexpr (!ALIGN_EPI) { if (wr == 0) S_BARRIER(); }
    S_BARRIER();
#undef PG8_SA
#undef PG8_SB
#undef PG8_STAGE
#undef PG8_LDA
#undef PG8_LDB
#undef PG8_MMA
#undef PG8_MMAZ
}
}
__device__ __forceinline__ void gemm_mfma(const bf16* A, int lda, const bf16* Bt, bf16* C, int ldc, int M, int N, int K, const Ctx& c, unsigned char* lds) {
    pg8::Gemm g{A, lda, Bt, M, N, K}; pg8::StaticOrder S; S.init(M, N, c.nblk, c.bid); pg8::EpiBf16 E{C, ldc};
    __syncthreads();
    pg8::gemm_phase<pg8::EpiBf16, pg8::StaticOrder, true>((LAS unsigned char*)lds, g, S, E, c.tid);
    __syncthreads();
}
__device__ __forceinline__ void transpose_item(const float* W, int ldw, int K, int N, bf16* WT, int row_off, float* scr, int item, int lane) {
    const int nblk = N / 64, kb = item / nblk, nb = item % nblk, k0 = 64 * kb, n0 = 64 * nb;
#pragma unroll 8
    for (int kk = 0; kk < 64; ++kk) scr[kk * 65 + lane] = W[(size_t)(k0 + kk) * ldw + n0 + lane];
    WAVE_SYNC();
    const int cc = lane & 7;
#pragma unroll
    for (int j = 0; j < 8; ++j) { const int n = (lane >> 3) + 8 * j; const float* sp = scr + (8 * cc) * 65 + n;
        u32x4 o; o.x = cvtpk(sp[0 * 65], sp[1 * 65]); o.y = cvtpk(sp[2 * 65], sp[3 * 65]); o.z = cvtpk(sp[4 * 65], sp[5 * 65]); o.w = cvtpk(sp[6 * 65], sp[7 * 65]);
        *(u32x4*)(WT + (size_t)(row_off + n0 + n) * K + k0 + 8 * cc) = o; }
    WAVE_SYNC();
}
constexpr int WI_AIN = (D_MODEL / 64) * (A_MAIN / 64), WI_AOUT = (A_VW / 64) * (D_MODEL / 64), WI_BIN = (D_MODEL / 64) * (B_IN / 64), WI_BKV = (D_MODEL / 64) * (2 * B_KVW / 64), WI_BOUT = (B_QW / 64) * (D_MODEL / 64);
constexpr int WI_A_END = N_A * (WI_AIN + WI_AOUT), WI_ALL = WI_A_END + N_B * (WI_BIN + WI_BOUT) + WI_BKV;
__device__ __forceinline__ void weights_range(PrmRef p, int lane, int wave, unsigned char* lds, int vw, int nvw, int lo, int hi) {
    float* scr = (float*)lds + wave * (64 * 65);
    bf16* WAIN = (bf16*)(p.ws + WS_WAIN); bf16* WAOUT = (bf16*)(p.ws + WS_WAOUT); bf16* WBIN = (bf16*)(p.ws + WS_WBIN); bf16* WBOUT = (bf16*)(p.ws + WS_WBOUT);
    for (int it = lo + vw; it < hi; it += nvw) {
        int r = it;
        if (r < N_A * WI_AIN) { const int li = r / WI_AIN; transpose_item(p.a_w_in + (size_t)li * D_MODEL * A_IN, A_IN, D_MODEL, A_MAIN, WAIN + (size_t)li * A_NG * D_MODEL, 0, scr, r % WI_AIN, lane); continue; } r -= N_A * WI_AIN;
        if (r < N_A * WI_AOUT) { const int li = r / WI_AOUT; transpose_item(p.a_w_out + (size_t)li * A_VW * D_MODEL, D_MODEL, A_VW, D_MODEL, WAOUT + (size_t)li * D_MODEL * A_VW, 0, scr, r % WI_AOUT, lane); continue; } r -= N_A * WI_AOUT;
        if (r < N_B * WI_BIN) { const int lj = r / WI_BIN; transpose_item(p.b_w_in + (size_t)lj * D_MODEL * B_IN, B_IN, D_MODEL, B_IN, WBIN + (size_t)lj * B_N0 * D_MODEL, 0, scr, r % WI_BIN, lane); continue; } r -= N_B * WI_BIN;
        if (r < N_B * WI_BOUT) { const int lj = r / WI_BOUT; transpose_item(p.b_w_out + (size_t)lj * B_QW * D_MODEL, D_MODEL, B_QW, D_MODEL, WBOUT + (size_t)lj * D_MODEL * B_QW, 0, scr, r % WI_BOUT, lane); continue; } r -= N_B * WI_BOUT;
        transpose_item(p.b_w_kv, 2 * B_KVW, D_MODEL, 2 * B_KVW, WBIN, B_IN, scr, r, lane);
    }
}
__device__ __forceinline__ void ph_weights(PrmRef p, const Ctx& c, unsigned char* lds) {
    weights_range(p, c.lane, c.wave, lds, c.gwave, c.nwaves, 0, WI_AIN);
    bf16* WAIN = (bf16*)(p.ws + WS_WAIN);
    for (int it = c.gtid; it < N_A * 256 * D_MODEL; it += c.nthreads) {
        const int k = it % D_MODEL, j = (it / D_MODEL) % 256, li = it / (256 * D_MODEL);
        WAIN[((size_t)li * A_NG + A_MAIN + j) * D_MODEL + k] = j < 2 * A_HEADS ? (bf16)f2bf(p.a_w_in[((size_t)li * D_MODEL + k) * A_IN + A_MAIN + j]) : (bf16)0;
    }
}
__device__ __forceinline__ void weights_deferred(PrmRef p, int lane, int wave, int li, unsigned char* lds, int vw, int nvw) {
    static_assert(N_A == 2, "deferred weight conversion schedule");
    if (li == 0) weights_range(p, lane, wave, lds, vw, nvw, WI_AIN, WI_A_END); else weights_range(p, lane, wave, lds, vw, nvw, WI_A_END, WI_ALL);
}

__device__ __forceinline__ void ph_init(PrmRef p, const Ctx& c) {
    bf16* XB = (bf16*)(p.ws + WS_XB);
    for (size_t i8 = c.gtid; i8 < (size_t)MT * D_MODEL / 8; i8 += c.nthreads) {
        const size_t i = i8 * 8; const float* src = i < (size_t)PT * D_MODEL ? p.x_prompt + i : p.x_sample + (i - (size_t)PT * D_MODEL);
        const f32x4 a = *(const f32x4*)src, b = *(const f32x4*)(src + 4);
        u32x4 o; o.x = cvtpk(a[0], a[1]); o.y = cvtpk(a[2], a[3]); o.z = cvtpk(b[0], b[1]); o.w = cvtpk(b[2], b[3]);
        *(u32x4*)(XB + i) = o;
    }
    float* rope = (float*)(p.ws + WS_ROPE);
    for (int i = c.gtid; i < (SEQ + DEC_SEQ) * ROPE_HALF; i += c.nthreads) {
        const int pi = i / ROPE_HALF, f = i % ROPE_HALF; const float pos = pi < SEQ ? (float)pi : (float)(PAST_LEN + pi - SEQ);
        const float inv = f == 0 ? 1.0f : f == 1 ? 0.1939227432012558f : f == 2 ? 0.03760603070259094f : f == 3 ? 0.007292664609849453f : f == 4 ? 0.0014142135623842478f
                        : f == 5 ? 0.00027424818836152554f : f == 6 ? 5.3182957344688475e-05f : 1.0313385246263351e-05f;
        const float ang = pos * inv;
        rope[2 * i] = cosf(ang); rope[2 * i + 1] = sinf(ang);
    }
}

constexpr int SS_KC = 128, SS_STB = 32768, SS_BOFF = 16384;
template <int MODE> __device__ __forceinline__ void ss_issue(const bf16* A, int lda, const bf16* Bt, int K, int row0, int col0, int cidx, int q, int lw, int lane, unsigned char* lds) {
    const unsigned char* sa = (const unsigned char*)(A + (size_t)row0 * lda + cidx * SS_KC); const unsigned char* sb = (const unsigned char*)(Bt + (size_t)col0 * K + cidx * SS_KC);
    unsigned char* st = lds + (q & 3) * SS_STB;
#pragma unroll
    for (int i = 0; i < 4; ++i) { const int row = (lw * 4 + i) * 4 + (lane >> 4), pc = (lane & 15) ^ (row & 15);
        GLDS16(sa + (unsigned)row * (unsigned)(lda * 2) + (unsigned)pc * 16u, st + (lw * 4 + i) * 1024);
        if (MODE != 1) GLDS16(sb + (unsigned)row * (unsigned)(K * 2) + (unsigned)pc * 16u, st + SS_BOFF + (lw * 4 + i) * 1024); }
    if (MODE == 1) { const int row = lw * 4 + (lane >> 4), pc = (lane & 15) ^ (row & 15); GLDS16(sb + (unsigned)row * (unsigned)(K * 2) + (unsigned)pc * 16u, st + SS_BOFF + lw * 1024); }
}
template <int MODE> __device__ __forceinline__ void sgemm_stream(PrmRef p, int li, const bf16* A, int lda, const bf16* Bt, int K, bf16* C, int ldc, int row_begin, int col_base, int tn, int it0, int itstep, int nitems, int tid, unsigned char* lds) {
    const int lane = tid & 63, wave = READFIRSTLANE(tid >> 6), nkc = K / SS_KC;
    const int nmine = it0 < nitems ? (nitems - it0 + itstep - 1) / itstep : 0, Q = nmine * nkc;
    LBAR();
    if (Q == 0) return;
    if (wave >= 4) {
        const int lw = wave - 4;
        int it = it0, cidx = 0, row0 = row_begin + (it / tn) * 64, col0 = col_base + (it % tn) * 64;
#define SS_NEXT() do { if (++cidx == nkc) { cidx = 0; it += itstep; row0 = row_begin + (it / tn) * 64; col0 = col_base + (it % tn) * 64; } } while (0)
        ss_issue<MODE>(A, lda, Bt, K, row0, col0, cidx, 0, lw, lane, lds); SS_NEXT();
        if (Q > 1) { ss_issue<MODE>(A, lda, Bt, K, row0, col0, cidx, 1, lw, lane, lds); SS_NEXT(); }
        if (Q > 2) { ss_issue<MODE>(A, lda, Bt, K, row0, col0, cidx, 2, lw, lane, lds); SS_NEXT(); }
        for (int q = 0; q < Q; ++q) {
            if (q + 2 < Q) { if (MODE == 1) { WAIT_VM(10); } else { WAIT_VM(16); } } else { WAIT_VM(0); }
            LBAR();
            if (q + 3 < Q) { ss_issue<MODE>(A, lda, Bt, K, row0, col0, cidx, q + 3, lw, lane, lds); SS_NEXT(); }
        }
#undef SS_NEXT
    } else {
        const int r = lane & 15, g = lane >> 4;
        f32x4 acc[4];
#pragma unroll
        for (int nt = 0; nt < 4; ++nt) acc[nt] = (f32x4){0.f, 0.f, 0.f, 0.f};
        int it = it0, cidx = 0;
        for (int q = 0; q < Q; ++q) {
            LBAR();
            const unsigned char* ap = lds + (q & 3) * SS_STB + (16 * wave + r) * 256; const unsigned char* bp = lds + (q & 3) * SS_STB + SS_BOFF + r * 256;
#pragma unroll
            for (int ks = 0; ks < 4; ++ks) { const int po = ((4 * ks + g) ^ r) << 4; const bf16x8 a = *(const bf16x8*)(ap + po);
#pragma unroll
                for (int nt = 0; nt < (MODE == 1 ? 1 : 4); ++nt) { const bf16x8 b = *(const bf16x8*)(bp + nt * 4096 + po); acc[nt] = MFMA16(b, a, acc[nt]); } }
            if (++cidx == nkc) {
                const int row0 = row_begin + (it / tn) * 64, col0 = col_base + (it % tn) * 64, row = row0 + 16 * wave + r;
                if (MODE == 1) {
                    static_assert(2 * A_HEADS <= 16, "gate columns");
                    float* GB = (float*)(p.ws + WS_GB);
#pragma unroll
                    for (int e = 0; e < 4; ++e) { const int col = 4 * g + e; const float v = acc[0][e];
                        if (col < A_HEADS) GB[((size_t)row * A_HEADS + col) * 2] = -expf(p.a_log[li * A_HEADS + col]) * softplusf_(v + p.a_dt_bias[li * A_HEADS + col]);
                        else if (col < 2 * A_HEADS) GB[((size_t)row * A_HEADS + (col - A_HEADS)) * 2 + 1] = sigmoidf_(v); }
                } else {
                    if (MODE == 2) {
                        const int kind = col0 < B_QW ? 0 : col0 < B_IN ? 1 : col0 < B_IN + B_KVW ? 2 : 3, srow = row - PT;
                        if (kind == 0 || kind == 2) {
                            const float* rp = (const float*)(p.ws + WS_ROPE) + ((size_t)(SEQ + srow % DEC_SEQ) * ROPE_HALF + 4 * (g & 1)) * 2;
                            const f32x4 cs0 = *(const f32x4*)rp, cs1 = *(const f32x4*)(rp + 4);
#pragma unroll
                            for (int e = 0; e < 4; ++e) { const float x = acc[0][e], o = __shfl_xor(x, 32), c_ = e < 2 ? cs0[2 * e] : cs1[2 * e - 4], s_ = e < 2 ? cs0[2 * e + 1] : cs1[2 * e - 3];
                                acc[0][e] = g < 2 ? x * c_ - o * s_ : x * c_ + o * s_; }
                        }
                        if (kind == 0) {
#pragma unroll
                            for (int nt = 0; nt < 4; ++nt) acc[nt] = acc[nt] * 0.125f; }
                        if (kind == 3) { bf16* VT = (bf16*)(p.ws + WS_VT); const int kvh = (col0 - (B_IN + B_KVW)) / B_HD, ck = NCP + srow / DEC_SEQ, key = srow % DEC_SEQ;
#pragma unroll
                            for (int nt = 0; nt < 4; ++nt)
#pragma unroll
                                for (int e = 0; e < 4; ++e) VT[(((size_t)ck * B_KV_HEADS + kvh) * B_HD + 16 * nt + 4 * g + e) * 64 + key] = (bf16)(cvtpk(acc[nt][e], 0.f) & 0xffffu); }
                    }
                    bf16* cp = C + (size_t)row * ldc + col0 + 4 * g;
#pragma unroll
                    for (int nt = 0; nt < 4; ++nt) { u32x2 w; w.x = cvtpk(acc[nt][0], acc[nt][1]); w.y = cvtpk(acc[nt][2], acc[nt][3]); *(u32x2*)(cp + 16 * nt) = w; }
                }
#pragma unroll
                for (int nt = 0; nt < 4; ++nt) acc[nt] = (f32x4){0.f, 0.f, 0.f, 0.f};
                cidx = 0; it += itstep;
            }
        }
    }
    LBAR();
}
template <int MODE = 0> __device__ __forceinline__ void sgemm_rows(PrmRef p, const bf16* A, int lda, const bf16* Bt, int K, bf16* C, int ldc, int row_begin, int nrows, int N, const Ctx& c, int first_wg, unsigned char* lds, bool only_tail = false) {
    const int tn = N / 64, nt = (nrows / 64) * tn;
    const int f = first_wg % c.nblk, np = (only_tail && f > 0) ? c.nblk - f : c.nblk;
    const int v = only_tail && f > 0 ? c.bid - f : (c.bid + c.nblk - f) % c.nblk;
    sgemm_stream<MODE>(p, 0, A, lda, Bt, K, C, ldc, row_begin, 0, tn, v >= 0 ? v : nt, np, nt, c.tid, lds);
}
__device__ __forceinline__ void ph_a_gemm(PrmRef p, const Ctx& c, int li, unsigned char* lds) {
    const bf16* XB = (const bf16*)(p.ws + WS_XB); bf16* PROJ = (bf16*)(p.ws + WS_PROJ); const bf16* Wt = (const bf16*)(p.ws + WS_WAIN) + (size_t)li * A_NG * D_MODEL;
    pg8::Gemm g{XB, D_MODEL, Wt, PT, A_MAIN, D_MODEL}; pg8::StaticOrder S; S.init(PT, A_MAIN, c.nblk, c.bid);
    pg8::EpiAIn E{PROJ, PLD, (bf16*)(p.ws + WS_HALO), p.out + O_PCONV + (size_t)li * BATCH * 3 * CONV_DIM};
    __syncthreads();
    pg8::gemm_phase<pg8::EpiAIn, pg8::StaticOrder, true>((LAS unsigned char*)lds, g, S, E, c.tid);
    __syncthreads();
    sgemm_stream<1>(p, li, XB, D_MODEL, Wt, D_MODEL, nullptr, 0, 0, A_MAIN, 1, c.bid, c.nblk, MT / 64, c.tid, lds);
    sgemm_rows(p, XB, D_MODEL, Wt, D_MODEL, PROJ, PLD, PT, ST, A_MAIN, c, MT / 64, lds);
}
constexpr int NPG = BATCH * A_HEADS, NSG = DEC_BATCH * A_HEADS, NPI = NPG * NCPS;
__device__ __forceinline__ unsigned pk2bf(float lo, float hi) { return cvtpk(lo, hi); }
__device__ __forceinline__ int p32(int d) { return (d & ~31) | (((d >> 2) & 3) << 3) | (((d >> 4) & 1) << 2) | (d & 3); }
constexpr int PP_KN = 0, PP_QN = 17408, PP_KF = 34816, PP_VF = 67584, PP_TT = 53248  , PP_GC = 100352, PP_LN = 102400, PP_LNP = 68, PP_TI = PP_LN + 64 * PP_LNP * 4, PP_TIP = 20, PP_WST = PP_TI + 4 * 16 * PP_TIP * 4, PP_CW = PP_WST + 17408, PP_END = PP_CW + 3 * 4 * 128 * 4;
static_assert(PP_END <= 163840 - 64 && PP_TI % 16 == 0 && PP_WST % 16 == 0 && PP_CW % 16 == 0, "prepass LDS");
typedef u32x4 RawTile[3][4][2];
__device__ __forceinline__ void prepass_load_raw(PrmRef p, int item, int tid, RawTile& xr) {
    const bf16* PROJ = (const bf16*)(p.ws + WS_PROJ); const bf16* HALO = (const bf16*)(p.ws + WS_HALO);
    const int n = item % NCPS, grp = item / NCPS, h = grp % A_HEADS, s = grp / A_HEADS, R0 = s * SEQ + n * CHUNK, r = tid >> 3, seg = tid & 7;
#pragma unroll
    for (int X = 0; X < 3; ++X) {
        const int cb = X * A_QK + h * A_DK + 16 * seg;
#pragma unroll
        for (int j = 0; j < 4; ++j) {
            const int rr = r - 3 + j;
            if (rr >= 0) { const u32x4* src = (const u32x4*)(PROJ + (size_t)(R0 + rr) * PLD + cb); xr[X][j][0] = src[0]; xr[X][j][1] = src[1]; }
            else if (n > 0) { const u32x4* src = (const u32x4*)(HALO + ((size_t)(s * NCPS + n - 1) * 3 + (3 + rr)) * CONV_DIM + cb); xr[X][j][0] = src[0]; xr[X][j][1] = src[1]; }
            else { xr[X][j][0] = (u32x4){0u, 0u, 0u, 0u}; xr[X][j][1] = xr[X][j][0]; }
        }
    }
}
__device__ __forceinline__ void prepass_gcum(PrmRef p, int item, int lane, float* GC) {
    const float* GB = (const float*)(p.ws + WS_GB); float* GL = (float*)(p.ws + WS_GL);
    const int n = item % NCPS, grp = item / NCPS, h = grp % A_HEADS, s = grp / A_HEADS, R0 = s * SEQ + n * CHUNK;
    const float g = GB[((size_t)(R0 + lane) * A_HEADS + h) * 2], bt = GB[((size_t)(R0 + lane) * A_HEADS + h) * 2 + 1];
    float cs = g;
#pragma unroll
    for (int d = 1; d < 64; d <<= 1) { const float o = __shfl(cs, lane >= d ? lane - d : lane); if (lane >= d) cs += o; }
    const float gl = __shfl(cs, 63);
    GC[lane] = cs; GC[64 + lane] = bt; GC[128 + lane] = fexp(cs); GC[192 + lane] = fexp(gl - cs);
    if (lane == 0) GL[item] = fexp(gl);
}
__device__ __forceinline__ void prepass_store_w(PrmRef p, int item, int tid, const unsigned char* lds) {
    bf16* WB = (bf16*)(p.ws + WS_WB); const bf16* WST = (const bf16*)(lds + PP_WST);
    const int n = item % NCPS, grp = item / NCPS, h = grp % A_HEADS, s = grp / A_HEADS, R0 = s * SEQ + n * CHUNK, r = tid >> 3, seg = tid & 7;
    const u32x4 w0 = *(const u32x4*)(WST + r * 136 + 16 * seg), w1 = *(const u32x4*)(WST + r * 136 + 16 * seg + 8);
    u32x4* dst = (u32x4*)(WB + (size_t)(R0 + r) * A_QK + h * A_DK + 16 * seg); dst[0] = w0; dst[1] = w1;
}
template <int VAR = 0> __device__ __forceinline__ void delta_prepass_item(PrmRef p, int li, int item, int next_item, int prev_item, int pb, int tid, unsigned char* lds, RawTile& xr) {
#ifndef EMU
    asm volatile("" : "+v"(tid));
#endif
    bf16* PROJ = (bf16*)(p.ws + WS_PROJ); bf16* IA = (bf16*)(p.ws + WS_IA);
    const int n = item % NCPS, grp = item / NCPS, h = grp % A_HEADS, s = grp / A_HEADS;
    const int R0 = s * SEQ + n * CHUNK, lane = tid & 63, wave = READFIRSTLANE(tid >> 6);
    bf16* KN = (bf16*)(lds + PP_KN); bf16* QN = (bf16*)(lds + PP_QN); bf16* VN = (bf16*)(lds + PP_KF);
    float* GC = (float*)(lds + PP_GC) + pb * 256; float* BT = GC + 64; float* EG = GC + 128; float* KD = GC + 192;
    float* LN = (float*)(lds + PP_LN);
    float* TI = (float*)(lds + PP_TI);
    bf16* WST = (bf16*)(lds + PP_WST);
    if (prev_item >= 0) prepass_store_w(p, prev_item, tid, lds);
    const int r = tid >> 3, seg = tid & 7;
    float qf[16];
#pragma unroll
    for (int X = 0; X < 3; ++X) {
        const int cb = X * A_QK + h * A_DK + 16 * seg;
        float acc[16];
#pragma unroll
        for (int e = 0; e < 16; ++e) acc[e] = 0.f;
#pragma unroll
        for (int j = 0; j < 4; ++j) {
            const f32x4* wp = (const f32x4*)(lds + PP_CW) + ((X * 4 + j) * 128 + 16 * seg) / 4;
#pragma unroll
            for (int e = 0; e < 4; ++e) {
                const f32x4 w4 = wp[e]; const unsigned a = xr[X][j][e >> 1][2 * (e & 1)], b = xr[X][j][e >> 1][2 * (e & 1) + 1];
                acc[4 * e] += w4[0] * bflo(a); acc[4 * e + 1] += w4[1] * bfhi(a); acc[4 * e + 2] += w4[2] * bflo(b); acc[4 * e + 3] += w4[3] * bfhi(b);
            }
        }
        float ss = 0.f;
#pragma unroll
        for (int e = 0; e < 16; ++e) { acc[e] = fsilu(acc[e]); ss += acc[e] * acc[e]; }
        if (X < 2) {
            ss = sum8(ss);
            const float rs = fast_rsq(ss + RMS_EPS) * (X == 0 ? 0.08838834764831845f : 1.f);
#pragma unroll
            for (int e = 0; e < 16; ++e) acc[e] *= rs;
        }
        if (X == 0) {
#pragma unroll
            for (int e = 0; e < 16; ++e) qf[e] = acc[e];
            u32x4 o0, o1;
#pragma unroll
            for (int e = 0; e < 4; ++e) { o0[e] = cvtpk(acc[2 * e], acc[2 * e + 1]); o1[e] = cvtpk(acc[8 + 2 * e], acc[8 + 2 * e + 1]); }
            *(u32x4*)(QN + r * 136 + 16 * seg) = o0; *(u32x4*)(QN + r * 136 + 16 * seg + 8) = o1;
        } else if (X == 1) {
            u32x4 o0, o1;
#pragma unroll
            for (int e = 0; e < 4; ++e) { o0[e] = cvtpk(acc[2 * e], acc[2 * e + 1]); o1[e] = cvtpk(acc[8 + 2 * e], acc[8 + 2 * e + 1]); }
            *(u32x4*)(KN + r * 136 + 16 * seg) = o0; *(u32x4*)(KN + r * 136 + 16 * seg + 8) = o1;
        } else {
            u32x4 o0, o1;
#pragma unroll
            for (int e = 0; e < 4; ++e) { o0[e] = cvtpk(acc[2 * e], acc[2 * e + 1]); o1[e] = cvtpk(acc[8 + 2 * e], acc[8 + 2 * e + 1]); }
            *(u32x4*)(VN + r * 136 + 16 * seg) = o0; *(u32x4*)(VN + r * 136 + 16 * seg + 8) = o1;
        }
    }
    LBAR();
    if (next_item >= 0) prepass_load_raw(p, next_item, tid, xr);
    {
        const float eg = EG[r];
        bf16* dst = PROJ + (size_t)(R0 + r) * PLD + h * A_DK + 32 * (seg >> 1) + 4 * (seg & 1);
#pragma unroll
        for (int gq = 0; gq < 4; ++gq) { u32x2 o; o.x = cvtpk(qf[4 * gq] * eg, qf[4 * gq + 1] * eg); o.y = cvtpk(qf[4 * gq + 2] * eg, qf[4 * gq + 3] * eg); *(u32x2*)(dst + 8 * gq) = o; }
    }
    if (VAR != 4) {
        const int kind = wave >> 2, ti = (wave >> 1) & 1, tj = wave & 1, l31 = lane & 31, hi = lane >> 5;
        if (wave == 1) {
            if (next_item >= 0) prepass_gcum(p, next_item, lane, (float*)(lds + PP_GC) + (pb ^ 1) * 256);
#pragma unroll
            for (int e = 0; e < 16; ++e) LN[((e & 3) + 8 * (e >> 2) + 4 * hi) * PP_LNP + 32 + l31] = 0.f;
        } else {
            f32x16 acc;
#pragma unroll
            for (int e = 0; e < 16; ++e) acc[e] = 0.f;
            const unsigned char* ap = (const unsigned char*)(kind == 0 ? KN : QN) + (32 * ti + l31) * 272 + 16 * hi;
            const unsigned char* bp = (const unsigned char*)KN + (32 * tj + l31) * 272 + 16 * hi;
            if (ti >= tj) {
#pragma unroll
                for (int ks = 0; ks < 8; ++ks) { const bf16x8 a = *(const bf16x8*)(ap + 32 * ks), b = *(const bf16x8*)(bp + 32 * ks); acc = MFMA32(a, b, acc); }
            }
            const int col = 32 * tj + l31; const float gcc = GC[col];
            f32x4 gr[4], br[4];
#pragma unroll
            for (int q4 = 0; q4 < 4; ++q4) { gr[q4] = *(const f32x4*)(GC + 32 * ti + 8 * q4 + 4 * hi); br[q4] = *(const f32x4*)(BT + 32 * ti + 8 * q4 + 4 * hi); }
#pragma unroll
            for (int e = 0; e < 16; ++e) {
                const int row = 32 * ti + (e & 3) + 8 * (e >> 2) + 4 * hi; const float gcr = gr[e >> 2][e & 3];
                if (kind == 0) LN[row * PP_LNP + col] = row > col ? -(br[e >> 2][e & 3] * acc[e] * fexp(gcr - gcc)) : 0.f;
                else IA[((size_t)item * 64 + row) * 64 + p32(col)] = (bf16)f2bf(row >= col ? acc[e] * fexp(gcr - gcc) : 0.f);
            }
            if (wave == 0 || wave == 3) {
                WAVE_SYNC();
                if (lane < 32) {
                    const int b = (wave == 3 ? 2 : 0) + (lane >> 4), j = lane & 15; float t[16];
#pragma unroll
                    for (int i = 0; i < 16; ++i) {
                        float v = i == j ? 1.f : 0.f;
                        f32x4 lr[4];
#pragma unroll
                        for (int q4 = 0; q4 < (i + 3) / 4; ++q4) lr[q4] = *(const f32x4*)(LN + (16 * b + i) * PP_LNP + 16 * b + 4 * q4);
#pragma unroll
                        for (int k = 0; k < i; ++k) v += lr[k >> 2][k & 3] * t[k];
                        t[i] = v;
                    }
#pragma unroll
                    for (int i = 0; i < 16; ++i) TI[(b * 16 + i) * PP_TIP + j] = t[i];
                }
            } else if (wave >= 4) {
                const int u = tid - 256, m = u & 127, half = u >> 7;
                unsigned char* dst = (unsigned char*)PROJ + ((size_t)(R0 + (m >> 1)) * PLD + A_QK + h * A_DK) * 2 + (m & 1) * 128 + half * 64;
#pragma unroll
                for (int q4 = 0; q4 < 4; ++q4) {
                    u32x4 o;
#pragma unroll
                    for (int e = 0; e < 4; ++e) { const int j = 32 * half + 4 * q4 + 16 * (e >> 1) + 2 * (e & 1); o[e] = cvtpk(bf2f(KN[j * 136 + m]) * KD[j], bf2f(KN[(j + 1) * 136 + m]) * KD[j + 1]); }
                    *(u32x4*)(dst + 16 * q4) = o;
                }
            }
        }
    }
    LBAR();
    bf16* TT = (bf16*)(lds + PP_TT);
    if (VAR != 4 && VAR != 1) {
        if (wave < 4) {
            const int g = lane >> 4, cl = lane & 15, c = wave;
            f32x4 X[4];
#pragma unroll
            for (int b = 0; b < 4; ++b) {
                f32x4 x = (f32x4){0.f, 0.f, 0.f, 0.f};
                if (b == c) {
#pragma unroll
                    for (int e = 0; e < 4; ++e) x[e] = TI[(b * 16 + 4 * g + e) * PP_TIP + cl];
                } else if (b > c) {
                    f32x4 l4[3];
#pragma unroll
                    for (int d = 0; d < b; ++d) l4[d] = *(const f32x4*)(LN + (16 * b + cl) * PP_LNP + 16 * d + 4 * g);
                    const f32x4 ta = *(const f32x4*)(TI + (b * 16 + cl) * PP_TIP + 4 * g);
                    f32x4 y = (f32x4){0.f, 0.f, 0.f, 0.f};
#pragma unroll
                    for (int d = 0; d < b; ++d) if (d >= c) {
#pragma unroll
                        for (int ks = 0; ks < 4; ++ks) y = MFMAF(l4[d][ks], X[d][ks], y); }
#pragma unroll
                    for (int ks = 0; ks < 4; ++ks) x = MFMAF(ta[ks], y[ks], x);
                }
                X[b] = x;
#pragma unroll
                for (int e = 0; e < 4; ++e) TT[(16 * b + 4 * g + e) * 72 + 16 * c + cl] = (bf16)(cvtpk(x[e], 0.f) & 0xffffu);
            }
        }
    }
    LBAR();
    if (VAR != 4 && VAR != 1) {
        const int g = lane >> 4, cl = lane & 15;
        bf16x8 Bv[2], Bk[2];
#pragma unroll
        for (int ks = 0; ks < 2; ++ks) {
            const int rb = 32 * ks + 8 * g;
            const unsigned char* vp = (const unsigned char*)VN + (rb + (cl >> 2)) * 272 + (16 * wave + 4 * (cl & 3)) * 2; const unsigned char* kp = (const unsigned char*)KN + (rb + (cl >> 2)) * 272 + (16 * wave + 4 * (cl & 3)) * 2;
            const s16x4 v0 = LDS_TR16(vp), v1 = LDS_TR16(vp + 4 * 272), k0 = LDS_TR16(kp), k1 = LDS_TR16(kp + 4 * 272);
            const f32x4 b0 = *(const f32x4*)(BT + rb), b1 = *(const f32x4*)(BT + rb + 4), e0 = *(const f32x4*)(EG + rb), e1 = *(const f32x4*)(EG + rb + 4);
            u32x4 ov, ok;
            ov.x = cvtpk(bf2f((bf16)v0[0]) * b0[0], bf2f((bf16)v0[1]) * b0[1]); ov.y = cvtpk(bf2f((bf16)v0[2]) * b0[2], bf2f((bf16)v0[3]) * b0[3]);
            ov.z = cvtpk(bf2f((bf16)v1[0]) * b1[0], bf2f((bf16)v1[1]) * b1[1]); ov.w = cvtpk(bf2f((bf16)v1[2]) * b1[2], bf2f((bf16)v1[3]) * b1[3]);
            ok.x = cvtpk(bf2f((bf16)k0[0]) * (b0[0] * e0[0]), bf2f((bf16)k0[1]) * (b0[1] * e0[1])); ok.y = cvtpk(bf2f((bf16)k0[2]) * (b0[2] * e0[2]), bf2f((bf16)k0[3]) * (b0[3] * e0[3]));
            ok.z = cvtpk(bf2f((bf16)k1[0]) * (b1[0] * e1[0]), bf2f((bf16)k1[1]) * (b1[1] * e1[1])); ok.w = cvtpk(bf2f((bf16)k1[2]) * (b1[2] * e1[2]), bf2f((bf16)k1[3]) * (b1[3] * e1[3]));
            Bv[ks] = __builtin_bit_cast(bf16x8, ov); Bk[ks] = __builtin_bit_cast(bf16x8, ok);
        }
#pragma unroll
        for (int b = 0; b < 4; ++b) {
            f32x4 xu = (f32x4){0.f, 0.f, 0.f, 0.f}, xw = xu;
#pragma unroll
            for (int ks = 0; ks < (b < 2 ? 1 : 2); ++ks) {
                const bf16x8 a = *(const bf16x8*)((const unsigned char*)TT + (16 * b + cl) * 144 + (32 * ks + 8 * g) * 2);
                xu = MFMA16(a, Bv[ks], xu); xw = MFMA16(a, Bk[ks], xw);
            }
            u32x2 o; o.x = cvtpk(xu[0], xu[1]); o.y = cvtpk(xu[2], xu[3]);
            *(u32x2*)((unsigned char*)PROJ + ((size_t)(R0 + wave * 8 + 2 * b + (lane >> 5)) * PLD + 2 * A_QK + h * A_DV) * 2 + (lane & 31) * 8) = o;
#pragma unroll
            for (int e = 0; e < 4; ++e) WST[(16 * b + 4 * g + e) * 136 + p32(16 * wave + cl)] = (bf16)(cvtpk(xw[e], 0.f) & 0xffffu);
        }
    }
    LBAR();
}

__device__ __forceinline__ bf16x8 pack_b(const f32x4 a, const f32x4 b) {
    u32x4 o; o.x = pk2bf(a[0], a[1]); o.y = pk2bf(a[2], a[3]); o.z = pk2bf(b[0], b[1]); o.w = pk2bf(b[2], b[3]); return __builtin_bit_cast(bf16x8, o);
}
constexpr int SC_BUF = 65536, SC_W = 0, SC_QD = 16384, SC_KDT = 32768, SC_IA = 49152, SC_U = 57344;
__device__ __forceinline__ void scan_dma(PrmRef p, int grp, int half, int n, int lw, int lane, unsigned char* buf) {
    const int h = grp % A_HEADS, s = grp / A_HEADS, R0 = s * SEQ + n * CHUNK;
    const BufRes rs = MAKE_RES(p.ws);
    const unsigned sW = (unsigned)(WS_WB + ((size_t)R0 * A_QK + h * A_DK) * 2);
    const unsigned sQ = (unsigned)(WS_PROJ + ((size_t)R0 * PLD + h * A_DK) * 2);
    const unsigned sK = (unsigned)(WS_PROJ + ((size_t)R0 * PLD + A_QK + h * A_DK) * 2);
    const unsigned sU = (unsigned)(WS_PROJ + ((size_t)(R0 + 32 * half) * PLD + 2 * A_QK + h * A_DV) * 2);
    const unsigned sI = (unsigned)(WS_IA + (size_t)(grp * NCPS + n) * 8192);
#pragma unroll
    for (int j = 0; j < 4; ++j) {
        const int ip = lw + 4 * j, sg = ip * 64 + lane;
        { const int row = sg >> 4, pc = (sg & 15) ^ (row & 15);
          BLDS16(rs, (unsigned)row * (unsigned)(A_QK * 2) + (unsigned)pc * 16u, sW, buf + SC_W + ip * 1024);
          BLDS16(rs, (unsigned)row * (unsigned)(PLD * 2) + (unsigned)pc * 16u, sQ, buf + SC_QD + ip * 1024); }
        { const int m = sg >> 3, pc = (sg & 7) ^ ((m >> 1) & 7);
          BLDS16(rs, (unsigned)(m >> 1) * (unsigned)(PLD * 2) + (unsigned)(m & 1) * 128u + (unsigned)pc * 16u, sK, buf + SC_KDT + ip * 1024); }
        if (j < 2) {
          { const int row = sg >> 3, pc = (sg & 7) ^ ((row >> 1) & 7); BLDS16(rs, (unsigned)row * 128u + (unsigned)pc * 16u, sI, buf + SC_IA + ip * 1024); }
          BLDS16(rs, (unsigned)(sg >> 4) * (unsigned)(PLD * 2) + (unsigned)(sg & 15) * 16u, sU, buf + SC_U + ip * 1024);
        }
    }
}
constexpr int SC_PF = 2 * SC_BUF, SC_PFD = 2;
static_assert(SC_PF + 1024 <= 163840 - 64, "scan LDS");
__device__ __forceinline__ void scan_prefetch(PrmRef p, int grp, int half, int n, int lw, int lane, unsigned char* lds) {
    const int h = grp % A_HEADS, s = grp / A_HEADS, R0 = s * SEQ + n * CHUNK;
    const BufRes rs = MAKE_RES(p.ws);
    const unsigned s0 = lw == 0 ? (unsigned)(WS_WB + ((size_t)R0 * A_QK + h * A_DK) * 2) : lw == 1 ? (unsigned)(WS_PROJ + ((size_t)R0 * PLD + h * A_DK) * 2)
                      : lw == 2 ? (unsigned)(WS_PROJ + ((size_t)R0 * PLD + A_QK + h * A_DK) * 2) : (unsigned)(WS_IA + (size_t)(grp * NCPS + n) * 8192);
    const unsigned s1 = lw == 3 ? (unsigned)(WS_PROJ + ((size_t)(R0 + 32 * half) * PLD + 2 * A_QK + h * A_DV) * 2) : s0 + 32u * (lw == 0 ? (unsigned)(A_QK * 2) : (unsigned)(PLD * 2));
    const unsigned pitch = lw == 0 ? (unsigned)(A_QK * 2) : (unsigned)(PLD * 2);
    const unsigned orow = (unsigned)(lane >> 1) * pitch + (unsigned)(lane & 1) * 128u;
    BLDS16(rs, lw == 3 ? (unsigned)lane * 128u : orow, s0, lds + SC_PF); BLDS16(rs, orow, s1, lds + SC_PF);
}
template <int SV = 0> __device__ __forceinline__ void delta_scan_group(PrmRef p, int li, int item, int tid, unsigned char* lds, bool wstate = true) {
    unsigned char* PROJ = (unsigned char*)(p.ws + WS_PROJ); const float* GL = (const float*)(p.ws + WS_GL);
    const int grp = item >> 1, half = item & 1;
    const int h = grp % A_HEADS, s = grp / A_HEADS, lane = tid & 63, wave = READFIRSTLANE(tid >> 6);
    const bool loader = wave >= 4; const int cw = 4 * half + (wave & 3);
    f32x4 S[8];
#pragma unroll
    for (int m = 0; m < 8; ++m) S[m] = (f32x4){0.f, 0.f, 0.f, 0.f};
    unsigned char* fp = PROJ + ((size_t)(s * SEQ + cw * 8 + (lane >> 5)) * PLD + 2 * A_QK + h * A_DV) * 2 + (lane & 31) * 8;
    constexpr size_t TSTEP = (size_t)2 * PLD * 2, CSTEP = (size_t)CHUNK * PLD * 2;
    static_assert(NCPS <= 64, "glast per lane");
    const float glv = GL[grp * NCPS + (lane < NCPS ? lane : 0)];
    if (loader) { if (SV != 1) { scan_dma(p, grp, half, 0, wave - 4, lane, lds);
#pragma unroll
        for (int d = 1; d < SC_PFD; ++d) scan_prefetch(p, grp, half, d, wave - 4, lane, lds); } }
    WAIT_VM(0); LBAR();
    for (int n = 0; n < NCPS; ++n) {
        unsigned char* buf = lds + (n & 1) * SC_BUF;
        if (loader) {
            if (n + 1 < NCPS) { if (SV != 1) scan_dma(p, grp, half, n + 1, wave - 4, lane, lds + ((n + 1) & 1) * SC_BUF); }
            if (SV != 1 && n + SC_PFD < NCPS) { scan_prefetch(p, grp, half, n + SC_PFD, wave - 4, lane, lds); WAIT_VM(2); }
            else { WAIT_VM(0); }
        } else {
        int lane2 = lane;
#ifndef EMU
        asm volatile("" : "+v"(lane2));
#endif
        const int g = lane2 >> 4, cl = lane2 & 15;
        int oW[4], oH[2];
#pragma unroll
        for (int ks = 0; ks < 4; ++ks) oW[ks] = cl * 256 + (((4 * ks + g) ^ cl) << 4);
#pragma unroll
        for (int ks = 0; ks < 2; ++ks) oH[ks] = cl * 128 + (((4 * ks + g) ^ (cl >> 1)) << 4);
        u32x2 uf[4];
#pragma unroll
        for (int t = 0; t < 4; ++t) uf[t] = *(const u32x2*)(buf + SC_U + ((wave & 3) * 8 + 2 * t + (lane2 >> 5)) * 256 + (lane2 & 31) * 8);
        const float glast = BCAST_LANE(glv, n);
        bf16x8 Bs[4];
#pragma unroll
        for (int ks = 0; ks < 4; ++ks) Bs[ks] = pack_b(S[2 * ks], S[2 * ks + 1]);
        bf16x8 fa[4][4];
#pragma unroll
        for (int t = 0; t < 4; ++t)
#pragma unroll
            for (int ks = 0; ks < 4; ++ks) fa[t][ks] = *(const bf16x8*)(buf + SC_W + t * 4096 + oW[ks]);
        SCHED_BARRIER();
        f32x4 vn[4];
#pragma unroll
        for (int t = 0; t < 4; ++t) vn[t] = (f32x4){0.f, 0.f, 0.f, 0.f};
#pragma unroll
        for (int ks = 0; ks < (SV == 3 ? 0 : 4); ++ks)
#pragma unroll
            for (int t = 0; t < 4; ++t) vn[t] = MFMA16(fa[t][ks], Bs[ks], vn[t]);
#pragma unroll
        for (int t = 0; t < 4; ++t) { const f32x4 u = (f32x4){bflo(uf[t].x), bfhi(uf[t].x), bflo(uf[t].y), bfhi(uf[t].y)}; vn[t] = u - vn[t]; }
        SCHED_BARRIER();
        bf16x8 fk[8][2];
#pragma unroll
        for (int m = 0; m < 8; ++m)
#pragma unroll
            for (int ks = 0; ks < 2; ++ks) fk[m][ks] = *(const bf16x8*)(buf + SC_KDT + m * 2048 + oH[ks]);
        SCHED_BARRIER();
        bf16x8 Vb[2];
        Vb[0] = pack_b(vn[0], vn[1]); Vb[1] = pack_b(vn[2], vn[3]);
#pragma unroll
        for (int m = 0; m < 8; ++m) S[m] = S[m] * glast;
#pragma unroll
        for (int ks = 0; ks < 2; ++ks)
#pragma unroll
            for (int m = 0; m < 8; ++m) S[m] = MFMA16(fk[m][ks], Vb[ks], S[m]);
#pragma unroll
        for (int t = 0; t < 4; ++t)
#pragma unroll
            for (int ks = 0; ks < 4; ++ks) fa[t][ks] = *(const bf16x8*)(buf + SC_QD + t * 4096 + oW[ks]);
        bf16x8 fi[4][2];
#pragma unroll
        for (int t = 0; t < 4; ++t)
#pragma unroll
            for (int ks = 0; ks < 2; ++ks) fi[t][ks] = *(const bf16x8*)(buf + SC_IA + t * 2048 + oH[ks]);
        SCHED_BARRIER();
        f32x4 oa[4];
#pragma unroll
        for (int t = 0; t < 4; ++t) oa[t] = (f32x4){0.f, 0.f, 0.f, 0.f};
        if (SV != 2) {
#pragma unroll
        for (int ks = 0; ks < 4; ++ks)
#pragma unroll
            for (int t = 0; t < 4; ++t) oa[t] = MFMA16(fa[t][ks], Bs[ks], oa[t]);
#pragma unroll
        for (int ks = 0; ks < 2; ++ks)
#pragma unroll
            for (int t = 0; t < 4; ++t) oa[t] = MFMA16(fi[t][ks], Vb[ks], oa[t]);
#pragma unroll
        for (int t = 0; t < 4; ++t) {
            u32x2 w; w.x = cvtpk(oa[t][0], oa[t][1]); w.y = cvtpk(oa[t][2], oa[t][3]);
            if (SV == 4) { asm volatile("" :: "v"(w.x), "v"(w.y)); } else
            *(u32x2*)(fp + (size_t)n * CSTEP + t * TSTEP) = w;
        }
        }
        WAIT_VM(4);
        }
        LBAR();
    }
    if (!loader && (wstate || SV != 0)) {
    float* so = SV != 0 ? (float*)(p.ws + WS_XB) + (size_t)grp * A_DK * A_DV : p.out + O_PDELTA + (((size_t)li * BATCH + s) * A_HEADS + h) * A_DK * A_DV;
#pragma unroll
    for (int m = 0; m < 8; ++m)
#pragma unroll
        for (int e = 0; e < 4; ++e) so[(size_t)(16 * m + 4 * (lane >> 4) + e) * A_DV + 16 * cw + (lane & 15)] = S[m][e];
    }
    LBAR();
}
constexpr int NM_PART = 0, NM_OST = 2048;
struct NormRaw { u32x2 of[4]; u32x4 z0, z1; };
__device__ __forceinline__ void norm_load(PrmRef p, int item, int tid, NormRaw& q) {
    const unsigned char* PROJ = (const unsigned char*)(p.ws + WS_PROJ);
    const int n = item % NCPS, grp = item / NCPS, h = grp % A_HEADS, s = grp / A_HEADS, R0 = s * SEQ + n * CHUNK;
    const int lane = tid & 63, wave = tid >> 6, r = tid >> 3, seg = tid & 7;
    const unsigned char* fp = PROJ + ((size_t)(R0 + wave * 8 + (lane >> 5)) * PLD + 2 * A_QK + h * A_DV) * 2 + (lane & 31) * 8;
#pragma unroll
    for (int t = 0; t < 4; ++t) q.of[t] = *(const u32x2*)(fp + (size_t)t * 2 * PLD * 2);
    const u32x4* zp = (const u32x4*)(PROJ + ((size_t)(R0 + r) * PLD + CONV_DIM + h * A_DV + 16 * seg) * 2); q.z0 = zp[0]; q.z1 = zp[1];
}
__device__ __forceinline__ void delta_norm_item(PrmRef p, int li, int item, int next_item, int tid, unsigned char* lds, NormRaw& raw) {
    unsigned char* PROJ = (unsigned char*)(p.ws + WS_PROJ);
    const int n = item % NCPS, grp = item / NCPS, h = grp % A_HEADS, s = grp / A_HEADS, R0 = s * SEQ + n * CHUNK;
    const int lane = tid & 63, wave = tid >> 6, g = lane >> 4, cl = lane & 15, r = tid >> 3, seg = tid & 7;
    float* PART = (float*)(lds + NM_PART);
    const float nw = p.a_norm_w[li * A_DV + 16 * wave + cl];
    const u32x4 z0 = raw.z0, z1 = raw.z1;
    f32x4 oa[4];
#pragma unroll
    for (int t = 0; t < 4; ++t) {
        oa[t] = (f32x4){bflo(raw.of[t].x), bfhi(raw.of[t].x), bflo(raw.of[t].y), bfhi(raw.of[t].y)};
        f32x4 q4;
#pragma unroll
        for (int e = 0; e < 4; ++e) q4[e] = sum16(oa[t][e] * oa[t][e]);
        if (cl < 4) PART[(16 * t + 4 * g + cl) * 8 + wave] = cl == 0 ? q4[0] : cl == 1 ? q4[1] : cl == 2 ? q4[2] : q4[3];
    }
    if (next_item >= 0) norm_load(p, next_item, tid, raw);
    LBAR();
#pragma unroll
    for (int t = 0; t < 4; ++t)
#pragma unroll
        for (int e = 0; e < 4; ++e) {
            const int row = 16 * t + 4 * g + e;
            const f32x4 p0 = *(const f32x4*)(PART + row * 8), p1 = *(const f32x4*)(PART + row * 8 + 4);
            const float ss = ((p0[0] + p0[1]) + (p0[2] + p0[3])) + ((p1[0] + p1[1]) + (p1[2] + p1[3]));
            *(bf16*)(lds + NM_OST + row * 272 + (16 * wave + cl) * 2) = (bf16)(cvtpk(oa[t][e] * fast_rsq(ss * (1.f / A_DV) + RMS_EPS) * nw, 0.f) & 0xffffu);
        }
    LBAR();
    {
        const u32x4 o0 = *(const u32x4*)(lds + NM_OST + r * 272 + 32 * seg), o1 = *(const u32x4*)(lds + NM_OST + r * 272 + 32 * seg + 16);
        u32x4 w0, w1;
#pragma unroll
        for (int e = 0; e < 4; ++e) {
            w0[e] = cvtpk(bflo(o0[e]) * fsilu(bflo(z0[e])), bfhi(o0[e]) * fsilu(bfhi(z0[e])));
            w1[e] = cvtpk(bflo(o1[e]) * fsilu(bflo(z1[e])), bfhi(o1[e]) * fsilu(bfhi(z1[e])));
        }
        u32x4* dst = (u32x4*)(PROJ + ((size_t)(R0 + r) * PLD + 2 * A_QK + h * A_DV + 16 * seg) * 2); dst[0] = w0; dst[1] = w1;
    }
    LBAR();
}
__device__ __forceinline__ void ph_a_norm(PrmRef p, const Ctx& c, int li, unsigned char* lds) {
    NormRaw raw;
    if (c.bid < NPI) norm_load(p, c.bid, c.tid, raw);
    for (int item = c.bid; item < NPI; item += c.nblk) delta_norm_item(p, li, item, item + c.nblk < NPI ? item + c.nblk : -1, c.tid, lds, raw);
    bf16* PROJ = (bf16*)(p.ws + WS_PROJ);
    sgemm_rows(p, PROJ + 2 * A_QK, PLD, (const bf16*)(p.ws + WS_WAOUT) + (size_t)li * D_MODEL * A_VW, A_VW, PROJ, PLD, PT, ST, D_MODEL, c, NPI, lds);
}
__device__ __forceinline__ void sample_conv(PrmRef p, const Ctx& c, int li) {
    bf16* PROJ = (bf16*)(p.ws + WS_PROJ);
    const float* cw = p.a_conv_w + (size_t)li * CONV_W * CONV_DIM;
    for (int it = c.gtid; it < DEC_BATCH * CONV_DIM; it += c.nthreads) {
        const int ch = it % CONV_DIM, b = it / CONV_DIM;
        const float* sp = p.state_conv + (((size_t)li * DEC_BATCH + b) * 3) * CONV_DIM + ch;
        float h0 = sp[0], h1 = sp[CONV_DIM], h2 = sp[2 * CONV_DIM];
        const float w0 = cw[ch], w1 = cw[CONV_DIM + ch], w2 = cw[2 * CONV_DIM + ch], w3 = cw[3 * CONV_DIM + ch];
        bf16* e0 = PROJ + (size_t)(PT + b * DEC_SEQ) * PLD + ch;
        bf16 xv[DEC_SEQ];
#pragma unroll
        for (int t = 0; t < DEC_SEQ; ++t) xv[t] = e0[(size_t)t * PLD];
#pragma unroll
        for (int t = 0; t < DEC_SEQ; ++t) {
            const float x = bf2f(xv[t]);
            const float y = w0 * h0 + w1 * h1 + w2 * h2 + w3 * x;
            e0[(size_t)t * PLD] = (bf16)(cvtpk(fsilu(y), 0.f) & 0xffffu); h0 = h1; h1 = h2; h2 = x;
        }
        float* so = p.out + O_SCONV + (((size_t)li * DEC_BATCH + b) * 3) * CONV_DIM + ch;
        so[0] = h0; so[CONV_DIM] = h1; so[2 * CONV_DIM] = h2;
    }
}
constexpr int SS2_KQ = 0, SS2_V = 32768, SS2_GE = 49152, SS2_O = 49408;
__device__ __forceinline__ void sample_scan_group(PrmRef p, int li, int sg, int tid, unsigned char* lds, bool wstate = true) {
    bf16* PROJ = (bf16*)(p.ws + WS_PROJ); const float* GB = (const float*)(p.ws + WS_GB);
    float* KQ = (float*)(lds + SS2_KQ); float* V = (float*)(lds + SS2_V); float* GE = (float*)(lds + SS2_GE); float* O = (float*)(lds + SS2_O);
    const int b = sg / A_HEADS, h = sg % A_HEADS, r0 = PT + b * DEC_SEQ, col = tid >> 2, part = tid & 3, lane = tid & 63, wave = tid >> 6;
    __syncthreads();
    float S[32];
    const float* s0 = p.state_delta + (((size_t)li * DEC_BATCH + b) * A_HEADS + h) * A_DK * A_DV;
#pragma unroll
    for (int k = 0; k < 32; ++k) S[k] = s0[(size_t)(part * 32 + k) * A_DV + col];
    {
        float a[8], bb[8];
#pragma unroll
        for (int i = 0; i < 8; ++i) { const int row = wave * 8 + i, t = row >> 1, kind = row & 1; const bf16* e = PROJ + (size_t)(r0 + t) * PLD + (kind == 0 ? A_QK : 0) + h * A_DK + 2 * lane; a[i] = bf2f(e[0]); bb[i] = bf2f(e[1]); }
#pragma unroll
        for (int i = 0; i < 8; ++i) { const int row = wave * 8 + i, kind = row & 1;
            const float sc = (1.f / sqrtf(wave_sum(a[i] * a[i] + bb[i] * bb[i]) + RMS_EPS)) * (kind == 0 ? 1.f : 0.08838834764831845f);
            KQ[row * 128 + 2 * lane] = a[i] * sc; KQ[row * 128 + 2 * lane + 1] = bb[i] * sc; }
#pragma unroll
        for (int i = 0; i < 8; ++i) { const int t = part * 8 + i; V[t * 128 + col] = bf2f(PROJ[(size_t)(r0 + t) * PLD + 2 * A_QK + h * A_DV + col]); }
        if (tid < DEC_SEQ) { GE[2 * tid] = expf(GB[((size_t)(r0 + tid) * A_HEADS + h) * 2]); GE[2 * tid + 1] = GB[((size_t)(r0 + tid) * A_HEADS + h) * 2 + 1]; }
    }
    __syncthreads();
    for (int t = 0; t < DEC_SEQ; ++t) {
        const float eg = GE[2 * t], beta = GE[2 * t + 1], v = V[t * 128 + col];
        const f32x4* kk = (const f32x4*)(KQ + (2 * t) * 128 + part * 32); const f32x4* qq = (const f32x4*)(KQ + (2 * t + 1) * 128 + part * 32);
        float ks = 0.f;
#pragma unroll
        for (int k4 = 0; k4 < 8; ++k4) { const f32x4 kv = kk[k4];
#pragma unroll
            for (int e = 0; e < 4; ++e) { S[4 * k4 + e] *= eg; ks += kv[e] * S[4 * k4 + e]; } }
        ks += __shfl_xor(ks, 1); ks += __shfl_xor(ks, 2);
        const float vn = (v - ks) * beta; float o = 0.f;
#pragma unroll
        for (int k4 = 0; k4 < 8; ++k4) { const f32x4 kv = kk[k4], qv = qq[k4];
#pragma unroll
            for (int e = 0; e < 4; ++e) { S[4 * k4 + e] += kv[e] * vn; o += qv[e] * S[4 * k4 + e]; } }
        o += __shfl_xor(o, 1); o += __shfl_xor(o, 2);
        if (part == 0) O[t * 128 + col] = bf2f((bf16)f2bf(o));
    }
    float* so = p.out + O_SDELTA + (((size_t)li * DEC_BATCH + b) * A_HEADS + h) * A_DK * A_DV;
    if (wstate) {
#pragma unroll
    for (int k = 0; k < 32; ++k) so[(size_t)(part * 32 + k) * A_DV + col] = S[k];
    }
    __syncthreads();
    const float* nw = p.a_norm_w + (size_t)li * A_DV;
#pragma unroll
    for (int i = 0; i < 4; ++i) {
        const int t = wave * 4 + i, row = r0 + t;
        bf16* e = PROJ + (size_t)row * PLD + 2 * A_QK + h * A_DV + 2 * lane; const bf16* z = PROJ + (size_t)row * PLD + CONV_DIM + h * A_DV + 2 * lane;
        const float a = O[t * 128 + 2 * lane], bb = O[t * 128 + 2 * lane + 1];
        const float r = 1.f / sqrtf(wave_sum(a * a + bb * bb) * (1.f / A_DV) + RMS_EPS);
        e[0] = (bf16)f2bf(a * r * nw[2 * lane] * siluf(bf2f(z[0]))); e[1] = (bf16)f2bf(bb * r * nw[2 * lane + 1] * siluf(bf2f(z[1])));
    }
    __syncthreads();
}
template <int VAR = 0> __device__ __forceinline__ void ph_a_pre(PrmRef p, const Ctx& c, int li, unsigned char* lds) {
    RawTile xr;
    if (c.bid < NPI) { prepass_load_raw(p, c.bid, c.tid, xr); if (c.wave == 1) prepass_gcum(p, c.bid, c.lane, (float*)(lds + PP_GC)); }
    int prev = -1, pb = 0, cur_h = -1;
    for (int item = c.bid; item < NPI; item += c.nblk) {
        const int h = (item / NCPS) % A_HEADS;
        if (h != cur_h) {
            LBAR();
            for (int i = c.tid; i < 3 * 4 * 128; i += NTHR) { const int X = i / 512, j = (i / 128) & 3, ch = i & 127; ((float*)(lds + PP_CW))[i] = p.a_conv_w[((size_t)li * CONV_W + j) * CONV_DIM + X * A_QK + h * A_DK + ch]; }
            LBAR(); cur_h = h;
        }
        delta_prepass_item<VAR>(p, li, item, item + c.nblk < NPI ? item + c.nblk : -1, prev, pb, c.tid, lds, xr); prev = item; pb ^= 1;
    }
    if (prev >= 0) prepass_store_w(p, prev, c.tid, lds);
    LBAR();
    if (VAR == 0) sample_conv(p, c, li);
}
template <int SV = 0> __device__ __forceinline__ void ph_a_scan2(PrmRef p, const Ctx& c, int li, unsigned char* lds, bool wstate = true, bool do_prompt = true, bool do_sample = true) {
    const int v = (c.bid + c.nblk - ((2 * NPG) % c.nblk)) % c.nblk;
    if (do_sample) for (int sg = v; sg < NSG; sg += c.nblk) sample_scan_group(p, li, sg, c.tid, lds, wstate);
    const int nfree = c.nblk > 2 * NPG ? c.nblk - 2 * NPG : 0;
    const int lane_s = c.lane, wave_s = READFIRSTLANE(c.wave), gw_s = READFIRSTLANE(c.gwave), nw_s = c.nwaves;
    if (SV == 0 && nfree > 0 && v < nfree) { weights_deferred(p, lane_s, wave_s, li, lds, v * (NTHR / 64) + wave_s, nfree * (NTHR / 64)); LBAR(); }
    if (do_prompt) for (int it = c.bid; it < 2 * NPG; it += c.nblk) delta_scan_group<SV>(p, li, it, c.tid, lds, wstate);
    if (SV == 0 && nfree == 0) { weights_deferred(p, lane_s, wave_s, li, lds, gw_s, nw_s); LBAR(); }
}

__device__ __forceinline__ void ph_ln(PrmRef p, const Ctx& c, const bf16* OUT, int ldo, const float* g, const float* b, bool last) {
    bf16* XB = (bf16*)(p.ws + WS_XB);
    constexpr int PER = D_MODEL / 64;
    constexpr int RB = 3;
    static_assert(PER % 8 == 0, "ln vector width");
    const int col0 = c.lane * PER;
    f32x4 gv[PER / 4], bv[PER / 4];
#pragma unroll
    for (int j = 0; j < PER / 4; ++j) { gv[j] = *(const f32x4*)(g + col0 + 4 * j); bv[j] = *(const f32x4*)(b + col0 + 4 * j); }
    for (int row0 = c.gwave; row0 < MT; row0 += RB * c.nwaves) {
        u32x4 xa[RB][PER / 8], oa[RB][PER / 8];
#pragma unroll
        for (int r = 0; r < RB; ++r) { const int row = row0 + r * c.nwaves;
            if (row < MT) {
#pragma unroll
                for (int j = 0; j < PER / 8; ++j) { xa[r][j] = *(const u32x4*)(XB + (size_t)row * D_MODEL + col0 + 8 * j); oa[r][j] = *(const u32x4*)(OUT + (size_t)row * ldo + col0 + 8 * j); } } }
#pragma unroll
        for (int r = 0; r < RB; ++r) { const int row = row0 + r * c.nwaves;
            if (row < MT) {
                float v[PER]; float s = 0.f;
#pragma unroll
                for (int j = 0; j < PER / 8; ++j)
#pragma unroll
                    for (int e = 0; e < 4; ++e) { v[8 * j + 2 * e] = DN_ALPHA * bflo(xa[r][j][e]) + bflo(oa[r][j][e]); v[8 * j + 2 * e + 1] = DN_ALPHA * bfhi(xa[r][j][e]) + bfhi(oa[r][j][e]); }
#pragma unroll
                for (int j = 0; j < PER; ++j) s += v[j];
                const float mean = wave_sum(s) * (1.f / D_MODEL); float q = 0.f;
#pragma unroll
                for (int j = 0; j < PER; ++j) { v[j] -= mean; q += v[j] * v[j]; }
                const float rstd = fast_rsq(wave_sum(q) * (1.f / D_MODEL) + LN_EPS);
#pragma unroll
                for (int j = 0; j < PER; ++j) v[j] = v[j] * rstd * gv[j >> 2][j & 3] + bv[j >> 2][j & 3];
#pragma unroll
                for (int j = 0; j < PER / 8; ++j) { u32x4 o;
#pragma unroll
                    for (int e = 0; e < 4; ++e) o[e] = cvtpk(v[8 * j + 2 * e], v[8 * j + 2 * e + 1]);
                    *(u32x4*)(XB + (size_t)row * D_MODEL + col0 + 8 * j) = o; }
                if (last) { float* yo = row < PT ? p.out + O_YP + (size_t)row * D_MODEL + col0 : p.out + O_YS + (size_t)(row - PT) * D_MODEL + col0;
#pragma unroll
                    for (int j = 0; j < PER; j += 4) *(f32x4*)(yo + j) = (f32x4){v[j], v[j + 1], v[j + 2], v[j + 3]}; }
            } }
    }
}
__device__ __forceinline__ float fast_exp2(float x) {
#ifdef EMU
    return exp2f(x);
#else
    return __builtin_amdgcn_exp2f(x);
#endif
}
__device__ __forceinline__ void b_cache_copies(PrmRef p, const Ctx& c) {
    bf16* CK = (bf16*)(p.ws + WS_CK); bf16* CVT = (bf16*)(p.ws + WS_CVT);
    for (int it = c.gtid; it < DEC_BATCH * WINDOW * B_KVW; it += c.nthreads) {
        const int dd = it % B_KVW, w = (it / B_KVW) % WINDOW, b = it / (B_KVW * WINDOW), kvh = dd / B_HD, d = dd % B_HD;
        CK[(((size_t)b * B_KV_HEADS + kvh) * WINDOW + w) * B_HD + d] = (bf16)f2bf(p.cache_k[it]);
        CVT[(((size_t)b * B_KV_HEADS + kvh) * B_HD + d) * WINDOW + w] = (bf16)f2bf(p.cache_v[it]);
    }
}
__device__ __forceinline__ void ph_b_gemm(PrmRef p, const Ctx& c, int lj, unsigned char* lds) {
    const bf16* XB = (const bf16*)(p.ws + WS_XB); bf16* PROJ = (bf16*)(p.ws + WS_PROJ); const bf16* Wt = (const bf16*)(p.ws + WS_WBIN) + (size_t)lj * B_N0 * D_MODEL;
    const int N = lj == 0 ? B_N0 : B_IN;
    pg8::Gemm g{XB, D_MODEL, Wt, PT, N, D_MODEL}; pg8::StaticOrder S; S.init(PT, N, c.nblk, c.bid);
    pg8::EpiBIn E{PROJ, PLD, (const float*)(p.ws + WS_ROPE), (bf16*)(p.ws + WS_VT)};
    __syncthreads();
    pg8::gemm_phase<pg8::EpiBIn, pg8::StaticOrder, true>((LAS unsigned char*)lds, g, S, E, c.tid);
    __syncthreads();
    sgemm_rows<2>(p, XB, D_MODEL, Wt, D_MODEL, PROJ, PLD, PT, ST, N, c, lj == 0 ? (PT / 256) * (B_N0 / 256) : 0, lds, true);
    if (lj == 0) b_cache_copies(p, c);
}
constexpr int AT_KPITCH = 144, AT_VPITCH = 400, AT_K = 0, AT_V = 192 * AT_KPITCH, AT_O = AT_V + 64 * AT_VPITCH + 64  , AT_OPITCH = 144;
static_assert(2 * SC_BUF <= 163840 - 64, "scan LDS");
static_assert(AT_O % 16 == 0 && AT_O + 256 * AT_OPITCH <= 131072, "attention LDS");
struct AttRaw { u32x4 k[3], v[3]; bf16x8 q[4]; };
__device__ __forceinline__ void att_load(PrmRef p, int ck, int kvh, int tid, AttRaw& raw) {
    const unsigned char* PROJ = (const unsigned char*)(p.ws + WS_PROJ); const unsigned char* VT = (const unsigned char*)(p.ws + WS_VT);
    const unsigned char* CK = (const unsigned char*)(p.ws + WS_CK); const unsigned char* CVT = (const unsigned char*)(p.ws + WS_CVT);
    const int lane = tid & 63, wave = tid >> 6, l31 = lane & 31, hi = lane >> 5;
    const bool smp = ck >= NCP; const int r0 = chunk_row0(ck);
    const int nc = smp ? 0 : ck % NCPS, nblk = smp ? 0 : (nc >= 2 ? 3 : nc + 1);
    if (!smp) {
        const int kfirst = r0 - (nblk - 1) * CHUNK;
#pragma unroll
        for (int j = 0; j < 3; ++j) if (j < nblk) { const int idx = tid + NTHR * j, key = idx >> 3, pc = idx & 7, d = (idx >> 3) & 63;
            raw.k[j] = *(const u32x4*)(PROJ + ((size_t)(kfirst + key) * PLD + B_IN + kvh * B_HD) * 2 + pc * 16);
            raw.v[j] = *(const u32x4*)(VT + ((((size_t)(ck - (nblk - 1) + j) * B_KV_HEADS + kvh) * B_HD + d) * 64) * 2 + pc * 16); }
    } else {
        const int b = ck - NCP;
#pragma unroll
        for (int j = 0; j < 3; ++j) { const int idx = tid + NTHR * j;
            if (idx < 160 * 8) { const int key = idx >> 3, pc = idx & 7;
                raw.k[j] = *(const u32x4*)(key < WINDOW ? CK + ((((size_t)b * B_KV_HEADS + kvh) * WINDOW + key) * B_HD) * 2 + pc * 16 : PROJ + ((size_t)(r0 + key - WINDOW) * PLD + B_IN + kvh * B_HD) * 2 + pc * 16); }
            if (idx < 64 * 20) { const int d = idx / 20, pc = idx % 20;
                raw.v[j] = *(const u32x4*)(pc < 16 ? CVT + ((((size_t)b * B_KV_HEADS + kvh) * B_HD + d) * WINDOW) * 2 + pc * 16 : VT + ((((size_t)ck * B_KV_HEADS + kvh) * B_HD + d) * 64) * 2 + (pc - 16) * 16); } }
    }
    const bool active = smp ? wave < 4 : true;
    const int hq = kvh * B_GROUP + (smp ? wave : (wave >> 1)), qrow0 = smp ? 0 : 32 * (wave & 1);
    if (active) {
#pragma unroll
        for (int ks = 0; ks < 4; ++ks) raw.q[ks] = *(const bf16x8*)(PROJ + ((size_t)(r0 + qrow0 + l31) * PLD + hq * B_HD + 16 * ks + 8 * hi) * 2);
    }
}
__device__ __forceinline__ void att_item(PrmRef p, int lj, int ck, int kvh, int nck, int nkvh, int tid, unsigned char* lds, AttRaw& raw) {
#ifndef EMU
    asm volatile("" : "+v"(tid));
#endif
    unsigned char* PROJ = (unsigned char*)(p.ws + WS_PROJ);
    const int lane = tid & 63, wave = READFIRSTLANE(tid >> 6), l31 = lane & 31, hi = lane >> 5;
    const bool smp = ck >= NCP; const int r0 = chunk_row0(ck);
    const int nc = smp ? 0 : ck % NCPS, nblk = smp ? 0 : (nc >= 2 ? 3 : nc + 1);
    const int nkt = smp ? 5 : 2 * nblk;
    if (!smp) {
#pragma unroll
        for (int j = 0; j < 3; ++j) if (j < nblk) { const int idx = tid + NTHR * j, key = idx >> 3, pc = idx & 7, d = (idx >> 3) & 63;
            *(u32x4*)(lds + AT_K + key * AT_KPITCH + pc * 16) = raw.k[j];
            unsigned char* dst = lds + AT_V + d * AT_VPITCH + j * 128 + (pc >> 1) * 32 + (pc & 1) * 8; *(u32x2*)dst = (u32x2){raw.v[j].x, raw.v[j].y}; *(u32x2*)(dst + 16) = (u32x2){raw.v[j].z, raw.v[j].w}; }
    } else {
#pragma unroll
        for (int j = 0; j < 3; ++j) { const int idx = tid + NTHR * j;
            if (idx < 160 * 8) { const int key = idx >> 3, pc = idx & 7; *(u32x4*)(lds + AT_K + key * AT_KPITCH + pc * 16) = raw.k[j]; }
            if (idx < 64 * 20) { const int d = idx / 20, pc = idx % 20; unsigned char* dst = lds + AT_V + d * AT_VPITCH + (pc >> 1) * 32 + (pc & 1) * 8; *(u32x2*)dst = (u32x2){raw.v[j].x, raw.v[j].y}; *(u32x2*)(dst + 16) = (u32x2){raw.v[j].z, raw.v[j].w}; } }
    }
    const bool active = smp ? wave < 4 : true;
    const int hq = kvh * B_GROUP + (smp ? wave : (wave >> 1));
    bf16x8 qf[4];
#pragma unroll
    for (int ks = 0; ks < 4; ++ks) qf[ks] = raw.q[ks];
    LBAR();
    if (nck >= 0) att_load(p, nck, nkvh, tid, raw);
    const int nrows = smp ? 128 : 256;
    u32x4 zr[4];
    if (active) {
        f32x16 sc[6];
#pragma unroll
        for (int kt = 0; kt < 6; ++kt) {
#pragma unroll
            for (int e = 0; e < 16; ++e) sc[kt][e] = 0.f;
            if (kt < nkt) {
#pragma unroll
                for (int ks = 0; ks < 4; ++ks) sc[kt] = MFMA32(*(const bf16x8*)(lds + AT_K + (32 * kt + l31) * AT_KPITCH + 32 * ks + 16 * hi), qf[ks], sc[kt]);
            }
        }
        const float sink = p.b_sinks[lj * B_Q_HEADS + hq];
        float m = sink;
#pragma unroll
        for (int kt = 0; kt < 6; ++kt) if (kt < nkt) {
#pragma unroll
            for (int e = 0; e < 16; ++e) m = fmaxf(m, sc[kt][e]); }
        m = fmaxf(m, __shfl_xor(m, 32));
        float l = 0.f; const float ml2 = m * 1.4426950408889634f;
#pragma unroll
        for (int kt = 0; kt < 6; ++kt) if (kt < nkt) {
#pragma unroll
            for (int e = 0; e < 16; ++e) { const float pe = fast_exp2(sc[kt][e] * 1.4426950408889634f - ml2); sc[kt][e] = pe; l += pe; } }
        l += __shfl_xor(l, 32);
        l += fast_exp2(sink * 1.4426950408889634f - ml2);
        f32x16 o[2];
#pragma unroll
        for (int e = 0; e < 16; ++e) { o[0][e] = 0.f; o[1][e] = 0.f; }
#pragma unroll
        for (int kt = 0; kt < 6; ++kt) if (kt < nkt) {
#pragma unroll
            for (int s = 0; s < 2; ++s) {
                u32x4 pw; pw.x = cvtpk(sc[kt][8 * s], sc[kt][8 * s + 1]); pw.y = cvtpk(sc[kt][8 * s + 2], sc[kt][8 * s + 3]); pw.z = cvtpk(sc[kt][8 * s + 4], sc[kt][8 * s + 5]); pw.w = cvtpk(sc[kt][8 * s + 6], sc[kt][8 * s + 7]);
                const bf16x8 pb = __builtin_bit_cast(bf16x8, pw);
#pragma unroll
                for (int mt = 0; mt < 2; ++mt) {
                    o[mt] = MFMA32(*(const bf16x8*)(lds + AT_V + (32 * mt + l31) * AT_VPITCH + (32 * kt + 16 * s) * 2 + 16 * hi), pb, o[mt]);
                }
            }
        }
        const float il = fast_rcp(l);
        unsigned char* orow = lds + AT_O + (32 * wave + l31) * AT_OPITCH;
#pragma unroll
        for (int mt = 0; mt < 2; ++mt)
#pragma unroll
            for (int cg4 = 0; cg4 < 4; ++cg4) {
                u32x2 w2; w2.x = cvtpk(o[mt][4 * cg4] * il, o[mt][4 * cg4 + 1] * il); w2.y = cvtpk(o[mt][4 * cg4 + 2] * il, o[mt][4 * cg4 + 3] * il);
                *(u32x2*)(orow + (32 * mt + 8 * cg4 + 4 * hi) * 2) = w2;
            }
    }
#pragma unroll
    for (int i = 0; i < 4; ++i) { const int idx = tid + NTHR * i;
        if (idx < nrows * 8) { const int qr = idx >> 3, pc = idx & 7, w = qr >> 5, hq2 = kvh * B_GROUP + (smp ? w : (w >> 1)), row = r0 + (smp ? 0 : 32 * (w & 1)) + (qr & 31);
            zr[i] = *(const u32x4*)(PROJ + ((size_t)row * PLD + B_QW + hq2 * B_HD) * 2 + pc * 16); } }
    LBAR();
#pragma unroll
    for (int i = 0; i < 4; ++i) { const int idx = tid + NTHR * i;
        if (idx < nrows * 8) { const int qr = idx >> 3, pc = idx & 7, w = qr >> 5, hq2 = kvh * B_GROUP + (smp ? w : (w >> 1)), row = r0 + (smp ? 0 : 32 * (w & 1)) + (qr & 31);
            const u32x4 ov = *(const u32x4*)(lds + AT_O + qr * AT_OPITCH + pc * 16); const u32x4 zv = zr[i];
            u32x4 r;
#pragma unroll
            for (int e = 0; e < 4; ++e) r[e] = cvtpk(bflo(ov[e]) * fsilu(bflo(zv[e])), bfhi(ov[e]) * fsilu(bfhi(zv[e])));
            *(u32x4*)(PROJ + ((size_t)row * PLD + hq2 * B_HD) * 2 + pc * 16) = r; } }
    LBAR();
}
__device__ __forceinline__ void ph_b_att2(PrmRef p, const Ctx& c, int lj, bool first, unsigned char* lds) {
    AttRaw raw;
    if (c.bid < NCH * B_KV_HEADS) att_load(p, c.bid / B_KV_HEADS, c.bid % B_KV_HEADS, c.tid, raw);
    for (int it = c.bid; it < NCH * B_KV_HEADS; it += c.nblk) { const int nx = it + c.nblk < NCH * B_KV_HEADS ? it + c.nblk : -1;
        att_item(p, lj, it / B_KV_HEADS, it % B_KV_HEADS, nx < 0 ? -1 : nx / B_KV_HEADS, nx < 0 ? 0 : nx % B_KV_HEADS, c.tid, lds, raw); }
    if (first) {
        const bf16* PROJ = (const bf16*)(p.ws + WS_PROJ);
        for (int it = c.gtid; it < (BATCH + DEC_BATCH) * WINDOW * B_KVW; it += c.nthreads) {
            const int e = it % B_KVW, w = (it / B_KVW) % WINDOW, s = it / (B_KVW * WINDOW);
            if (s < BATCH) { const int row = s * SEQ + SEQ - WINDOW + w; const bf16* kp = PROJ + (size_t)row * PLD + B_IN;
                p.out[O_PK + ((size_t)s * WINDOW + w) * B_KVW + e] = bf2f(kp[e]); p.out[O_PV + ((size_t)s * WINDOW + w) * B_KVW + e] = bf2f(kp[B_KVW + e]); }
            else { const int b = s - BATCH; float kx, vx;
                if (w < WINDOW - DEC_SEQ) { kx = p.cache_k[((size_t)b * WINDOW + w + DEC_SEQ) * B_KVW + e]; vx = p.cache_v[((size_t)b * WINDOW + w + DEC_SEQ) * B_KVW + e]; }
                else { const int row = PT + b * DEC_SEQ + (w - (WINDOW - DEC_SEQ)); const bf16* kp = PROJ + (size_t)row * PLD + B_IN; kx = bf2f(kp[e]); vx = bf2f(kp[B_KVW + e]); }
                p.out[O_SK + ((size_t)b * WINDOW + w) * B_KVW + e] = kx; p.out[O_SV + ((size_t)b * WINDOW + w) * B_KVW + e] = vx; }
        }
    }
}

#ifndef EMU
#define XB_TMO      128
#define XB_XCNT(j)  (256  + 64 * (j))
#define XB_XSUB(j)  (1280 + 64 * (j))
#define XB_XGEN(j)  (2304 + 64 * (j))
#define XB_TOP      3328
#define XB_TOPGEN   3392
#define XCD_BAR_WORDS 3456
#define XB_SPIN_CAP (1u << 20)
__device__ __forceinline__ unsigned xb_ld(unsigned* p)              { return __hip_atomic_load(p, __ATOMIC_RELAXED, __HIP_MEMORY_SCOPE_AGENT); }
__device__ __forceinline__ unsigned xb_add(unsigned* p, unsigned v) { return __hip_atomic_fetch_add(p, v, __ATOMIC_RELAXED, __HIP_MEMORY_SCOPE_AGENT); }
__device__ __forceinline__ unsigned xb_xcc_id() { return (unsigned)__builtin_amdgcn_s_getreg((3 << 11) | 20) & 0xFu; }
#define XB_SPIN(cond, bar) do { unsigned _sp = 0; while (cond) { __builtin_amdgcn_s_sleep(1); \
    if ((++_sp & 255u) == 0u) { if (xb_ld(&(bar)[XB_TMO])) break; if (_sp > XB_SPIN_CAP) { atomicAdd(&(bar)[XB_TMO], 1u); break; } } } } while (0)
__device__ __forceinline__ void xcd_barrier_complete(unsigned* bar, unsigned x, unsigned& nloc, unsigned& nx) {
    const unsigned G = gridDim.x * gridDim.y * gridDim.z;
    unsigned sum, cnt, mine, sp = 0u;
    for (;;) {
        sum = 0u; cnt = 0u; mine = 0u;
#pragma unroll
        for (unsigned j = 0; j < 16; ++j) { const unsigned c = xb_ld(&bar[XB_XCNT(j)]); sum += c; cnt += (c > 0u) ? 1u : 0u; mine = (j == x) ? c : mine; }
        if (sum == G) break;
        __builtin_amdgcn_s_sleep(1);
        if ((++sp & 255u) == 0u) { if (xb_ld(&bar[XB_TMO])) break; if (sp > XB_SPIN_CAP) { atomicAdd(&bar[XB_TMO], 1u); break; } }
    }
    nloc = mine > 0u ? mine : 1u; nx = cnt > 0u ? cnt : 1u;
}
__device__ __forceinline__ void xcd_barrier(unsigned* bar, volatile LAS unsigned* st, const int tid) {
    asm volatile("s_waitcnt vmcnt(0)" ::: "memory");
    __syncthreads();
    if (tid == 0) {
        __builtin_amdgcn_s_waitcnt(0);
        const unsigned x = xb_xcc_id();
        unsigned nloc = st[0], nx = st[1];
        if (nloc == 0u) { xcd_barrier_complete(bar, x, nloc, nx); st[0] = nloc; st[1] = nx; }
        const unsigned old = xb_add(&bar[XB_XSUB(x)], 1u);
        const unsigned gen = old / nloc;
        if (old + 1u == (gen + 1u) * nloc) {
            __builtin_amdgcn_fence(__ATOMIC_RELEASE, "agent");
            asm volatile("s_waitcnt vmcnt(0)" ::: "memory");
            const unsigned og = xb_add(&bar[XB_TOP], 1u);
            const unsigned tg = og / nx;
            if (og + 1u == (tg + 1u) * nx) xb_add(&bar[XB_TOPGEN], 1u);
            else XB_SPIN(xb_ld(&bar[XB_TOPGEN]) == tg, bar);
            __builtin_amdgcn_fence(__ATOMIC_ACQUIRE, "agent");
            xb_add(&bar[XB_XGEN(x)], 1u);
            asm volatile("s_waitcnt vmcnt(0)" ::: "memory");
        } else {
            XB_SPIN(xb_ld(&bar[XB_XGEN(x)]) == gen, bar);
            __builtin_amdgcn_fence(__ATOMIC_ACQUIRE, "agent");
            asm volatile("s_waitcnt vmcnt(0)" ::: "memory");
        }
    }
    __syncthreads();
}
#endif
constexpr int PH_A0 = 1, PH_APER = 6, PH_B0 = PH_A0 + N_A * PH_APER, PH_BPER = 4, N_PHASES = PH_B0 + N_B * PH_BPER;
constexpr int LDS_BAR_OFF = 163840 - 64;
constexpr int LDS_BYTES = 163840;
#ifdef EMU
#define DECL_LDS(name) unsigned char* name = emu::blk()->lds
#else
#define DECL_LDS(name) extern __shared__ __attribute__((aligned(16))) unsigned char name[]
#endif

#ifdef EMU
#define PH_PROLOGUE() PrmRef p = p_; int tid_ = threadIdx.x, bid_ = blockIdx.x;
#define GRID_SYNC()
#else
#define PH_PROLOGUE() const __attribute__((address_space(4))) Prm* pp = (const __attribute__((address_space(4))) Prm*)__builtin_amdgcn_kernarg_segment_ptr(); \
    int tid_ = wave_s_ * 64 + (int)__builtin_amdgcn_mbcnt_hi(~0u, __builtin_amdgcn_mbcnt_lo(~0u, 0u)), bid_ = blockIdx.x; asm volatile("" : "+s"(pp), "+v"(tid_), "+s"(bid_)); PrmRef p = *pp;
#define GRID_SYNC() xcd_barrier((unsigned*)(p.ws + WS_CTL), (volatile LAS unsigned*)(lds + LDS_BAR_OFF), c.tid)
#endif
#define PHASE(k, ...) if (ph_lo <= (k) && (k) < ph_hi) { PH_PROLOGUE() \
        Ctx c; c.tid = tid_; c.lane = c.tid & 63; c.wave = c.tid >> 6; c.bid = bid_; c.nblk = gridDim.x; \
        c.gtid = c.bid * NTHR + c.tid; c.nthreads = c.nblk * NTHR; c.gwave = c.bid * (NTHR / 64) + c.wave; c.nwaves = c.nblk * (NTHR / 64); \
        bf16* PROJ = (bf16*)(p.ws + WS_PROJ); const bf16* XB = (const bf16*)(p.ws + WS_XB); (void)PROJ; (void)XB; \
        __VA_ARGS__; \
        if ((k) + 1 < ph_hi) { GRID_SYNC(); } }
#define A_LAYER(li) \
    PHASE(PH_A0 + (li) * PH_APER + 0, ph_a_gemm(p, c, li, lds)) \
    PHASE(PH_A0 + (li) * PH_APER + 1, ph_a_pre(p, c, li, lds)) \
    PHASE(PH_A0 + (li) * PH_APER + 2, ph_a_scan2(p, c, li, lds)) \
    PHASE(PH_A0 + (li) * PH_APER + 3, ph_a_norm(p, c, li, lds)) \
    PHASE(PH_A0 + (li) * PH_APER + 4, gemm_mfma(PROJ + 2 * A_QK, PLD, (const bf16*)(p.ws + WS_WAOUT) + (size_t)(li) * D_MODEL * A_VW, PROJ, PLD, PT, D_MODEL, A_VW, c, lds)) \
    PHASE(PH_A0 + (li) * PH_APER + 5, ph_ln(p, c, PROJ, PLD, p.a_ln_g + (size_t)(li) * D_MODEL, p.a_ln_b + (size_t)(li) * D_MODEL, false))
#define B_LAYER(lj) \
    PHASE(PH_B0 + (lj) * PH_BPER + 0, ph_b_gemm(p, c, lj, lds)) \
    PHASE(PH_B0 + (lj) * PH_BPER + 1, ph_b_att2(p, c, lj, (lj) == 0, lds)) \
    PHASE(PH_B0 + (lj) * PH_BPER + 2, gemm_mfma(PROJ, PLD, (const bf16*)(p.ws + WS_WBOUT) + (size_t)(lj) * D_MODEL * B_QW, PROJ + B_QW, PLD, PT, D_MODEL, B_QW, c, lds); \
        sgemm_rows(p, PROJ, PLD, (const bf16*)(p.ws + WS_WBOUT) + (size_t)(lj) * D_MODEL * B_QW, B_QW, PROJ + B_QW, PLD, PT, ST, D_MODEL, c, 0, lds)) \
    PHASE(PH_B0 + (lj) * PH_BPER + 3, ph_ln(p, c, PROJ + B_QW, PLD, p.b_ln_g + (size_t)(lj) * D_MODEL, p.b_ln_b + (size_t)(lj) * D_MODEL, (lj) == N_B - 1))

__global__ void __launch_bounds__(NTHR, 2) fwd_kernel(Prm p_, int ph_lo, int ph_hi) {
    DECL_LDS(lds);
#ifndef EMU
    const int wave_s_ = __builtin_amdgcn_readfirstlane((int)threadIdx.x >> 6);
    {
        if (threadIdx.x < 2) ((volatile LAS unsigned*)(lds + LDS_BAR_OFF))[threadIdx.x] = 0u;
        if (threadIdx.x == 0) (void)xb_add((unsigned*)(p_.ws + WS_CTL) + XB_XCNT(xb_xcc_id()), 1u);
        __syncthreads();
    }
#endif
    PHASE(0, ph_init(p, c); ph_weights(p, c, lds))
    A_LAYER(0)
    A_LAYER(1)
    B_LAYER(0)
    B_LAYER(1)
#ifdef PROBE_TAIL
    PROBE_TAIL
#endif
}

extern "C" void kernel_launch(void* const* d_in, const int* in_sizes, int n_in, void* d_out, int out_size, void* d_ws, size_t ws_size, hipStream_t stream) {
    if (n_in != 20 || (size_t)out_size != O_END || ws_size < WS_NEED) { fprintf(stderr, "kernel_launch: unexpected sizes n_in=%d out=%d ws=%zu (need %zu, out %zu)\n", n_in, out_size, ws_size, (size_t)WS_END, (size_t)O_END); return; }
    Prm p{};
    const float** pp = (const float**)&p;
    for (int i = 0; i < 20; ++i) pp[i] = (const float*)d_in[i];
    p.out = (float*)d_out; p.ws = (unsigned char*)d_ws;
#ifdef EMU
    const int grid = 8;
    const int stop = getenv("EMU_STOP") ? atoi(getenv("EMU_STOP")) : N_PHASES;
    for (int ph = 0; ph < N_PHASES && ph < stop; ++ph) { emu::launch([=]() { fwd_kernel(p, ph, ph + 1); }, dim3(grid), dim3(NTHR), LDS_BYTES); fprintf(stderr, "phase %d done\n", ph); }
#else
    static int grid = 0;
    if (grid == 0) {
        int dev = 0, cus = 0, per_cu = 0;
        (void)hipGetDevice(&dev); (void)hipDeviceGetAttribute(&cus, hipDeviceAttributeMultiprocessorCount, dev);
        (void)hipFuncSetAttribute((const void*)fwd_kernel, hipFuncAttributeMaxDynamicSharedMemorySize, LDS_BYTES);
        (void)hipOccupancyMaxActiveBlocksPerMultiprocessor(&per_cu, (const void*)fwd_kernel, NTHR, LDS_BYTES);
        if (per_cu < 1) { fprintf(stderr, "kernel_launch: occupancy query says %d blocks per CU\n", per_cu); per_cu = 1; }
        grid = cus;
    }
    (void)hipMemsetAsync((char*)d_ws + WS_CTL, 0, 65536, stream);
#ifdef PROBE_TAIL
    int lo = 0, hi = N_PHASES + PROBE_NTAIL;
#else
    int lo = 0, hi = N_PHASES;
#endif
    void* args[] = {(void*)&p, (void*)&lo, (void*)&hi};
    hipError_t e = hipLaunchCooperativeKernel((const void*)fwd_kernel, dim3(grid), dim3(NTHR), args, LDS_BYTES, stream);
    if (e != hipSuccess) fprintf(stderr, "cooperative launch failed: %s (grid %d)\n", hipGetErrorString(e), grid);
#endif
}
```

```cpp
#ifdef EMU
#include "hip_emu.h"
#else
#include <hip/hip_runtime.h>
#include <hip/hip_cooperative_groups.h>
namespace cg = cooperative_groups;
#endif
#include <cstdint>
#include <cstddef>
#include <cstdio>

typedef short bf16x8 __attribute__((ext_vector_type(8)));
typedef float f32x4 __attribute__((ext_vector_type(4)));
typedef float f32x16 __attribute__((ext_vector_type(16)));
typedef unsigned u32x4 __attribute__((ext_vector_type(4)));
typedef unsigned u32x2 __attribute__((ext_vector_type(2)));
#ifdef EMU
#define LAS
#define WAVE_SYNC() emu::wave_sync()
#define GLDS16(gp, lp) memcpy((unsigned char*)(lp) + emu::lane_id() * 16, (const void*)(gp), 16)
typedef const unsigned char* BufRes;
#define MAKE_RES(p) ((const unsigned char*)(p))
#define BLDS16(res, voff, soff, lp) memcpy((unsigned char*)(lp) + emu::lane_id() * 16, (res) + (voff) + (soff), 16)
#define MFMA16(a, b, c) emu_mfma_16x16x32_bf16(a, b, c)
#define MFMA32(a, b, c) emu_mfma_32x32x16_bf16(a, b, c)
#define MFMAF(a, b, c) emu_mfma_16x16x4_f32(a, b, c)
#define SETPRIO(n)
#define SCHED_BARRIER()
#define S_BARRIER() emu::block_sync()
#define WAIT_VM(n)
#define WAIT_LGKM(n)
#define READFIRSTLANE(x) (x)
#define BCAST_LANE(v, n) __shfl(v, n)
#define LBAR() emu::block_sync()
typedef short s16x4 __attribute__((ext_vector_type(4)));
inline s16x4 emu_ds_read_tr16(const void* pp) { s16x4 mine = *(const s16x4*)pp, r; const int l = emu::lane_id(), i = l & 15;
    for (int e = 0; e < 4; ++e) { const s16x4 o = emu::shfl_idx(mine, (l & ~15) + 4 * e + (i >> 2)); r[e] = o[i & 3]; } return r; }
#define LDS_TR16(ptr) emu_ds_read_tr16(ptr)
#else
#define LAS __attribute__((address_space(3)))
#define WAVE_SYNC() asm volatile("s_waitcnt lgkmcnt(0)" ::: "memory")
#define GLDS16(gp, lp) __builtin_amdgcn_global_load_lds((const unsigned*)(gp), (LAS unsigned*)(lp), 16, 0, 0)
typedef __amdgpu_buffer_rsrc_t BufRes;
#define MAKE_RES(p) __builtin_amdgcn_make_buffer_rsrc((void*)(p), 0, 0x7fffffff, 0x00020000)
#define BLDS16(res, voff, soff, lp) __builtin_amdgcn_raw_ptr_buffer_load_lds(res, (LAS unsigned*)(lp), 16, (int)(voff), (int)(soff), 0, 0)
#define MFMA16(a, b, c) __builtin_amdgcn_mfma_f32_16x16x32_bf16(a, b, c, 0, 0, 0)
#define MFMA32(a, b, c) __builtin_amdgcn_mfma_f32_32x32x16_bf16(a, b, c, 0, 0, 0)
#define MFMAF(a, b, c) __builtin_amdgcn_mfma_f32_16x16x4f32(a, b, c, 0, 0, 0)
#define SETPRIO(n) __builtin_amdgcn_s_setprio(n)
#define SCHED_BARRIER() __builtin_amdgcn_sched_barrier(0)
#define S_BARRIER() __builtin_amdgcn_s_barrier()
#define WAIT_VM(n) asm volatile("s_waitcnt vmcnt(" #n ")" ::: "memory")
#define WAIT_LGKM(n) asm volatile("s_waitcnt lgkmcnt(" #n ")" ::: "memory")
#define READFIRSTLANE(x) __builtin_amdgcn_readfirstlane(x)
#define BCAST_LANE(v, n) __builtin_bit_cast(float, __builtin_amdgcn_readlane(__builtin_bit_cast(int, v), n))
typedef short s16x4 __attribute__((ext_vector_type(4)));
#define LDS_TR16(ptr) __builtin_amdgcn_ds_read_tr16_b64_v4i16((LAS s16x4*)(ptr))
#define LBAR() do { asm volatile("s_waitcnt lgkmcnt(0)" ::: "memory"); __builtin_amdgcn_s_barrier(); asm volatile("" ::: "memory"); } while (0)
#endif

#ifdef CFG_SMALL
constexpr int D_MODEL = 512, BATCH = 2, SEQ = 256, DEC_BATCH = 8, DEC_SEQ = 32, A_HEADS = 4, B_Q_HEADS = 8, B_KV_HEADS = 2;
#else
constexpr int D_MODEL = 1024, BATCH = 8, SEQ = 2048, DEC_BATCH = 16, DEC_SEQ = 32, A_HEADS = 8, B_Q_HEADS = 16, B_KV_HEADS = 4;
#endif
constexpr int PAST_LEN = 4096, CHUNK = 64, N_A = 2, N_B = 2, DEPTH = 4;
constexpr int A_DK = 128, A_DV = 128, A_QK = A_HEADS * A_DK, A_VW = A_HEADS * A_DV, CONV_W = 4, CONV_DIM = 2 * A_QK + A_VW;
constexpr int A_IN = CONV_DIM + A_VW + 2 * A_HEADS, A_MAIN = CONV_DIM + A_VW;
constexpr int B_GROUP = B_Q_HEADS / B_KV_HEADS, B_HD = 64, B_QW = B_Q_HEADS * B_HD, B_KVW = B_KV_HEADS * B_HD, B_IN = 2 * B_QW;
constexpr int WINDOW = 128, ROPE_DIMS = 16, ROPE_HALF = 8;
constexpr float LN_EPS = 1e-5f, RMS_EPS = 1e-6f;
constexpr float DN_ALPHA = 1.681792830507429f;
constexpr int PT = BATCH * SEQ, ST = DEC_BATCH * DEC_SEQ, MT = PT + ST, NSEQ = BATCH + DEC_BATCH;
constexpr int NCPS = SEQ / CHUNK, NCP = BATCH * NCPS, NCH = NCP + DEC_BATCH;
constexpr int PLD = A_MAIN > B_IN + 2 * B_KVW ? A_MAIN : B_IN + 2 * B_KVW;
static_assert(B_GROUP == 4, "attention wave map");
static_assert(PT % 256 == 0 && ST % 64 == 0 && D_MODEL % 256 == 0 && A_VW % 256 == 0 && B_QW % 256 == 0 && A_MAIN % 256 == 0 && D_MODEL % 256 == 0 && B_IN % 256 == 0 && (2 * B_KVW) % 256 == 0 && D_MODEL % 128 == 0 && D_MODEL >= 256, "gemm tiles");
static_assert(DEC_SEQ == 32 && WINDOW == 128 && CHUNK == 64, "fixed");

constexpr size_t O_YP = 0, O_YS = O_YP + (size_t)PT * D_MODEL, O_PDELTA = O_YS + (size_t)ST * D_MODEL;
constexpr size_t O_PCONV = O_PDELTA + (size_t)N_A * BATCH * A_HEADS * A_DK * A_DV, O_PK = O_PCONV + (size_t)N_A * BATCH * 3 * CONV_DIM;
constexpr size_t O_PV = O_PK + (size_t)BATCH * WINDOW * B_KVW, O_SDELTA = O_PV + (size_t)BATCH * WINDOW * B_KVW;
constexpr size_t O_SCONV = O_SDELTA + (size_t)N_A * DEC_BATCH * A_HEADS * A_DK * A_DV, O_SK = O_SCONV + (size_t)N_A * DEC_BATCH * 3 * CONV_DIM;
constexpr size_t O_SV = O_SK + (size_t)DEC_BATCH * WINDOW * B_KVW, O_END = O_SV + (size_t)DEC_BATCH * WINDOW * B_KVW;

constexpr size_t al256(size_t x) { return (x + 255) & ~(size_t)255; }
constexpr size_t WS_CTL = 0, WS_ROPE = 1u << 20;
constexpr size_t WS_GB = al256(WS_ROPE + (size_t)(SEQ + DEC_SEQ) * ROPE_HALF * 2 * 4);
constexpr size_t WS_HALO = al256(WS_GB + (size_t)MT * A_HEADS * 2 * 4);
constexpr size_t WS_XB = al256(WS_HALO + (size_t)NCH * 3 * CONV_DIM * 2);
constexpr size_t WS_PROJ = al256(WS_XB + (size_t)MT * D_MODEL * 2);
constexpr size_t WS_WAIN = al256(WS_PROJ + (size_t)MT * PLD * 2);
constexpr int A_NG = A_MAIN + 256;
constexpr size_t WS_WAOUT = al256(WS_WAIN + (size_t)N_A * A_NG * D_MODEL * 2);
constexpr int B_N0 = B_IN + 2 * B_KVW;
constexpr size_t WS_WBIN = al256(WS_WAOUT + (size_t)N_A * D_MODEL * A_VW * 2);
constexpr size_t WS_WBOUT = al256(WS_WBIN + (size_t)(B_N0 + B_IN) * D_MODEL * 2);
constexpr size_t WS_WB = al256(WS_WBOUT + (size_t)N_B * D_MODEL * B_QW * 2);
constexpr size_t WS_IA = al256(WS_WB + (size_t)PT * A_QK * 2);
constexpr size_t WS_GL = al256(WS_IA + (size_t)BATCH * A_HEADS * (SEQ / CHUNK) * 64 * 64 * 2);
constexpr size_t WS_END = al256(WS_GL + (size_t)BATCH * A_HEADS * (SEQ / CHUNK) * 4);
static_assert(WS_END <= ((size_t)256 << 20), "workspace");
constexpr size_t WS_VT = WS_WB, WS_CK = al256(WS_VT + (size_t)NCH * B_KV_HEADS * 64 * 64 * 2), WS_CVT = al256(WS_CK + (size_t)DEC_BATCH * B_KV_HEADS * 128 * 64 * 2);
constexpr size_t WS_BEND = al256(WS_CVT + (size_t)DEC_BATCH * B_KV_HEADS * 128 * 64 * 2), WS_NEED = WS_BEND > WS_END ? WS_BEND : WS_END;
static_assert(WS_NEED <= ((size_t)256 << 20), "workspace (B-layer buffers overlay the A-layer WB | IA | GL region)");

static_assert(N_B == 2, "weight map");

typedef unsigned short bf16;
constexpr int NTHR = 512;

struct Prm {
    const float *x_prompt, *x_sample, *state_delta, *state_conv, *cache_k, *cache_v, *a_w_in, *a_conv_w, *a_log, *a_dt_bias, *a_norm_w, *a_w_out, *a_ln_g, *a_ln_b,
        *b_w_kv, *b_w_in, *b_sinks, *b_w_out, *b_ln_g, *b_ln_b;
    float* out; unsigned char* ws;
};

__device__ __forceinline__ unsigned f2bf(float f) { unsigned u = __builtin_bit_cast(unsigned, f); return (u + 0x7fffu + ((u >> 16) & 1u)) >> 16; }
__device__ __forceinline__ float bf2f(bf16 h) { return __builtin_bit_cast(float, (unsigned)h << 16); }
__device__ __forceinline__ float siluf(float x) { return x / (1.f + expf(-x)); }
__device__ __forceinline__ float sigmoidf_(float x) { return 1.f / (1.f + expf(-x)); }
__device__ __forceinline__ float softplusf_(float x) { return x > 20.f ? x : log1pf(expf(x)); }
__device__ __forceinline__ float wave_sum(float v) {
#pragma unroll
    for (int o = 1; o < 64; o <<= 1) v += __shfl_xor(v, o);
    return v;
}

#ifdef EMU
__device__ __forceinline__ float fast_rcp(float x) { return 1.f / x; }
__device__ __forceinline__ float fast_rsq(float x) { return 1.f / sqrtf(x); }
__device__ __forceinline__ float fast_ex2(float x) { return exp2f(x); }
__device__ __forceinline__ unsigned cvtpk(float lo, float hi) { return f2bf(lo) | (f2bf(hi) << 16); }
__device__ __forceinline__ float dpp_xor1(float v) { return __shfl(v, emu::lane_id() ^ 1); }
__device__ __forceinline__ float dpp_xor2(float v) { return __shfl(v, emu::lane_id() ^ 2); }
__device__ __forceinline__ float dpp_hmirror(float v) { const int l = emu::lane_id(); return __shfl(v, (l & ~7) | (7 - (l & 7))); }
__device__ __forceinline__ float dpp_mirror(float v) { const int l = emu::lane_id(); return __shfl(v, (l & ~15) | (15 - (l & 15))); }
#else
__device__ __forceinline__ float fast_rcp(float x) { return __builtin_amdgcn_rcpf(x); }
__device__ __forceinline__ float fast_rsq(float x) { return __builtin_amdgcn_rsqf(x); }
__device__ __forceinline__ float fast_ex2(float x) { return __builtin_amdgcn_exp2f(x); }
__device__ __forceinline__ unsigned cvtpk(float lo, float hi) { typedef float f2_t __attribute__((ext_vector_type(2))); typedef __bf16 b2_t __attribute__((ext_vector_type(2)));
    f2_t v = {lo, hi}; b2_t b = __builtin_convertvector(v, b2_t); return __builtin_bit_cast(unsigned, b); }
template <int CTRL> __device__ __forceinline__ float dpp_mov(float v) { return __builtin_bit_cast(float, __builtin_amdgcn_update_dpp(0, __builtin_bit_cast(int, v), CTRL, 0xf, 0xf, true)); }
__device__ __forceinline__ float dpp_xor1(float v) { return dpp_mov<0xB1>(v); }
__device__ __forceinline__ float dpp_xor2(float v) { return dpp_mov<0x4E>(v); }
__device__ __forceinline__ float dpp_hmirror(float v) { return dpp_mov<0x141>(v); }
__device__ __forceinline__ float dpp_mirror(float v) { return dpp_mov<0x140>(v); }
#endif
__device__ __forceinline__ float sum8(float v) { v += dpp_xor1(v); v += dpp_xor2(v); v += dpp_hmirror(v); return v; }
__device__ __forceinline__ float sum16(float v) { v = sum8(v); v += dpp_mirror(v); return v; }
__device__ __forceinline__ float fsilu(float x) { return x * fast_rcp(1.f + fast_ex2(-1.4426950408889634f * x)); }
__device__ __forceinline__ float fexp(float x) { return fast_ex2(1.4426950408889634f * x); }
__device__ __forceinline__ float bflo(unsigned u) { return __builtin_bit_cast(float, u << 16); }
__device__ __forceinline__ float bfhi(unsigned u) { return __builtin_bit_cast(float, u & 0xffff0000u); }
__device__ __forceinline__ int seq_row0(int s) { return s < BATCH ? s * SEQ : PT + (s - BATCH) * DEC_SEQ; }
__device__ __forceinline__ int seq_len(int s) { return s < BATCH ? SEQ : DEC_SEQ; }
__device__ __forceinline__ int chunk_row0(int c) { return c < NCP ? c * CHUNK : PT + (c - NCP) * DEC_SEQ; }
__device__ __forceinline__ int chunk_len(int c) { return c < NCP ? CHUNK : DEC_SEQ; }
__device__ __forceinline__ int row_posidx(int row) { return row < PT ? (row % SEQ) : SEQ + ((row - PT) % DEC_SEQ); }

#ifdef EMU
typedef const Prm& PrmRef;
#else
typedef const __attribute__((address_space(4))) Prm& PrmRef;
#endif
struct Ctx { int tid, lane, wave, gtid, gwave, nthreads, nwaves, bid, nblk; };

namespace pg8 {
constexpr int BM = 256, BK = 64, HALF = 128, HTB = HALF * BK * 2  , STAGE_BYTES = 8 * HTB, NXCD = 8, WGM = 8;
__host__ __device__ __forceinline__ int lds_byte(int r, int c) { const int st = (r >> 4) * 2 + (c >> 5), rr = r & 15, cc = c & 31, ob = rr * 64 + cc * 2; return st * 1024 + (ob ^ (((ob >> 9) & 1) << 5)); }
__host__ __device__ __forceinline__ void stage_rc(int b, int& R, int& C) { const int st = b / 1024, sb = b % 1024, swz = sb ^ (((sb >> 9) & 1) << 5); R = (st >> 1) * 16 + swz / 64; C = (st & 1) * 32 + (swz % 64) / 2; }
__host__ __device__ __forceinline__ int perm32(int rho) { const int n = rho >> 4, i = rho & 15; return 8 * (i >> 2) + 4 * n + (i & 3); }
struct Unit { int pm, pn; };
struct Gemm { const bf16* A; int lda; const bf16* Bt; int M, N, K; };
struct StaticOrder {
    int nM, nN, nwg, G, c;
    __host__ __device__ void init(int M, int N, int G_, int c_) { nM = M / BM; nN = N / BM; nwg = nM * nN; G = G_; c = c_; }
    __host__ __device__ bool next(int i, Unit& u) const {
        const long L = (long)i * G + c; if (L >= nwg) return false;
        int wgid = (int)L; { const int q = nwg / NXCD, r = nwg % NXCD, xcd = wgid % NXCD, off = wgid / NXCD; wgid = (xcd < r ? xcd * (q + 1) : r * (q + 1) + (xcd - r) * q) + off; }
        const int nig = WGM * nN, gid = wgid / nig, fm = gid * WGM, gsz = (nM - fm) < WGM ? (nM - fm) : WGM;
        u.pm = fm + ((wgid % nig) % gsz); u.pn = (wgid % nig) / gsz; return true;
    }
};
__device__ __forceinline__ unsigned cvt_pk_bf16(float lo, float hi) {
#ifdef EMU
    return f2bf(lo) | (f2bf(hi) << 16);
#else
    unsigned r; asm volatile("v_cvt_pk_bf16_f32 %0, %1, %2" : "=v"(r) : "v"(lo), "v"(hi)); return r;
#endif
}
struct EpiBf16 {
    static constexpr bool PERM = true;
    bf16* O; int ldc;
    __device__ __forceinline__ void operator()(const f32x4 (&acc)[2][2][4][2], const Unit& u, int wr, int wc, int fr, int fq) const {
        int fr_ = fr, fq_ = fq;
#ifndef EMU
        asm volatile("" : "+v"(fr_), "+v"(fq_));
#endif
        const int row0 = u.pm * BM + wr * 64 + fr_, col0 = u.pn * BM + wc * 32 + 8 * fq_;
#pragma unroll
        for (int ai = 0; ai < 2; ++ai)
#pragma unroll
            for (int m = 0; m < 4; ++m) { bf16* rowp = O + (size_t)(row0 + ai * HALF + m * 16) * ldc + col0;
#pragma unroll
                for (int bj = 0; bj < 2; ++bj) { const f32x4 v0 = acc[ai][bj][m][0], v1 = acc[ai][bj][m][1];
                    u32x4 w; w.x = cvt_pk_bf16(v0[0], v0[1]); w.y = cvt_pk_bf16(v0[2], v0[3]); w.z = cvt_pk_bf16(v1[0], v1[1]); w.w = cvt_pk_bf16(v1[2], v1[3]);
                    *(u32x4*)(rowp + bj * HALF) = w; } }
    }
};
struct EpiAIn {
    static constexpr bool PERM = true;
    bf16* O; int ldc; bf16* HALO; float* pconv;
    __device__ __forceinline__ void operator()(const f32x4 (&acc)[2][2][4][2], const Unit& u, int wr, int wc, int fr, int fq) const {
        int fr_ = fr, fq_ = fq;
#ifndef EMU
        asm volatile("" : "+v"(fr_), "+v"(fq_));
#endif
        const int row0 = u.pm * BM + wr * 64 + fr_, col0 = u.pn * BM + wc * 32 + 8 * fq_;
#pragma unroll
        for (int ai = 0; ai < 2; ++ai)
#pragma unroll
            for (int m = 0; m < 4; ++m) { const int row = row0 + ai * HALF + m * 16; bf16* rowp = O + (size_t)row * ldc + col0;
#pragma unroll
                for (int bj = 0; bj < 2; ++bj) { const f32x4 v0 = acc[ai][bj][m][0], v1 = acc[ai][bj][m][1];
                    u32x4 w; w.x = cvt_pk_bf16(v0[0], v0[1]); w.y = cvt_pk_bf16(v0[2], v0[3]); w.z = cvt_pk_bf16(v1[0], v1[1]); w.w = cvt_pk_bf16(v1[2], v1[3]);
                    *(u32x4*)(rowp + bj * HALF) = w;
                    if (m == 3 && fr_ >= 13 && col0 + bj * HALF < CONV_DIM) {
                        const int ck = row >> 6, hr = fr_ - 13, col = col0 + bj * HALF;
                        *(u32x4*)(HALO + ((size_t)ck * 3 + hr) * CONV_DIM + col) = w;
                        if (ck % NCPS == NCPS - 1) { float* dst = pconv + ((size_t)(ck / NCPS) * 3 + hr) * CONV_DIM + col; *(f32x4*)dst = v0; *(f32x4*)(dst + 4) = v1; }
                    } } }
    }
};
struct EpiBIn {
    static constexpr bool PERM = true;
    bf16* O; int ldc; const float* rope; bf16* VT;
    __device__ __forceinline__ void operator()(const f32x4 (&acc)[2][2][4][2], const Unit& u, int wr, int wc, int fr, int fq) const {
        int fr_ = fr, fq_ = fq;
#ifndef EMU
        asm volatile("" : "+v"(fr_), "+v"(fq_));
#endif
        static_assert(B_QW % 128 == 0 && B_KVW % 128 == 0, "a 128-column half tile has one kind");
        const int ct = u.pn * BM;
        int kinds[2]; bool ropes[2];
#pragma unroll
        for (int bj = 0; bj < 2; ++bj) { const int cc = ct + bj * HALF; kinds[bj] = cc < B_QW ? 0 : cc < B_IN ? 1 : cc < B_IN + B_KVW ? 2 : 3;
            ropes[bj] = (kinds[bj] == 0 || kinds[bj] == 2) && (wc & 1) == 0; }
        const int row0 = u.pm * BM + wr * 64 + fr_, col0 = ct + wc * 32 + 8 * fq_;
#pragma unroll
        for (int ai = 0; ai < 2; ++ai)
#pragma unroll
            for (int m = 0; m < 4; ++m) { const int row = row0 + ai * HALF + m * 16; bf16* rowp = O + (size_t)row * ldc + col0;
                f32x4 cs[4];
                if (ropes[0] || ropes[1]) { const f32x4* rp = (const f32x4*)(rope + (size_t)(row % SEQ) * ROPE_HALF * 2);
#pragma unroll
                    for (int q4 = 0; q4 < 4; ++q4) cs[q4] = rp[q4]; }
#pragma unroll
                for (int bj = 0; bj < 2; ++bj) { f32x4 v0 = acc[ai][bj][m][0], v1 = acc[ai][bj][m][1]; const int kind = kinds[bj]; const float sc = kind == 0 ? 0.125f : 1.f;
                    if (ropes[bj]) {
                        float x[8] = {v0[0], v0[1], v0[2], v0[3], v1[0], v1[1], v1[2], v1[3]}, o[8];
#pragma unroll
                        for (int j = 0; j < 8; ++j) o[j] = __shfl_xor(x[j], 16);
                        if (fq_ < 2) {
#pragma unroll
                            for (int j = 0; j < 8; ++j) { const float c_ = cs[j >> 1][2 * (j & 1)], s_ = cs[j >> 1][2 * (j & 1) + 1]; x[j] = fq_ == 0 ? x[j] * c_ - o[j] * s_ : x[j] * c_ + o[j] * s_; }
                        }
                        v0 = (f32x4){x[0], x[1], x[2], x[3]}; v1 = (f32x4){x[4], x[5], x[6], x[7]};
                    }
                    v0 = v0 * sc; v1 = v1 * sc;
                    u32x4 w; w.x = cvt_pk_bf16(v0[0], v0[1]); w.y = cvt_pk_bf16(v0[2], v0[3]); w.z = cvt_pk_bf16(v1[0], v1[1]); w.w = cvt_pk_bf16(v1[2], v1[3]);
                    *(u32x4*)(rowp + bj * HALF) = w;
                    if (kind == 3) { const int dd = col0 + bj * HALF - (B_IN + B_KVW), kvh = dd / B_HD, d = dd % B_HD; bf16* vt = VT + (((size_t)(row >> 6) * B_KV_HEADS + kvh) * B_HD + d) * 64 + (row & 63);
                        vt[0] = (bf16)(w.x & 0xffffu); vt[64] = (bf16)(w.x >> 16); vt[128] = (bf16)(w.y & 0xffffu); vt[192] = (bf16)(w.y >> 16);
                        vt[256] = (bf16)(w.z & 0xffffu); vt[320] = (bf16)(w.z >> 16); vt[384] = (bf16)(w.w & 0xffffu); vt[448] = (bf16)(w.w >> 16); }
                } }
    }
};
template <class Epi, class Sched, bool ALIGN_EPI>
__device__ __forceinline__ void gemm_phase(LAS unsigned char* lds, const Gemm g, const Sched& S, const Epi& E, const int tid) {
    const int wid = READFIRSTLANE(tid >> 6), lane = tid & 63, wr = wid >> 2, wc = wid & 3, fr = lane & 15, fq = lane >> 4;
    const int K = g.K, nt = K / BK;
    unsigned voffA[2], voffB[2];
#pragma unroll
    for (int i = 0; i < 2; ++i) { int R, C; stage_rc(tid * 16 + i * 8192, R, C); const int Rb = Epi::PERM ? ((R & ~31) + perm32(R & 31)) : R;
        voffA[i] = (unsigned)(R * g.lda + C) * 2u; voffB[i] = (unsigned)(Rb * K + C) * 2u; }
    const unsigned kstep = (unsigned)(BK * 2);
    const unsigned hstepA = (unsigned)HALF * (unsigned)g.lda * 2u, hstepB = (unsigned)HALF * (unsigned)K * 2u;
    const unsigned tstepA = 2 * hstepA, tstepB = 2 * hstepB;
    const BufRes rA = MAKE_RES(g.A), rB = MAKE_RES(g.Bt);
    const unsigned ldsw = (unsigned)wid * 1024u;
    const int aoff = lds_byte(wr * 64 + fr, fq * 8), boff = lds_byte(wc * 32 + fr, fq * 8);
#define PG8_SA(b, h) (((b) * 2 + (h)) * HTB)
#define PG8_SB(b, h) ((4 + (b) * 2 + (h)) * HTB)
#define PG8_STAGE(bufoff, res, soff, voff) do { _Pragma("unroll") for (int _i = 0; _i < 2; ++_i) \
        BLDS16(res, (voff)[_i], soff, lds + (bufoff) + ldsw + _i * 8192); } while (0)
#define PG8_LDA(dst, b, h) do { _Pragma("unroll") for (int m = 0; m < 4; ++m) _Pragma("unroll") for (int k = 0; k < 2; ++k) dst[m][k] = *(const LAS bf16x8*)(lds + PG8_SA(b, h) + aoff + m * 2048 + k * 1024); } while (0)
#define PG8_LDB(dst, b, h) do { _Pragma("unroll") for (int n = 0; n < 2; ++n) _Pragma("unroll") for (int k = 0; k < 2; ++k) dst[n][k] = *(const LAS bf16x8*)(lds + PG8_SB(b, h) + boff + n * 2048 + k * 1024); } while (0)
#define PG8_MMA(ai, bj, At, Bt) do { SETPRIO(1); _Pragma("unroll") for (int m = 0; m < 4; ++m) _Pragma("unroll") for (int n = 0; n < 2; ++n) _Pragma("unroll") for (int k = 0; k < 2; ++k) \
        acc[ai][bj][m][n] = MFMA16(Bt[n][k], At[m][k], acc[ai][bj][m][n]); SETPRIO(0); } while (0)
#define PG8_MMAZ(ai, bj, At, Bt) do { SETPRIO(1); _Pragma("unroll") for (int m = 0; m < 4; ++m) _Pragma("unroll") for (int n = 0; n < 2; ++n) { \
        acc[ai][bj][m][n] = MFMA16(Bt[n][0], At[m][0], ((f32x4){0.f, 0.f, 0.f, 0.f})); acc[ai][bj][m][n] = MFMA16(Bt[n][1], At[m][1], acc[ai][bj][m][n]); } SETPRIO(0); } while (0)
    Unit cur, nxt; int ui = 0;
    if (!S.next(0, cur)) return;
    f32x4 acc[2][2][4][2];
#pragma unroll
    for (int a = 0; a < 2; ++a)
#pragma unroll
        for (int b = 0; b < 2; ++b)
#pragma unroll
            for (int m = 0; m < 4; ++m)
#pragma unroll
                for (int n = 0; n < 2; ++n) acc[a][b][m][n] = (f32x4){0.f, 0.f, 0.f, 0.f};
    bf16x8 At[4][2], B0[2][2], B1[2][2];
    unsigned cA = (unsigned)cur.pm * tstepA, cB = (unsigned)cur.pn * tstepB;
    PG8_STAGE(PG8_SB(0, 0), rB, cB, voffB); PG8_STAGE(PG8_SB(0, 1), rB, cB + hstepB, voffB); PG8_STAGE(PG8_SA(0, 0), rA, cA, voffA); PG8_STAGE(PG8_SA(0, 1), rA, cA + hstepA, voffA);
    if (wr == 1) S_BARRIER();
    WAIT_VM(2); S_BARRIER();
    PG8_STAGE(PG8_SB(1, 0), rB, cB + kstep, voffB); PG8_STAGE(PG8_SA(1, 0), rA, cA + kstep, voffA); PG8_STAGE(PG8_SB(1, 1), rB, cB + hstepB + kstep, voffB);
    WAIT_VM(6); S_BARRIER();
    for (;;) {
        const bool has_next = S.next(ui + 1, nxt);
        const unsigned nA = has_next ? (unsigned)nxt.pm * tstepA : cA, nB = has_next ? (unsigned)nxt.pn * tstepB : cB;
#define PG8_TRIP(W, LAST, MM) do { \
            const unsigned a1 = cA + (unsigned)(t + 1) * kstep; \
            const unsigned a2 = (LAST) ? nA : cA + (unsigned)(t + 2) * kstep, b2 = (LAST) ? nB : cB + (unsigned)(t + 2) * kstep; \
            const unsigned a3 = a2 + kstep, b3 = b2 + kstep; \
            PG8_LDB(B0, 0, 0); PG8_LDB(B1, 0, 1); SCHED_BARRIER(); PG8_LDA(At, 0, 0); PG8_STAGE(PG8_SA(1, 1), rA, a1 + hstepA, voffA); \
            WAIT_VM(W); WAIT_LGKM(0); S_BARRIER(); MM(0, 0, At, B0); MM(0, 1, At, B1); S_BARRIER(); SCHED_BARRIER(); \
            PG8_LDA(At, 0, 1); PG8_STAGE(PG8_SB(0, 0), rB, b2, voffB); PG8_STAGE(PG8_SB(0, 1), rB, b2 + hstepB, voffB); PG8_STAGE(PG8_SA(0, 0), rA, a2, voffA); \
            WAIT_VM(W); WAIT_LGKM(0); S_BARRIER(); MM(1, 0, At, B0); MM(1, 1, At, B1); S_BARRIER(); SCHED_BARRIER(); \
            PG8_LDB(B0, 1, 0); PG8_LDB(B1, 1, 1); SCHED_BARRIER(); PG8_LDA(At, 1, 0); PG8_STAGE(PG8_SA(0, 1), rA, a2 + hstepA, voffA); \
            WAIT_VM(8); WAIT_LGKM(0); S_BARRIER(); PG8_MMA(0, 0, At, B0); PG8_MMA(0, 1, At, B1); S_BARRIER(); SCHED_BARRIER(); \
            PG8_LDA(At, 1, 1); PG8_STAGE(PG8_SB(1, 0), rB, b3, voffB); PG8_STAGE(PG8_SB(1, 1), rB, b3 + hstepB, voffB); PG8_STAGE(PG8_SA(1, 0), rA, a3, voffA); \
            WAIT_VM(8); WAIT_LGKM(0); S_BARRIER(); PG8_MMA(1, 0, At, B0); PG8_MMA(1, 1, At, B1); S_BARRIER(); SCHED_BARRIER(); } while (0)
        int t = 0;
        if (ui > 0) { PG8_TRIP(24, false, PG8_MMAZ); t = 2; }
        for (; t < nt; t += 2) { const bool last = (t == nt - 2); PG8_TRIP(8, last, PG8_MMA); }
#undef PG8_TRIP
        if constexpr (ALIGN_EPI) { if (wr == 0) S_BARRIER(); }
        E(acc, cur, wr, wc, fr, fq);
        if (!has_next) break;
        cur = nxt; cA = nA; cB = nB; ++ui;
        if constexpr (ALIGN_EPI) { if (wr == 1) S_BARRIER(); }
    }
    WAIT_VM(0);
    if constexpr (!ALIGN_EPI) { if (wr == 0) S_BARRIER(); }
    S_BARRIER();
#undef PG8_SA
#undef PG8_SB
#undef PG8_STAGE
#undef PG8_LDA
#undef PG8_LDB
#undef PG8_MMA
#undef PG8_MMAZ
}
}
__device__ __forceinline__ void gemm_mfma(const bf16* A, int lda, const bf16* Bt, bf16* C, int ldc, int M, int N, int K, const Ctx& c, unsigned char* lds) {
    pg8::Gemm g{A, lda, Bt, M, N, K}; pg8::StaticOrder S; S.init(M, N, c.nblk, c.bid); pg8::EpiBf16 E{C, ldc};
    __syncthreads();
    pg8::gemm_phase<pg8::EpiBf16, pg8::StaticOrder, true>((LAS unsigned char*)lds, g, S, E, c.tid);
    __syncthreads();
}
__device__ __forceinline__ void transpose_item(const float* W, int ldw, int K, int N, bf16* WT, int row_off, float* scr, int item, int lane) {
    const int nblk = N / 64, kb = item / nblk, nb = item % nblk, k0 = 64 * kb, n0 = 64 * nb;
#pragma unroll 8
    for (int kk = 0; kk < 64; ++kk) scr[kk * 65 + lane] = W[(size_t)(k0 + kk) * ldw + n0 + lane];
    WAVE_SYNC();
    const int cc = lane & 7;
#pragma unroll
    for (int j = 0; j < 8; ++j) { const int n = (lane >> 3) + 8 * j; const float* sp = scr + (8 * cc) * 65 + n;
        u32x4 o; o.x = cvtpk(sp[0 * 65], sp[1 * 65]); o.y = cvtpk(sp[2 * 65], sp[3 * 65]); o.z = cvtpk(sp[4 * 65], sp[5 * 65]); o.w = cvtpk(sp[6 * 65], sp[7 * 65]);
        *(u32x4*)(WT + (size_t)(row_off + n0 + n) * K + k0 + 8 * cc) = o; }
    WAVE_SYNC();
}
constexpr int WI_AIN = (D_MODEL / 64) * (A_MAIN / 64), WI_AOUT = (A_VW / 64) * (D_MODEL / 64), WI_BIN = (D_MODEL / 64) * (B_IN / 64), WI_BKV = (D_MODEL / 64) * (2 * B_KVW / 64), WI_BOUT = (B_QW / 64) * (D_MODEL / 64);
constexpr int WI_A_END = N_A * (WI_AIN + WI_AOUT), WI_ALL = WI_A_END + N_B * (WI_BIN + WI_BOUT) + WI_BKV;
__device__ __forceinline__ void weights_range(PrmRef p, int lane, int wave, unsigned char* lds, int vw, int nvw, int lo, int hi) {
    float* scr = (float*)lds + wave * (64 * 65);
    bf16* WAIN = (bf16*)(p.ws + WS_WAIN); bf16* WAOUT = (bf16*)(p.ws + WS_WAOUT); bf16* WBIN = (bf16*)(p.ws + WS_WBIN); bf16* WBOUT = (bf16*)(p.ws + WS_WBOUT);
    for (int it = lo + vw; it < hi; it += nvw) {
        int r = it;
        if (r < N_A * WI_AIN) { const int li = r / WI_AIN; transpose_item(p.a_w_in + (size_t)li * D_MODEL * A_IN, A_IN, D_MODEL, A_MAIN, WAIN + (size_t)li * A_NG * D_MODEL, 0, scr, r % WI_AIN, lane); continue; } r -= N_A * WI_AIN;
        if (r < N_A * WI_AOUT) { const int li = r / WI_AOUT; transpose_item(p.a_w_out + (size_t)li * A_VW * D_MODEL, D_MODEL, A_VW, D_MODEL, WAOUT + (size_t)li * D_MODEL * A_VW, 0, scr, r % WI_AOUT, lane); continue; } r -= N_A * WI_AOUT;
        if (r < N_B * WI_BIN) { const int lj = r / WI_BIN; transpose_item(p.b_w_in + (size_t)lj * D_MODEL * B_IN, B_IN, D_MODEL, B_IN, WBIN + (size_t)lj * B_N0 * D_MODEL, 0, scr, r % WI_BIN, lane); continue; } r -= N_B * WI_BIN;
        if (r < N_B * WI_BOUT) { const int lj = r / WI_BOUT; transpose_item(p.b_w_out + (size_t)lj * B_QW * D_MODEL, D_MODEL, B_QW, D_MODEL, WBOUT + (size_t)lj * D_MODEL * B_QW, 0, scr, r % WI_BOUT, lane); continue; } r -= N_B * WI_BOUT;
        transpose_item(p.b_w_kv, 2 * B_KVW, D_MODEL, 2 * B_KVW, WBIN, B_IN, scr, r, lane);
    }
}
__device__ __forceinline__ void ph_weights(PrmRef p, const Ctx& c, unsigned char* lds) {
    weights_range(p, c.lane, c.wave, lds, c.gwave, c.nwaves, 0, WI_AIN);
    bf16* WAIN = (bf16*)(p.ws + WS_WAIN);
    for (int it = c.gtid; it < N_A * 256 * D_MODEL; it += c.nthreads) {
        const int k = it % D_MODEL, j = (it / D_MODEL) % 256, li = it / (256 * D_MODEL);
        WAIN[((size_t)li * A_NG + A_MAIN + j) * D_MODEL + k] = j < 2 * A_HEADS ? (bf16)f2bf(p.a_w_in[((size_t)li * D_MODEL + k) * A_IN + A_MAIN + j]) : (bf16)0;
    }
}
__device__ __forceinline__ void weights_deferred(PrmRef p, int lane, int wave, int li, unsigned char* lds, int vw, int nvw) {
    static_assert(N_A == 2, "deferred weight conversion schedule");
    if (li == 0) weights_range(p, lane, wave, lds, vw, nvw, WI_AIN, WI_A_END); else weights_range(p, lane, wave, lds, vw, nvw, WI_A_END, WI_ALL);
}

__device__ __forceinline__ void ph_init(PrmRef p, const Ctx& c) {
    bf16* XB = (bf16*)(p.ws + WS_XB);
    for (size_t i8 = c.gtid; i8 < (size_t)MT * D_MODEL / 8; i8 += c.nthreads) {
        const size_t i = i8 * 8; const float* src = i < (size_t)PT * D_MODEL ? p.x_prompt + i : p.x_sample + (i - (size_t)PT * D_MODEL);
        const f32x4 a = *(const f32x4*)src, b = *(const f32x4*)(src + 4);
        u32x4 o; o.x = cvtpk(a[0], a[1]); o.y = cvtpk(a[2], a[3]); o.z = cvtpk(b[0], b[1]); o.w = cvtpk(b[2], b[3]);
        *(u32x4*)(XB + i) = o;
    }
    float* rope = (float*)(p.ws + WS_ROPE);
    for (int i = c.gtid; i < (SEQ + DEC_SEQ) * ROPE_HALF; i += c.nthreads) {
        const int pi = i / ROPE_HALF, f = i % ROPE_HALF; const float pos = pi < SEQ ? (float)pi : (float)(PAST_LEN + pi - SEQ);
        const float inv = f == 0 ? 1.0f : f == 1 ? 0.1939227432012558f : f == 2 ? 0.03760603070259094f : f == 3 ? 0.007292664609849453f : f == 4 ? 0.0014142135623842478f
                        : f == 5 ? 0.00027424818836152554f : f == 6 ? 5.3182957344688475e-05f : 1.0313385246263351e-05f;
        const float ang = pos * inv;
        rope[2 * i] = cosf(ang); rope[2 * i + 1] = sinf(ang);
    }
}

constexpr int SS_KC = 128, SS_STB = 32768, SS_BOFF = 16384;
template <int MODE> __device__ __forceinline__ void ss_issue(const bf16* A, int lda, const bf16* Bt, int K, int row0, int col0, int cidx, int q, int lw, int lane, unsigned char* lds) {
    const unsigned char* sa = (const unsigned char*)(A + (size_t)row0 * lda + cidx * SS_KC); const unsigned char* sb = (const unsigned char*)(Bt + (size_t)col0 * K + cidx * SS_KC);
    unsigned char* st = lds + (q & 3) * SS_STB;
#pragma unroll
    for (int i = 0; i < 4; ++i) { const int row = (lw * 4 + i) * 4 + (lane >> 4), pc = (lane & 15) ^ (row & 15);
        GLDS16(sa + (unsigned)row * (unsigned)(lda * 2) + (unsigned)pc * 16u, st + (lw * 4 + i) * 1024);
        if (MODE != 1) GLDS16(sb + (unsigned)row * (unsigned)(K * 2) + (unsigned)pc * 16u, st + SS_BOFF + (lw * 4 + i) * 1024); }
    if (MODE == 1) { const int row = lw * 4 + (lane >> 4), pc = (lane & 15) ^ (row & 15); GLDS16(sb + (unsigned)row * (unsigned)(K * 2) + (unsigned)pc * 16u, st + SS_BOFF + lw * 1024); }
}
template <int MODE> __device__ __forceinline__ void sgemm_stream(PrmRef p, int li, const bf16* A, int lda, const bf16* Bt, int K, bf16* C, int ldc, int row_begin, int col_base, int tn, int it0, int itstep, int nitems, int tid, unsigned char* lds) {
    const int lane = tid & 63, wave = READFIRSTLANE(tid >> 6), nkc = K / SS_KC;
    const int nmine = it0 < nitems ? (nitems - it0 + itstep - 1) / itstep : 0, Q = nmine * nkc;
    LBAR();
    if (Q == 0) return;
    if (wave >= 4) {
        const int lw = wave - 4;
        int it = it0, cidx = 0, row0 = row_begin + (it / tn) * 64, col0 = col_base + (it % tn) * 64;
#define SS_NEXT() do { if (++cidx == nkc) { cidx = 0; it += itstep; row0 = row_begin + (it / tn) * 64; col0 = col_base + (it % tn) * 64; } } while (0)
        ss_issue<MODE>(A, lda, Bt, K, row0, col0, cidx, 0, lw, lane, lds); SS_NEXT();
        if (Q > 1) { ss_issue<MODE>(A, lda, Bt, K, row0, col0, cidx, 1, lw, lane, lds); SS_NEXT(); }
        if (Q > 2) { ss_issue<MODE>(A, lda, Bt, K, row0, col0, cidx, 2, lw, lane, lds); SS_NEXT(); }
        for (int q = 0; q < Q; ++q) {
            if (q + 2 < Q) { if (MODE == 1) { WAIT_VM(10); } else { WAIT_VM(16); } } else { WAIT_VM(0); }
            LBAR();
            if (q + 3 < Q) { ss_issue<MODE>(A, lda, Bt, K, row0, col0, cidx, q + 3, lw, lane, lds); SS_NEXT(); }
        }
#undef SS_NEXT
    } else {
        const int r = lane & 15, g = lane >> 4;
        f32x4 acc[4];
#pragma unroll
        for (int nt = 0; nt < 4; ++nt) acc[nt] = (f32x4){0.f, 0.f, 0.f, 0.f};
        int it = it0, cidx = 0;
        for (int q = 0; q < Q; ++q) {
            LBAR();
            const unsigned char* ap = lds + (q & 3) * SS_STB + (16 * wave + r) * 256; const unsigned char* bp = lds + (q & 3) * SS_STB + SS_BOFF + r * 256;
#pragma unroll
            for (int ks = 0; ks < 4; ++ks) { const int po = ((4 * ks + g) ^ r) << 4; const bf16x8 a = *(const bf16x8*)(ap + po);
#pragma unroll
                for (int nt = 0; nt < (MODE == 1 ? 1 : 4); ++nt) { const bf16x8 b = *(const bf16x8*)(bp + nt * 4096 + po); acc[nt] = MFMA16(b, a, acc[nt]); } }
            if (++cidx == nkc) {
                const int row0 = row_begin + (it / tn) * 64, col0 = col_base + (it % tn) * 64, row = row0 + 16 * wave + r;
                if (MODE == 1) {
                    static_assert(2 * A_HEADS <= 16, "gate columns");
                    float* GB = (float*)(p.ws + WS_GB);
#pragma unroll
                    for (int e = 0; e < 4; ++e) { const int col = 4 * g + e; const float v = acc[0][e];
                        if (col < A_HEADS) GB[((size_t)row * A_HEADS + col) * 2] = -expf(p.a_log[li * A_HEADS + col]) * softplusf_(v + p.a_dt_bias[li * A_HEADS + col]);
                        else if (col < 2 * A_HEADS) GB[((size_t)row * A_HEADS + (col - A_HEADS)) * 2 + 1] = sigmoidf_(v); }
                } else {
                    if (MODE == 2) {
                        const int kind = col0 < B_QW ? 0 : col0 < B_IN ? 1 : col0 < B_IN + B_KVW ? 2 : 3, srow = row - PT;
                        if (kind == 0 || kind == 2) {
                            const float* rp = (const float*)(p.ws + WS_ROPE) + ((size_t)(SEQ + srow % DEC_SEQ) * ROPE_HALF + 4 * (g & 1)) * 2;
                            const f32x4 cs0 = *(const f32x4*)rp, cs1 = *(const f32x4*)(rp + 4);
#pragma unroll
                            for (int e = 0; e < 4; ++e) { const float x = acc[0][e], o = __shfl_xor(x, 32), c_ = e < 2 ? cs0[2 * e] : cs1[2 * e - 4], s_ = e < 2 ? cs0[2 * e + 1] : cs1[2 * e - 3];
                                acc[0][e] = g < 2 ? x * c_ - o * s_ : x * c_ + o * s_; }
                        }
                        if (kind == 0) {
#pragma unroll
                            for (int nt = 0; nt < 4; ++nt) acc[nt] = acc[nt] * 0.125f; }
                        if (kind == 3) { bf16* VT = (bf16*)(p.ws + WS_VT); const int kvh = (col0 - (B_IN + B_KVW)) / B_HD, ck = NCP + srow / DEC_SEQ, key = srow % DEC_SEQ;
#pragma unroll
                            for (int nt = 0; nt < 4; ++nt)
#pragma unroll
                                for (int e = 0; e < 4; ++e) VT[(((size_t)ck * B_KV_HEADS + kvh) * B_HD + 16 * nt + 4 * g + e) * 64 + key] = (bf16)(cvtpk(acc[nt][e], 0.f) & 0xffffu); }
                    }
                    bf16* cp = C + (size_t)row * ldc + col0 + 4 * g;
#pragma unroll
                    for (int nt = 0; nt < 4; ++nt) { u32x2 w; w.x = cvtpk(acc[nt][0], acc[nt][1]); w.y = cvtpk(acc[nt][2], acc[nt][3]); *(u32x2*)(cp + 16 * nt) = w; }
                }
#pragma unroll
                for (int nt = 0; nt < 4; ++nt) acc[nt] = (f32x4){0.f, 0.f, 0.f, 0.f};
                cidx = 0; it += itstep;
            }
        }
    }
    LBAR();
}
template <int MODE = 0> __device__ __forceinline__ void sgemm_rows(PrmRef p, const bf16* A, int lda, const bf16* Bt, int K, bf16* C, int ldc, int row_begin, int nrows, int N, const Ctx& c, int first_wg, unsigned char* lds, bool only_tail = false) {
    const int tn = N / 64, nt = (nrows / 64) * tn;
    const int f = first_wg % c.nblk, np = (only_tail && f > 0) ? c.nblk - f : c.nblk;
    const int v = only_tail && f > 0 ? c.bid - f : (c.bid + c.nblk - f) % c.nblk;
    sgemm_stream<MODE>(p, 0, A, lda, Bt, K, C, ldc, row_begin, 0, tn, v >= 0 ? v : nt, np, nt, c.tid, lds);
}
__device__ __forceinline__ void ph_a_gemm(PrmRef p, const Ctx& c, int li, unsigned char* lds) {
    const bf16* XB = (const bf16*)(p.ws + WS_XB); bf16* PROJ = (bf16*)(p.ws + WS_PROJ); const bf16* Wt = (const bf16*)(p.ws + WS_WAIN) + (size_t)li * A_NG * D_MODEL;
    pg8::Gemm g{XB, D_MODEL, Wt, PT, A_MAIN, D_MODEL}; pg8::StaticOrder S; S.init(PT, A_MAIN, c.nblk, c.bid);
    pg8::EpiAIn E{PROJ, PLD, (bf16*)(p.ws + WS_HALO), p.out + O_PCONV + (size_t)li * BATCH * 3 * CONV_DIM};
    __syncthreads();
    pg8::gemm_phase<pg8::EpiAIn, pg8::StaticOrder, true>((LAS unsigned char*)lds, g, S, E, c.tid);
    __syncthreads();
    sgemm_stream<1>(p, li, XB, D_MODEL, Wt, D_MODEL, nullptr, 0, 0, A_MAIN, 1, c.bid, c.nblk, MT / 64, c.tid, lds);
    sgemm_rows(p, XB, D_MODEL, Wt, D_MODEL, PROJ, PLD, PT, ST, A_MAIN, c, MT / 64, lds);
}
constexpr int NPG = BATCH * A_HEADS, NSG = DEC_BATCH * A_HEADS, NPI = NPG * NCPS;
__device__ __forceinline__ unsigned pk2bf(float lo, float hi) { return cvtpk(lo, hi); }
__device__ __forceinline__ int p32(int d) { return (d & ~31) | (((d >> 2) & 3) << 3) | (((d >> 4) & 1) << 2) | (d & 3); }
constexpr int PP_KN = 0, PP_QN = 17408, PP_KF = 34816, PP_VF = 67584, PP_TT = 53248  , PP_GC = 100352, PP_LN = 102400, PP_LNP = 68, PP_TI = PP_LN + 64 * PP_LNP * 4, PP_TIP = 20, PP_WST = PP_TI + 4 * 16 * PP_TIP * 4, PP_CW = PP_WST + 17408, PP_END = PP_CW + 3 * 4 * 128 * 4;
static_assert(PP_END <= 163840 - 64 && PP_TI % 16 == 0 && PP_WST % 16 == 0 && PP_CW % 16 == 0, "prepass LDS");
typedef u32x4 RawTile[3][4][2];
__device__ __forceinline__ void prepass_load_raw(PrmRef p, int item, int tid, RawTile& xr) {
    const bf16* PROJ = (const bf16*)(p.ws + WS_PROJ); const bf16* HALO = (const bf16*)(p.ws + WS_HALO);
    const int n = item % NCPS, grp = item / NCPS, h = grp % A_HEADS, s = grp / A_HEADS, R0 = s * SEQ + n * CHUNK, r = tid >> 3, seg = tid & 7;
#pragma unroll
    for (int X = 0; X < 3; ++X) {
        const int cb = X * A_QK + h * A_DK + 16 * seg;
#pragma unroll
        for (int j = 0; j < 4; ++j) {
            const int rr = r - 3 + j;
            if (rr >= 0) { const u32x4* src = (const u32x4*)(PROJ + (size_t)(R0 + rr) * PLD + cb); xr[X][j][0] = src[0]; xr[X][j][1] = src[1]; }
            else if (n > 0) { const u32x4* src = (const u32x4*)(HALO + ((size_t)(s * NCPS + n - 1) * 3 + (3 + rr)) * CONV_DIM + cb); xr[X][j][0] = src[0]; xr[X][j][1] = src[1]; }
            else { xr[X][j][0] = (u32x4){0u, 0u, 0u, 0u}; xr[X][j][1] = xr[X][j][0]; }
        }
    }
}
__device__ __forceinline__ void prepass_gcum(PrmRef p, int item, int lane, float* GC) {
    const float* GB = (const float*)(p.ws + WS_GB); float* GL = (float*)(p.ws + WS_GL);
    const int n = item % NCPS, grp = item / NCPS, h = grp % A_HEADS, s = grp / A_HEADS, R0 = s * SEQ + n * CHUNK;
    const float g = GB[((size_t)(R0 + lane) * A_HEADS + h) * 2], bt = GB[((size_t)(R0 + lane) * A_HEADS + h) * 2 + 1];
    float cs = g;
#pragma unroll
    for (int d = 1; d < 64; d <<= 1) { const float o = __shfl(cs, lane >= d ? lane - d : lane); if (lane >= d) cs += o; }
    const float gl = __shfl(cs, 63);
    GC[lane] = cs; GC[64 + lane] = bt; GC[128 + lane] = fexp(cs); GC[192 + lane] = fexp(gl - cs);
    if (lane == 0) GL[item] = fexp(gl);
}
__device__ __forceinline__ void prepass_store_w(PrmRef p, int item, int tid, const unsigned char* lds) {
    bf16* WB = (bf16*)(p.ws + WS_WB); const bf16* WST = (const bf16*)(lds + PP_WST);
    const int n = item % NCPS, grp = item / NCPS, h = grp % A_HEADS, s = grp / A_HEADS, R0 = s * SEQ + n * CHUNK, r = tid >> 3, seg = tid & 7;
    const u32x4 w0 = *(const u32x4*)(WST + r * 136 + 16 * seg), w1 = *(const u32x4*)(WST + r * 136 + 16 * seg + 8);
    u32x4* dst = (u32x4*)(WB + (size_t)(R0 + r) * A_QK + h * A_DK + 16 * seg); dst[0] = w0; dst[1] = w1;
}
template <int VAR = 0> __device__ __forceinline__ void delta_prepass_item(PrmRef p, int li, int item, int next_item, int prev_item, int pb, int tid, unsigned char* lds, RawTile& xr) {
#ifndef EMU
    asm volatile("" : "+v"(tid));
#endif
    bf16* PROJ = (bf16*)(p.ws + WS_PROJ); bf16* IA = (bf16*)(p.ws + WS_IA);
    const int n = item % NCPS, grp = item / NCPS, h = grp % A_HEADS, s = grp / A_HEADS;
    const int R0 = s * SEQ + n * CHUNK, lane = tid & 63, wave = READFIRSTLANE(tid >> 6);
    bf16* KN = (bf16*)(lds + PP_KN); bf16* QN = (bf16*)(lds + PP_QN); bf16* VN = (bf16*)(lds + PP_KF);
    float* GC = (float*)(lds + PP_GC) + pb * 256; float* BT = GC + 64; float* EG = GC + 128; float* KD = GC + 192;
    float* LN = (float*)(lds + PP_LN);
    float* TI = (float*)(lds + PP_TI);
    bf16* WST = (bf16*)(lds + PP_WST);
    if (prev_item >= 0) prepass_store_w(p, prev_item, tid, lds);
    const int r = tid >> 3, seg = tid & 7;
    float qf[16];
#pragma unroll
    for (int X = 0; X < 3; ++X) {
        const int cb = X * A_QK + h * A_DK + 16 * seg;
        float acc[16];
#pragma unroll
        for (int e = 0; e < 16; ++e) acc[e] = 0.f;
#pragma unroll
        for (int j = 0; j < 4; ++j) {
            const f32x4* wp = (const f32x4*)(lds + PP_CW) + ((X * 4 + j) * 128 + 16 * seg) / 4;
#pragma unroll
            for (int e = 0; e < 4; ++e) {
                const f32x4 w4 = wp[e]; const unsigned a = xr[X][j][e >> 1][2 * (e & 1)], b = xr[X][j][e >> 1][2 * (e & 1) + 1];
                acc[4 * e] += w4[0] * bflo(a); acc[4 * e + 1] += w4[1] * bfhi(a); acc[4 * e + 2] += w4[2] * bflo(b); acc[4 * e + 3] += w4[3] * bfhi(b);
            }
        }
        float ss = 0.f;
#pragma unroll
        for (int e = 0; e < 16; ++e) { acc[e] = fsilu(acc[e]); ss += acc[e] * acc[e]; }
        if (X < 2) {
            ss = sum8(ss);
            const float rs = fast_rsq(ss + RMS_EPS) * (X == 0 ? 0.08838834764831845f : 1.f);
#pragma unroll
            for (int e = 0; e < 16; ++e) acc[e] *= rs;
        }
        if (X == 0) {
#pragma unroll
            for (int e = 0; e < 16; ++e) qf[e] = acc[e];
            u32x4 o0, o1;
#pragma unroll
            for (int e = 0; e < 4; ++e) { o0[e] = cvtpk(acc[2 * e], acc[2 * e + 1]); o1[e] = cvtpk(acc[8 + 2 * e], acc[8 + 2 * e + 1]); }
            *(u32x4*)(QN + r * 136 + 16 * seg) = o0; *(u32x4*)(QN + r * 136 + 16 * seg + 8) = o1;
        } else if (X == 1) {
            u32x4 o0, o1;
#pragma unroll
            for (int e = 0; e < 4; ++e) { o0[e] = cvtpk(acc[2 * e], acc[2 * e + 1]); o1[e] = cvtpk(acc[8 + 2 * e], acc[8 + 2 * e + 1]); }
            *(u32x4*)(KN + r * 136 + 16 * seg) = o0; *(u32x4*)(KN + r * 136 + 16 * seg + 8) = o1;
        } else {
            u32x4 o0, o1;
#pragma unroll
            for (int e = 0; e < 4; ++e) { o0[e] = cvtpk(acc[2 * e], acc[2 * e + 1]); o1[e] = cvtpk(acc[8 + 2 * e], acc[8 + 2 * e + 1]); }
            *(u32x4*)(VN + r * 136 + 16 * seg) = o0; *(u32x4*)(VN + r * 136 + 16 * seg + 8) = o1;
        }
    }
    LBAR();
    if (next_item >= 0) prepass_load_raw(p, next_item, tid, xr);
    {
        const float eg = EG[r];
        bf16* dst = PROJ + (size_t)(R0 + r) * PLD + h * A_DK + 32 * (seg >> 1) + 4 * (seg & 1);
#pragma unroll
        for (int gq = 0; gq < 4; ++gq) { u32x2 o; o.x = cvtpk(qf[4 * gq] * eg, qf[4 * gq + 1] * eg); o.y = cvtpk(qf[4 * gq + 2] * eg, qf[4 * gq + 3] * eg); *(u32x2*)(dst + 8 * gq) = o; }
    }
    if (VAR != 4) {
        const int kind = wave >> 2, ti = (wave >> 1) & 1, tj = wave & 1, l31 = lane & 31, hi = lane >> 5;
        if (wave == 1) {
            if (next_item >= 0) prepass_gcum(p, next_item, lane, (float*)(lds + PP_GC) + (pb ^ 1) * 256);
#pragma unroll
            for (int e = 0; e < 16; ++e) LN[((e & 3) + 8 * (e >> 2) + 4 * hi) * PP_LNP + 32 + l31] = 0.f;
        } else {
            f32x16 acc;
#pragma unroll
            for (int e = 0; e < 16; ++e) acc[e] = 0.f;
            const unsigned char* ap = (const unsigned char*)(kind == 0 ? KN : QN) + (32 * ti + l31) * 272 + 16 * hi;
            const unsigned char* bp = (const unsigned char*)KN + (32 * tj + l31) * 272 + 16 * hi;
            if (ti >= tj) {
#pragma unroll
                for (int ks = 0; ks < 8; ++ks) { const bf16x8 a = *(const bf16x8*)(ap + 32 * ks), b = *(const bf16x8*)(bp + 32 * ks); acc = MFMA32(a, b, acc); }
            }
            const int col = 32 * tj + l31; const float gcc = GC[col];
            f32x4 gr[4], br[4];
#pragma unroll
            for (int q4 = 0; q4 < 4; ++q4) { gr[q4] = *(const f32x4*)(GC + 32 * ti + 8 * q4 + 4 * hi); br[q4] = *(const f32x4*)(BT + 32 * ti + 8 * q4 + 4 * hi); }
#pragma unroll
            for (int e = 0; e < 16; ++e) {
                const int row = 32 * ti + (e & 3) + 8 * (e >> 2) + 4 * hi; const float gcr = gr[e >> 2][e & 3];
                if (kind == 0) LN[row * PP_LNP + col] = row > col ? -(br[e >> 2][e & 3] * acc[e] * fexp(gcr - gcc)) : 0.f;
                else IA[((size_t)item * 64 + row) * 64 + p32(col)] = (bf16)f2bf(row >= col ? acc[e] * fexp(gcr - gcc) : 0.f);
            }
            if (wave == 0 || wave == 3) {
                WAVE_SYNC();
                if (lane < 32) {
                    const int b = (wave == 3 ? 2 : 0) + (lane >> 4), j = lane & 15; float t[16];
#pragma unroll
                    for (int i = 0; i < 16; ++i) {
                        float v = i == j ? 1.f : 0.f;
                        f32x4 lr[4];
#pragma unroll
                        for (int q4 = 0; q4 < (i + 3) / 4; ++q4) lr[q4] = *(const f32x4*)(LN + (16 * b + i) * PP_LNP + 16 * b + 4 * q4);
#pragma unroll
                        for (int k = 0; k < i; ++k) v += lr[k >> 2][k & 3] * t[k];
                        t[i] = v;
                    }
#pragma unroll
                    for (int i = 0; i < 16; ++i) TI[(b * 16 + i) * PP_TIP + j] = t[i];
                }
            } else if (wave >= 4) {
                const int u = tid - 256, m = u & 127, half = u >> 7;
                unsigned char* dst = (unsigned char*)PROJ + ((size_t)(R0 + (m >> 1)) * PLD + A_QK + h * A_DK) * 2 + (m & 1) * 128 + half * 64;
#pragma unroll
                for (int q4 = 0; q4 < 4; ++q4) {
                    u32x4 o;
#pragma unroll
                    for (int e = 0; e < 4; ++e) { const int j = 32 * half + 4 * q4 + 16 * (e >> 1) + 2 * (e & 1); o[e] = cvtpk(bf2f(KN[j * 136 + m]) * KD[j], bf2f(KN[(j + 1) * 136 + m]) * KD[j + 1]); }
                    *(u32x4*)(dst + 16 * q4) = o;
                }
            }
        }
    }
    LBAR();
    bf16* TT = (bf16*)(lds + PP_TT);
    if (VAR != 4 && VAR != 1) {
        if (wave < 4) {
            const int g = lane >> 4, cl = lane & 15, c = wave;
            f32x4 X[4];
#pragma unroll
            for (int b = 0; b < 4; ++b) {
                f32x4 x = (f32x4){0.f, 0.f, 0.f, 0.f};
                if (b == c) {
#pragma unroll
                    for (int e = 0; e < 4; ++e) x[e] = TI[(b * 16 + 4 * g + e) * PP_TIP + cl];
                } else if (b > c) {
                    f32x4 l4[3];
#pragma unroll
                    for (int d = 0; d < b; ++d) l4[d] = *(const f32x4*)(LN + (16 * b + cl) * PP_LNP + 16 * d + 4 * g);
                    const f32x4 ta = *(const f32x4*)(TI + (b * 16 + cl) * PP_TIP + 4 * g);
                    f32x4 y = (f32x4){0.f, 0.f, 0.f, 0.f};
#pragma unroll
                    for (int d = 0; d < b; ++d) if (d >= c) {
#pragma unroll
                        for (int ks = 0; ks < 4; ++ks) y = MFMAF(l4[d][ks], X[d][ks], y); }
#pragma unroll
                    for (int ks = 0; ks < 4; ++ks) x = MFMAF(ta[ks], y[ks], x);
                }
                X[b] = x;
#pragma unroll
                for (int e = 0; e < 4; ++e) TT[(16 * b + 4 * g + e) * 72 + 16 * c + cl] = (bf16)(cvtpk(x[e], 0.f) & 0xffffu);
            }
        }
    }
    LBAR();
    if (VAR != 4 && VAR != 1) {
        const int g = lane >> 4, cl = lane & 15;
        bf16x8 Bv[2], Bk[2];
#pragma unroll
        for (int ks = 0; ks < 2; ++ks) {
            const int rb = 32 * ks + 8 * g;
            const unsigned char* vp = (const unsigned char*)VN + (rb + (cl >> 2)) * 272 + (16 * wave + 4 * (cl & 3)) * 2; const unsigned char* kp = (const unsigned char*)KN + (rb + (cl >> 2)) * 272 + (16 * wave + 4 * (cl & 3)) * 2;
            const s16x4 v0 = LDS_TR16(vp), v1 = LDS_TR16(vp + 4 * 272), k0 = LDS_TR16(kp), k1 = LDS_TR16(kp + 4 * 272);
            const f32x4 b0 = *(const f32x4*)(BT + rb), b1 = *(const f32x4*)(BT + rb + 4), e0 = *(const f32x4*)(EG + rb), e1 = *(const f32x4*)(EG + rb + 4);
            u32x4 ov, ok;
            ov.x = cvtpk(bf2f((bf16)v0[0]) * b0[0], bf2f((bf16)v0[1]) * b0[1]); ov.y = cvtpk(bf2f((bf16)v0[2]) * b0[2], bf2f((bf16)v0[3]) * b0[3]);
            ov.z = cvtpk(bf2f((bf16)v1[0]) * b1[0], bf2f((bf16)v1[1]) * b1[1]); ov.w = cvtpk(bf2f((bf16)v1[2]) * b1[2], bf2f((bf16)v1[3]) * b1[3]);
            ok.x = cvtpk(bf2f((bf16)k0[0]) * (b0[0] * e0[0]), bf2f((bf16)k0[1]) * (b0[1] * e0[1])); ok.y = cvtpk(bf2f((bf16)k0[2]) * (b0[2] * e0[2]), bf2f((bf16)k0[3]) * (b0[3] * e0[3]));
            ok.z = cvtpk(bf2f((bf16)k1[0]) * (b1[0] * e1[0]), bf2f((bf16)k1[1]) * (b1[1] * e1[1])); ok.w = cvtpk(bf2f((bf16)k1[2]) * (b1[2] * e1[2]), bf2f((bf16)k1[3]) * (b1[3] * e1[3]));
            Bv[ks] = __builtin_bit_cast(bf16x8, ov); Bk[ks] = __builtin_bit_cast(bf16x8, ok);
        }
#pragma unroll
        for (int b = 0; b < 4; ++b) {
            f32x4 xu = (f32x4){0.f, 0.f, 0.f, 0.f}, xw = xu;
#pragma unroll
            for (int ks = 0; ks < (b < 2 ? 1 : 2); ++ks) {
                const bf16x8 a = *(const bf16x8*)((const unsigned char*)TT + (16 * b + cl) * 144 + (32 * ks + 8 * g) * 2);
                xu = MFMA16(a, Bv[ks], xu); xw = MFMA16(a, Bk[ks], xw);
            }
            u32x2 o; o.x = cvtpk(xu[0], xu[1]); o.y = cvtpk(xu[2], xu[3]);
            *(u32x2*)((unsigned char*)PROJ + ((size_t)(R0 + wave * 8 + 2 * b + (lane >> 5)) * PLD + 2 * A_QK + h * A_DV) * 2 + (lane & 31) * 8) = o;
#pragma unroll
            for (int e = 0; e < 4; ++e) WST[(16 * b + 4 * g + e) * 136 + p32(16 * wave + cl)] = (bf16)(cvtpk(xw[e], 0.f) & 0xffffu);
        }
    }
    LBAR();
}

__device__ __forceinline__ bf16x8 pack_b(const f32x4 a, const f32x4 b) {
    u32x4 o; o.x = pk2bf(a[0], a[1]); o.y = pk2bf(a[2], a[3]); o.z = pk2bf(b[0], b[1]); o.w = pk2bf(b[2], b[3]); return __builtin_bit_cast(bf16x8, o);
}
constexpr int SC_BUF = 65536, SC_W = 0, SC_QD = 16384, SC_KDT = 32768, SC_IA = 49152, SC_U = 57344;
__device__ __forceinline__ void scan_dma(PrmRef p, int grp, int half, int n, int lw, int lane, unsigned char* buf) {
    const int h = grp % A_HEADS, s = grp / A_HEADS, R0 = s * SEQ + n * CHUNK;
    const BufRes rs = MAKE_RES(p.ws);
    const unsigned sW = (unsigned)(WS_WB + ((size_t)R0 * A_QK + h * A_DK) * 2);
    const unsigned sQ = (unsigned)(WS_PROJ + ((size_t)R0 * PLD + h * A_DK) * 2);
    const unsigned sK = (unsigned)(WS_PROJ + ((size_t)R0 * PLD + A_QK + h * A_DK) * 2);
    const unsigned sU = (unsigned)(WS_PROJ + ((size_t)(R0 + 32 * half) * PLD + 2 * A_QK + h * A_DV) * 2);
    const unsigned sI = (unsigned)(WS_IA + (size_t)(grp * NCPS + n) * 8192);
#pragma unroll
    for (int j = 0; j < 4; ++j) {
        const int ip = lw + 4 * j, sg = ip * 64 + lane;
        { const int row = sg >> 4, pc = (sg & 15) ^ (row & 15);
          BLDS16(rs, (unsigned)row * (unsigned)(A_QK * 2) + (unsigned)pc * 16u, sW, buf + SC_W + ip * 1024);
          BLDS16(rs, (unsigned)row * (unsigned)(PLD * 2) + (unsigned)pc * 16u, sQ, buf + SC_QD + ip * 1024); }
        { const int m = sg >> 3, pc = (sg & 7) ^ ((m >> 1) & 7);
          BLDS16(rs, (unsigned)(m >> 1) * (unsigned)(PLD * 2) + (unsigned)(m & 1) * 128u + (unsigned)pc * 16u, sK, buf + SC_KDT + ip * 1024); }
        if (j < 2) {
          { const int row = sg >> 3, pc = (sg & 7) ^ ((row >> 1) & 7); BLDS16(rs, (unsigned)row * 128u + (unsigned)pc * 16u, sI, buf + SC_IA + ip * 1024); }
          BLDS16(rs, (unsigned)(sg >> 4) * (unsigned)(PLD * 2) + (unsigned)(sg & 15) * 16u, sU, buf + SC_U + ip * 1024);
        }
    }
}
template <int SV = 0> __device__ __forceinline__ void delta_scan_group(PrmRef p, int li, int item, int tid, unsigned char* lds, bool wstate = true) {
    unsigned char* PROJ = (unsigned char*)(p.ws + WS_PROJ); const float* GL = (const float*)(p.ws + WS_GL);
    const int grp = item >> 1, half = item & 1;
    const int h = grp % A_HEADS, s = grp / A_HEADS, lane = tid & 63, wave = READFIRSTLANE(tid >> 6);
    const bool loader = wave >= 4; const int cw = 4 * half + (wave & 3);
    f32x4 S[8];
#pragma unroll
    for (int m = 0; m < 8; ++m) S[m] = (f32x4){0.f, 0.f, 0.f, 0.f};
    unsigned char* fp = PROJ + ((size_t)(s * SEQ + cw * 8 + (lane >> 5)) * PLD + 2 * A_QK + h * A_DV) * 2 + (lane & 31) * 8;
    constexpr size_t TSTEP = (size_t)2 * PLD * 2, CSTEP = (size_t)CHUNK * PLD * 2;
    static_assert(NCPS <= 64, "glast per lane");
    const float glv = GL[grp * NCPS + (lane < NCPS ? lane : 0)];
    if (loader) { if (SV != 1) scan_dma(p, grp, half, 0, wave - 4, lane, lds); }
    WAIT_VM(0); LBAR();
    for (int n = 0; n < NCPS; ++n) {
        unsigned char* buf = lds + (n & 1) * SC_BUF;
        if (loader) {
            if (n + 1 < NCPS) { if (SV != 1) scan_dma(p, grp, half, n + 1, wave - 4, lane, lds + ((n + 1) & 1) * SC_BUF); }
            WAIT_VM(0);
        } else {
        int lane2 = lane;
#ifndef EMU
        asm volatile("" : "+v"(lane2));
#endif
        const int g = lane2 >> 4, cl = lane2 & 15;
        int oW[4], oH[2];
#pragma unroll
        for (int ks = 0; ks < 4; ++ks) oW[ks] = cl * 256 + (((4 * ks + g) ^ cl) << 4);
#pragma unroll
        for (int ks = 0; ks < 2; ++ks) oH[ks] = cl * 128 + (((4 * ks + g) ^ (cl >> 1)) << 4);
        u32x2 uf[4];
#pragma unroll
        for (int t = 0; t < 4; ++t) uf[t] = *(const u32x2*)(buf + SC_U + ((wave & 3) * 8 + 2 * t + (lane2 >> 5)) * 256 + (lane2 & 31) * 8);
        const float glast = BCAST_LANE(glv, n);
        bf16x8 Bs[4];
#pragma unroll
        for (int ks = 0; ks < 4; ++ks) Bs[ks] = pack_b(S[2 * ks], S[2 * ks + 1]);
        bf16x8 fa[4][4];
#pragma unroll
        for (int t = 0; t < 4; ++t)
#pragma unroll
            for (int ks = 0; ks < 4; ++ks) fa[t][ks] = *(const bf16x8*)(buf + SC_W + t * 4096 + oW[ks]);
        SCHED_BARRIER();
        f32x4 vn[4];
#pragma unroll
        for (int t = 0; t < 4; ++t) vn[t] = (f32x4){0.f, 0.f, 0.f, 0.f};
#pragma unroll
        for (int ks = 0; ks < (SV == 3 ? 0 : 4); ++ks)
#pragma unroll
            for (int t = 0; t < 4; ++t) vn[t] = MFMA16(fa[t][ks], Bs[ks], vn[t]);
#pragma unroll
        for (int t = 0; t < 4; ++t) { const f32x4 u = (f32x4){bflo(uf[t].x), bfhi(uf[t].x), bflo(uf[t].y), bfhi(uf[t].y)}; vn[t] = u - vn[t]; }
        SCHED_BARRIER();
        bf16x8 fk[8][2];
#pragma unroll
        for (int m = 0; m < 8; ++m)
#pragma unroll
            for (int ks = 0; ks < 2; ++ks) fk[m][ks] = *(const bf16x8*)(buf + SC_KDT + m * 2048 + oH[ks]);
        SCHED_BARRIER();
        bf16x8 Vb[2];
        Vb[0] = pack_b(vn[0], vn[1]); Vb[1] = pack_b(vn[2], vn[3]);
#pragma unroll
        for (int m = 0; m < 8; ++m) S[m] = S[m] * glast;
#pragma unroll
        for (int ks = 0; ks < 2; ++ks)
#pragma unroll
            for (int m = 0; m < 8; ++m) S[m] = MFMA16(fk[m][ks], Vb[ks], S[m]);
#pragma unroll
        for (int t = 0; t < 4; ++t)
#pragma unroll
            for (int ks = 0; ks < 4; ++ks) fa[t][ks] = *(const bf16x8*)(buf + SC_QD + t * 4096 + oW[ks]);
        bf16x8 fi[4][2];
#pragma unroll
        for (int t = 0; t < 4; ++t)
#pragma unroll
            for (int ks = 0; ks < 2; ++ks) fi[t][ks] = *(const bf16x8*)(buf + SC_IA + t * 2048 + oH[ks]);
        SCHED_BARRIER();
        f32x4 oa[4];
#pragma unroll
        for (int t = 0; t < 4; ++t) oa[t] = (f32x4){0.f, 0.f, 0.f, 0.f};
        if (SV != 2) {
#pragma unroll
        for (int ks = 0; ks < 4; ++ks)
#pragma unroll
            for (int t = 0; t < 4; ++t) oa[t] = MFMA16(fa[t][ks], Bs[ks], oa[t]);
#pragma unroll
        for (int ks = 0; ks < 2; ++ks)
#pragma unroll
            for (int t = 0; t < 4; ++t) oa[t] = MFMA16(fi[t][ks], Vb[ks], oa[t]);
#pragma unroll
        for (int t = 0; t < 4; ++t) {
            u32x2 w; w.x = cvtpk(oa[t][0], oa[t][1]); w.y = cvtpk(oa[t][2], oa[t][3]);
            if (SV == 4) { asm volatile("" :: "v"(w.x), "v"(w.y)); } else
            *(u32x2*)(fp + (size_t)n * CSTEP + t * TSTEP) = w;
        }
        }
        WAIT_VM(4);
        }
        LBAR();
    }
    if (!loader && (wstate || SV != 0)) {
    float* so = SV != 0 ? (float*)(p.ws + WS_XB) + (size_t)grp * A_DK * A_DV : p.out + O_PDELTA + (((size_t)li * BATCH + s) * A_HEADS + h) * A_DK * A_DV;
#pragma unroll
    for (int m = 0; m < 8; ++m)
#pragma unroll
        for (int e = 0; e < 4; ++e) so[(size_t)(16 * m + 4 * (lane >> 4) + e) * A_DV + 16 * cw + (lane & 15)] = S[m][e];
    }
    LBAR();
}
constexpr int NM_PART = 0, NM_OST = 2048;
struct NormRaw { u32x2 of[4]; u32x4 z0, z1; };
__device__ __forceinline__ void norm_load(PrmRef p, int item, int tid, NormRaw& q) {
    const unsigned char* PROJ = (const unsigned char*)(p.ws + WS_PROJ);
    const int n = item % NCPS, grp = item / NCPS, h = grp % A_HEADS, s = grp / A_HEADS, R0 = s * SEQ + n * CHUNK;
    const int lane = tid & 63, wave = tid >> 6, r = tid >> 3, seg = tid & 7;
    const unsigned char* fp = PROJ + ((size_t)(R0 + wave * 8 + (lane >> 5)) * PLD + 2 * A_QK + h * A_DV) * 2 + (lane & 31) * 8;
#pragma unroll
    for (int t = 0; t < 4; ++t) q.of[t] = *(const u32x2*)(fp + (size_t)t * 2 * PLD * 2);
    const u32x4* zp = (const u32x4*)(PROJ + ((size_t)(R0 + r) * PLD + CONV_DIM + h * A_DV + 16 * seg) * 2); q.z0 = zp[0]; q.z1 = zp[1];
}
__device__ __forceinline__ void delta_norm_item(PrmRef p, int li, int item, int next_item, int tid, unsigned char* lds, NormRaw& raw) {
    unsigned char* PROJ = (unsigned char*)(p.ws + WS_PROJ);
    const int n = item % NCPS, grp = item / NCPS, h = grp % A_HEADS, s = grp / A_HEADS, R0 = s * SEQ + n * CHUNK;
    const int lane = tid & 63, wave = tid >> 6, g = lane >> 4, cl = lane & 15, r = tid >> 3, seg = tid & 7;
    float* PART = (float*)(lds + NM_PART);
    const float nw = p.a_norm_w[li * A_DV + 16 * wave + cl];
    const u32x4 z0 = raw.z0, z1 = raw.z1;
    f32x4 oa[4];
#pragma unroll
    for (int t = 0; t < 4; ++t) {
        oa[t] = (f32x4){bflo(raw.of[t].x), bfhi(raw.of[t].x), bflo(raw.of[t].y), bfhi(raw.of[t].y)};
        f32x4 q4;
#pragma unroll
        for (int e = 0; e < 4; ++e) q4[e] = sum16(oa[t][e] * oa[t][e]);
        if (cl < 4) PART[(16 * t + 4 * g + cl) * 8 + wave] = cl == 0 ? q4[0] : cl == 1 ? q4[1] : cl == 2 ? q4[2] : q4[3];
    }
    if (next_item >= 0) norm_load(p, next_item, tid, raw);
    LBAR();
#pragma unroll
    for (int t = 0; t < 4; ++t)
#pragma unroll
        for (int e = 0; e < 4; ++e) {
            const int row = 16 * t + 4 * g + e;
            const f32x4 p0 = *(const f32x4*)(PART + row * 8), p1 = *(const f32x4*)(PART + row * 8 + 4);
            const float ss = ((p0[0] + p0[1]) + (p0[2] + p0[3])) + ((p1[0] + p1[1]) + (p1[2] + p1[3]));
            *(bf16*)(lds + NM_OST + row * 272 + (16 * wave + cl) * 2) = (bf16)(cvtpk(oa[t][e] * fast_rsq(ss * (1.f / A_DV) + RMS_EPS) * nw, 0.f) & 0xffffu);
        }
    LBAR();
    {
        const u32x4 o0 = *(const u32x4*)(lds + NM_OST + r * 272 + 32 * seg), o1 = *(const u32x4*)(lds + NM_OST + r * 272 + 32 * seg + 16);
        u32x4 w0, w1;
#pragma unroll
        for (int e = 0; e < 4; ++e) {
            w0[e] = cvtpk(bflo(o0[e]) * fsilu(bflo(z0[e])), bfhi(o0[e]) * fsilu(bfhi(z0[e])));
            w1[e] = cvtpk(bflo(o1[e]) * fsilu(bflo(z1[e])), bfhi(o1[e]) * fsilu(bfhi(z1[e])));
        }
        u32x4* dst = (u32x4*)(PROJ + ((size_t)(R0 + r) * PLD + 2 * A_QK + h * A_DV + 16 * seg) * 2); dst[0] = w0; dst[1] = w1;
    }
    LBAR();
}
__device__ __forceinline__ void ph_a_norm(PrmRef p, const Ctx& c, int li, unsigned char* lds) {
    NormRaw raw;
    if (c.bid < NPI) norm_load(p, c.bid, c.tid, raw);
    for (int item = c.bid; item < NPI; item += c.nblk) delta_norm_item(p, li, item, item + c.nblk < NPI ? item + c.nblk : -1, c.tid, lds, raw);
    bf16* PROJ = (bf16*)(p.ws + WS_PROJ);
    sgemm_rows(p, PROJ + 2 * A_QK, PLD, (const bf16*)(p.ws + WS_WAOUT) + (size_t)li * D_MODEL * A_VW, A_VW, PROJ, PLD, PT, ST, D_MODEL, c, NPI, lds);
}
__device__ __forceinline__ void sample_conv(PrmRef p, const Ctx& c, int li) {
    bf16* PROJ = (bf16*)(p.ws + WS_PROJ);
    const float* cw = p.a_conv_w + (size_t)li * CONV_W * CONV_DIM;
    for (int it = c.gtid; it < DEC_BATCH * CONV_DIM; it += c.nthreads) {
        const int ch = it % CONV_DIM, b = it / CONV_DIM;
        const float* sp = p.state_conv + (((size_t)li * DEC_BATCH + b) * 3) * CONV_DIM + ch;
        float h0 = sp[0], h1 = sp[CONV_DIM], h2 = sp[2 * CONV_DIM];
        const float w0 = cw[ch], w1 = cw[CONV_DIM + ch], w2 = cw[2 * CONV_DIM + ch], w3 = cw[3 * CONV_DIM + ch];
        bf16* e0 = PROJ + (size_t)(PT + b * DEC_SEQ) * PLD + ch;
        bf16 xv[DEC_SEQ];
#pragma unroll
        for (int t = 0; t < DEC_SEQ; ++t) xv[t] = e0[(size_t)t * PLD];
#pragma unroll
        for (int t = 0; t < DEC_SEQ; ++t) {
            const float x = bf2f(xv[t]);
            const float y = w0 * h0 + w1 * h1 + w2 * h2 + w3 * x;
            e0[(size_t)t * PLD] = (bf16)(cvtpk(fsilu(y), 0.f) & 0xffffu); h0 = h1; h1 = h2; h2 = x;
        }
        float* so = p.out + O_SCONV + (((size_t)li * DEC_BATCH + b) * 3) * CONV_DIM + ch;
        so[0] = h0; so[CONV_DIM] = h1; so[2 * CONV_DIM] = h2;
    }
}
constexpr int SS2_KQ = 0, SS2_V = 32768, SS2_GE = 49152, SS2_O = 49408;
__device__ __forceinline__ void sample_scan_group(PrmRef p, int li, int sg, int tid, unsigned char* lds, bool wstate = true) {
    bf16* PROJ = (bf16*)(p.ws + WS_PROJ); const float* GB = (const float*)(p.ws + WS_GB);
    float* KQ = (float*)(lds + SS2_KQ); float* V = (float*)(lds + SS2_V); float* GE = (float*)(lds + SS2_GE); float* O = (float*)(lds + SS2_O);
    const int b = sg / A_HEADS, h = sg % A_HEADS, r0 = PT + b * DEC_SEQ, col = tid >> 2, part = tid & 3, lane = tid & 63, wave = tid >> 6;
    __syncthreads();
    float S[32];
    const float* s0 = p.state_delta + (((size_t)li * DEC_BATCH + b) * A_HEADS + h) * A_DK * A_DV;
#pragma unroll
    for (int k = 0; k < 32; ++k) S[k] = s0[(size_t)(part * 32 + k) * A_DV + col];
    {
        float a[8], bb[8];
#pragma unroll
        for (int i = 0; i < 8; ++i) { const int row = wave * 8 + i, t = row >> 1, kind = row & 1; const bf16* e = PROJ + (size_t)(r0 + t) * PLD + (kind == 0 ? A_QK : 0) + h * A_DK + 2 * lane; a[i] = bf2f(e[0]); bb[i] = bf2f(e[1]); }
#pragma unroll
        for (int i = 0; i < 8; ++i) { const int row = wave * 8 + i, kind = row & 1;
            const float sc = (1.f / sqrtf(wave_sum(a[i] * a[i] + bb[i] * bb[i]) + RMS_EPS)) * (kind == 0 ? 1.f : 0.08838834764831845f);
            KQ[row * 128 + 2 * lane] = a[i] * sc; KQ[row * 128 + 2 * lane + 1] = bb[i] * sc; }
#pragma unroll
        for (int i = 0; i < 8; ++i) { const int t = part * 8 + i; V[t * 128 + col] = bf2f(PROJ[(size_t)(r0 + t) * PLD + 2 * A_QK + h * A_DV + col]); }
        if (tid < DEC_SEQ) { GE[2 * tid] = expf(GB[((size_t)(r0 + tid) * A_HEADS + h) * 2]); GE[2 * tid + 1] = GB[((size_t)(r0 + tid) * A_HEADS + h) * 2 + 1]; }
    }
    __syncthreads();
    for (int t = 0; t < DEC_SEQ; ++t) {
        const float eg = GE[2 * t], beta = GE[2 * t + 1], v = V[t * 128 + col];
        const f32x4* kk = (const f32x4*)(KQ + (2 * t) * 128 + part * 32); const f32x4* qq = (const f32x4*)(KQ + (2 * t + 1) * 128 + part * 32);
        float ks = 0.f;
#pragma unroll
        for (int k4 = 0; k4 < 8; ++k4) { const f32x4 kv = kk[k4];
#pragma unroll
            for (int e = 0; e < 4; ++e) { S[4 * k4 + e] *= eg; ks += kv[e] * S[4 * k4 + e]; } }
        ks += __shfl_xor(ks, 1); ks += __shfl_xor(ks, 2);
        const float vn = (v - ks) * beta; float o = 0.f;
#pragma unroll
        for (int k4 = 0; k4 < 8; ++k4) { const f32x4 kv = kk[k4], qv = qq[k4];
#pragma unroll
            for (int e = 0; e < 4; ++e) { S[4 * k4 + e] += kv[e] * vn; o += qv[e] * S[4 * k4 + e]; } }
        o += __shfl_xor(o, 1); o += __shfl_xor(o, 2);
        if (part == 0) O[t * 128 + col] = bf2f((bf16)f2bf(o));
    }
    float* so = p.out + O_SDELTA + (((size_t)li * DEC_BATCH + b) * A_HEADS + h) * A_DK * A_DV;
    if (wstate) {
#pragma unroll
    for (int k = 0; k < 32; ++k) so[(size_t)(part * 32 + k) * A_DV + col] = S[k];
    }
    __syncthreads();
    const float* nw = p.a_norm_w + (size_t)li * A_DV;
#pragma unroll
    for (int i = 0; i < 4; ++i) {
        const int t = wave * 4 + i, row = r0 + t;
        bf16* e = PROJ + (size_t)row * PLD + 2 * A_QK + h * A_DV + 2 * lane; const bf16* z = PROJ + (size_t)row * PLD + CONV_DIM + h * A_DV + 2 * lane;
        const float a = O[t * 128 + 2 * lane], bb = O[t * 128 + 2 * lane + 1];
        const float r = 1.f / sqrtf(wave_sum(a * a + bb * bb) * (1.f / A_DV) + RMS_EPS);
        e[0] = (bf16)f2bf(a * r * nw[2 * lane] * siluf(bf2f(z[0]))); e[1] = (bf16)f2bf(bb * r * nw[2 * lane + 1] * siluf(bf2f(z[1])));
    }
    __syncthreads();
}
template <int VAR = 0> __device__ __forceinline__ void ph_a_pre(PrmRef p, const Ctx& c, int li, unsigned char* lds) {
    RawTile xr;
    if (c.bid < NPI) { prepass_load_raw(p, c.bid, c.tid, xr); if (c.wave == 1) prepass_gcum(p, c.bid, c.lane, (float*)(lds + PP_GC)); }
    int prev = -1, pb = 0, cur_h = -1;
    for (int item = c.bid; item < NPI; item += c.nblk) {
        const int h = (item / NCPS) % A_HEADS;
        if (h != cur_h) {
            LBAR();
            for (int i = c.tid; i < 3 * 4 * 128; i += NTHR) { const int X = i / 512, j = (i / 128) & 3, ch = i & 127; ((float*)(lds + PP_CW))[i] = p.a_conv_w[((size_t)li * CONV_W + j) * CONV_DIM + X * A_QK + h * A_DK + ch]; }
            LBAR(); cur_h = h;
        }
        delta_prepass_item<VAR>(p, li, item, item + c.nblk < NPI ? item + c.nblk : -1, prev, pb, c.tid, lds, xr); prev = item; pb ^= 1;
    }
    if (prev >= 0) prepass_store_w(p, prev, c.tid, lds);
    LBAR();
    if (VAR == 0) sample_conv(p, c, li);
}
template <int SV = 0> __device__ __forceinline__ void ph_a_scan2(PrmRef p, const Ctx& c, int li, unsigned char* lds, bool wstate = true, bool do_prompt = true, bool do_sample = true) {
    const int v = (c.bid + c.nblk - ((2 * NPG) % c.nblk)) % c.nblk;
    if (do_sample) for (int sg = v; sg < NSG; sg += c.nblk) sample_scan_group(p, li, sg, c.tid, lds, wstate);
    const int nfree = c.nblk > 2 * NPG ? c.nblk - 2 * NPG : 0;
    const int lane_s = c.lane, wave_s = READFIRSTLANE(c.wave), gw_s = READFIRSTLANE(c.gwave), nw_s = c.nwaves;
    if (SV == 0 && nfree > 0 && v < nfree) { weights_deferred(p, lane_s, wave_s, li, lds, v * (NTHR / 64) + wave_s, nfree * (NTHR / 64)); LBAR(); }
    if (do_prompt) for (int it = c.bid; it < 2 * NPG; it += c.nblk) delta_scan_group<SV>(p, li, it, c.tid, lds, wstate);
    if (SV == 0 && nfree == 0) { weights_deferred(p, lane_s, wave_s, li, lds, gw_s, nw_s); LBAR(); }
}

__device__ __forceinline__ void ph_ln(PrmRef p, const Ctx& c, const bf16* OUT, int ldo, const float* g, const float* b, bool last) {
    bf16* XB = (bf16*)(p.ws + WS_XB);
    constexpr int PER = D_MODEL / 64;
    constexpr int RB = 3;
    static_assert(PER % 8 == 0, "ln vector width");
    const int col0 = c.lane * PER;
    f32x4 gv[PER / 4], bv[PER / 4];
#pragma unroll
    for (int j = 0; j < PER / 4; ++j) { gv[j] = *(const f32x4*)(g + col0 + 4 * j); bv[j] = *(const f32x4*)(b + col0 + 4 * j); }
    for (int row0 = c.gwave; row0 < MT; row0 += RB * c.nwaves) {
        u32x4 xa[RB][PER / 8], oa[RB][PER / 8];
#pragma unroll
        for (int r = 0; r < RB; ++r) { const int row = row0 + r * c.nwaves;
            if (row < MT) {
#pragma unroll
                for (int j = 0; j < PER / 8; ++j) { xa[r][j] = *(const u32x4*)(XB + (size_t)row * D_MODEL + col0 + 8 * j); oa[r][j] = *(const u32x4*)(OUT + (size_t)row * ldo + col0 + 8 * j); } } }
#pragma unroll
        for (int r = 0; r < RB; ++r) { const int row = row0 + r * c.nwaves;
            if (row < MT) {
                float v[PER]; float s = 0.f;
#pragma unroll
                for (int j = 0; j < PER / 8; ++j)
#pragma unroll
                    for (int e = 0; e < 4; ++e) { v[8 * j + 2 * e] = DN_ALPHA * bflo(xa[r][j][e]) + bflo(oa[r][j][e]); v[8 * j + 2 * e + 1] = DN_ALPHA * bfhi(xa[r][j][e]) + bfhi(oa[r][j][e]); }
#pragma unroll
                for (int j = 0; j < PER; ++j) s += v[j];
                const float mean = wave_sum(s) * (1.f / D_MODEL); float q = 0.f;
#pragma unroll
                for (int j = 0; j < PER; ++j) { v[j] -= mean; q += v[j] * v[j]; }
                const float rstd = fast_rsq(wave_sum(q) * (1.f / D_MODEL) + LN_EPS);
#pragma unroll
                for (int j = 0; j < PER; ++j) v[j] = v[j] * rstd * gv[j >> 2][j & 3] + bv[j >> 2][j & 3];
#pragma unroll
                for (int j = 0; j < PER / 8; ++j) { u32x4 o;
#pragma unroll
                    for (int e = 0; e < 4; ++e) o[e] = cvtpk(v[8 * j + 2 * e], v[8 * j + 2 * e + 1]);
                    *(u32x4*)(XB + (size_t)row * D_MODEL + col0 + 8 * j) = o; }
                if (last) { float* yo = row < PT ? p.out + O_YP + (size_t)row * D_MODEL + col0 : p.out + O_YS + (size_t)(row - PT) * D_MODEL + col0;
#pragma unroll
                    for (int j = 0; j < PER; j += 4) *(f32x4*)(yo + j) = (f32x4){v[j], v[j + 1], v[j + 2], v[j + 3]}; }
            } }
    }
}
__device__ __forceinline__ float fast_exp2(float x) {
#ifdef EMU
    return exp2f(x);
#else
    return __builtin_amdgcn_exp2f(x);
#endif
}
__device__ __forceinline__ void b_cache_copies(PrmRef p, const Ctx& c) {
    bf16* CK = (bf16*)(p.ws + WS_CK); bf16* CVT = (bf16*)(p.ws + WS_CVT);
    for (int it = c.gtid; it < DEC_BATCH * WINDOW * B_KVW; it += c.nthreads) {
        const int dd = it % B_KVW, w = (it / B_KVW) % WINDOW, b = it / (B_KVW * WINDOW), kvh = dd / B_HD, d = dd % B_HD;
        CK[(((size_t)b * B_KV_HEADS + kvh) * WINDOW + w) * B_HD + d] = (bf16)f2bf(p.cache_k[it]);
        CVT[(((size_t)b * B_KV_HEADS + kvh) * B_HD + d) * WINDOW + w] = (bf16)f2bf(p.cache_v[it]);
    }
}
__device__ __forceinline__ void ph_b_gemm(PrmRef p, const Ctx& c, int lj, unsigned char* lds) {
    const bf16* XB = (const bf16*)(p.ws + WS_XB); bf16* PROJ = (bf16*)(p.ws + WS_PROJ); const bf16* Wt = (const bf16*)(p.ws + WS_WBIN) + (size_t)lj * B_N0 * D_MODEL;
    const int N = lj == 0 ? B_N0 : B_IN;
    pg8::Gemm g{XB, D_MODEL, Wt, PT, N, D_MODEL}; pg8::StaticOrder S; S.init(PT, N, c.nblk, c.bid);
    pg8::EpiBIn E{PROJ, PLD, (const float*)(p.ws + WS_ROPE), (bf16*)(p.ws + WS_VT)};
    __syncthreads();
    pg8::gemm_phase<pg8::EpiBIn, pg8::StaticOrder, true>((LAS unsigned char*)lds, g, S, E, c.tid);
    __syncthreads();
    sgemm_rows<2>(p, XB, D_MODEL, Wt, D_MODEL, PROJ, PLD, PT, ST, N, c, lj == 0 ? (PT / 256) * (B_N0 / 256) : 0, lds, true);
    if (lj == 0) b_cache_copies(p, c);
}
constexpr int AT_KPITCH = 144, AT_VPITCH = 400, AT_K = 0, AT_V = 192 * AT_KPITCH, AT_O = AT_V + 64 * AT_VPITCH + 64  , AT_OPITCH = 144;
static_assert(2 * SC_BUF <= 163840 - 64, "scan LDS");
static_assert(AT_O % 16 == 0 && AT_O + 256 * AT_OPITCH <= 131072, "attention LDS");
struct AttRaw { u32x4 k[3], v[3]; bf16x8 q[4]; };
__device__ __forceinline__ void att_load(PrmRef p, int ck, int kvh, int tid, AttRaw& raw) {
    const unsigned char* PROJ = (const unsigned char*)(p.ws + WS_PROJ); const unsigned char* VT = (const unsigned char*)(p.ws + WS_VT);
    const unsigned char* CK = (const unsigned char*)(p.ws + WS_CK); const unsigned char* CVT = (const unsigned char*)(p.ws + WS_CVT);
    const int lane = tid & 63, wave = tid >> 6, l31 = lane & 31, hi = lane >> 5;
    const bool smp = ck >= NCP; const int r0 = chunk_row0(ck);
    const int nc = smp ? 0 : ck % NCPS, nblk = smp ? 0 : (nc >= 2 ? 3 : nc + 1);
    if (!smp) {
        const int kfirst = r0 - (nblk - 1) * CHUNK;
#pragma unroll
        for (int j = 0; j < 3; ++j) if (j < nblk) { const int idx = tid + NTHR * j, key = idx >> 3, pc = idx & 7, d = (idx >> 3) & 63;
            raw.k[j] = *(const u32x4*)(PROJ + ((size_t)(kfirst + key) * PLD + B_IN + kvh * B_HD) * 2 + pc * 16);
            raw.v[j] = *(const u32x4*)(VT + ((((size_t)(ck - (nblk - 1) + j) * B_KV_HEADS + kvh) * B_HD + d) * 64) * 2 + pc * 16); }
    } else {
        const int b = ck - NCP;
#pragma unroll
        for (int j = 0; j < 3; ++j) { const int idx = tid + NTHR * j;
            if (idx < 160 * 8) { const int key = idx >> 3, pc = idx & 7;
                raw.k[j] = *(const u32x4*)(key < WINDOW ? CK + ((((size_t)b * B_KV_HEADS + kvh) * WINDOW + key) * B_HD) * 2 + pc * 16 : PROJ + ((size_t)(r0 + key - WINDOW) * PLD + B_IN + kvh * B_HD) * 2 + pc * 16); }
            if (idx < 64 * 20) { const int d = idx / 20, pc = idx % 20;
                raw.v[j] = *(const u32x4*)(pc < 16 ? CVT + ((((size_t)b * B_KV_HEADS + kvh) * B_HD + d) * WINDOW) * 2 + pc * 16 : VT + ((((size_t)ck * B_KV_HEADS + kvh) * B_HD + d) * 64) * 2 + (pc - 16) * 16); } }
    }
    const bool active = smp ? wave < 4 : true;
    const int hq = kvh * B_GROUP + (smp ? wave : (wave >> 1)), qrow0 = smp ? 0 : 32 * (wave & 1);
    if (active) {
#pragma unroll
        for (int ks = 0; ks < 4; ++ks) raw.q[ks] = *(const bf16x8*)(PROJ + ((size_t)(r0 + qrow0 + l31) * PLD + hq * B_HD + 16 * ks + 8 * hi) * 2);
    }
}
__device__ __forceinline__ void att_item(PrmRef p, int lj, int ck, int kvh, int nck, int nkvh, int tid, unsigned char* lds, AttRaw& raw) {
#ifndef EMU
    asm volatile("" : "+v"(tid));
#endif
    unsigned char* PROJ = (unsigned char*)(p.ws + WS_PROJ);
    const int lane = tid & 63, wave = READFIRSTLANE(tid >> 6), l31 = lane & 31, hi = lane >> 5;
    const bool smp = ck >= NCP; const int r0 = chunk_row0(ck);
    const int nc = smp ? 0 : ck % NCPS, nblk = smp ? 0 : (nc >= 2 ? 3 : nc + 1);
    const int nkt = smp ? 5 : 2 * nblk;
    if (!smp) {
#pragma unroll
        for (int j = 0; j < 3; ++j) if (j < nblk) { const int idx = tid + NTHR * j, key = idx >> 3, pc = idx & 7, d = (idx >> 3) & 63;
            *(u32x4*)(lds + AT_K + key * AT_KPITCH + pc * 16) = raw.k[j];
            unsigned char* dst = lds + AT_V + d * AT_VPITCH + j * 128 + (pc >> 1) * 32 + (pc & 1) * 8; *(u32x2*)dst = (u32x2){raw.v[j].x, raw.v[j].y}; *(u32x2*)(dst + 16) = (u32x2){raw.v[j].z, raw.v[j].w}; }
    } else {
#pragma unroll
        for (int j = 0; j < 3; ++j) { const int idx = tid + NTHR * j;
            if (idx < 160 * 8) { const int key = idx >> 3, pc = idx & 7; *(u32x4*)(lds + AT_K + key * AT_KPITCH + pc * 16) = raw.k[j]; }
            if (idx < 64 * 20) { const int d = idx / 20, pc = idx % 20; unsigned char* dst = lds + AT_V + d * AT_VPITCH + (pc >> 1) * 32 + (pc & 1) * 8; *(u32x2*)dst = (u32x2){raw.v[j].x, raw.v[j].y}; *(u32x2*)(dst + 16) = (u32x2){raw.v[j].z, raw.v[j].w}; } }
    }
    const bool active = smp ? wave < 4 : true;
    const int hq = kvh * B_GROUP + (smp ? wave : (wave >> 1));
    bf16x8 qf[4];
#pragma unroll
    for (int ks = 0; ks < 4; ++ks) qf[ks] = raw.q[ks];
    LBAR();
    if (nck >= 0) att_load(p, nck, nkvh, tid, raw);
    const int nrows = smp ? 128 : 256;
    u32x4 zr[4];
    if (active) {
        f32x16 sc[6];
#pragma unroll
        for (int kt = 0; kt < 6; ++kt) {
#pragma unroll
            for (int e = 0; e < 16; ++e) sc[kt][e] = 0.f;
            if (kt < nkt) {
#pragma unroll
                for (int ks = 0; ks < 4; ++ks) sc[kt] = MFMA32(*(const bf16x8*)(lds + AT_K + (32 * kt + l31) * AT_KPITCH + 32 * ks + 16 * hi), qf[ks], sc[kt]);
            }
        }
        const float sink = p.b_sinks[lj * B_Q_HEADS + hq];
        float m = sink;
#pragma unroll
        for (int kt = 0; kt < 6; ++kt) if (kt < nkt) {
#pragma unroll
            for (int e = 0; e < 16; ++e) m = fmaxf(m, sc[kt][e]); }
        m = fmaxf(m, __shfl_xor(m, 32));
        float l = 0.f; const float ml2 = m * 1.4426950408889634f;
#pragma unroll
        for (int kt = 0; kt < 6; ++kt) if (kt < nkt) {
#pragma unroll
            for (int e = 0; e < 16; ++e) { const float pe = fast_exp2(sc[kt][e] * 1.4426950408889634f - ml2); sc[kt][e] = pe; l += pe; } }
        l += __shfl_xor(l, 32);
        l += fast_exp2(sink * 1.4426950408889634f - ml2);
        f32x16 o[2];
#pragma unroll
        for (int e = 0; e < 16; ++e) { o[0][e] = 0.f; o[1][e] = 0.f; }
#pragma unroll
        for (int kt = 0; kt < 6; ++kt) if (kt < nkt) {
#pragma unroll
            for (int s = 0; s < 2; ++s) {
                u32x4 pw; pw.x = cvtpk(sc[kt][8 * s], sc[kt][8 * s + 1]); pw.y = cvtpk(sc[kt][8 * s + 2], sc[kt][8 * s + 3]); pw.z = cvtpk(sc[kt][8 * s + 4], sc[kt][8 * s + 5]); pw.w = cvtpk(sc[kt][8 * s + 6], sc[kt][8 * s + 7]);
                const bf16x8 pb = __builtin_bit_cast(bf16x8, pw);
#pragma unroll
                for (int mt = 0; mt < 2; ++mt) {
                    o[mt] = MFMA32(*(const bf16x8*)(lds + AT_V + (32 * mt + l31) * AT_VPITCH + (32 * kt + 16 * s) * 2 + 16 * hi), pb, o[mt]);
                }
            }
        }
        const float il = fast_rcp(l);
        unsigned char* orow = lds + AT_O + (32 * wave + l31) * AT_OPITCH;
#pragma unroll
        for (int mt = 0; mt < 2; ++mt)
#pragma unroll
            for (int cg4 = 0; cg4 < 4; ++cg4) {
                u32x2 w2; w2.x = cvtpk(o[mt][4 * cg4] * il, o[mt][4 * cg4 + 1] * il); w2.y = cvtpk(o[mt][4 * cg4 + 2] * il, o[mt][4 * cg4 + 3] * il);
                *(u32x2*)(orow + (32 * mt + 8 * cg4 + 4 * hi) * 2) = w2;
            }
    }
#pragma unroll
    for (int i = 0; i < 4; ++i) { const int idx = tid + NTHR * i;
        if (idx < nrows * 8) { const int qr = idx >> 3, pc = idx & 7, w = qr >> 5, hq2 = kvh * B_GROUP + (smp ? w : (w >> 1)), row = r0 + (smp ? 0 : 32 * (w & 1)) + (qr & 31);
            zr[i] = *(const u32x4*)(PROJ + ((size_t)row * PLD + B_QW + hq2 * B_HD) * 2 + pc * 16); } }
    LBAR();
#pragma unroll
    for (int i = 0; i < 4; ++i) { const int idx = tid + NTHR * i;
        if (idx < nrows * 8) { const int qr = idx >> 3, pc = idx & 7, w = qr >> 5, hq2 = kvh * B_GROUP + (smp ? w : (w >> 1)), row = r0 + (smp ? 0 : 32 * (w & 1)) + (qr & 31);
            const u32x4 ov = *(const u32x4*)(lds + AT_O + qr * AT_OPITCH + pc * 16); const u32x4 zv = zr[i];
            u32x4 r;
#pragma unroll
            for (int e = 0; e < 4; ++e) r[e] = cvtpk(bflo(ov[e]) * fsilu(bflo(zv[e])), bfhi(ov[e]) * fsilu(bfhi(zv[e])));
            *(u32x4*)(PROJ + ((size_t)row * PLD + hq2 * B_HD) * 2 + pc * 16) = r; } }
    LBAR();
}
__device__ __forceinline__ void ph_b_att2(PrmRef p, const Ctx& c, int lj, bool first, unsigned char* lds) {
    AttRaw raw;
    if (c.bid < NCH * B_KV_HEADS) att_load(p, c.bid / B_KV_HEADS, c.bid % B_KV_HEADS, c.tid, raw);
    for (int it = c.bid; it < NCH * B_KV_HEADS; it += c.nblk) { const int nx = it + c.nblk < NCH * B_KV_HEADS ? it + c.nblk : -1;
        att_item(p, lj, it / B_KV_HEADS, it % B_KV_HEADS, nx < 0 ? -1 : nx / B_KV_HEADS, nx < 0 ? 0 : nx % B_KV_HEADS, c.tid, lds, raw); }
    if (first) {
        const bf16* PROJ = (const bf16*)(p.ws + WS_PROJ);
        for (int it = c.gtid; it < (BATCH + DEC_BATCH) * WINDOW * B_KVW; it += c.nthreads) {
            const int e = it % B_KVW, w = (it / B_KVW) % WINDOW, s = it / (B_KVW * WINDOW);
            if (s < BATCH) { const int row = s * SEQ + SEQ - WINDOW + w; const bf16* kp = PROJ + (size_t)row * PLD + B_IN;
                p.out[O_PK + ((size_t)s * WINDOW + w) * B_KVW + e] = bf2f(kp[e]); p.out[O_PV + ((size_t)s * WINDOW + w) * B_KVW + e] = bf2f(kp[B_KVW + e]); }
            else { const int b = s - BATCH; float kx, vx;
                if (w < WINDOW - DEC_SEQ) { kx = p.cache_k[((size_t)b * WINDOW + w + DEC_SEQ) * B_KVW + e]; vx = p.cache_v[((size_t)b * WINDOW + w + DEC_SEQ) * B_KVW + e]; }
                else { const int row = PT + b * DEC_SEQ + (w - (WINDOW - DEC_SEQ)); const bf16* kp = PROJ + (size_t)row * PLD + B_IN; kx = bf2f(kp[e]); vx = bf2f(kp[B_KVW + e]); }
                p.out[O_SK + ((size_t)b * WINDOW + w) * B_KVW + e] = kx; p.out[O_SV + ((size_t)b * WINDOW + w) * B_KVW + e] = vx; }
        }
    }
}

#ifndef EMU
#define XB_TMO      128
#define XB_XCNT(j)  (256  + 64 * (j))
#define XB_XSUB(j)  (1280 + 64 * (j))
#define XB_XGEN(j)  (2304 + 64 * (j))
#define XB_TOP      3328
#define XB_TOPGEN   3392
#define XCD_BAR_WORDS 3456
#define XB_SPIN_CAP (1u << 20)
__device__ __forceinline__ unsigned xb_ld(unsigned* p)              { return __hip_atomic_load(p, __ATOMIC_RELAXED, __HIP_MEMORY_SCOPE_AGENT); }
__device__ __forceinline__ unsigned xb_add(unsigned* p, unsigned v) { return __hip_atomic_fetch_add(p, v, __ATOMIC_RELAXED, __HIP_MEMORY_SCOPE_AGENT); }
__device__ __forceinline__ unsigned xb_xcc_id() { return (unsigned)__builtin_amdgcn_s_getreg((3 << 11) | 20) & 0xFu; }
#define XB_SPIN(cond, bar) do { unsigned _sp = 0; while (cond) { __builtin_amdgcn_s_sleep(1); \
    if ((++_sp & 255u) == 0u) { if (xb_ld(&(bar)[XB_TMO])) break; if (_sp > XB_SPIN_CAP) { atomicAdd(&(bar)[XB_TMO], 1u); break; } } } } while (0)
__device__ __forceinline__ void xcd_barrier_complete(unsigned* bar, unsigned x, unsigned& nloc, unsigned& nx) {
    const unsigned G = gridDim.x * gridDim.y * gridDim.z;
    unsigned sum, cnt, mine, sp = 0u;
    for (;;) {
        sum = 0u; cnt = 0u; mine = 0u;
#pragma unroll
        for (unsigned j = 0; j < 16; ++j) { const unsigned c = xb_ld(&bar[XB_XCNT(j)]); sum += c; cnt += (c > 0u) ? 1u : 0u; mine = (j == x) ? c : mine; }
        if (sum == G) break;
        __builtin_amdgcn_s_sleep(1);
        if ((++sp & 255u) == 0u) { if (xb_ld(&bar[XB_TMO])) break; if (sp > XB_SPIN_CAP) { atomicAdd(&bar[XB_TMO], 1u); break; } }
    }
    nloc = mine > 0u ? mine : 1u; nx = cnt > 0u ? cnt : 1u;
}
__device__ __forceinline__ void xcd_barrier(unsigned* bar, volatile LAS unsigned* st, const int tid) {
    asm volatile("s_waitcnt vmcnt(0)" ::: "memory");
    __syncthreads();
    if (tid == 0) {
        __builtin_amdgcn_s_waitcnt(0);
        const unsigned x = xb_xcc_id();
        unsigned nloc = st[0], nx = st[1];
        if (nloc == 0u) { xcd_barrier_complete(bar, x, nloc, nx); st[0] = nloc; st[1] = nx; }
        const unsigned old = xb_add(&bar[XB_XSUB(x)], 1u);
        const unsigned gen = old / nloc;
        if (old + 1u == (gen + 1u) * nloc) {
            __builtin_amdgcn_fence(__ATOMIC_RELEASE, "agent");
            asm volatile("s_waitcnt vmcnt(0)" ::: "memory");
            const unsigned og = xb_add(&bar[XB_TOP], 1u);
            const unsigned tg = og / nx;
            if (og + 1u == (tg + 1u) * nx) xb_add(&bar[XB_TOPGEN], 1u);
            else XB_SPIN(xb_ld(&bar[XB_TOPGEN]) == tg, bar);
            __builtin_amdgcn_fence(__ATOMIC_ACQUIRE, "agent");
            xb_add(&bar[XB_XGEN(x)], 1u);
            asm volatile("s_waitcnt vmcnt(0)" ::: "memory");
        } else {
            XB_SPIN(xb_ld(&bar[XB_XGEN(x)]) == gen, bar);
            __builtin_amdgcn_fence(__ATOMIC_ACQUIRE, "agent");
            asm volatile("s_waitcnt vmcnt(0)" ::: "memory");
        }
    }
    __syncthreads();
}
#endif
constexpr int PH_A0 = 1, PH_APER = 6, PH_B0 = PH_A0 + N_A * PH_APER, PH_BPER = 4, N_PHASES = PH_B0 + N_B * PH_BPER;
constexpr int LDS_BAR_OFF = 163840 - 64;
constexpr int LDS_BYTES = 163840;
#ifdef EMU
#define DECL_LDS(name) unsigned char* name = emu::blk()->lds
#else
#define DECL_LDS(name) extern __shared__ __attribute__((aligned(16))) unsigned char name[]
#endif

#ifdef EMU
#define PH_PROLOGUE() PrmRef p = p_; int tid_ = threadIdx.x, bid_ = blockIdx.x;
#define GRID_SYNC()
#else
#define PH_PROLOGUE() const __attribute__((address_space(4))) Prm* pp = (const __attribute__((address_space(4))) Prm*)__builtin_amdgcn_kernarg_segment_ptr(); \
    int tid_ = wave_s_ * 64 + (int)__builtin_amdgcn_mbcnt_hi(~0u, __builtin_amdgcn_mbcnt_lo(~0u, 0u)), bid_ = blockIdx.x; asm volatile("" : "+s"(pp), "+v"(tid_), "+s"(bid_)); PrmRef p = *pp;
#define GRID_SYNC() xcd_barrier((unsigned*)(p.ws + WS_CTL), (volatile LAS unsigned*)(lds + LDS_BAR_OFF), c.tid)
#endif
#define PHASE(k, ...) if (ph_lo <= (k) && (k) < ph_hi) { PH_PROLOGUE() \
        Ctx c; c.tid = tid_; c.lane = c.tid & 63; c.wave = c.tid >> 6; c.bid = bid_; c.nblk = gridDim.x; \
        c.gtid = c.bid * NTHR + c.tid; c.nthreads = c.nblk * NTHR; c.gwave = c.bid * (NTHR / 64) + c.wave; c.nwaves = c.nblk * (NTHR / 64); \
        bf16* PROJ = (bf16*)(p.ws + WS_PROJ); const bf16* XB = (const bf16*)(p.ws + WS_XB); (void)PROJ; (void)XB; \
        __VA_ARGS__; \
        if ((k) + 1 < ph_hi) { GRID_SYNC(); } }
#define A_LAYER(li) \
    PHASE(PH_A0 + (li) * PH_APER + 0, ph_a_gemm(p, c, li, lds)) \
    PHASE(PH_A0 + (li) * PH_APER + 1, ph_a_pre(p, c, li, lds)) \
    PHASE(PH_A0 + (li) * PH_APER + 2, ph_a_scan2(p, c, li, lds)) \
    PHASE(PH_A0 + (li) * PH_APER + 3, ph_a_norm(p, c, li, lds)) \
    PHASE(PH_A0 + (li) * PH_APER + 4, gemm_mfma(PROJ + 2 * A_QK, PLD, (const bf16*)(p.ws + WS_WAOUT) + (size_t)(li) * D_MODEL * A_VW, PROJ, PLD, PT, D_MODEL, A_VW, c, lds)) \
    PHASE(PH_A0 + (li) * PH_APER + 5, ph_ln(p, c, PROJ, PLD, p.a_ln_g + (size_t)(li) * D_MODEL, p.a_ln_b + (size_t)(li) * D_MODEL, false))
#define B_LAYER(lj) \
    PHASE(PH_B0 + (lj) * PH_BPER + 0, ph_b_gemm(p, c, lj, lds)) \
    PHASE(PH_B0 + (lj) * PH_BPER + 1, ph_b_att2(p, c, lj, (lj) == 0, lds)) \
    PHASE(PH_B0 + (lj) * PH_BPER + 2, gemm_mfma(PROJ, PLD, (const bf16*)(p.ws + WS_WBOUT) + (size_t)(lj) * D_MODEL * B_QW, PROJ + B_QW, PLD, PT, D_MODEL, B_QW, c, lds); \
        sgemm_rows(p, PROJ, PLD, (const bf16*)(p.ws + WS_WBOUT) + (size_t)(lj) * D_MODEL * B_QW, B_QW, PROJ + B_QW, PLD, PT, ST, D_MODEL, c, 0, lds)) \
    PHASE(PH_B0 + (lj) * PH_BPER + 3, ph_ln(p, c, PROJ + B_QW, PLD, p.b_ln_g + (size_t)(lj) * D_MODEL, p.b_ln_b + (size_t)(lj) * D_MODEL, (lj) == N_B - 1))

__global__ void __launch_bounds__(NTHR, 2) fwd_kernel(Prm p_, int ph_lo, int ph_hi) {
    DECL_LDS(lds);
#ifndef EMU
    const int wave_s_ = __builtin_amdgcn_readfirstlane((int)threadIdx.x >> 6);
    {
        if (threadIdx.x < 2) ((volatile LAS unsigned*)(lds + LDS_BAR_OFF))[threadIdx.x] = 0u;
        if (threadIdx.x == 0) (void)xb_add((unsigned*)(p_.ws + WS_CTL) + XB_XCNT(xb_xcc_id()), 1u);
        __syncthreads();
    }
#endif
    PHASE(0, ph_init(p, c); ph_weights(p, c, lds))
    A_LAYER(0)
    A_LAYER(1)
    B_LAYER(0)
    B_LAYER(1)
#ifdef PROBE_TAIL
    PROBE_TAIL
#endif
}

extern "C" void kernel_launch(void* const* d_in, const int* in_sizes, int n_in, void* d_out, int out_size, void* d_ws, size_t ws_size, hipStream_t stream) {
    if (n_in != 20 || (size_t)out_size != O_END || ws_size < WS_NEED) { fprintf(stderr, "kernel_launch: unexpected sizes n_in=%d out=%d ws=%zu (need %zu, out %zu)\n", n_in, out_size, ws_size, (size_t)WS_END, (size_t)O_END); return; }
    Prm p{};
    const float** pp = (const float**)&p;
    for (int i = 0; i < 20; ++i) pp[i] = (const float*)d_in[i];
    p.out = (float*)d_out; p.ws = (unsigned char*)d_ws;
#ifdef EMU
    const int grid = 8;
    const int stop = getenv("EMU_STOP") ? atoi(getenv("EMU_STOP")) : N_PHASES;
    for (int ph = 0; ph < N_PHASES && ph < stop; ++ph) { emu::launch([=]() { fwd_kernel(p, ph, ph + 1); }, dim3(grid), dim3(NTHR), LDS_BYTES); fprintf(stderr, "phase %d done\n", ph); }
#else
    static int grid = 0;
    if (grid == 0) {
        int dev = 0, cus = 0, per_cu = 0;
        (void)hipGetDevice(&dev); (void)hipDeviceGetAttribute(&cus, hipDeviceAttributeMultiprocessorCount, dev);
        (void)hipFuncSetAttribute((const void*)fwd_kernel, hipFuncAttributeMaxDynamicSharedMemorySize, LDS_BYTES);
        (void)hipOccupancyMaxActiveBlocksPerMultiprocessor(&per_cu, (const void*)fwd_kernel, NTHR, LDS_BYTES);
        if (per_cu < 1) { fprintf(stderr, "kernel_launch: occupancy query says %d blocks per CU\n", per_cu); per_cu = 1; }
        grid = cus;
    }
    (void)hipMemsetAsync((char*)d_ws + WS_CTL, 0, 65536, stream);
#ifdef PROBE_TAIL
    int lo = 0, hi = N_PHASES + PROBE_NTAIL;
#else
    int lo = 0, hi = N_PHASES;
#endif
    void* args[] = {(void*)&p, (void*)&lo, (void*)&hi};
    hipError_t e = hipLaunchCooperativeKernel((const void*)fwd_kernel, dim3(grid), dim3(NTHR), args, LDS_BYTES, stream);
    if (e != hipSuccess) fprintf(stderr, "cooperative launch failed: %s (grid %d)\n", hipGetErrorString(e), grid);
#endif
}
```

```cpp
#ifdef EMU
#include "hip_emu.h"
#else
#include <hip/hip_runtime.h>
#include <hip/hip_cooperative_groups.h>
namespace cg = cooperative_groups;
#endif
#include <cstdint>
#include <cstddef>
#include <cstdio>

typedef short bf16x8 __attribute__((ext_vector_type(8)));
typedef float f32x4 __attribute__((ext_vector_type(4)));
typedef float f32x16 __attribute__((ext_vector_type(16)));
typedef unsigned u32x4 __attribute__((ext_vector_type(4)));
typedef unsigned u32x2 __attribute__((ext_vector_type(2)));
#ifdef EMU
#define LAS
#define WAVE_SYNC() emu::wave_sync()
#define GLDS16(gp, lp) memcpy((unsigned char*)(lp) + emu::lane_id() * 16, (const void*)(gp), 16)
typedef const unsigned char* BufRes;
#define MAKE_RES(p) ((const unsigned char*)(p))
#define BLDS16(res, voff, soff, lp) memcpy((unsigned char*)(lp) + emu::lane_id() * 16, (res) + (voff) + (soff), 16)
#define MFMA16(a, b, c) emu_mfma_16x16x32_bf16(a, b, c)
#define MFMA32(a, b, c) emu_mfma_32x32x16_bf16(a, b, c)
#define MFMAF(a, b, c) emu_mfma_16x16x4_f32(a, b, c)
#define SETPRIO(n)
#define SCHED_BARRIER()
#define S_BARRIER() emu::block_sync()
#define WAIT_VM(n)
#define WAIT_LGKM(n)
#define READFIRSTLANE(x) (x)
#define BCAST_LANE(v, n) __shfl(v, n)
#define LBAR() emu::block_sync()
typedef short s16x4 __attribute__((ext_vector_type(4)));
inline s16x4 emu_ds_read_tr16(const void* pp) { s16x4 mine = *(const s16x4*)pp, r; const int l = emu::lane_id(), i = l & 15;
    for (int e = 0; e < 4; ++e) { const s16x4 o = emu::shfl_idx(mine, (l & ~15) + 4 * e + (i >> 2)); r[e] = o[i & 3]; } return r; }
#define LDS_TR16(ptr) emu_ds_read_tr16(ptr)
#else
#define LAS __attribute__((address_space(3)))
#define WAVE_SYNC() asm volatile("s_waitcnt lgkmcnt(0)" ::: "memory")
#define GLDS16(gp, lp) __builtin_amdgcn_global_load_lds((const unsigned*)(gp), (LAS unsigned*)(lp), 16, 0, 0)
typedef __amdgpu_buffer_rsrc_t BufRes;
#define MAKE_RES(p) __builtin_amdgcn_make_buffer_rsrc((void*)(p), 0, 0x7fffffff, 0x00020000)
#define BLDS16(res, voff, soff, lp) __builtin_amdgcn_raw_ptr_buffer_load_lds(res, (LAS unsigned*)(lp), 16, (int)(voff), (int)(soff), 0, 0)
#define MFMA16(a, b, c) __builtin_amdgcn_mfma_f32_16x16x32_bf16(a, b, c, 0, 0, 0)
#define MFMA32(a, b, c) __builtin_amdgcn_mfma_f32_32x32x16_bf16(a, b, c, 0, 0, 0)
#define MFMAF(a, b, c) __builtin_amdgcn_mfma_f32_16x16x4f32(a, b, c, 0, 0, 0)
#define SETPRIO(n) __builtin_amdgcn_s_setprio(n)
#define SCHED_BARRIER() __builtin_amdgcn_sched_barrier(0)
#define S_BARRIER() __builtin_amdgcn_s_barrier()
#define WAIT_VM(n) asm volatile("s_waitcnt vmcnt(" #n ")" ::: "memory")
#define WAIT_LGKM(n) asm volatile("s_waitcnt lgkmcnt(" #n ")" ::: "memory")
#define READFIRSTLANE(x) __builtin_amdgcn_readfirstlane(x)
#define BCAST_LANE(v, n) __builtin_bit_cast(float, __builtin_amdgcn_readlane(__builtin_bit_cast(int, v), n))
typedef short s16x4 __attribute__((ext_vector_type(4)));
#define LDS_TR16(ptr) __builtin_amdgcn_ds_read_tr16_b64_v4i16((LAS s16x4*)(ptr))
#define LBAR() do { asm volatile("s_waitcnt lgkmcnt(0)" ::: "memory"); __builtin_amdgcn_s_barrier(); asm volatile("" ::: "memory"); } while (0)
#endif

#ifdef CFG_SMALL
constexpr int D_MODEL = 512, BATCH = 2, SEQ = 256, DEC_BATCH = 8, DEC_SEQ = 32, A_HEADS = 4, B_Q_HEADS = 8, B_KV_HEADS = 2;
#else
constexpr int D_MODEL = 1024, BATCH = 8, SEQ = 2048, DEC_BATCH = 16, DEC_SEQ = 32, A_HEADS = 8, B_Q_HEADS = 16, B_KV_HEADS = 4;
#endif
constexpr int PAST_LEN = 4096, CHUNK = 64, N_A = 2, N_B = 2, DEPTH = 4;
constexpr int A_DK = 128, A_DV = 128, A_QK = A_HEADS * A_DK, A_VW = A_HEADS * A_DV, CONV_W = 4, CONV_DIM = 2 * A_QK + A_VW;
constexpr int A_IN = CONV_DIM + A_VW + 2 * A_HEADS, A_MAIN = CONV_DIM + A_VW;
constexpr int B_GROUP = B_Q_HEADS / B_KV_HEADS, B_HD = 64, B_QW = B_Q_HEADS * B_HD, B_KVW = B_KV_HEADS * B_HD, B_IN = 2 * B_QW;
constexpr int WINDOW = 128, ROPE_DIMS = 16, ROPE_HALF = 8;
constexpr float LN_EPS = 1e-5f, RMS_EPS = 1e-6f;
constexpr float DN_ALPHA = 1.681792830507429f;
constexpr int PT = BATCH * SEQ, ST = DEC_BATCH * DEC_SEQ, MT = PT + ST, NSEQ = BATCH + DEC_BATCH;
constexpr int NCPS = SEQ / CHUNK, NCP = BATCH * NCPS, NCH = NCP + DEC_BATCH;
constexpr int PLD = A_MAIN > B_IN + 2 * B_KVW ? A_MAIN : B_IN + 2 * B_KVW;
static_assert(B_GROUP == 4, "attention wave map");
static_assert(PT % 256 == 0 && ST % 64 == 0 && D_MODEL % 256 == 0 && A_VW % 256 == 0 && B_QW % 256 == 0 && A_MAIN % 256 == 0 && D_MODEL % 256 == 0 && B_IN % 256 == 0 && (2 * B_KVW) % 256 == 0 && D_MODEL % 128 == 0 && D_MODEL >= 256, "gemm tiles");
static_assert(DEC_SEQ == 32 && WINDOW == 128 && CHUNK == 64, "fixed");

constexpr size_t O_YP = 0, O_YS = O_YP + (size_t)PT * D_MODEL, O_PDELTA = O_YS + (size_t)ST * D_MODEL;
constexpr size_t O_PCONV = O_PDELTA + (size_t)N_A * BATCH * A_HEADS * A_DK * A_DV, O_PK = O_PCONV + (size_t)N_A * BATCH * 3 * CONV_DIM;
constexpr size_t O_PV = O_PK + (size_t)BATCH * WINDOW * B_KVW, O_SDELTA = O_PV + (size_t)BATCH * WINDOW * B_KVW;
constexpr size_t O_SCONV = O_SDELTA + (size_t)N_A * DEC_BATCH * A_HEADS * A_DK * A_DV, O_SK = O_SCONV + (size_t)N_A * DEC_BATCH * 3 * CONV_DIM;
constexpr size_t O_SV = O_SK + (size_t)DEC_BATCH * WINDOW * B_KVW, O_END = O_SV + (size_t)DEC_BATCH * WINDOW * B_KVW;

constexpr size_t al256(size_t x) { return (x + 255) & ~(size_t)255; }
constexpr size_t WS_CTL = 0, WS_ROPE = 1u << 20;
constexpr size_t WS_GB = al256(WS_ROPE + (size_t)(SEQ + DEC_SEQ) * ROPE_HALF * 2 * 4);
constexpr size_t WS_HALO = al256(WS_GB + (size_t)MT * A_HEADS * 2 * 4);
constexpr size_t WS_XB = al256(WS_HALO + (size_t)NCH * 3 * CONV_DIM * 2);
constexpr size_t WS_PROJ = al256(WS_XB + (size_t)MT * D_MODEL * 2);
constexpr size_t WS_WAIN = al256(WS_PROJ + (size_t)MT * PLD * 2);
constexpr int A_NG = A_MAIN + 256;
constexpr size_t WS_WAOUT = al256(WS_WAIN + (size_t)N_A * A_NG * D_MODEL * 2);
constexpr int B_N0 = B_IN + 2 * B_KVW;
constexpr size_t WS_WBIN = al256(WS_WAOUT + (size_t)N_A * D_MODEL * A_VW * 2);
constexpr size_t WS_WBOUT = al256(WS_WBIN + (size_t)(B_N0 + B_IN) * D_MODEL * 2);
constexpr size_t WS_WB = al256(WS_WBOUT + (size_t)N_B * D_MODEL * B_QW * 2);
constexpr size_t WS_IA = al256(WS_WB + (size_t)PT * A_QK * 2);
constexpr size_t WS_GL = al256(WS_IA + (size_t)BATCH * A_HEADS * (SEQ / CHUNK) * 64 * 64 * 2);
constexpr size_t WS_END = al256(WS_GL + (size_t)BATCH * A_HEADS * (SEQ / CHUNK) * 4);
static_assert(WS_END <= ((size_t)256 << 20), "workspace");
constexpr size_t WS_VT = WS_WB, WS_CK = al256(WS_VT + (size_t)NCH * B_KV_HEADS * 64 * 64 * 2), WS_CVT = al256(WS_CK + (size_t)DEC_BATCH * B_KV_HEADS * 128 * 64 * 2);
constexpr size_t WS_BEND = al256(WS_CVT + (size_t)DEC_BATCH * B_KV_HEADS * 128 * 64 * 2), WS_NEED = WS_BEND > WS_END ? WS_BEND : WS_END;
static_assert(WS_NEED <= ((size_t)256 << 20), "workspace (B-layer buffers overlay the A-layer WB | IA | GL region)");

static_assert(N_B == 2, "weight map");

typedef unsigned short bf16;
constexpr int NTHR = 512;

struct Prm {
    const float *x_prompt, *x_sample, *state_delta, *state_conv, *cache_k, *cache_v, *a_w_in, *a_conv_w, *a_log, *a_dt_bias, *a_norm_w, *a_w_out, *a_ln_g, *a_ln_b,
        *b_w_kv, *b_w_in, *b_sinks, *b_w_out, *b_ln_g, *b_ln_b;
    float* out; unsigned char* ws;
};

__device__ __forceinline__ unsigned f2bf(float f) { unsigned u = __builtin_bit_cast(unsigned, f); return (u + 0x7fffu + ((u >> 16) & 1u)) >> 16; }
__device__ __forceinline__ float bf2f(bf16 h) { return __builtin_bit_cast(float, (unsigned)h << 16); }
__device__ __forceinline__ float siluf(float x) { return x / (1.f + expf(-x)); }
__device__ __forceinline__ float sigmoidf_(float x) { return 1.f / (1.f + expf(-x)); }
__device__ __forceinline__ float softplusf_(float x) { return x > 20.f ? x : log1pf(expf(x)); }
__device__ __forceinline__ float wave_sum(float v) {
#pragma unroll
    for (int o = 1; o < 64; o <<= 1) v += __shfl_xor(v, o);
    return v;
}

#ifdef EMU
__device__ __forceinline__ float fast_rcp(float x) { return 1.f / x; }
__device__ __forceinline__ float fast_rsq(float x) { return 1.f / sqrtf(x); }
__device__ __forceinline__ float fast_ex2(float x) { return exp2f(x); }
__device__ __forceinline__ unsigned cvtpk(float lo, float hi) { return f2bf(lo) | (f2bf(hi) << 16); }
__device__ __forceinline__ float dpp_xor1(float v) { return __shfl(v, emu::lane_id() ^ 1); }
__device__ __forceinline__ float dpp_xor2(float v) { return __shfl(v, emu::lane_id() ^ 2); }
__device__ __forceinline__ float dpp_hmirror(float v) { const int l = emu::lane_id(); return __shfl(v, (l & ~7) | (7 - (l & 7))); }
__device__ __forceinline__ float dpp_mirror(float v) { const int l = emu::lane_id(); return __shfl(v, (l & ~15) | (15 - (l & 15))); }
#else
__device__ __forceinline__ float fast_rcp(float x) { return __builtin_amdgcn_rcpf(x); }
__device__ __forceinline__ float fast_rsq(float x) { return __builtin_amdgcn_rsqf(x); }
__device__ __forceinline__ float fast_ex2(float x) { return __builtin_amdgcn_exp2f(x); }
__device__ __forceinline__ unsigned cvtpk(float lo, float hi) { typedef float f2_t __attribute__((ext_vector_type(2))); typedef __bf16 b2_t __attribute__((ext_vector_type(2)));
    f2_t v = {lo, hi}; b2_t b = __builtin_convertvector(v, b2_t); return __builtin_bit_cast(unsigned, b); }
template <int CTRL> __device__ __forceinline__ float dpp_mov(float v) { return __builtin_bit_cast(float, __builtin_amdgcn_update_dpp(0, __builtin_bit_cast(int, v), CTRL, 0xf, 0xf, true)); }
__device__ __forceinline__ float dpp_xor1(float v) { return dpp_mov<0xB1>(v); }
__device__ __forceinline__ float dpp_xor2(float v) { return dpp_mov<0x4E>(v); }
__device__ __forceinline__ float dpp_hmirror(float v) { return dpp_mov<0x141>(v); }
__device__ __forceinline__ float dpp_mirror(float v) { return dpp_mov<0x140>(v); }
#endif
__device__ __forceinline__ float sum8(float v) { v += dpp_xor1(v); v += dpp_xor2(v); v += dpp_hmirror(v); return v; }
__device__ __forceinline__ float sum16(float v) { v = sum8(v); v += dpp_mirror(v); return v; }
__device__ __forceinline__ float fsilu(float x) { return x * fast_rcp(1.f + fast_ex2(-1.4426950408889634f * x)); }
__device__ __forceinline__ float fexp(float x) { return fast_ex2(1.4426950408889634f * x); }
__device__ __forceinline__ float bflo(unsigned u) { return __builtin_bit_cast(float, u << 16); }
__device__ __forceinline__ float bfhi(unsigned u) { return __builtin_bit_cast(float, u & 0xffff0000u); }
__device__ __forceinline__ int seq_row0(int s) { return s < BATCH ? s * SEQ : PT + (s - BATCH) * DEC_SEQ; }
__device__ __forceinline__ int seq_len(int s) { return s < BATCH ? SEQ : DEC_SEQ; }
__device__ __forceinline__ int chunk_row0(int c) { return c < NCP ? c * CHUNK : PT + (c - NCP) * DEC_SEQ; }
__device__ __forceinline__ int chunk_len(int c) { return c < NCP ? CHUNK : DEC_SEQ; }
__device__ __forceinline__ int row_posidx(int row) { return row < PT ? (row % SEQ) : SEQ + ((row - PT) % DEC_SEQ); }

#ifdef EMU
typedef const Prm& PrmRef;
#else
typedef const __attribute__((address_space(4))) Prm& PrmRef;
#endif
struct Ctx { int tid, lane, wave, gtid, gwave, nthreads, nwaves, bid, nblk; };

namespace pg8 {
constexpr int BM = 256, BK = 64, HALF = 128, HTB = HALF * BK * 2  , STAGE_BYTES = 8 * HTB, NXCD = 8, WGM = 8;
__host__ __device__ __forceinline__ int lds_byte(int r, int c) { const int st = (r >> 4) * 2 + (c >> 5), rr = r & 15, cc = c & 31, ob = rr * 64 + cc * 2; return st * 1024 + (ob ^ (((ob >> 9) & 1) << 5)); }
__host__ __device__ __forceinline__ void stage_rc(int b, int& R, int& C) { const int st = b / 1024, sb = b % 1024, swz = sb ^ (((sb >> 9) & 1) << 5); R = (st >> 1) * 16 + swz / 64; C = (st & 1) * 32 + (swz % 64) / 2; }
__host__ __device__ __forceinline__ int perm32(int rho) { const int n = rho >> 4, i = rho & 15; return 8 * (i >> 2) + 4 * n + (i & 3); }
struct Unit { int pm, pn; };
struct Gemm { const bf16* A; int lda; const bf16* Bt; int M, N, K; };
struct StaticOrder {
    int nM, nN, nwg, G, c;
    __host__ __device__ void init(int M, int N, int G_, int c_) { nM = M / BM; nN = N / BM; nwg = nM * nN; G = G_; c = c_; }
    __host__ __device__ bool next(int i, Unit& u) const {
        const long L = (long)i * G + c; if (L >= nwg) return false;
        int wgid = (int)L; { const int q = nwg / NXCD, r = nwg % NXCD, xcd = wgid % NXCD, off = wgid / NXCD; wgid = (xcd < r ? xcd * (q + 1) : r * (q + 1) + (xcd - r) * q) + off; }
        const int nig = WGM * nN, gid = wgid / nig, fm = gid * WGM, gsz = (nM - fm) < WGM ? (nM - fm) : WGM;
        u.pm = fm + ((wgid % nig) % gsz); u.pn = (wgid % nig) / gsz; return true;
    }
};
__device__ __forceinline__ unsigned cvt_pk_bf16(float lo, float hi) {
#ifdef EMU
    return f2bf(lo) | (f2bf(hi) << 16);
#else
    unsigned r; asm volatile("v_cvt_pk_bf16_f32 %0, %1, %2" : "=v"(r) : "v"(lo), "v"(hi)); return r;
#endif
}
struct EpiBf16 {
    static constexpr bool PERM = true;
    bf16* O; int ldc;
    __device__ __forceinline__ void operator()(const f32x4 (&acc)[2][2][4][2], const Unit& u, int wr, int wc, int fr, int fq) const {
        int fr_ = fr, fq_ = fq;
#ifndef EMU
        asm volatile("" : "+v"(fr_), "+v"(fq_));
#endif
        const int row0 = u.pm * BM + wr * 64 + fr_, col0 = u.pn * BM + wc * 32 + 8 * fq_;
#pragma unroll
        for (int ai = 0; ai < 2; ++ai)
#pragma unroll
            for (int m = 0; m < 4; ++m) { bf16* rowp = O + (size_t)(row0 + ai * HALF + m * 16) * ldc + col0;
#pragma unroll
                for (int bj = 0; bj < 2; ++bj) { const f32x4 v0 = acc[ai][bj][m][0], v1 = acc[ai][bj][m][1];
                    u32x4 w; w.x = cvt_pk_bf16(v0[0], v0[1]); w.y = cvt_pk_bf16(v0[2], v0[3]); w.z = cvt_pk_bf16(v1[0], v1[1]); w.w = cvt_pk_bf16(v1[2], v1[3]);
                    *(u32x4*)(rowp + bj * HALF) = w; } }
    }
};
struct EpiAIn {
    static constexpr bool PERM = true;
    bf16* O; int ldc; bf16* HALO; float* pconv;
    __device__ __forceinline__ void operator()(const f32x4 (&acc)[2][2][4][2], const Unit& u, int wr, int wc, int fr, int fq) const {
        int fr_ = fr, fq_ = fq;
#ifndef EMU
        asm volatile("" : "+v"(fr_), "+v"(fq_));
#endif
        const int row0 = u.pm * BM + wr * 64 + fr_, col0 = u.pn * BM + wc * 32 + 8 * fq_;
#pragma unroll
        for (int ai = 0; ai < 2; ++ai)
#pragma unroll
            for (int m = 0; m < 4; ++m) { const int row = row0 + ai * HALF + m * 16; bf16* rowp = O + (size_t)row * ldc + col0;
#pragma unroll
                for (int bj = 0; bj < 2; ++bj) { const f32x4 v0 = acc[ai][bj][m][0], v1 = acc[ai][bj][m][1];
                    u32x4 w; w.x = cvt_pk_bf16(v0[0], v0[1]); w.y = cvt_pk_bf16(v0[2], v0[3]); w.z = cvt_pk_bf16(v1[0], v1[1]); w.w = cvt_pk_bf16(v1[2], v1[3]);
                    *(u32x4*)(rowp + bj * HALF) = w;
                    if (m == 3 && fr_ >= 13 && col0 + bj * HALF < CONV_DIM) {
                        const int ck = row >> 6, hr = fr_ - 13, col = col0 + bj * HALF;
                        *(u32x4*)(HALO + ((size_t)ck * 3 + hr) * CONV_DIM + col) = w;
                        if (ck % NCPS == NCPS - 1) { float* dst = pconv + ((size_t)(ck / NCPS) * 3 + hr) * CONV_DIM + col; *(f32x4*)dst = v0; *(f32x4*)(dst + 4) = v1; }
                    } } }
    }
};
struct EpiBIn {
    static constexpr bool PERM = true;
    bf16* O; int ldc; const float* rope; bf16* VT; LAS const float* ropeL; int pmL;
    __device__ __forceinline__ void operator()(const f32x4 (&acc)[2][2][4][2], const Unit& u, int wr, int wc, int fr, int fq) const {
        int fr_ = fr, fq_ = fq;
#ifndef EMU
        asm volatile("" : "+v"(fr_), "+v"(fq_));
#endif
        static_assert(B_QW % 128 == 0 && B_KVW % 128 == 0, "a 128-column half tile has one kind");
        const int ct = u.pn * BM;
        int kinds[2]; bool ropes[2];
#pragma unroll
        for (int bj = 0; bj < 2; ++bj) { const int cc = ct + bj * HALF; kinds[bj] = cc < B_QW ? 0 : cc < B_IN ? 1 : cc < B_IN + B_KVW ? 2 : 3;
            ropes[bj] = (kinds[bj] == 0 || kinds[bj] == 2) && (wc & 1) == 0; }
        const int row0 = u.pm * BM + wr * 64 + fr_, col0 = ct + wc * 32 + 8 * fq_;
#pragma unroll
        for (int ai = 0; ai < 2; ++ai)
#pragma unroll
            for (int m = 0; m < 4; ++m) { const int row = row0 + ai * HALF + m * 16; bf16* rowp = O + (size_t)row * ldc + col0;
                f32x4 cs[4];
                if (ropes[0] || ropes[1]) {
                    if (u.pm == pmL) { LAS const f32x4* rp = (LAS const f32x4*)(ropeL + (row & (BM - 1)) * ROPE_HALF * 2);
#pragma unroll
                        for (int q4 = 0; q4 < 4; ++q4) cs[q4] = rp[q4]; }
                    else { const f32x4* rp = (const f32x4*)(rope + (size_t)(row % SEQ) * ROPE_HALF * 2);
#pragma unroll
                        for (int q4 = 0; q4 < 4; ++q4) cs[q4] = rp[q4]; } }
#pragma unroll
                for (int bj = 0; bj < 2; ++bj) { f32x4 v0 = acc[ai][bj][m][0], v1 = acc[ai][bj][m][1]; const int kind = kinds[bj]; const float sc = kind == 0 ? 0.125f : 1.f;
                    if (ropes[bj]) {
                        float x[8] = {v0[0], v0[1], v0[2], v0[3], v1[0], v1[1], v1[2], v1[3]}, o[8];
#pragma unroll
                        for (int j = 0; j < 8; ++j) o[j] = __shfl_xor(x[j], 16);
                        if (fq_ < 2) {
#pragma unroll
                            for (int j = 0; j < 8; ++j) { const float c_ = cs[j >> 1][2 * (j & 1)], s_ = cs[j >> 1][2 * (j & 1) + 1]; x[j] = fq_ == 0 ? x[j] * c_ - o[j] * s_ : x[j] * c_ + o[j] * s_; }
                        }
                        v0 = (f32x4){x[0], x[1], x[2], x[3]}; v1 = (f32x4){x[4], x[5], x[6], x[7]};
                    }
                    v0 = v0 * sc; v1 = v1 * sc;
                    u32x4 w; w.x = cvt_pk_bf16(v0[0], v0[1]); w.y = cvt_pk_bf16(v0[2], v0[3]); w.z = cvt_pk_bf16(v1[0], v1[1]); w.w = cvt_pk_bf16(v1[2], v1[3]);
                    *(u32x4*)(rowp + bj * HALF) = w;
                    if (kind == 3) { const int dd = col0 + bj * HALF - (B_IN + B_KVW), kvh = dd / B_HD, d = dd % B_HD; bf16* vt = VT + (((size_t)(row >> 6) * B_KV_HEADS + kvh) * B_HD + d) * 64 + (row & 63);
                        vt[0] = (bf16)(w.x & 0xffffu); vt[64] = (bf16)(w.x >> 16); vt[128] = (bf16)(w.y & 0xffffu); vt[192] = (bf16)(w.y >> 16);
                        vt[256] = (bf16)(w.z & 0xffffu); vt[320] = (bf16)(w.z >> 16); vt[384] = (bf16)(w.w & 0xffffu); vt[448] = (bf16)(w.w >> 16); }
                } }
    }
};
template <class Epi, class Sched, bool ALIGN_EPI>
__device__ __forceinline__ void gemm_phase(LAS unsigned char* lds, const Gemm g, const Sched& S, const Epi& E, const int tid) {
    const int wid = READFIRSTLANE(tid >> 6), lane = tid & 63, wr = wid >> 2, wc = wid & 3, fr = lane & 15, fq = lane >> 4;
    const int K = g.K, nt = K / BK;
    unsigned voffA[2], voffB[2];
#pragma unroll
    for (int i = 0; i < 2; ++i) { int R, C; stage_rc(tid * 16 + i * 8192, R, C); const int Rb = Epi::PERM ? ((R & ~31) + perm32(R & 31)) : R;
        voffA[i] = (unsigned)(R * g.lda + C) * 2u; voffB[i] = (unsigned)(Rb * K + C) * 2u; }
    const unsigned kstep = (unsigned)(BK * 2);
    const unsigned hstepA = (unsigned)HALF * (unsigned)g.lda * 2u, hstepB = (unsigned)HALF * (unsigned)K * 2u;
    const unsigned tstepA = 2 * hstepA, tstepB = 2 * hstepB;
    const BufRes rA = MAKE_RES(g.A), rB = MAKE_RES(g.Bt);
    const unsigned ldsw = (unsigned)wid * 1024u;
    const int aoff = lds_byte(wr * 64 + fr, fq * 8), boff = lds_byte(wc * 32 + fr, fq * 8);
#define PG8_SA(b, h) (((b) * 2 + (h)) * HTB)
#define PG8_SB(b, h) ((4 + (b) * 2 + (h)) * HTB)
#define PG8_STAGE(bufoff, res, soff, voff) do { _Pragma("unroll") for (int _i = 0; _i < 2; ++_i) \
        BLDS16(res, (voff)[_i], soff, lds + (bufoff) + ldsw + _i * 8192); } while (0)
#define PG8_LDA(dst, b, h) do { _Pragma("unroll") for (int m = 0; m < 4; ++m) _Pragma("unroll") for (int k = 0; k < 2; ++k) dst[m][k] = *(const LAS bf16x8*)(lds + PG8_SA(b, h) + aoff + m * 2048 + k * 1024); } while (0)
#define PG8_LDB(dst, b, h) do { _Pragma("unroll") for (int n = 0; n < 2; ++n) _Pragma("unroll") for (int k = 0; k < 2; ++k) dst[n][k] = *(const LAS bf16x8*)(lds + PG8_SB(b, h) + boff + n * 2048 + k * 1024); } while (0)
#define PG8_MMA(ai, bj, At, Bt) do { SETPRIO(1); _Pragma("unroll") for (int m = 0; m < 4; ++m) _Pragma("unroll") for (int n = 0; n < 2; ++n) _Pragma("unroll") for (int k = 0; k < 2; ++k) \
        acc[ai][bj][m][n] = MFMA16(Bt[n][k], At[m][k], acc[ai][bj][m][n]); SETPRIO(0); } while (0)
#define PG8_MMAZ(ai, bj, At, Bt) do { SETPRIO(1); _Pragma("unroll") for (int m = 0; m < 4; ++m) _Pragma("unroll") for (int n = 0; n < 2; ++n) { \
        acc[ai][bj][m][n] = MFMA16(Bt[n][0], At[m][0], ((f32x4){0.f, 0.f, 0.f, 0.f})); acc[ai][bj][m][n] = MFMA16(Bt[n][1], At[m][1], acc[ai][bj][m][n]); } SETPRIO(0); } while (0)
    Unit cur, nxt; int ui = 0;
    if (!S.next(0, cur)) return;
    f32x4 acc[2][2][4][2];
#pragma unroll
    for (int a = 0; a < 2; ++a)
#pragma unroll
        for (int b = 0; b < 2; ++b)
#pragma unroll
            for (int m = 0; m < 4; ++m)
#pragma unroll
                for (int n = 0; n < 2; ++n) acc[a][b][m][n] = (f32x4){0.f, 0.f, 0.f, 0.f};
    bf16x8 At[4][2], B0[2][2], B1[2][2];
    unsigned cA = (unsigned)cur.pm * tstepA, cB = (unsigned)cur.pn * tstepB;
    PG8_STAGE(PG8_SB(0, 0), rB, cB, voffB); PG8_STAGE(PG8_SB(0, 1), rB, cB + hstepB, voffB); PG8_STAGE(PG8_SA(0, 0), rA, cA, voffA); PG8_STAGE(PG8_SA(0, 1), rA, cA + hstepA, voffA);
    if (wr == 1) S_BARRIER();
    WAIT_VM(2); S_BARRIER();
    PG8_STAGE(PG8_SB(1, 0), rB, cB + kstep, voffB); PG8_STAGE(PG8_SA(1, 0), rA, cA + kstep, voffA); PG8_STAGE(PG8_SB(1, 1), rB, cB + hstepB + kstep, voffB);
    WAIT_VM(6); S_BARRIER();
    for (;;) {
        const bool has_next = S.next(ui + 1, nxt);
        const unsigned nA = has_next ? (unsigned)nxt.pm * tstepA : cA, nB = has_next ? (unsigned)nxt.pn * tstepB : cB;
#define PG8_TRIP(W, LAST, MM) do { \
            const unsigned a1 = cA + (unsigned)(t + 1) * kstep; \
            const unsigned a2 = (LAST) ? nA : cA + (unsigned)(t + 2) * kstep, b2 = (LAST) ? nB : cB + (unsigned)(t + 2) * kstep; \
            const unsigned a3 = a2 + kstep, b3 = b2 + kstep; \
            PG8_LDB(B0, 0, 0); PG8_LDB(B1, 0, 1); SCHED_BARRIER(); PG8_LDA(At, 0, 0); PG8_STAGE(PG8_SA(1, 1), rA, a1 + hstepA, voffA); \
            WAIT_VM(W); WAIT_LGKM(0); S_BARRIER(); MM(0, 0, At, B0); MM(0, 1, At, B1); S_BARRIER(); SCHED_BARRIER(); \
            PG8_LDA(At, 0, 1); PG8_STAGE(PG8_SB(0, 0), rB, b2, voffB); PG8_STAGE(PG8_SB(0, 1), rB, b2 + hstepB, voffB); PG8_STAGE(PG8_SA(0, 0), rA, a2, voffA); \
            WAIT_VM(W); WAIT_LGKM(0); S_BARRIER(); MM(1, 0, At, B0); MM(1, 1, At, B1); S_BARRIER(); SCHED_BARRIER(); \
            PG8_LDB(B0, 1, 0); PG8_LDB(B1, 1, 1); SCHED_BARRIER(); PG8_LDA(At, 1, 0); PG8_STAGE(PG8_SA(0, 1), rA, a2 + hstepA, voffA); \
            WAIT_VM(8); WAIT_LGKM(0); S_BARRIER(); PG8_MMA(0, 0, At, B0); PG8_MMA(0, 1, At, B1); S_BARRIER(); SCHED_BARRIER(); \
            PG8_LDA(At, 1, 1); PG8_STAGE(PG8_SB(1, 0), rB, b3, voffB); PG8_STAGE(PG8_SB(1, 1), rB, b3 + hstepB, voffB); PG8_STAGE(PG8_SA(1, 0), rA, a3, voffA); \
            WAIT_VM(8); WAIT_LGKM(0); S_BARRIER(); PG8_MMA(1, 0, At, B0); PG8_MMA(1, 1, At, B1); S_BARRIER(); SCHED_BARRIER(); } while (0)
        int t = 0;
        if (ui > 0) { PG8_TRIP(8, false, PG8_MMAZ); t = 2; }
        for (; t < nt; t += 2) { const bool last = (t == nt - 2); PG8_TRIP(8, last, PG8_MMA); }
#undef PG8_TRIP
        if constexpr (ALIGN_EPI) { if (wr == 0) S_BARRIER(); }
        E(acc, cur, wr, wc, fr, fq);
        if (!has_next) break;
        cur = nxt; cA = nA; cB = nB; ++ui;
        if constexpr (ALIGN_EPI) { if (wr == 1) S_BARRIER(); }
    }
    WAIT_VM(0);
    if constexpr (!ALIGN_EPI) { if (wr == 0) S_BARRIER(); }
    S_BARRIER();
#undef PG8_SA
#undef PG8_SB
#undef PG8_STAGE
#undef PG8_LDA
#undef PG8_LDB
#undef PG8_MMA
#undef PG8_MMAZ
}
}
__device__ __forceinline__ void gemm_mfma(const bf16* A, int lda, const bf16* Bt, bf16* C, int ldc, int M, int N, int K, const Ctx& c, unsigned char* lds) {
    pg8::Gemm g{A, lda, Bt, M, N, K}; pg8::StaticOrder S; S.init(M, N, c.nblk, c.bid); pg8::EpiBf16 E{C, ldc};
    __syncthreads();
    pg8::gemm_phase<pg8::EpiBf16, pg8::StaticOrder, true>((LAS unsigned char*)lds, g, S, E, c.tid);
    __syncthreads();
}
__device__ __forceinline__ void transpose_item(const float* W, int ldw, int K, int N, bf16* WT, int row_off, float* scr, int item, int lane) {
    const int nblk = N / 64, kb = item / nblk, nb = item % nblk, k0 = 64 * kb, n0 = 64 * nb;
#pragma unroll 8
    for (int kk = 0; kk < 64; ++kk) scr[kk * 65 + lane] = W[(size_t)(k0 + kk) * ldw + n0 + lane];
    WAVE_SYNC();
    const int cc = lane & 7;
#pragma unroll
    for (int j = 0; j < 8; ++j) { const int n = (lane >> 3) + 8 * j; const float* sp = scr + (8 * cc) * 65 + n;
        u32x4 o; o.x = cvtpk(sp[0 * 65], sp[1 * 65]); o.y = cvtpk(sp[2 * 65], sp[3 * 65]); o.z = cvtpk(sp[4 * 65], sp[5 * 65]); o.w = cvtpk(sp[6 * 65], sp[7 * 65]);
        *(u32x4*)(WT + (size_t)(row_off + n0 + n) * K + k0 + 8 * cc) = o; }
    WAVE_SYNC();
}
constexpr int WI_AIN = (D_MODEL / 64) * (A_MAIN / 64), WI_AOUT = (A_VW / 64) * (D_MODEL / 64), WI_BIN = (D_MODEL / 64) * (B_IN / 64), WI_BKV = (D_MODEL / 64) * (2 * B_KVW / 64), WI_BOUT = (B_QW / 64) * (D_MODEL / 64);
constexpr int WI_A_END = N_A * (WI_AIN + WI_AOUT), WI_ALL = WI_A_END + N_B * (WI_BIN + WI_BOUT) + WI_BKV;
__device__ __forceinline__ void weights_range(PrmRef p, int lane, int wave, unsigned char* lds, int vw, int nvw, int lo, int hi) {
    float* scr = (float*)lds + wave * (64 * 65);
    bf16* WAIN = (bf16*)(p.ws + WS_WAIN); bf16* WAOUT = (bf16*)(p.ws + WS_WAOUT); bf16* WBIN = (bf16*)(p.ws + WS_WBIN); bf16* WBOUT = (bf16*)(p.ws + WS_WBOUT);
    for (int it = lo + vw; it < hi; it += nvw) {
        int r = it;
        if (r < N_A * WI_AIN) { const int li = r / WI_AIN; transpose_item(p.a_w_in + (size_t)li * D_MODEL * A_IN, A_IN, D_MODEL, A_MAIN, WAIN + (size_t)li * A_NG * D_MODEL, 0, scr, r % WI_AIN, lane); continue; } r -= N_A * WI_AIN;
        if (r < N_A * WI_AOUT) { const int li = r / WI_AOUT; transpose_item(p.a_w_out + (size_t)li * A_VW * D_MODEL, D_MODEL, A_VW, D_MODEL, WAOUT + (size_t)li * D_MODEL * A_VW, 0, scr, r % WI_AOUT, lane); continue; } r -= N_A * WI_AOUT;
        if (r < N_B * WI_BIN) { const int lj = r / WI_BIN; transpose_item(p.b_w_in + (size_t)lj * D_MODEL * B_IN, B_IN, D_MODEL, B_IN, WBIN + (size_t)lj * B_N0 * D_MODEL, 0, scr, r % WI_BIN, lane); continue; } r -= N_B * WI_BIN;
        if (r < N_B * WI_BOUT) { const int lj = r / WI_BOUT; transpose_item(p.b_w_out + (size_t)lj * B_QW * D_MODEL, D_MODEL, B_QW, D_MODEL, WBOUT + (size_t)lj * D_MODEL * B_QW, 0, scr, r % WI_BOUT, lane); continue; } r -= N_B * WI_BOUT;
        transpose_item(p.b_w_kv, 2 * B_KVW, D_MODEL, 2 * B_KVW, WBIN, B_IN, scr, r, lane);
    }
}
__device__ __forceinline__ void ph_weights(PrmRef p, const Ctx& c, unsigned char* lds) {
    weights_range(p, c.lane, c.wave, lds, c.gwave, c.nwaves, 0, WI_AIN);
    bf16* WAIN = (bf16*)(p.ws + WS_WAIN);
    for (int it = c.gtid; it < N_A * 256 * D_MODEL; it += c.nthreads) {
        const int k = it % D_MODEL, j = (it / D_MODEL) % 256, li = it / (256 * D_MODEL);
        WAIN[((size_t)li * A_NG + A_MAIN + j) * D_MODEL + k] = j < 2 * A_HEADS ? (bf16)f2bf(p.a_w_in[((size_t)li * D_MODEL + k) * A_IN + A_MAIN + j]) : (bf16)0;
    }
}
__device__ __forceinline__ void weights_deferred(PrmRef p, int lane, int wave, int li, unsigned char* lds, int vw, int nvw) {
    static_assert(N_A == 2, "deferred weight conversion schedule");
    if (li == 0) weights_range(p, lane, wave, lds, vw, nvw, WI_AIN, WI_A_END); else weights_range(p, lane, wave, lds, vw, nvw, WI_A_END, WI_ALL);
}

__device__ __forceinline__ void ph_init(PrmRef p, const Ctx& c) {
    bf16* XB = (bf16*)(p.ws + WS_XB);
    for (size_t i8 = c.gtid; i8 < (size_t)MT * D_MODEL / 8; i8 += c.nthreads) {
        const size_t i = i8 * 8; const float* src = i < (size_t)PT * D_MODEL ? p.x_prompt + i : p.x_sample + (i - (size_t)PT * D_MODEL);
        const f32x4 a = *(const f32x4*)src, b = *(const f32x4*)(src + 4);
        u32x4 o; o.x = cvtpk(a[0], a[1]); o.y = cvtpk(a[2], a[3]); o.z = cvtpk(b[0], b[1]); o.w = cvtpk(b[2], b[3]);
        *(u32x4*)(XB + i) = o;
    }
    float* rope = (float*)(p.ws + WS_ROPE);
    for (int i = c.gtid; i < (SEQ + DEC_SEQ) * ROPE_HALF; i += c.nthreads) {
        const int pi = i / ROPE_HALF, f = i % ROPE_HALF; const float pos = pi < SEQ ? (float)pi : (float)(PAST_LEN + pi - SEQ);
        const float inv = f == 0 ? 1.0f : f == 1 ? 0.1939227432012558f : f == 2 ? 0.03760603070259094f : f == 3 ? 0.007292664609849453f : f == 4 ? 0.0014142135623842478f
                        : f == 5 ? 0.00027424818836152554f : f == 6 ? 5.3182957344688475e-05f : 1.0313385246263351e-05f;
        const float ang = pos * inv;
        rope[2 * i] = cosf(ang); rope[2 * i + 1] = sinf(ang);
    }
}

constexpr int SS_KC = 128, SS_STB = 32768, SS_BOFF = 16384;
template <int MODE> __device__ __forceinline__ void ss_issue(const bf16* A, int lda, const bf16* Bt, int K, int row0, int col0, int cidx, int q, int lw, int lane, unsigned char* lds) {
    const unsigned char* sa = (const unsigned char*)(A + (size_t)row0 * lda + cidx * SS_KC); const unsigned char* sb = (const unsigned char*)(Bt + (size_t)col0 * K + cidx * SS_KC);
    unsigned char* st = lds + (q & 3) * SS_STB;
#pragma unroll
    for (int i = 0; i < 4; ++i) { const int row = (lw * 4 + i) * 4 + (lane >> 4), pc = (lane & 15) ^ (row & 15);
        GLDS16(sa + (unsigned)row * (unsigned)(lda * 2) + (unsigned)pc * 16u, st + (lw * 4 + i) * 1024);
        if (MODE != 1) GLDS16(sb + (unsigned)row * (unsigned)(K * 2) + (unsigned)pc * 16u, st + SS_BOFF + (lw * 4 + i) * 1024); }
    if (MODE == 1) { const int row = lw * 4 + (lane >> 4), pc = (lane & 15) ^ (row & 15); GLDS16(sb + (unsigned)row * (unsigned)(K * 2) + (unsigned)pc * 16u, st + SS_BOFF + lw * 1024); }
}
template <int MODE> __device__ __forceinline__ void sgemm_stream(PrmRef p, int li, const bf16* A, int lda, const bf16* Bt, int K, bf16* C, int ldc, int row_begin, int col_base, int tn, int it0, int itstep, int nitems, int tid, unsigned char* lds) {
    const int lane = tid & 63, wave = READFIRSTLANE(tid >> 6), nkc = K / SS_KC;
    const int nmine = it0 < nitems ? (nitems - it0 + itstep - 1) / itstep : 0, Q = nmine * nkc;
    LBAR();
    if (Q == 0) return;
    if (wave >= 4) {
        const int lw = wave - 4;
        int it = it0, cidx = 0, row0 = row_begin + (it / tn) * 64, col0 = col_base + (it % tn) * 64;
#define SS_NEXT() do { if (++cidx == nkc) { cidx = 0; it += itstep; row0 = row_begin + (it / tn) * 64; col0 = col_base + (it % tn) * 64; } } while (0)
        ss_issue<MODE>(A, lda, Bt, K, row0, col0, cidx, 0, lw, lane, lds); SS_NEXT();
        if (Q > 1) { ss_issue<MODE>(A, lda, Bt, K, row0, col0, cidx, 1, lw, lane, lds); SS_NEXT(); }
        if (Q > 2) { ss_issue<MODE>(A, lda, Bt, K, row0, col0, cidx, 2, lw, lane, lds); SS_NEXT(); }
        for (int q = 0; q < Q; ++q) {
            if (q + 2 < Q) { if (MODE == 1) { WAIT_VM(10); } else { WAIT_VM(16); } } else { WAIT_VM(0); }
            LBAR();
            if (q + 3 < Q) { ss_issue<MODE>(A, lda, Bt, K, row0, col0, cidx, q + 3, lw, lane, lds); SS_NEXT(); }
        }
#undef SS_NEXT
    } else {
        const int r = lane & 15, g = lane >> 4;
        f32x4 acc[4];
#pragma unroll
        for (int nt = 0; nt < 4; ++nt) acc[nt] = (f32x4){0.f, 0.f, 0.f, 0.f};
        int it = it0, cidx = 0;
        float gal[4] = {0.f, 0.f, 0.f, 0.f}, gdb[4] = {0.f, 0.f, 0.f, 0.f};
        if (MODE == 1) {
#pragma unroll
            for (int e = 0; e < 4; ++e) { const int col = 4 * g + e; if (col < A_HEADS) { gal[e] = -expf(p.a_log[li * A_HEADS + col]); gdb[e] = p.a_dt_bias[li * A_HEADS + col]; } } }
        for (int q = 0; q < Q; ++q) {
            LBAR();
            const unsigned char* ap = lds + (q & 3) * SS_STB + (16 * wave + r) * 256; const unsigned char* bp = lds + (q & 3) * SS_STB + SS_BOFF + r * 256;
#pragma unroll
            for (int ks = 0; ks < 4; ++ks) { const int po = ((4 * ks + g) ^ r) << 4; const bf16x8 a = *(const bf16x8*)(ap + po);
#pragma unroll
                for (int nt = 0; nt < (MODE == 1 ? 1 : 4); ++nt) { const bf16x8 b = *(const bf16x8*)(bp + nt * 4096 + po); acc[nt] = MFMA16(b, a, acc[nt]); } }
            if (++cidx == nkc) {
                const int row0 = row_begin + (it / tn) * 64, col0 = col_base + (it % tn) * 64, row = row0 + 16 * wave + r;
                if (MODE == 1) {
                    static_assert(2 * A_HEADS <= 16, "gate columns");
                    float* GB = (float*)(p.ws + WS_GB);
#pragma unroll
                    for (int e = 0; e < 4; ++e) { const int col = 4 * g + e; const float v = acc[0][e];
                        if (col < A_HEADS) GB[((size_t)row * A_HEADS + col) * 2] = gal[e] * softplusf_(v + gdb[e]);
                        else if (col < 2 * A_HEADS) GB[((size_t)row * A_HEADS + (col - A_HEADS)) * 2 + 1] = sigmoidf_(v); }
                } else {
                    if (MODE == 2) {
                        const int kind = col0 < B_QW ? 0 : col0 < B_IN ? 1 : col0 < B_IN + B_KVW ? 2 : 3, srow = row - PT;
                        if (kind == 0 || kind == 2) {
                            const float* rp = (const float*)(p.ws + WS_ROPE) + ((size_t)(SEQ + srow % DEC_SEQ) * ROPE_HALF + 4 * (g & 1)) * 2;
                            const f32x4 cs0 = *(const f32x4*)rp, cs1 = *(const f32x4*)(rp + 4);
#pragma unroll
                            for (int e = 0; e < 4; ++e) { const float x = acc[0][e], o = __shfl_xor(x, 32), c_ = e < 2 ? cs0[2 * e] : cs1[2 * e - 4], s_ = e < 2 ? cs0[2 * e + 1] : cs1[2 * e - 3];
                                acc[0][e] = g < 2 ? x * c_ - o * s_ : x * c_ + o * s_; }
                        }
                        if (kind == 0) {
#pragma unroll
                            for (int nt = 0; nt < 4; ++nt) acc[nt] = acc[nt] * 0.125f; }
                        if (kind == 3) { bf16* VT = (bf16*)(p.ws + WS_VT); const int kvh = (col0 - (B_IN + B_KVW)) / B_HD, ck = NCP + srow / DEC_SEQ, key = srow % DEC_SEQ;
#pragma unroll
                            for (int nt = 0; nt < 4; ++nt)
#pragma unroll
                                for (int e = 0; e < 4; ++e) VT[(((size_t)ck * B_KV_HEADS + kvh) * B_HD + 16 * nt + 4 * g + e) * 64 + key] = (bf16)(cvtpk(acc[nt][e], 0.f) & 0xffffu); }
                    }
                    bf16* cp = C + (size_t)row * ldc + col0 + 4 * g;
#pragma unroll
                    for (int nt = 0; nt < 4; ++nt) { u32x2 w; w.x = cvtpk(acc[nt][0], acc[nt][1]); w.y = cvtpk(acc[nt][2], acc[nt][3]); *(u32x2*)(cp + 16 * nt) = w; }
                }
#pragma unroll
                for (int nt = 0; nt < 4; ++nt) acc[nt] = (f32x4){0.f, 0.f, 0.f, 0.f};
                cidx = 0; it += itstep;
            }
        }
    }
    LBAR();
}
template <int MODE = 0> __device__ __forceinline__ void sgemm_rows(PrmRef p, const bf16* A, int lda, const bf16* Bt, int K, bf16* C, int ldc, int row_begin, int nrows, int N, const Ctx& c, int first_wg, unsigned char* lds, bool only_tail = false) {
    const int tn = N / 64, nt = (nrows / 64) * tn;
    const int f = first_wg % c.nblk, np = (only_tail && f > 0) ? c.nblk - f : c.nblk;
    const int v = only_tail && f > 0 ? c.bid - f : (c.bid + c.nblk - f) % c.nblk;
    sgemm_stream<MODE>(p, 0, A, lda, Bt, K, C, ldc, row_begin, 0, tn, v >= 0 ? v : nt, np, nt, c.tid, lds);
}
__device__ __forceinline__ void ph_a_gemm(PrmRef p, const Ctx& c, int li, unsigned char* lds) {
    const bf16* XB = (const bf16*)(p.ws + WS_XB); bf16* PROJ = (bf16*)(p.ws + WS_PROJ); const bf16* Wt = (const bf16*)(p.ws + WS_WAIN) + (size_t)li * A_NG * D_MODEL;
    pg8::Gemm g{XB, D_MODEL, Wt, PT, A_MAIN, D_MODEL}; pg8::StaticOrder S; S.init(PT, A_MAIN, c.nblk, c.bid);
    pg8::EpiAIn E{PROJ, PLD, (bf16*)(p.ws + WS_HALO), p.out + O_PCONV + (size_t)li * BATCH * 3 * CONV_DIM};
    __syncthreads();
    pg8::gemm_phase<pg8::EpiAIn, pg8::StaticOrder, true>((LAS unsigned char*)lds, g, S, E, c.tid);
    __syncthreads();
    sgemm_stream<1>(p, li, XB, D_MODEL, Wt, D_MODEL, nullptr, 0, 0, A_MAIN, 1, c.bid, c.nblk, MT / 64, c.tid, lds);
    sgemm_rows(p, XB, D_MODEL, Wt, D_MODEL, PROJ, PLD, PT, ST, A_MAIN, c, MT / 64, lds);
}
constexpr int NPG = BATCH * A_HEADS, NSG = DEC_BATCH * A_HEADS, NPI = NPG * NCPS;
__device__ __forceinline__ unsigned pk2bf(float lo, float hi) { return cvtpk(lo, hi); }
__device__ __forceinline__ int p32(int d) { return (d & ~31) | (((d >> 2) & 3) << 3) | (((d >> 4) & 1) << 2) | (d & 3); }
constexpr int PP_KN = 0, PP_QN = 17408, PP_KF = 34816, PP_VF = 67584, PP_TT = 53248  , PP_GC = 100352, PP_LN = 102400, PP_LNP = 68, PP_TI = PP_LN + 64 * PP_LNP * 4, PP_TIP = 20, PP_WST = PP_TI + 4 * 16 * PP_TIP * 4, PP_CW = PP_WST + 17408, PP_END = PP_CW + 3 * 4 * 128 * 4;
static_assert(PP_END <= 163840 - 64 && PP_TI % 16 == 0 && PP_WST % 16 == 0 && PP_CW % 16 == 0, "prepass LDS");
typedef u32x2 RawTile[3][7];
__device__ __forceinline__ void prepass_load_raw(PrmRef p, int item, int tid, RawTile& xr) {
    const bf16* PROJ = (const bf16*)(p.ws + WS_PROJ); const bf16* HALO = (const bf16*)(p.ws + WS_HALO);
    const int n = item % NCPS, grp = item / NCPS, h = grp % A_HEADS, s = grp / A_HEADS, R0 = s * SEQ + n * CHUNK, q = tid >> 5, sg = tid & 31;
#pragma unroll
    for (int X = 0; X < 3; ++X) {
        const int cb = X * A_QK + h * A_DK + 4 * sg;
#pragma unroll
        for (int i = 0; i < 7; ++i) {
            const int rr = 4 * q - 3 + i;
            if (i >= 3 || rr >= 0) xr[X][i] = *(const u32x2*)(PROJ + (size_t)(R0 + rr) * PLD + cb);
            else if (n > 0) xr[X][i] = *(const u32x2*)(HALO + ((size_t)(s * NCPS + n - 1) * 3 + (3 + rr)) * CONV_DIM + cb);
            else xr[X][i] = (u32x2){0u, 0u};
        }
    }
}
__device__ __forceinline__ void prepass_gb_load(PrmRef p, int item, int lane, float& g, float& bt) {
    const float* GB = (const float*)(p.ws + WS_GB);
    const int n = item % NCPS, grp = item / NCPS, h = grp % A_HEADS, s = grp / A_HEADS, R0 = s * SEQ + n * CHUNK;
    g = GB[((size_t)(R0 + lane) * A_HEADS + h) * 2]; bt = GB[((size_t)(R0 + lane) * A_HEADS + h) * 2 + 1];
}
__device__ __forceinline__ void prepass_gcum(PrmRef p, int item, int lane, float* GC, float g, float bt) {
    float* GL = (float*)(p.ws + WS_GL);
    float cs = g;
#pragma unroll
    for (int d = 1; d < 64; d <<= 1) { const float o = __shfl(cs, lane >= d ? lane - d : lane); if (lane >= d) cs += o; }
    const float gl = __shfl(cs, 63);
    GC[lane] = cs; GC[64 + lane] = bt; GC[128 + lane] = fexp(cs); GC[192 + lane] = fexp(gl - cs);
    if (lane == 0) GL[item] = fexp(gl);
}
__device__ __forceinline__ void prepass_store_w(PrmRef p, int item, int tid, const unsigned char* lds) {
    bf16* WB = (bf16*)(p.ws + WS_WB); const bf16* WST = (const bf16*)(lds + PP_WST);
    const int n = item % NCPS, grp = item / NCPS, h = grp % A_HEADS, s = grp / A_HEADS, R0 = s * SEQ + n * CHUNK, r = tid >> 3, seg = tid & 7;
    const u32x4 w0 = *(const u32x4*)(WST + r * 136 + 16 * seg), w1 = *(const u32x4*)(WST + r * 136 + 16 * seg + 8);
    u32x4* dst = (u32x4*)(WB + (size_t)(R0 + r) * A_QK + h * A_DK + 16 * seg); dst[0] = w0; dst[1] = w1;
}
template <int VAR = 0> __device__ __forceinline__ void delta_prepass_item(PrmRef p, int li, int item, int next_item, int prev_item, int pb, int tid, unsigned char* lds, RawTile& xr) {
#ifndef EMU
    asm volatile("" : "+v"(tid));
#endif
    bf16* PROJ = (bf16*)(p.ws + WS_PROJ); bf16* IA = (bf16*)(p.ws + WS_IA);
    const int n = item % NCPS, grp = item / NCPS, h = grp % A_HEADS, s = grp / A_HEADS;
    const int R0 = s * SEQ + n * CHUNK, lane = tid & 63, wave = READFIRSTLANE(tid >> 6);
    bf16* KN = (bf16*)(lds + PP_KN); bf16* QN = (bf16*)(lds + PP_QN); bf16* VN = (bf16*)(lds + PP_KF);
    float* GC = (float*)(lds + PP_GC) + pb * 256; float* BT = GC + 64; float* EG = GC + 128; float* KD = GC + 192;
    float* LN = (float*)(lds + PP_LN);
    float* TI = (float*)(lds + PP_TI);
    bf16* WST = (bf16*)(lds + PP_WST);
    float gn = 0.f, bn = 0.f;
    if (wave == 1 && next_item >= 0) prepass_gb_load(p, next_item, lane, gn, bn);
    if (prev_item >= 0) prepass_store_w(p, prev_item, tid, lds);
    const int q4 = tid >> 5, sg = tid & 31;
    f32x4 qf[4];
#pragma unroll
    for (int X = 0; X < 3; ++X) {
        f32x4 xf[7];
#pragma unroll
        for (int i = 0; i < 7; ++i) xf[i] = (f32x4){bflo(xr[X][i].x), bfhi(xr[X][i].x), bflo(xr[X][i].y), bfhi(xr[X][i].y)};
        f32x4 acc[4];
#pragma unroll
        for (int o = 0; o < 4; ++o) acc[o] = (f32x4){0.f, 0.f, 0.f, 0.f};
#pragma unroll
        for (int j = 0; j < 4; ++j) {
            const f32x4 w4 = *((const f32x4*)(lds + PP_CW) + ((X * 4 + j) * 128 + 4 * sg) / 4);
#pragma unroll
            for (int o = 0; o < 4; ++o) acc[o] += w4 * xf[o + j];
        }
        bf16* TILE = X == 0 ? QN : X == 1 ? KN : VN;
#pragma unroll
        for (int o = 0; o < 4; ++o) {
            f32x4 a = acc[o];
#pragma unroll
            for (int e = 0; e < 4; ++e) a[e] = fsilu(a[e]);
            if (X < 2) {
                float ss = (a[0] * a[0] + a[1] * a[1]) + (a[2] * a[2] + a[3] * a[3]);
                ss = sum16(ss); ss += __shfl_xor(ss, 16);
                a = a * (fast_rsq(ss + RMS_EPS) * (X == 0 ? 0.08838834764831845f : 1.f));
            }
            if (X == 0) qf[o] = a;
            u32x2 w; w.x = cvtpk(a[0], a[1]); w.y = cvtpk(a[2], a[3]);
            *(u32x2*)(TILE + (4 * q4 + o) * 136 + 4 * sg) = w;
        }
    }
    LBAR();
    if (next_item >= 0) prepass_load_raw(p, next_item, tid, xr);
    {
        const f32x4 eg4 = *(const f32x4*)(EG + 4 * q4);
        bf16* dst = PROJ + (size_t)(R0 + 4 * q4) * PLD + h * A_DK + 32 * (sg >> 3) + 8 * (sg & 3) + 4 * ((sg >> 2) & 1);
#pragma unroll
        for (int o = 0; o < 4; ++o) { u32x2 w; w.x = cvtpk(qf[o][0] * eg4[o], qf[o][1] * eg4[o]); w.y = cvtpk(qf[o][2] * eg4[o], qf[o][3] * eg4[o]); *(u32x2*)(dst + (size_t)o * PLD) = w; }
    }
    if (VAR != 4) {
        const int kind = wave >> 2, ti = (wave >> 1) & 1, tj = wave & 1, l31 = lane & 31, hi = lane >> 5;
        if (wave == 1) {
            if (next_item >= 0) prepass_gcum(p, next_item, lane, (float*)(lds + PP_GC) + (pb ^ 1) * 256, gn, bn);
#pragma unroll
            for (int e = 0; e < 16; ++e) LN[((e & 3) + 8 * (e >> 2) + 4 * hi) * PP_LNP + 32 + l31] = 0.f;
        } else {
            f32x16 acc;
#pragma unroll
            for (int e = 0; e < 16; ++e) acc[e] = 0.f;
            const unsigned char* ap = (const unsigned char*)(kind == 0 ? KN : QN) + (32 * ti + l31) * 272 + 16 * hi;
            const unsigned char* bp = (const unsigned char*)KN + (32 * tj + l31) * 272 + 16 * hi;
            if (ti >= tj) {
#pragma unroll
                for (int ks = 0; ks < 8; ++ks) { const bf16x8 a = *(const bf16x8*)(ap + 32 * ks), b = *(const bf16x8*)(bp + 32 * ks); acc = MFMA32(a, b, acc); }
            }
            const int col = 32 * tj + l31; const float gcc = GC[col];
            f32x4 gr[4], br[4];
#pragma unroll
            for (int q4 = 0; q4 < 4; ++q4) { gr[q4] = *(const f32x4*)(GC + 32 * ti + 8 * q4 + 4 * hi); br[q4] = *(const f32x4*)(BT + 32 * ti + 8 * q4 + 4 * hi); }
#pragma unroll
            for (int e = 0; e < 16; ++e) {
                const int row = 32 * ti + (e & 3) + 8 * (e >> 2) + 4 * hi; const float gcr = gr[e >> 2][e & 3];
                if (kind == 0) LN[row * PP_LNP + col] = row > col ? -(br[e >> 2][e & 3] * acc[e] * fexp(gcr - gcc)) : 0.f;
                else IA[((size_t)item * 64 + row) * 64 + p32(col)] = (bf16)f2bf(row >= col ? acc[e] * fexp(gcr - gcc) : 0.f);
            }
            if (wave == 0 || wave == 3) {
                WAVE_SYNC();
                if (lane < 32) {
                    const int b = (wave == 3 ? 2 : 0) + (lane >> 4), j = lane & 15; float t[16];
#pragma unroll
                    for (int i = 0; i < 16; ++i) {
                        float v = i == j ? 1.f : 0.f;
                        f32x4 lr[4];
#pragma unroll
                        for (int q4 = 0; q4 < (i + 3) / 4; ++q4) lr[q4] = *(const f32x4*)(LN + (16 * b + i) * PP_LNP + 16 * b + 4 * q4);
#pragma unroll
                        for (int k = 0; k < i; ++k) v += lr[k >> 2][k & 3] * t[k];
                        t[i] = v;
                    }
#pragma unroll
                    for (int i = 0; i < 16; ++i) TI[(b * 16 + i) * PP_TIP + j] = t[i];
                }
            } else if (wave >= 4) {
                const int u = tid - 256, m = u & 127, half = u >> 7;
                unsigned char* dst = (unsigned char*)PROJ + ((size_t)(R0 + (m >> 1)) * PLD + A_QK + h * A_DK) * 2 + (m & 1) * 128 + half * 64;
#pragma unroll
                for (int q4 = 0; q4 < 4; ++q4) {
                    u32x4 o;
#pragma unroll
                    for (int e = 0; e < 4; ++e) { const int j = 32 * half + 4 * q4 + 16 * (e >> 1) + 2 * (e & 1); o[e] = cvtpk(bf2f(KN[j * 136 + m]) * KD[j], bf2f(KN[(j + 1) * 136 + m]) * KD[j + 1]); }
                    *(u32x4*)(dst + 16 * q4) = o;
                }
            }
        }
    }
    LBAR();
    bf16* TT = (bf16*)(lds + PP_TT);
    if (VAR != 4 && VAR != 1) {
        if (wave < 4) {
            const int g = lane >> 4, cl = lane & 15, c = wave;
            f32x4 X[4];
#pragma unroll
            for (int b = 0; b < 4; ++b) {
                f32x4 x = (f32x4){0.f, 0.f, 0.f, 0.f};
                if (b == c) {
#pragma unroll
                    for (int e = 0; e < 4; ++e) x[e] = TI[(b * 16 + 4 * g + e) * PP_TIP + cl];
                } else if (b > c) {
                    f32x4 l4[3];
#pragma unroll
                    for (int d = 0; d < b; ++d) l4[d] = *(const f32x4*)(LN + (16 * b + cl) * PP_LNP + 16 * d + 4 * g);
                    const f32x4 ta = *(const f32x4*)(TI + (b * 16 + cl) * PP_TIP + 4 * g);
                    f32x4 y = (f32x4){0.f, 0.f, 0.f, 0.f};
#pragma unroll
                    for (int d = 0; d < b; ++d) if (d >= c) {
#pragma unroll
                        for (int ks = 0; ks < 4; ++ks) y = MFMAF(l4[d][ks], X[d][ks], y); }
#pragma unroll
                    for (int ks = 0; ks < 4; ++ks) x = MFMAF(ta[ks], y[ks], x);
                }
                X[b] = x;
#pragma unroll
                for (int e = 0; e < 4; ++e) TT[(16 * b + 4 * g + e) * 72 + 16 * c + cl] = (bf16)(cvtpk(x[e], 0.f) & 0xffffu);
            }
        }
    }
    LBAR();
    if (VAR != 4 && VAR != 1) {
        const int g = lane >> 4, cl = lane & 15;
        bf16x8 Bv[2], Bk[2];
#pragma unroll
        for (int ks = 0; ks < 2; ++ks) {
            const int rb = 32 * ks + 8 * g;
            const unsigned char* vp = (const unsigned char*)VN + (rb + (cl >> 2)) * 272 + (16 * wave + 4 * (cl & 3)) * 2; const unsigned char* kp = (const unsigned char*)KN + (rb + (cl >> 2)) * 272 + (16 * wave + 4 * (cl & 3)) * 2;
            const s16x4 v0 = LDS_TR16(vp), v1 = LDS_TR16(vp + 4 * 272), k0 = LDS_TR16(kp), k1 = LDS_TR16(kp + 4 * 272);
            const f32x4 b0 = *(const f32x4*)(BT + rb), b1 = *(const f32x4*)(BT + rb + 4), e0 = *(const f32x4*)(EG + rb), e1 = *(const f32x4*)(EG + rb + 4);
            u32x4 ov, ok;
            ov.x = cvtpk(bf2f((bf16)v0[0]) * b0[0], bf2f((bf16)v0[1]) * b0[1]); ov.y = cvtpk(bf2f((bf16)v0[2]) * b0[2], bf2f((bf16)v0[3]) * b0[3]);
            ov.z = cvtpk(bf2f((bf16)v1[0]) * b1[0], bf2f((bf16)v1[1]) * b1[1]); ov.w = cvtpk(bf2f((bf16)v1[2]) * b1[2], bf2f((bf16)v1[3]) * b1[3]);
            ok.x = cvtpk(bf2f((bf16)k0[0]) * (b0[0] * e0[0]), bf2f((bf16)k0[1]) * (b0[1] * e0[1])); ok.y = cvtpk(bf2f((bf16)k0[2]) * (b0[2] * e0[2]), bf2f((bf16)k0[3]) * (b0[3] * e0[3]));
            ok.z = cvtpk(bf2f((bf16)k1[0]) * (b1[0] * e1[0]), bf2f((bf16)k1[1]) * (b1[1] * e1[1])); ok.w = cvtpk(bf2f((bf16)k1[2]) * (b1[2] * e1[2]), bf2f((bf16)k1[3]) * (b1[3] * e1[3]));
            Bv[ks] = __builtin_bit_cast(bf16x8, ov); Bk[ks] = __builtin_bit_cast(bf16x8, ok);
        }
#pragma unroll
        for (int b = 0; b < 4; ++b) {
            f32x4 xu = (f32x4){0.f, 0.f, 0.f, 0.f}, xw = xu;
#pragma unroll
            for (int ks = 0; ks < (b < 2 ? 1 : 2); ++ks) {
                const bf16x8 a = *(const bf16x8*)((const unsigned char*)TT + (16 * b + cl) * 144 + (32 * ks + 8 * g) * 2);
                xu = MFMA16(a, Bv[ks], xu); xw = MFMA16(a, Bk[ks], xw);
            }
            u32x2 o; o.x = cvtpk(xu[0], xu[1]); o.y = cvtpk(xu[2], xu[3]);
            *(u32x2*)((unsigned char*)PROJ + ((size_t)(R0 + wave * 8 + 2 * b + (lane >> 5)) * PLD + 2 * A_QK + h * A_DV) * 2 + (lane & 31) * 8) = o;
#pragma unroll
            for (int e = 0; e < 4; ++e) WST[(16 * b + 4 * g + e) * 136 + p32(16 * wave + cl)] = (bf16)(cvtpk(xw[e], 0.f) & 0xffffu);
        }
    }
    LBAR();
}

__device__ __forceinline__ bf16x8 pack_b(const f32x4 a, const f32x4 b) {
    u32x4 o; o.x = pk2bf(a[0], a[1]); o.y = pk2bf(a[2], a[3]); o.z = pk2bf(b[0], b[1]); o.w = pk2bf(b[2], b[3]); return __builtin_bit_cast(bf16x8, o);
}
constexpr int SC_BUF = 65536, SC_W = 0, SC_QD = 16384, SC_KDT = 32768, SC_IA = 49152, SC_U = 57344;
__device__ __forceinline__ void scan_dma(PrmRef p, int grp, int half, int n, int lw, int lane, unsigned char* buf) {
    const int h = grp % A_HEADS, s = grp / A_HEADS, R0 = s * SEQ + n * CHUNK;
    const BufRes rs = MAKE_RES(p.ws);
    const unsigned sW = (unsigned)(WS_WB + ((size_t)R0 * A_QK + h * A_DK) * 2);
    const unsigned sQ = (unsigned)(WS_PROJ + ((size_t)R0 * PLD + h * A_DK) * 2);
    const unsigned sK = (unsigned)(WS_PROJ + ((size_t)R0 * PLD + A_QK + h * A_DK) * 2);
    const unsigned sU = (unsigned)(WS_PROJ + ((size_t)(R0 + 32 * half) * PLD + 2 * A_QK + h * A_DV) * 2);
    const unsigned sI = (unsigned)(WS_IA + (size_t)(grp * NCPS + n) * 8192);
#pragma unroll
    for (int j = 0; j < 4; ++j) {
        const int ip = lw + 4 * j, sg = ip * 64 + lane;
        { const int row = sg >> 4, pc = (sg & 15) ^ (row & 15);
          BLDS16(rs, (unsigned)row * (unsigned)(A_QK * 2) + (unsigned)pc * 16u, sW, buf + SC_W + ip * 1024);
          BLDS16(rs, (unsigned)row * (unsigned)(PLD * 2) + (unsigned)pc * 16u, sQ, buf + SC_QD + ip * 1024); }
        { const int m = sg >> 3, pc = (sg & 7) ^ ((m >> 1) & 7);
          BLDS16(rs, (unsigned)(m >> 1) * (unsigned)(PLD * 2) + (unsigned)(m & 1) * 128u + (unsigned)pc * 16u, sK, buf + SC_KDT + ip * 1024); }
        if (j < 2) {
          { const int row = sg >> 3, pc = (sg & 7) ^ ((row >> 1) & 7); BLDS16(rs, (unsigned)row * 128u + (unsigned)pc * 16u, sI, buf + SC_IA + ip * 1024); }
          BLDS16(rs, (unsigned)(sg >> 4) * (unsigned)(PLD * 2) + (unsigned)(sg & 15) * 16u, sU, buf + SC_U + ip * 1024);
        }
    }
}
template <int SV = 0> __device__ __forceinline__ void delta_scan_group(PrmRef p, int li, int item, int tid, unsigned char* lds, bool wstate = true) {
    unsigned char* PROJ = (unsigned char*)(p.ws + WS_PROJ); const float* GL = (const float*)(p.ws + WS_GL);
    const int grp = item >> 1, half = item & 1;
    const int h = grp % A_HEADS, s = grp / A_HEADS, lane = tid & 63, wave = READFIRSTLANE(tid >> 6);
    const bool loader = wave >= 4; const int cw = 4 * half + (wave & 3);
    f32x4 S[8];
#pragma unroll
    for (int m = 0; m < 8; ++m) S[m] = (f32x4){0.f, 0.f, 0.f, 0.f};
    unsigned char* fp = PROJ + ((size_t)(s * SEQ + cw * 8 + ((lane & 15) >> 3)) * PLD + 2 * A_QK + h * A_DV) * 2 + (lane & 7) * 32 + (lane >> 4) * 8;
    constexpr size_t TSTEP = (size_t)2 * PLD * 2, CSTEP = (size_t)CHUNK * PLD * 2;
    static_assert(NCPS <= 64, "glast per lane");
    const float glv = GL[grp * NCPS + (lane < NCPS ? lane : 0)];
    if (loader) { if (SV != 1) scan_dma(p, grp, half, 0, wave - 4, lane, lds); }
    WAIT_VM(0); LBAR();
    for (int n = 0; n < NCPS; ++n) {
        unsigned char* buf = lds + (n & 1) * SC_BUF;
        if (loader) {
            if (n + 1 < NCPS) { if (SV != 1) scan_dma(p, grp, half, n + 1, wave - 4, lane, lds + ((n + 1) & 1) * SC_BUF); }
            WAIT_VM(0);
        } else {
        int lane2 = lane;
#ifndef EMU
        asm volatile("" : "+v"(lane2));
#endif
        const int g = lane2 >> 4, cl = lane2 & 15;
        int oW[4], oH[2];
#pragma unroll
        for (int ks = 0; ks < 4; ++ks) oW[ks] = cl * 256 + (((4 * ks + g) ^ cl) << 4);
#pragma unroll
        for (int ks = 0; ks < 2; ++ks) oH[ks] = cl * 128 + (((4 * ks + g) ^ (cl >> 1)) << 4);
        u32x2 uf[4];
#pragma unroll
        for (int t = 0; t < 4; ++t) uf[t] = *(const u32x2*)(buf + SC_U + ((wave & 3) * 8 + 2 * t + (lane2 >> 5)) * 256 + (lane2 & 31) * 8);
        const float glast = BCAST_LANE(glv, n);
        bf16x8 Bs[4];
#pragma unroll
        for (int ks = 0; ks < 4; ++ks) Bs[ks] = pack_b(S[2 * ks], S[2 * ks + 1]);
        bf16x8 fa[4][4];
#pragma unroll
        for (int t = 0; t < 4; ++t)
#pragma unroll
            for (int ks = 0; ks < 4; ++ks) fa[t][ks] = *(const bf16x8*)(buf + SC_W + t * 4096 + oW[ks]);
        SCHED_BARRIER();
        f32x4 vn[4];
#pragma unroll
        for (int t = 0; t < 4; ++t) vn[t] = (f32x4){0.f, 0.f, 0.f, 0.f};
#pragma unroll
        for (int ks = 0; ks < (SV == 3 ? 0 : 4); ++ks)
#pragma unroll
            for (int t = 0; t < 4; ++t) vn[t] = MFMA16(fa[t][ks], Bs[ks], vn[t]);
#pragma unroll
        for (int t = 0; t < 4; ++t) { const f32x4 u = (f32x4){bflo(uf[t].x), bfhi(uf[t].x), bflo(uf[t].y), bfhi(uf[t].y)}; vn[t] = u - vn[t]; }
        SCHED_BARRIER();
        bf16x8 fk[8][2];
#pragma unroll
        for (int m = 0; m < 8; ++m)
#pragma unroll
            for (int ks = 0; ks < 2; ++ks) fk[m][ks] = *(const bf16x8*)(buf + SC_KDT + m * 2048 + oH[ks]);
        SCHED_BARRIER();
        bf16x8 Vb[2];
        Vb[0] = pack_b(vn[0], vn[1]); Vb[1] = pack_b(vn[2], vn[3]);
#pragma unroll
        for (int m = 0; m < 8; ++m) S[m] = S[m] * glast;
#pragma unroll
        for (int ks = 0; ks < 2; ++ks)
#pragma unroll
            for (int m = 0; m < 8; ++m) S[m] = MFMA16(fk[m][ks], Vb[ks], S[m]);
#pragma unroll
        for (int t = 0; t < 4; ++t)
#pragma unroll
            for (int ks = 0; ks < 4; ++ks) fa[t][ks] = *(const bf16x8*)(buf + SC_QD + t * 4096 + oW[ks]);
        bf16x8 fi[4][2];
#pragma unroll
        for (int t = 0; t < 4; ++t)
#pragma unroll
            for (int ks = 0; ks < 2; ++ks) fi[t][ks] = *(const bf16x8*)(buf + SC_IA + t * 2048 + oH[ks]);
        SCHED_BARRIER();
        f32x4 oa[4];
#pragma unroll
        for (int t = 0; t < 4; ++t) oa[t] = (f32x4){0.f, 0.f, 0.f, 0.f};
        if (SV != 2) {
#pragma unroll
        for (int ks = 0; ks < 4; ++ks)
#pragma unroll
            for (int t = 0; t < 4; ++t) oa[t] = MFMA16(Bs[ks], fa[t][ks], oa[t]);
#pragma unroll
        for (int ks = 0; ks < 2; ++ks)
#pragma unroll
            for (int t = 0; t < 4; ++t) oa[t] = MFMA16(Vb[ks], fi[t][ks], oa[t]);
#pragma unroll
        for (int t = 0; t < 4; ++t) {
            u32x2 w; w.x = cvtpk(oa[t][0], oa[t][1]); w.y = cvtpk(oa[t][2], oa[t][3]);
            if (SV == 4) { asm volatile("" :: "v"(w.x), "v"(w.y)); } else
            *(u32x2*)(fp + (size_t)n * CSTEP + t * TSTEP) = w;
        }
        }
        WAIT_VM(12);
        }
        LBAR();
    }
    if (!loader && (wstate || SV != 0)) {
    float* so = SV != 0 ? (float*)(p.ws + WS_XB) + (size_t)grp * A_DK * A_DV : p.out + O_PDELTA + (((size_t)li * BATCH + s) * A_HEADS + h) * A_DK * A_DV;
#pragma unroll
    for (int m = 0; m < 8; ++m)
#pragma unroll
        for (int e = 0; e < 4; ++e) so[(size_t)(16 * m + 4 * (lane >> 4) + e) * A_DV + 16 * cw + (lane & 15)] = S[m][e];
    }
    LBAR();
}
struct NormRaw { u32x4 o0, o1, z0, z1; };
__device__ __forceinline__ void norm_load(PrmRef p, int item, int tid, NormRaw& q) {
    const unsigned char* PROJ = (const unsigned char*)(p.ws + WS_PROJ);
    const int n = item % NCPS, grp = item / NCPS, h = grp % A_HEADS, s = grp / A_HEADS, R0 = s * SEQ + n * CHUNK;
    const int r = tid >> 3, seg = tid & 7;
    const u32x4* op = (const u32x4*)(PROJ + ((size_t)(R0 + 8 * seg + 2 * (r >> 4) + ((r & 15) >> 3)) * PLD + 2 * A_QK + h * A_DV) * 2 + (r & 7) * 32); q.o0 = op[0]; q.o1 = op[1];
    const u32x4* zp = (const u32x4*)(PROJ + ((size_t)(R0 + r) * PLD + CONV_DIM + h * A_DV + 16 * seg) * 2); q.z0 = zp[0]; q.z1 = zp[1];
}
__device__ __forceinline__ void delta_norm_item(PrmRef p, int li, int item, int next_item, int tid, unsigned char* lds, NormRaw& raw, const f32x4 (&nw)[4]) {
    unsigned char* PROJ = (unsigned char*)(p.ws + WS_PROJ);
    const int n = item % NCPS, grp = item / NCPS, h = grp % A_HEADS, s = grp / A_HEADS, R0 = s * SEQ + n * CHUNK;
    const int r = tid >> 3, seg = tid & 7;
    float o[16]; float ss = 0.f;
#pragma unroll
    for (int e = 0; e < 8; ++e) { const unsigned w = e < 4 ? raw.o0[e] : raw.o1[e - 4]; o[2 * e] = bflo(w); o[2 * e + 1] = bfhi(w); ss += o[2 * e] * o[2 * e] + o[2 * e + 1] * o[2 * e + 1]; }
    const float rs = fast_rsq(sum8(ss) * (1.f / A_DV) + RMS_EPS);
    u32x4 w0, w1;
#pragma unroll
    for (int e = 0; e < 8; ++e) { const unsigned zw = e < 4 ? raw.z0[e] : raw.z1[e - 4];
        const unsigned nb = cvtpk(o[2 * e] * rs * nw[e >> 1][2 * (e & 1)], o[2 * e + 1] * rs * nw[e >> 1][2 * (e & 1) + 1]);
        const unsigned g = cvtpk(bflo(nb) * fsilu(bflo(zw)), bfhi(nb) * fsilu(bfhi(zw)));
        if (e < 4) w0[e] = g; else w1[e - 4] = g; }
    if (next_item >= 0) norm_load(p, next_item, tid, raw);
    u32x4* dst = (u32x4*)(PROJ + ((size_t)(R0 + r) * PLD + CONV_DIM + h * A_DV + 16 * seg) * 2); dst[0] = w0; dst[1] = w1;
}
__device__ __forceinline__ void ph_a_norm(PrmRef p, const Ctx& c, int li, unsigned char* lds) {
    NormRaw raw;
    if (c.bid < NPI) norm_load(p, c.bid, c.tid, raw);
    f32x4 nw[4];
#pragma unroll
    for (int q4 = 0; q4 < 4; ++q4) nw[q4] = *(const f32x4*)(p.a_norm_w + (size_t)li * A_DV + 16 * (c.tid & 7) + 4 * q4);
    for (int item = c.bid; item < NPI; item += c.nblk) delta_norm_item(p, li, item, item + c.nblk < NPI ? item + c.nblk : -1, c.tid, lds, raw, nw);
    bf16* PROJ = (bf16*)(p.ws + WS_PROJ);
    sgemm_rows(p, PROJ + 2 * A_QK, PLD, (const bf16*)(p.ws + WS_WAOUT) + (size_t)li * D_MODEL * A_VW, A_VW, PROJ, PLD, PT, ST, D_MODEL, c, NPI, lds);
}
__device__ __forceinline__ void sample_conv(PrmRef p, const Ctx& c, int li) {
    bf16* PROJ = (bf16*)(p.ws + WS_PROJ);
    const float* cw = p.a_conv_w + (size_t)li * CONV_W * CONV_DIM;
    for (int it = c.gtid; it < DEC_BATCH * CONV_DIM; it += c.nthreads) {
        const int ch = it % CONV_DIM, b = it / CONV_DIM;
        const float* sp = p.state_conv + (((size_t)li * DEC_BATCH + b) * 3) * CONV_DIM + ch;
        float h0 = sp[0], h1 = sp[CONV_DIM], h2 = sp[2 * CONV_DIM];
        const float w0 = cw[ch], w1 = cw[CONV_DIM + ch], w2 = cw[2 * CONV_DIM + ch], w3 = cw[3 * CONV_DIM + ch];
        bf16* e0 = PROJ + (size_t)(PT + b * DEC_SEQ) * PLD + ch;
        bf16 xv[DEC_SEQ];
#pragma unroll
        for (int t = 0; t < DEC_SEQ; ++t) xv[t] = e0[(size_t)t * PLD];
#pragma unroll
        for (int t = 0; t < DEC_SEQ; ++t) {
            const float x = bf2f(xv[t]);
            const float y = w0 * h0 + w1 * h1 + w2 * h2 + w3 * x;
            e0[(size_t)t * PLD] = (bf16)(cvtpk(fsilu(y), 0.f) & 0xffffu); h0 = h1; h1 = h2; h2 = x;
        }
        float* so = p.out + O_SCONV + (((size_t)li * DEC_BATCH + b) * 3) * CONV_DIM + ch;
        so[0] = h0; so[CONV_DIM] = h1; so[2 * CONV_DIM] = h2;
    }
}
constexpr int SS2_KQ = 0, SS2_V = 32768, SS2_GE = 49152, SS2_O = 49408;
__device__ __forceinline__ void sample_scan_group(PrmRef p, int li, int sg, int tid, unsigned char* lds, bool wstate = true) {
    bf16* PROJ = (bf16*)(p.ws + WS_PROJ); const float* GB = (const float*)(p.ws + WS_GB);
    float* KQ = (float*)(lds + SS2_KQ); float* V = (float*)(lds + SS2_V); float* GE = (float*)(lds + SS2_GE); float* O = (float*)(lds + SS2_O);
    const int b = sg / A_HEADS, h = sg % A_HEADS, r0 = PT + b * DEC_SEQ, col = tid >> 2, part = tid & 3, lane = tid & 63, wave = tid >> 6;
    __syncthreads();
    float S[32];
    const float* s0 = p.state_delta + (((size_t)li * DEC_BATCH + b) * A_HEADS + h) * A_DK * A_DV;
#pragma unroll
    for (int k = 0; k < 32; ++k) S[k] = s0[(size_t)(part * 32 + k) * A_DV + col];
    {
        float a[8], bb[8];
#pragma unroll
        for (int i = 0; i < 8; ++i) { const int row = wave * 8 + i, t = row >> 1, kind = row & 1; const bf16* e = PROJ + (size_t)(r0 + t) * PLD + (kind == 0 ? A_QK : 0) + h * A_DK + 2 * lane; a[i] = bf2f(e[0]); bb[i] = bf2f(e[1]); }
#pragma unroll
        for (int i = 0; i < 8; ++i) { const int row = wave * 8 + i, kind = row & 1;
            const float sc = (1.f / sqrtf(wave_sum(a[i] * a[i] + bb[i] * bb[i]) + RMS_EPS)) * (kind == 0 ? 1.f : 0.08838834764831845f);
            KQ[row * 128 + 2 * lane] = a[i] * sc; KQ[row * 128 + 2 * lane + 1] = bb[i] * sc; }
#pragma unroll
        for (int i = 0; i < 8; ++i) { const int t = part * 8 + i; V[t * 128 + col] = bf2f(PROJ[(size_t)(r0 + t) * PLD + 2 * A_QK + h * A_DV + col]); }
        if (tid < DEC_SEQ) { GE[2 * tid] = expf(GB[((size_t)(r0 + tid) * A_HEADS + h) * 2]); GE[2 * tid + 1] = GB[((size_t)(r0 + tid) * A_HEADS + h) * 2 + 1]; }
    }
    __syncthreads();
    for (int t = 0; t < DEC_SEQ; ++t) {
        const float eg = GE[2 * t], beta = GE[2 * t + 1], v = V[t * 128 + col];
        const f32x4* kk = (const f32x4*)(KQ + (2 * t) * 128 + part * 32); const f32x4* qq = (const f32x4*)(KQ + (2 * t + 1) * 128 + part * 32);
        float ks = 0.f;
#pragma unroll
        for (int k4 = 0; k4 < 8; ++k4) { const f32x4 kv = kk[k4];
#pragma unroll
            for (int e = 0; e < 4; ++e) { S[4 * k4 + e] *= eg; ks += kv[e] * S[4 * k4 + e]; } }
        ks += __shfl_xor(ks, 1); ks += __shfl_xor(ks, 2);
        const float vn = (v - ks) * beta; float o = 0.f;
#pragma unroll
        for (int k4 = 0; k4 < 8; ++k4) { const f32x4 kv = kk[k4], qv = qq[k4];
#pragma unroll
            for (int e = 0; e < 4; ++e) { S[4 * k4 + e] += kv[e] * vn; o += qv[e] * S[4 * k4 + e]; } }
        o += __shfl_xor(o, 1); o += __shfl_xor(o, 2);
        if (part == 0) O[t * 128 + col] = bf2f((bf16)f2bf(o));
    }
    float* so = p.out + O_SDELTA + (((size_t)li * DEC_BATCH + b) * A_HEADS + h) * A_DK * A_DV;
    if (wstate) {
#pragma unroll
    for (int k = 0; k < 32; ++k) so[(size_t)(part * 32 + k) * A_DV + col] = S[k];
    }
    __syncthreads();
    const float* nw = p.a_norm_w + (size_t)li * A_DV;
#pragma unroll
    for (int i = 0; i < 4; ++i) {
        const int t = wave * 4 + i, row = r0 + t;
        bf16* e = PROJ + (size_t)row * PLD + 2 * A_QK + h * A_DV + 2 * lane; const bf16* z = PROJ + (size_t)row * PLD + CONV_DIM + h * A_DV + 2 * lane;
        const float a = O[t * 128 + 2 * lane], bb = O[t * 128 + 2 * lane + 1];
        const float r = 1.f / sqrtf(wave_sum(a * a + bb * bb) * (1.f / A_DV) + RMS_EPS);
        e[0] = (bf16)f2bf(a * r * nw[2 * lane] * siluf(bf2f(z[0]))); e[1] = (bf16)f2bf(bb * r * nw[2 * lane + 1] * siluf(bf2f(z[1])));
    }
    __syncthreads();
}
template <int VAR = 0> __device__ __forceinline__ void ph_a_pre(PrmRef p, const Ctx& c, int li, unsigned char* lds) {
    RawTile xr;
    if (c.bid < NPI) { prepass_load_raw(p, c.bid, c.tid, xr); if (c.wave == 1) { float g0, b0; prepass_gb_load(p, c.bid, c.lane, g0, b0); prepass_gcum(p, c.bid, c.lane, (float*)(lds + PP_GC), g0, b0); } }
    int prev = -1, pb = 0, cur_h = -1;
    for (int item = c.bid; item < NPI; item += c.nblk) {
        const int h = (item / NCPS) % A_HEADS;
        if (h != cur_h) {
            LBAR();
            for (int i = c.tid; i < 3 * 4 * 128; i += NTHR) { const int X = i / 512, j = (i / 128) & 3, ch = i & 127; ((float*)(lds + PP_CW))[i] = p.a_conv_w[((size_t)li * CONV_W + j) * CONV_DIM + X * A_QK + h * A_DK + ch]; }
            LBAR(); cur_h = h;
        }
        delta_prepass_item<VAR>(p, li, item, item + c.nblk < NPI ? item + c.nblk : -1, prev, pb, c.tid, lds, xr); prev = item; pb ^= 1;
    }
    if (prev >= 0) prepass_store_w(p, prev, c.tid, lds);
    LBAR();
    if (VAR == 0) sample_conv(p, c, li);
}
template <int SV = 0> __device__ __forceinline__ void ph_a_scan2(PrmRef p, const Ctx& c, int li, unsigned char* lds, bool wstate = true, bool do_prompt = true, bool do_sample = true) {
    const int v = (c.bid + c.nblk - ((2 * NPG) % c.nblk)) % c.nblk;
    if (do_sample) for (int sg = v; sg < NSG; sg += c.nblk) sample_scan_group(p, li, sg, c.tid, lds, wstate);
    const int nfree = c.nblk > 2 * NPG ? c.nblk - 2 * NPG : 0;
    const int lane_s = c.lane, wave_s = READFIRSTLANE(c.wave), gw_s = READFIRSTLANE(c.gwave), nw_s = c.nwaves;
    if (SV == 0 && nfree > 0 && v < nfree) { weights_deferred(p, lane_s, wave_s, li, lds, v * (NTHR / 64) + wave_s, nfree * (NTHR / 64)); LBAR(); }
    if (do_prompt) for (int it = c.bid; it < 2 * NPG; it += c.nblk) delta_scan_group<SV>(p, li, it, c.tid, lds, wstate);
    if (SV == 0 && nfree == 0) { weights_deferred(p, lane_s, wave_s, li, lds, gw_s, nw_s); LBAR(); }
}

__device__ __forceinline__ void ph_ln(PrmRef p, const Ctx& c, const bf16* OUT, int ldo, const float* g, const float* b, bool last) {
    bf16* XB = (bf16*)(p.ws + WS_XB);
    constexpr int PER = D_MODEL / 64;
    constexpr int RB = 3;
    static_assert(PER % 8 == 0, "ln vector width");
    const int col0 = c.lane * PER;
    f32x4 gv[PER / 4], bv[PER / 4];
#pragma unroll
    for (int j = 0; j < PER / 4; ++j) { gv[j] = *(const f32x4*)(g + col0 + 4 * j); bv[j] = *(const f32x4*)(b + col0 + 4 * j); }
    for (int row0 = c.gwave; row0 < MT; row0 += RB * c.nwaves) {
        u32x4 xa[RB][PER / 8], oa[RB][PER / 8];
#pragma unroll
        for (int r = 0; r < RB; ++r) { const int row = row0 + r * c.nwaves;
            if (row < MT) {
#pragma unroll
                for (int j = 0; j < PER / 8; ++j) { xa[r][j] = *(const u32x4*)(XB + (size_t)row * D_MODEL + col0 + 8 * j); oa[r][j] = *(const u32x4*)(OUT + (size_t)row * ldo + col0 + 8 * j); } } }
#pragma unroll
        for (int r = 0; r < RB; ++r) { const int row = row0 + r * c.nwaves;
            if (row < MT) {
                float v[PER]; float s = 0.f;
#pragma unroll
                for (int j = 0; j < PER / 8; ++j)
#pragma unroll
                    for (int e = 0; e < 4; ++e) { v[8 * j + 2 * e] = DN_ALPHA * bflo(xa[r][j][e]) + bflo(oa[r][j][e]); v[8 * j + 2 * e + 1] = DN_ALPHA * bfhi(xa[r][j][e]) + bfhi(oa[r][j][e]); }
#pragma unroll
                for (int j = 0; j < PER; ++j) s += v[j];
                const float mean = wave_sum(s) * (1.f / D_MODEL); float q = 0.f;
#pragma unroll
                for (int j = 0; j < PER; ++j) { v[j] -= mean; q += v[j] * v[j]; }
                const float rstd = fast_rsq(wave_sum(q) * (1.f / D_MODEL) + LN_EPS);
#pragma unroll
                for (int j = 0; j < PER; ++j) v[j] = v[j] * rstd * gv[j >> 2][j & 3] + bv[j >> 2][j & 3];
                if (!last) {
#pragma unroll
                for (int j = 0; j < PER / 8; ++j) { u32x4 o;
#pragma unroll
                    for (int e = 0; e < 4; ++e) o[e] = cvtpk(v[8 * j + 2 * e], v[8 * j + 2 * e + 1]);
                    *(u32x4*)(XB + (size_t)row * D_MODEL + col0 + 8 * j) = o; }
                }
                if (last) { float* yo = row < PT ? p.out + O_YP + (size_t)row * D_MODEL + col0 : p.out + O_YS + (size_t)(row - PT) * D_MODEL + col0;
#pragma unroll
                    for (int j = 0; j < PER; j += 4) *(f32x4*)(yo + j) = (f32x4){v[j], v[j + 1], v[j + 2], v[j + 3]}; }
            } }
    }
}
__device__ __forceinline__ float fast_exp2(float x) {
#ifdef EMU
    return exp2f(x);
#else
    return __builtin_amdgcn_exp2f(x);
#endif
}
__device__ __forceinline__ void b_cache_copies(PrmRef p, int gt, int nt) {
    bf16* CK = (bf16*)(p.ws + WS_CK); bf16* CVT = (bf16*)(p.ws + WS_CVT);
    constexpr int NE = DEC_BATCH * WINDOW * B_KVW;
    for (int it0 = gt; it0 < NE; it0 += 4 * nt) {
        float kx[4], vx[4];
#pragma unroll
        for (int u = 0; u < 4; ++u) { const int it = it0 + u * nt; if (it < NE) { kx[u] = p.cache_k[it]; vx[u] = p.cache_v[it]; } }
#pragma unroll
        for (int u = 0; u < 4; ++u) { const int it = it0 + u * nt;
            if (it < NE) { const int dd = it % B_KVW, w = (it / B_KVW) % WINDOW, b = it / (B_KVW * WINDOW), kvh = dd / B_HD, d = dd % B_HD;
                CK[(((size_t)b * B_KV_HEADS + kvh) * WINDOW + w) * B_HD + d] = (bf16)f2bf(kx[u]);
                CVT[(((size_t)b * B_KV_HEADS + kvh) * B_HD + d) * WINDOW + w] = (bf16)f2bf(vx[u]); } }
    }
}
__device__ __forceinline__ void ph_b_gemm(PrmRef p, const Ctx& c, int lj, unsigned char* lds) {
    const bf16* XB = (const bf16*)(p.ws + WS_XB); bf16* PROJ = (bf16*)(p.ws + WS_PROJ); const bf16* Wt = (const bf16*)(p.ws + WS_WBIN) + (size_t)lj * B_N0 * D_MODEL;
    const int N = lj == 0 ? B_N0 : B_IN;
    pg8::Gemm g{XB, D_MODEL, Wt, PT, N, D_MODEL}; pg8::StaticOrder S; S.init(PT, N, c.nblk, c.bid);
    static_assert(SEQ % pg8::BM == 0 && pg8::STAGE_BYTES + pg8::BM * ROPE_HALF * 2 * 4 <= 163840 - 64, "rope slice");
    pg8::Unit u0; const bool have = S.next(0, u0); const int pm0 = have ? u0.pm : -1;
    float* ropeL = (float*)(lds + pg8::STAGE_BYTES);
    __syncthreads();
    if (have) { const float* src = (const float*)(p.ws + WS_ROPE) + (size_t)((pm0 * pg8::BM) % SEQ) * ROPE_HALF * 2;
        for (int i = c.tid; i < pg8::BM * ROPE_HALF * 2 / 4; i += NTHR) ((f32x4*)ropeL)[i] = ((const f32x4*)src)[i]; }
    pg8::EpiBIn E{PROJ, PLD, (const float*)(p.ws + WS_ROPE), (bf16*)(p.ws + WS_VT), (LAS const float*)ropeL, pm0};
    __syncthreads();
    pg8::gemm_phase<pg8::EpiBIn, pg8::StaticOrder, true>((LAS unsigned char*)lds, g, S, E, c.tid);
    __syncthreads();
    sgemm_rows<2>(p, XB, D_MODEL, Wt, D_MODEL, PROJ, PLD, PT, ST, N, c, lj == 0 ? (PT / 256) * (B_N0 / 256) : 0, lds, true);
    if (lj == 0) {
        const int f = ((PT / 256) * (B_N0 / 256)) % c.nblk;
        if (f == 0) b_cache_copies(p, c.gtid, c.nthreads); else if (c.bid >= f) b_cache_copies(p, (c.bid - f) * NTHR + c.tid, (c.nblk - f) * NTHR);
    }
}
constexpr int AT_KPITCH = 144, AT_VPITCH = 400, AT_K = 0, AT_V = 192 * AT_KPITCH, AT_O = AT_V + 64 * AT_VPITCH + 64  , AT_OPITCH = 144;
static_assert(2 * SC_BUF <= 163840 - 64, "scan LDS");
static_assert(AT_O % 16 == 0 && AT_O + 256 * AT_OPITCH <= 131072, "attention LDS");
struct AttRaw { u32x4 k[3], v[3]; bf16x8 q[4]; float sink; };
__device__ __forceinline__ void att_load(PrmRef p, int lj, int ck, int kvh, int tid, AttRaw& raw) {
    const unsigned char* PROJ = (const unsigned char*)(p.ws + WS_PROJ); const unsigned char* VT = (const unsigned char*)(p.ws + WS_VT);
    const unsigned char* CK = (const unsigned char*)(p.ws + WS_CK); const unsigned char* CVT = (const unsigned char*)(p.ws + WS_CVT);
    const int lane = tid & 63, wave = tid >> 6, l31 = lane & 31, hi = lane >> 5;
    const bool smp = ck >= NCP; const int r0 = chunk_row0(ck);
    const int nc = smp ? 0 : ck % NCPS, nblk = smp ? 0 : (nc >= 2 ? 3 : nc + 1);
    if (!smp) {
        const int kfirst = r0 - (nblk - 1) * CHUNK;
#pragma unroll
        for (int j = 0; j < 3; ++j) if (j < nblk) { const int idx = tid + NTHR * j, key = idx >> 3, pc = idx & 7, d = (idx >> 3) & 63;
            raw.k[j] = *(const u32x4*)(PROJ + ((size_t)(kfirst + key) * PLD + B_IN + kvh * B_HD) * 2 + pc * 16);
            raw.v[j] = *(const u32x4*)(VT + ((((size_t)(ck - (nblk - 1) + j) * B_KV_HEADS + kvh) * B_HD + d) * 64) * 2 + pc * 16); }
    } else {
        const int b = ck - NCP;
#pragma unroll
        for (int j = 0; j < 3; ++j) { const int idx = tid + NTHR * j;
            if (idx < 160 * 8) { const int key = idx >> 3, pc = idx & 7;
                raw.k[j] = *(const u32x4*)(key < WINDOW ? CK + ((((size_t)b * B_KV_HEADS + kvh) * WINDOW + key) * B_HD) * 2 + pc * 16 : PROJ + ((size_t)(r0 + key - WINDOW) * PLD + B_IN + kvh * B_HD) * 2 + pc * 16); }
            if (idx < 64 * 20) { const int d = idx / 20, pc = idx % 20;
                raw.v[j] = *(const u32x4*)(pc < 16 ? CVT + ((((size_t)b * B_KV_HEADS + kvh) * B_HD + d) * WINDOW) * 2 + pc * 16 : VT + ((((size_t)ck * B_KV_HEADS + kvh) * B_HD + d) * 64) * 2 + (pc - 16) * 16); } }
    }
    const bool active = smp ? wave < 4 : true;
    const int hq = kvh * B_GROUP + (smp ? wave : (wave >> 1)), qrow0 = smp ? 0 : 32 * (wave & 1);
    raw.sink = active ? p.b_sinks[lj * B_Q_HEADS + hq] : 0.f;
    if (active) {
#pragma unroll
        for (int ks = 0; ks < 4; ++ks) raw.q[ks] = *(const bf16x8*)(PROJ + ((size_t)(r0 + qrow0 + l31) * PLD + hq * B_HD + 16 * ks + 8 * hi) * 2);
    }
}
__device__ __forceinline__ void att_item(PrmRef p, int lj, int ck, int kvh, int nck, int nkvh, int tid, unsigned char* lds, AttRaw& raw) {
#ifndef EMU
    asm volatile("" : "+v"(tid));
#endif
    unsigned char* PROJ = (unsigned char*)(p.ws + WS_PROJ);
    const int lane = tid & 63, wave = READFIRSTLANE(tid >> 6), l31 = lane & 31, hi = lane >> 5;
    const bool smp = ck >= NCP; const int r0 = chunk_row0(ck);
    const int nc = smp ? 0 : ck % NCPS, nblk = smp ? 0 : (nc >= 2 ? 3 : nc + 1);
    const int nkt = smp ? 5 : 2 * nblk;
    if (!smp) {
#pragma unroll
        for (int j = 0; j < 3; ++j) if (j < nblk) { const int idx = tid + NTHR * j, key = idx >> 3, pc = idx & 7, d = (idx >> 3) & 63;
            *(u32x4*)(lds + AT_K + key * AT_KPITCH + pc * 16) = raw.k[j];
            unsigned char* dst = lds + AT_V + d * AT_VPITCH + j * 128 + (pc >> 1) * 32 + (pc & 1) * 8; *(u32x2*)dst = (u32x2){raw.v[j].x, raw.v[j].y}; *(u32x2*)(dst + 16) = (u32x2){raw.v[j].z, raw.v[j].w}; }
    } else {
#pragma unroll
        for (int j = 0; j < 3; ++j) { const int idx = tid + NTHR * j;
            if (idx < 160 * 8) { const int key = idx >> 3, pc = idx & 7; *(u32x4*)(lds + AT_K + key * AT_KPITCH + pc * 16) = raw.k[j]; }
            if (idx < 64 * 20) { const int d = idx / 20, pc = idx % 20; unsigned char* dst = lds + AT_V + d * AT_VPITCH + (pc >> 1) * 32 + (pc & 1) * 8; *(u32x2*)dst = (u32x2){raw.v[j].x, raw.v[j].y}; *(u32x2*)(dst + 16) = (u32x2){raw.v[j].z, raw.v[j].w}; } }
    }
    const bool active = smp ? wave < 4 : true;
    const int hq = kvh * B_GROUP + (smp ? wave : (wave >> 1));
    bf16x8 qf[4];
#pragma unroll
    for (int ks = 0; ks < 4; ++ks) qf[ks] = raw.q[ks];
    const float sink = raw.sink;
    LBAR();
    if (nck >= 0) att_load(p, lj, nck, nkvh, tid, raw);
    const int nrows = smp ? 128 : 256;
    u32x4 zr[4];
    if (active) {
        f32x16 sc[6];
        bf16x8 kf[2][4];
#pragma unroll
        for (int ks = 0; ks < 4; ++ks) kf[0][ks] = *(const bf16x8*)(lds + AT_K + l31 * AT_KPITCH + 32 * ks + 16 * hi);
#pragma unroll
        for (int kt = 0; kt < 6; ++kt) {
            if (kt + 1 < 6 && kt + 1 < nkt) {
#pragma unroll
                for (int ks = 0; ks < 4; ++ks) kf[(kt + 1) & 1][ks] = *(const bf16x8*)(lds + AT_K + (32 * (kt + 1) + l31) * AT_KPITCH + 32 * ks + 16 * hi);
            }
#pragma unroll
            for (int e = 0; e < 16; ++e) sc[kt][e] = 0.f;
            if (kt < nkt) {
#pragma unroll
                for (int ks = 0; ks < 4; ++ks) sc[kt] = MFMA32(kf[kt & 1][ks], qf[ks], sc[kt]);
            }
        }
        float m = sink;
#pragma unroll
        for (int kt = 0; kt < 6; ++kt) if (kt < nkt) {
#pragma unroll
            for (int e = 0; e < 16; ++e) m = fmaxf(m, sc[kt][e]); }
        m = fmaxf(m, __shfl_xor(m, 32));
        float l = 0.f; const float ml2 = m * 1.4426950408889634f;
#pragma unroll
        for (int kt = 0; kt < 6; ++kt) if (kt < nkt) {
#pragma unroll
            for (int e = 0; e < 16; ++e) { const float pe = fast_exp2(sc[kt][e] * 1.4426950408889634f - ml2); sc[kt][e] = pe; l += pe; } }
        l += __shfl_xor(l, 32);
        l += fast_exp2(sink * 1.4426950408889634f - ml2);
        f32x16 o[2];
#pragma unroll
        for (int e = 0; e < 16; ++e) { o[0][e] = 0.f; o[1][e] = 0.f; }
        bf16x8 vf[2][4];
#pragma unroll
        for (int i = 0; i < 4; ++i) vf[0][i] = *(const bf16x8*)(lds + AT_V + (32 * (i & 1) + l31) * AT_VPITCH + (16 * (i >> 1)) * 2 + 16 * hi);
#pragma unroll
        for (int kt = 0; kt < 6; ++kt) if (kt < nkt) {
            if (kt + 1 < 6 && kt + 1 < nkt) {
#pragma unroll
                for (int i = 0; i < 4; ++i) vf[(kt + 1) & 1][i] = *(const bf16x8*)(lds + AT_V + (32 * (i & 1) + l31) * AT_VPITCH + (32 * (kt + 1) + 16 * (i >> 1)) * 2 + 16 * hi);
            }
#pragma unroll
            for (int s = 0; s < 2; ++s) {
                u32x4 pw; pw.x = cvtpk(sc[kt][8 * s], sc[kt][8 * s + 1]); pw.y = cvtpk(sc[kt][8 * s + 2], sc[kt][8 * s + 3]); pw.z = cvtpk(sc[kt][8 * s + 4], sc[kt][8 * s + 5]); pw.w = cvtpk(sc[kt][8 * s + 6], sc[kt][8 * s + 7]);
                const bf16x8 pb = __builtin_bit_cast(bf16x8, pw);
#pragma unroll
                for (int mt = 0; mt < 2; ++mt) {
                    o[mt] = MFMA32(vf[kt & 1][2 * s + mt], pb, o[mt]);
                }
            }
        }
        const float il = fast_rcp(l);
        unsigned char* orow = lds + AT_O + (32 * wave + l31) * AT_OPITCH;
#pragma unroll
        for (int mt = 0; mt < 2; ++mt)
#pragma unroll
            for (int cg4 = 0; cg4 < 4; ++cg4) {
                u32x2 w2; w2.x = cvtpk(o[mt][4 * cg4] * il, o[mt][4 * cg4 + 1] * il); w2.y = cvtpk(o[mt][4 * cg4 + 2] * il, o[mt][4 * cg4 + 3] * il);
                *(u32x2*)(orow + (32 * mt + 8 * cg4 + 4 * hi) * 2) = w2;
            }
    }
#pragma unroll
    for (int i = 0; i < 4; ++i) { const int idx = tid + NTHR * i;
        if (idx < nrows * 8) { const int qr = idx >> 3, pc = idx & 7, w = qr >> 5, hq2 = kvh * B_GROUP + (smp ? w : (w >> 1)), row = r0 + (smp ? 0 : 32 * (w & 1)) + (qr & 31);
            zr[i] = *(const u32x4*)(PROJ + ((size_t)row * PLD + B_QW + hq2 * B_HD) * 2 + pc * 16); } }
    LBAR();
#pragma unroll
    for (int i = 0; i < 4; ++i) { const int idx = tid + NTHR * i;
        if (idx < nrows * 8) { const int qr = idx >> 3, pc = idx & 7, w = qr >> 5, hq2 = kvh * B_GROUP + (smp ? w : (w >> 1)), row = r0 + (smp ? 0 : 32 * (w & 1)) + (qr & 31);
            const u32x4 ov = *(const u32x4*)(lds + AT_O + qr * AT_OPITCH + pc * 16); const u32x4 zv = zr[i];
            u32x4 r;
#pragma unroll
            for (int e = 0; e < 4; ++e) r[e] = cvtpk(bflo(ov[e]) * fsilu(bflo(zv[e])), bfhi(ov[e]) * fsilu(bfhi(zv[e])));
            *(u32x4*)(PROJ + ((size_t)row * PLD + hq2 * B_HD) * 2 + pc * 16) = r; } }
    LBAR();
}
__device__ __forceinline__ void ph_b_att2(PrmRef p, const Ctx& c, int lj, bool first, unsigned char* lds) {
    AttRaw raw;
    if (c.bid < NCH * B_KV_HEADS) att_load(p, lj, c.bid / B_KV_HEADS, c.bid % B_KV_HEADS, c.tid, raw);
    for (int it = c.bid; it < NCH * B_KV_HEADS; it += c.nblk) { const int nx = it + c.nblk < NCH * B_KV_HEADS ? it + c.nblk : -1;
        att_item(p, lj, it / B_KV_HEADS, it % B_KV_HEADS, nx < 0 ? -1 : nx / B_KV_HEADS, nx < 0 ? 0 : nx % B_KV_HEADS, c.tid, lds, raw); }
    if (first) {
        const bf16* PROJ = (const bf16*)(p.ws + WS_PROJ);
        constexpr int NE = (BATCH + DEC_BATCH) * WINDOW * B_KVW;
        const int extra = (NCH * B_KV_HEADS) % c.nblk;
        const int gt = extra == 0 ? c.gtid : (c.bid - extra) * NTHR + c.tid, nt = extra == 0 ? c.nthreads : (c.nblk - extra) * NTHR;
        if (extra == 0 || c.bid >= extra) {
            for (int it0 = gt; it0 < NE; it0 += 4 * nt) {
                float kx[4], vx[4];
#pragma unroll
                for (int u = 0; u < 4; ++u) { const int it = it0 + u * nt;
                    if (it < NE) { const int e = it % B_KVW, w = (it / B_KVW) % WINDOW, s = it / (B_KVW * WINDOW);
                        if (s < BATCH) { const int row = s * SEQ + SEQ - WINDOW + w; const bf16* kp = PROJ + (size_t)row * PLD + B_IN; kx[u] = bf2f(kp[e]); vx[u] = bf2f(kp[B_KVW + e]); }
                        else { const int b = s - BATCH;
                            if (w < WINDOW - DEC_SEQ) { kx[u] = p.cache_k[((size_t)b * WINDOW + w + DEC_SEQ) * B_KVW + e]; vx[u] = p.cache_v[((size_t)b * WINDOW + w + DEC_SEQ) * B_KVW + e]; }
                            else { const int row = PT + b * DEC_SEQ + (w - (WINDOW - DEC_SEQ)); const bf16* kp = PROJ + (size_t)row * PLD + B_IN; kx[u] = bf2f(kp[e]); vx[u] = bf2f(kp[B_KVW + e]); } } } }
#pragma unroll
                for (int u = 0; u < 4; ++u) { const int it = it0 + u * nt;
                    if (it < NE) { const int e = it % B_KVW, w = (it / B_KVW) % WINDOW, s = it / (B_KVW * WINDOW);
                        if (s < BATCH) { p.out[O_PK + ((size_t)s * WINDOW + w) * B_KVW + e] = kx[u]; p.out[O_PV + ((size_t)s * WINDOW + w) * B_KVW + e] = vx[u]; }
                        else { const int b = s - BATCH; p.out[O_SK + ((size_t)b * WINDOW + w) * B_KVW + e] = kx[u]; p.out[O_SV + ((size_t)b * WINDOW + w) * B_KVW + e] = vx[u]; } } }
            }
        }
    }
}

#ifndef EMU
#define XB_TMO      128
#define XB_XCNT(j)  (256  + 64 * (j))
#define XB_XSUB(j)  (1280 + 64 * (j))
#define XB_XGEN(j)  (2304 + 64 * (j))
#define XB_TOP      3328
#define XB_TOPGEN   3392
#define XCD_BAR_WORDS 3456
#define XB_SPIN_CAP (1u << 20)
__device__ __forceinline__ unsigned xb_ld(unsigned* p)              { return __hip_atomic_load(p, __ATOMIC_RELAXED, __HIP_MEMORY_SCOPE_AGENT); }
__device__ __forceinline__ unsigned xb_add(unsigned* p, unsigned v) { return __hip_atomic_fetch_add(p, v, __ATOMIC_RELAXED, __HIP_MEMORY_SCOPE_AGENT); }
__device__ __forceinline__ unsigned xb_xcc_id() { return (unsigned)__builtin_amdgcn_s_getreg((3 << 11) | 20) & 0xFu; }
#define XB_SPIN(cond, bar) do { unsigned _sp = 0; while (cond) { __builtin_amdgcn_s_sleep(1); \
    if ((++_sp & 255u) == 0u) { if (xb_ld(&(bar)[XB_TMO])) break; if (_sp > XB_SPIN_CAP) { atomicAdd(&(bar)[XB_TMO], 1u); break; } } } } while (0)
__device__ __forceinline__ void xcd_barrier_complete(unsigned* bar, unsigned x, unsigned& nloc, unsigned& nx) {
    const unsigned G = gridDim.x * gridDim.y * gridDim.z;
    unsigned sum, cnt, mine, sp = 0u;
    for (;;) {
        sum = 0u; cnt = 0u; mine = 0u;
#pragma unroll
        for (unsigned j = 0; j < 16; ++j) { const unsigned c = xb_ld(&bar[XB_XCNT(j)]); sum += c; cnt += (c > 0u) ? 1u : 0u; mine = (j == x) ? c : mine; }
        if (sum == G) break;
        __builtin_amdgcn_s_sleep(1);
        if ((++sp & 255u) == 0u) { if (xb_ld(&bar[XB_TMO])) break; if (sp > XB_SPIN_CAP) { atomicAdd(&bar[XB_TMO], 1u); break; } }
    }
    nloc = mine > 0u ? mine : 1u; nx = cnt > 0u ? cnt : 1u;
}
__device__ __forceinline__ void xcd_barrier(unsigned* bar, volatile LAS unsigned* st, const int tid) {
    asm volatile("s_waitcnt vmcnt(0)" ::: "memory");
    __syncthreads();
    if (tid == 0) {
        __builtin_amdgcn_s_waitcnt(0);
        const unsigned x = xb_xcc_id();
        unsigned nloc = st[0], nx = st[1];
        if (nloc == 0u) { xcd_barrier_complete(bar, x, nloc, nx); st[0] = nloc; st[1] = nx; }
        const unsigned old = xb_add(&bar[XB_XSUB(x)], 1u);
        const unsigned gen = old / nloc;
        if (old + 1u == (gen + 1u) * nloc) {
            __builtin_amdgcn_fence(__ATOMIC_RELEASE, "agent");
            asm volatile("s_waitcnt vmcnt(0)" ::: "memory");
            const unsigned og = xb_add(&bar[XB_TOP], 1u);
            const unsigned tg = og / nx;
            if (og + 1u == (tg + 1u) * nx) xb_add(&bar[XB_TOPGEN], 1u);
            else XB_SPIN(xb_ld(&bar[XB_TOPGEN]) == tg, bar);
            __builtin_amdgcn_fence(__ATOMIC_ACQUIRE, "agent");
            xb_add(&bar[XB_XGEN(x)], 1u);
            asm volatile("s_waitcnt vmcnt(0)" ::: "memory");
        } else {
            XB_SPIN(xb_ld(&bar[XB_XGEN(x)]) == gen, bar);
            __builtin_amdgcn_fence(__ATOMIC_ACQUIRE, "agent");
            asm volatile("s_waitcnt vmcnt(0)" ::: "memory");
        }
    }
    __syncthreads();
}
#endif
constexpr int PH_A0 = 1, PH_APER = 6, PH_B0 = PH_A0 + N_A * PH_APER, PH_BPER = 4, N_PHASES = PH_B0 + N_B * PH_BPER;
constexpr int LDS_BAR_OFF = 163840 - 64;
constexpr int LDS_BYTES = 163840;
#ifdef EMU
#define DECL_LDS(name) unsigned char* name = emu::blk()->lds
#else
#define DECL_LDS(name) extern __shared__ __attribute__((aligned(16))) unsigned char name[]
#endif

#ifdef EMU
#define PH_PROLOGUE() PrmRef p = p_; int tid_ = threadIdx.x, bid_ = blockIdx.x;
#define GRID_SYNC()
#else
#define PH_PROLOGUE() const __attribute__((address_space(4))) Prm* pp = (const __attribute__((address_space(4))) Prm*)__builtin_amdgcn_kernarg_segment_ptr(); \
    int tid_ = wave_s_ * 64 + (int)__builtin_amdgcn_mbcnt_hi(~0u, __builtin_amdgcn_mbcnt_lo(~0u, 0u)), bid_ = blockIdx.x; asm volatile("" : "+s"(pp), "+v"(tid_), "+s"(bid_)); PrmRef p = *pp;
#define GRID_SYNC() xcd_barrier((unsigned*)(p.ws + WS_CTL), (volatile LAS unsigned*)(lds + LDS_BAR_OFF), c.tid)
#endif
#define PHASE(k, ...) if (ph_lo <= (k) && (k) < ph_hi) { PH_PROLOGUE() \
        Ctx c; c.tid = tid_; c.lane = c.tid & 63; c.wave = c.tid >> 6; c.bid = bid_; c.nblk = gridDim.x; \
        c.gtid = c.bid * NTHR + c.tid; c.nthreads = c.nblk * NTHR; c.gwave = c.bid * (NTHR / 64) + c.wave; c.nwaves = c.nblk * (NTHR / 64); \
        bf16* PROJ = (bf16*)(p.ws + WS_PROJ); const bf16* XB = (const bf16*)(p.ws + WS_XB); (void)PROJ; (void)XB; \
        __VA_ARGS__; \
        if ((k) + 1 < ph_hi) { GRID_SYNC(); } }
#define A_LAYER(li) \
    PHASE(PH_A0 + (li) * PH_APER + 0, ph_a_gemm(p, c, li, lds)) \
    PHASE(PH_A0 + (li) * PH_APER + 1, ph_a_pre(p, c, li, lds)) \
    PHASE(PH_A0 + (li) * PH_APER + 2, ph_a_scan2(p, c, li, lds)) \
    PHASE(PH_A0 + (li) * PH_APER + 3, ph_a_norm(p, c, li, lds)) \
    PHASE(PH_A0 + (li) * PH_APER + 4, gemm_mfma(PROJ + CONV_DIM, PLD, (const bf16*)(p.ws + WS_WAOUT) + (size_t)(li) * D_MODEL * A_VW, PROJ, PLD, PT, D_MODEL, A_VW, c, lds)) \
    PHASE(PH_A0 + (li) * PH_APER + 5, ph_ln(p, c, PROJ, PLD, p.a_ln_g + (size_t)(li) * D_MODEL, p.a_ln_b + (size_t)(li) * D_MODEL, false))
#define B_LAYER(lj) \
    PHASE(PH_B0 + (lj) * PH_BPER + 0, ph_b_gemm(p, c, lj, lds)) \
    PHASE(PH_B0 + (lj) * PH_BPER + 1, ph_b_att2(p, c, lj, (lj) == 0, lds)) \
    PHASE(PH_B0 + (lj) * PH_BPER + 2, gemm_mfma(PROJ, PLD, (const bf16*)(p.ws + WS_WBOUT) + (size_t)(lj) * D_MODEL * B_QW, PROJ + B_QW, PLD, PT, D_MODEL, B_QW, c, lds); \
        sgemm_rows(p, PROJ, PLD, (const bf16*)(p.ws + WS_WBOUT) + (size_t)(lj) * D_MODEL * B_QW, B_QW, PROJ + B_QW, PLD, PT, ST, D_MODEL, c, 0, lds)) \
    PHASE(PH_B0 + (lj) * PH_BPER + 3, ph_ln(p, c, PROJ + B_QW, PLD, p.b_ln_g + (size_t)(lj) * D_MODEL, p.b_ln_b + (size_t)(lj) * D_MODEL, (lj) == N_B - 1))

__global__ void __launch_bounds__(NTHR, 2) fwd_kernel(Prm p_, int ph_lo, int ph_hi) {
    DECL_LDS(lds);
#ifndef EMU
    const int wave_s_ = __builtin_amdgcn_readfirstlane((int)threadIdx.x >> 6);
    {
        if (threadIdx.x < 2) ((volatile LAS unsigned*)(lds + LDS_BAR_OFF))[threadIdx.x] = 0u;
        if (threadIdx.x == 0) (void)xb_add((unsigned*)(p_.ws + WS_CTL) + XB_XCNT(xb_xcc_id()), 1u);
        __syncthreads();
    }
#endif
    PHASE(0, ph_init(p, c); ph_weights(p, c, lds))
    A_LAYER(0)
    A_LAYER(1)
    B_LAYER(0)
    B_LAYER(1)
#ifdef PROBE_TAIL
    PROBE_TAIL
#endif
}

extern "C" void kernel_launch(void* const* d_in, const int* in_sizes, int n_in, void* d_out, int out_size, void* d_ws, size_t ws_size, hipStream_t stream) {
    if (n_in != 20 || (size_t)out_size != O_END || ws_size < WS_NEED) { fprintf(stderr, "kernel_launch: unexpected sizes n_in=%d out=%d ws=%zu (need %zu, out %zu)\n", n_in, out_size, ws_size, (size_t)WS_END, (size_t)O_END); return; }
    Prm p{};
    const float** pp = (const float**)&p;
    for (int i = 0; i < 20; ++i) pp[i] = (const float*)d_in[i];
    p.out = (float*)d_out; p.ws = (unsigned char*)d_ws;
#ifdef EMU
    const int grid = 8;
    const int stop = getenv("EMU_STOP") ? atoi(getenv("EMU_STOP")) : N_PHASES;
    for (int ph = 0; ph < N_PHASES && ph < stop; ++ph) { emu::launch([=]() { fwd_kernel(p, ph, ph + 1); }, dim3(grid), dim3(NTHR), LDS_BYTES); fprintf(stderr, "phase %d done\n", ph); }
#else
    static int grid = 0;
    if (grid == 0) {
        int dev = 0, cus = 0, per_cu = 0;
        (void)hipGetDevice(&dev); (void)hipDeviceGetAttribute(&cus, hipDeviceAttributeMultiprocessorCount, dev);
        (void)hipFuncSetAttribute((const void*)fwd_kernel, hipFuncAttributeMaxDynamicSharedMemorySize, LDS_BYTES);
        (void)hipOccupancyMaxActiveBlocksPerMultiprocessor(&per_cu, (const void*)fwd_kernel, NTHR, LDS_BYTES);
        if (per_cu < 1) { fprintf(stderr, "kernel_launch: occupancy query says %d blocks per CU\n", per_cu); per_cu = 1; }
        grid = cus;
    }
    (void)hipMemsetAsync((char*)d_ws + WS_CTL, 0, 65536, stream);
#ifdef PROBE_TAIL
    int lo = 0, hi = N_PHASES + PROBE_NTAIL;
#else
    int lo = 0, hi = N_PHASES;
#endif
    void* args[] = {(void*)&p, (void*)&lo, (void*)&hi};
    hipError_t e = hipLaunchCooperativeKernel((const void*)fwd_kernel, dim3(grid), dim3(NTHR), args, LDS_BYTES, stream);
    if (e != hipSuccess) fprintf(stderr, "cooperative launch failed: %s (grid %d)\n", hipGetErrorString(e), grid);
#endif
}
```
